# Optimizing an MI355X kernel written in HIP

```python
import math
import jax, jax.numpy as jnp
from jax import lax
import numpy as np

D_MODEL = 1024
BATCH = 4
SEQ = 8192
DEPTH = 2

CHUNK = 64
EPS = 1e-6
NEG = -1e30

A_HEADS = 4
A_DH = 128
A_WIDTH = A_HEADS * A_DH
CONV_W = 4
GATE_CAP = 15.0

B_HEADS = 8
B_DH = 64
B_WIDTH = B_HEADS * B_DH
B_LEFT_CHUNKS = 8
B_BAND = (B_LEFT_CHUNKS + 1) * CHUNK
B_MAX_REL = 256
B_REL_SIZE = 2 * B_MAX_REL + 1

C_HEADS = 4
C_DQK = 64
C_DV = 2 * C_DQK
C_WIDTH = C_HEADS * C_DV
Q_BLOCK = 128

T5_BUCKETS = 32
T5_MAX_DIST = 1024

N_BRANCH = 3
BRANCH_WIDTH = 512

N_GROUPS = 4
EXPERTS_PER_GROUP = 8
N_EXPERTS = N_GROUPS * EXPERTS_PER_GROUP
TOP_K = 2
D_EXPERT = D_MODEL // 4

IN_SIZES = (A_WIDTH, A_WIDTH, A_WIDTH, A_WIDTH, A_HEADS, A_HEADS,
            B_WIDTH, B_WIDTH, B_WIDTH,
            2 * C_HEADS * C_DQK, 2 * C_HEADS * C_DQK, C_WIDTH,
            N_BRANCH * D_MODEL)
IN_COLS = sum(IN_SIZES)
IN_SPLITS = tuple(int(v) for v in np.cumsum(IN_SIZES)[:-1])

kernel_name = 'hybrid_mlstm_bandattn_diffattn_hiermoe'


def rmsnorm(x, g):
    xf = x.astype(jnp.float32)
    xf = xf * lax.rsqrt(jnp.mean(xf * xf, axis=-1, keepdims=True) + EPS)
    return xf.astype(x.dtype) * g


def causal_conv(u, w, b):
    K = w.shape[0]
    S = u.shape[1]
    up = jnp.pad(u, ((0, 0), (K - 1, 0), (0, 0)))
    y = b + w[0] * u
    for j in range(1, K):
        y = y + w[j] * up[:, K - 1 - j:K - 1 - j + S]
    return y


def to_chunks(t):
    Bn, S, H = t.shape[:3]
    t = t.reshape((Bn, S // CHUNK, CHUNK, H) + t.shape[3:])
    return jnp.moveaxis(t, (1, 3), (0, 2))


def mlstm_chunkwise(q, k, v, ig, lf):
    Bn, S, H, D = q.shape
    in_dtype = v.dtype
    f32 = jnp.float32
    q = q.astype(f32)
    k = k.astype(f32) * (D ** -0.5)
    v = v.astype(f32)
    causal = jnp.tril(jnp.ones((CHUNK, CHUNK), dtype=bool))

    def step(carry, inp):
        C, n, m = carry
        qc, kc, vc, igc, lfc = inp
        b = jnp.cumsum(lfc, axis=-1)
        b_last = b[..., -1]
        dmat = jnp.where(causal, b[..., :, None] - b[..., None, :] + igc[..., None, :], NEG)
        inter = b + m[..., None]
        m_t = jnp.maximum(inter, jnp.max(dmat, axis=-1))
        w_inter = jnp.exp(inter - m_t)
        s = jnp.einsum('bhld,bhsd->bhls', qc, kc) * jnp.exp(dmat - m_t[..., None])
        num = w_inter[..., None] * jnp.einsum('bhld,bhde->bhle', qc, C) + jnp.einsum('bhls,bhse->bhle', s, vc)
        den = w_inter * jnp.einsum('bhld,bhd->bhl', qc, n) + jnp.sum(s, axis=-1)
        h = num / jnp.maximum(jnp.abs(den), jnp.exp(-m_t))[..., None]
        g_end = b_last[..., None] - b + igc
        m_new = jnp.maximum(b_last + m, jnp.max(g_end, axis=-1))
        dec = jnp.exp(b_last + m - m_new)
        w_end = jnp.exp(g_end - m_new[..., None])
        C_new = dec[..., None, None] * C + jnp.einsum('bhl,bhld,bhle->bhde', w_end, kc, vc)
        n_new = dec[..., None] * n + jnp.einsum('bhl,bhld->bhd', w_end, kc)
        return (C_new, n_new, m_new), h

    init = (jnp.zeros((Bn, H, D, D), f32), jnp.zeros((Bn, H, D), f32), jnp.zeros((Bn, H), f32))
    xs = (to_chunks(q), to_chunks(k), to_chunks(v), to_chunks(ig), to_chunks(lf))
    _, h = lax.scan(step, init, xs)
    h = jnp.moveaxis(h, (0, 2), (1, 3))
    return h.reshape(Bn, S, H, D).astype(in_dtype)


def chunk_band_attention(q, k, v, rel_table):
    Bn, S, H, D = q.shape
    nc = S // CHUNK
    pad = B_LEFT_CHUNKS * CHUNK
    kp = jnp.pad(k, ((0, 0), (pad, 0), (0, 0), (0, 0)))
    vp = jnp.pad(v, ((0, 0), (pad, 0), (0, 0), (0, 0)))
    qpos = jnp.arange(CHUNK)
    kpos = jnp.arange(B_BAND) - pad
    rel = jnp.clip(qpos[:, None] - kpos[None, :], -B_MAX_REL, B_MAX_REL) + B_MAX_REL
    bias = jnp.transpose(rel_table[rel], (2, 0, 1)).astype(jnp.float32)
    scale = D ** -0.5

    def one_chunk(c):
        start = c * CHUNK
        qc = lax.dynamic_slice_in_dim(q, start, CHUNK, axis=1)
        kc = lax.dynamic_slice_in_dim(kp, start, B_BAND, axis=1)
        vc = lax.dynamic_slice_in_dim(vp, start, B_BAND, axis=1)
        s = jnp.einsum('blhd,bkhd->bhlk', qc, kc).astype(jnp.float32) * scale + bias
        s = jnp.where((start + kpos) >= 0, s, NEG)
        p = jax.nn.softmax(s, axis=-1).astype(v.dtype)
        return jnp.einsum('bhlk,bkhd->blhd', p, vc)

    out = lax.map(one_chunk, jnp.arange(nc))
    return jnp.moveaxis(out, 0, 1).reshape(Bn, S, H * D)


def t5_bucket(rel):
    nb = T5_BUCKETS // 2
    max_exact = nb // 2
    ret = (rel > 0).astype(jnp.int32) * nb
    n = jnp.abs(rel)
    large = max_exact + (jnp.log(jnp.maximum(n, max_exact).astype(jnp.float32) / max_exact)
                         / math.log(T5_MAX_DIST / max_exact) * (nb - max_exact)).astype(jnp.int32)
    large = jnp.minimum(large, nb - 1)
    return ret + jnp.where(n < max_exact, n, large)


def diff_attention(q1, q2, k1, k2, v, t5_table, lam):
    Bn, S, H, D = q1.shape
    nblk = S // Q_BLOCK
    kpos = jnp.arange(S)
    scale = D ** -0.5

    def one_block(i):
        start = i * Q_BLOCK
        qp = start + jnp.arange(Q_BLOCK)
        bias = jnp.moveaxis(t5_table[t5_bucket(kpos[None, :] - qp[:, None])], -1, 0).astype(jnp.float32)
        allowed = (kpos[None, :] // CHUNK) <= (qp[:, None] // CHUNK)

        def probs(qf, kf):
            qb = lax.dynamic_slice_in_dim(qf, start, Q_BLOCK, axis=1)
            s = jnp.einsum('bqhd,bkhd->bhqk', qb, kf).astype(jnp.float32) * scale + bias
            return jax.nn.softmax(jnp.where(allowed, s, NEG), axis=-1)

        a = (probs(q1, k1) - lam * probs(q2, k2)).astype(v.dtype)
        return jnp.einsum('bhqk,bkhe->bqhe', a, v)

    out = lax.map(one_block, jnp.arange(nblk))
    return jnp.moveaxis(out, 0, 1).reshape(Bn, S, H, v.shape[-1])


def token_mixers(x, layer, norm_g, w_in, conv_w, conv_b, gate_bias, a_norm_g,
                 b_qk_g, b_rel, c_qk_g, c_lam, c_sub_g, t5_table, w_br, w_o):
    Bn, S, _ = x.shape
    h = rmsnorm(x, norm_g)
    aq, ak, av, ao, ai, af, bq, bk, bv, cq, ck, cv, gates = jnp.split(h @ w_in, IN_SPLITS, axis=-1)

    def heads(t, n):
        return t.reshape(Bn, S, n, -1)

    qk = jax.nn.silu(causal_conv(jnp.concatenate([aq, ak], axis=-1), conv_w, conv_b))
    aq, ak = jnp.split(qk, 2, axis=-1)
    ig = GATE_CAP * jnp.tanh((ai + gate_bias[:A_HEADS]).astype(jnp.float32) / GATE_CAP)
    lf = jax.nn.log_sigmoid((af + gate_bias[A_HEADS:]).astype(jnp.float32))
    ha = mlstm_chunkwise(heads(aq, A_HEADS), heads(ak, A_HEADS), heads(av, A_HEADS), ig, lf)
    ha = rmsnorm(ha, a_norm_g).reshape(Bn, S, A_WIDTH) * jax.nn.sigmoid(ao)

    bq = rmsnorm(heads(bq, B_HEADS), b_qk_g[0])
    bk = rmsnorm(heads(bk, B_HEADS), b_qk_g[1])
    hb = chunk_band_attention(bq, bk, heads(bv, B_HEADS), b_rel)

    cq = rmsnorm(cq.reshape(Bn, S, C_HEADS, 2, C_DQK), c_qk_g[0])
    ck = rmsnorm(ck.reshape(Bn, S, C_HEADS, 2, C_DQK), c_qk_g[1])
    lam_init = 0.8 - 0.6 * math.exp(-0.3 * layer)
    lf32 = c_lam.astype(jnp.float32)
    lam = jnp.exp(jnp.sum(lf32[0] * lf32[1])) - jnp.exp(jnp.sum(lf32[2] * lf32[3])) + lam_init
    hc = diff_attention(cq[..., 0, :], cq[..., 1, :], ck[..., 0, :], ck[..., 1, :],
                        heads(cv, C_HEADS), t5_table, lam)
    hc = (rmsnorm(hc, c_sub_g) * (1.0 - lam_init)).reshape(Bn, S, C_WIDTH)

    g = jax.nn.sigmoid(gates).reshape(Bn, S, N_BRANCH, D_MODEL)
    y = g[..., 0, :] * (ha @ w_br[0]) + g[..., 1, :] * (hb @ w_br[1]) + g[..., 2, :] * (hc @ w_br[2])
    return y @ w_o


def hier_moe(h, w_group, b_group, w_router, b_router, w_gate, w_up, w_down):
    Bn, S, D = h.shape
    N = Bn * S
    t = h.reshape(N, D)
    rows = jnp.arange(N)
    glog = (t @ w_group + b_group).astype(jnp.float32)
    g_idx = jnp.argmax(glog, axis=-1)
    p_g = jax.nn.softmax(glog, axis=-1)[rows, g_idx]
    elog = (t @ w_router + b_router).astype(jnp.float32).reshape(N, N_GROUPS, EXPERTS_PER_GROUP)
    ep = jax.nn.softmax(elog[rows, g_idx], axis=-1)
    top_p, top_i = lax.top_k(ep, TOP_K)
    top_p = top_p / jnp.sum(top_p, axis=-1, keepdims=True)
    weights = p_g[:, None] * top_p
    expert_id = g_idx[:, None] * EXPERTS_PER_GROUP + top_i
    combine = jnp.sum(jax.nn.one_hot(expert_id, N_EXPERTS, dtype=jnp.float32) * weights[..., None], axis=1)
    combine = combine.astype(t.dtype)
    out = jnp.zeros_like(t)
    for e in range(N_EXPERTS):
        he = jax.nn.silu(t @ w_gate[e]) * (t @ w_up[e])
        out = out + combine[:, e:e + 1] * (he @ w_down[e])
    return out.reshape(Bn, S, D)


def setup_inputs(seed: int = 0) -> dict:
    key = jax.random.key(seed)
    ks = jax.random.split(key, 26)
    L = DEPTH

    def nrm(k, shape, scale):
        return scale * jax.random.normal(k, shape, jnp.float32)

    def gain(k, shape):
        return 1.0 + nrm(k, shape, 0.02)

    i_bias = nrm(ks[5], (L, A_HEADS), 0.1) - 1.0
    f_bias = jnp.linspace(3.0, 6.0, A_HEADS)[None, :] + nrm(ks[6], (L, A_HEADS), 0.1)
    return {
        'x': nrm(ks[0], (BATCH, SEQ, D_MODEL), 1.0),
        'norm1_g': gain(ks[1], (L, D_MODEL)),
        'w_in': nrm(ks[2], (L, D_MODEL, IN_COLS), D_MODEL ** -0.5),
        'a_conv_w': nrm(ks[3], (L, CONV_W, 2 * A_WIDTH), CONV_W ** -0.5),
        'a_conv_b': nrm(ks[4], (L, 2 * A_WIDTH), 0.02),
        'a_gate_bias': jnp.concatenate([i_bias, f_bias], axis=-1),
        'a_out_norm_g': gain(ks[7], (L, A_HEADS, A_DH)),
        'b_qk_norm_g': gain(ks[8], (L, 2, B_DH)),
        'b_rel_bias': nrm(ks[9], (L, B_REL_SIZE, B_HEADS), 0.2),
        'c_qk_norm_g': gain(ks[10], (L, 2, C_DQK)),
        'c_lambda': nrm(ks[11], (L, 4, C_DQK), 0.1),
        'c_sub_norm_g': gain(ks[12], (L, C_DV)),
        't5_bias': nrm(ks[13], (T5_BUCKETS, C_HEADS), 0.2),
        'w_branch': nrm(ks[14], (L, N_BRANCH, BRANCH_WIDTH, D_MODEL), BRANCH_WIDTH ** -0.5),
        'w_out': nrm(ks[15], (L, D_MODEL, D_MODEL), D_MODEL ** -0.5),
        'norm2_g': gain(ks[16], (L, D_MODEL)),
        'w_group': nrm(ks[17], (L, D_MODEL, N_GROUPS), D_MODEL ** -0.5),
        'b_group': nrm(ks[18], (L, N_GROUPS), 0.01),
        'w_router': nrm(ks[19], (L, D_MODEL, N_EXPERTS), D_MODEL ** -0.5),
        'b_router': nrm(ks[20], (L, N_EXPERTS), 0.01),
        'w_e_gate': nrm(ks[21], (L, N_EXPERTS, D_MODEL, D_EXPERT), D_MODEL ** -0.5),
        'w_e_up': nrm(ks[22], (L, N_EXPERTS, D_MODEL, D_EXPERT), D_MODEL ** -0.5),
        'w_e_down': nrm(ks[23], (L, N_EXPERTS, D_EXPERT, D_MODEL), D_EXPERT ** -0.5),
    }


def reference(x, norm1_g, w_in, a_conv_w, a_conv_b, a_gate_bias, a_out_norm_g,
              b_qk_norm_g, b_rel_bias, c_qk_norm_g, c_lambda, c_sub_norm_g, t5_bias,
              w_branch, w_out, norm2_g, w_group, b_group, w_router, b_router,
              w_e_gate, w_e_up, w_e_down):
    for l in range(DEPTH):
        x = x + token_mixers(x, l, norm1_g[l], w_in[l], a_conv_w[l], a_conv_b[l], a_gate_bias[l],
                             a_out_norm_g[l], b_qk_norm_g[l], b_rel_bias[l], c_qk_norm_g[l],
                             c_lambda[l], c_sub_norm_g[l], t5_bias, w_branch[l], w_out[l])
        x = x + hier_moe(rmsnorm(x, norm2_g[l]), w_group[l], b_group[l], w_router[l], b_router[l],
                         w_e_gate[l], w_e_up[l], w_e_down[l])
    return x
```

```cpp
#include <hip/hip_runtime.h>
#include <cstdio>
#include <cstdint>
#include <cmath>
namespace pg8 {
#define PG8_LAS __attribute__((address_space(3)))
typedef unsigned short bf16_t;
typedef short bf16x8 __attribute__((ext_vector_type(8)));
typedef float f32x4 __attribute__((ext_vector_type(4)));
typedef unsigned u32x4 __attribute__((ext_vector_type(4)));
constexpr int BM = 256, BK = 64, HALF = 128, HTB = HALF * BK * 2  , STAGE_BYTES = 8 * HTB, NXCD = 8, WGM = 8;

__host__ __device__ __forceinline__ int lds_byte(int r, int c) { const int st = (r >> 4) * 2 + (c >> 5), rr = r & 15, cc = c & 31, ob = rr * 64 + cc * 2; return st * 1024 + (ob ^ (((ob >> 9) & 1) << 5)); }
__host__ __device__ __forceinline__ void stage_rc(int b, int& R, int& C) { const int st = b / 1024, sb = b % 1024, swz = sb ^ (((sb >> 9) & 1) << 5); R = (st >> 1) * 16 + swz / 64; C = (st & 1) * 32 + (swz % 64) / 2; }
__host__ __device__ __forceinline__ int perm32(int rho) { const int n = rho >> 4, i = rho & 15; return 8 * (i >> 2) + 4 * n + (i & 3); }

struct Unit { int pm, pn; };
struct Gemm { const bf16_t* A; const bf16_t* Bt; int M, N, K; };

struct StaticOrder {
    int nM, nN, nwg, G, c;
    __host__ __device__ void init(int M, int N, int G_, int c_) { nM = M / BM; nN = N / BM; nwg = nM * nN; G = G_; c = c_; }
    __host__ __device__ bool next(int i, Unit& u) const {
        const long L = (long)i * G + c; if (L >= nwg) return false;
        int wgid = (int)L; { const int q = nwg / NXCD, r = nwg % NXCD, xcd = wgid % NXCD, off = wgid / NXCD; wgid = (xcd < r ? xcd * (q + 1) : r * (q + 1) + (xcd - r) * q) + off; }
        const int nig = WGM * nN, gid = wgid / nig, fm = gid * WGM, gsz = (nM - fm) < WGM ? (nM - fm) : WGM;
        u.pm = fm + ((wgid % nig) % gsz); u.pn = (wgid % nig) / gsz; return true;
    }
    __device__ __forceinline__ void a_ready(const Unit&) const {}
    __device__ __forceinline__ void done(const Unit&) const {}
};

__device__ __forceinline__ unsigned cvt_pk_bf16(float lo, float hi) { unsigned r; asm volatile("v_cvt_pk_bf16_f32 %0, %1, %2" : "=v"(r) : "v"(lo), "v"(hi)); return r; }
#ifndef GAS
#define GAS __attribute__((address_space(1)))
#endif
typedef float f32x2 __attribute__((ext_vector_type(2)));
__device__ __forceinline__ float bflo(unsigned u) { return __builtin_bit_cast(float, u << 16); }
__device__ __forceinline__ float bfhi(unsigned u) { return __builtin_bit_cast(float, u & 0xffff0000u); }
__device__ __forceinline__ float sigmoidf_(float x) { return 1.f / (1.f + __expf(-x)); }
template <int MODE> struct EpiOut {
    static constexpr bool PERM = true, AFTER_DRAIN = false, CHAIN = false;
    bf16_t* b0; bf16_t* b1; bf16_t* b2; size_t stride;
    __device__ __forceinline__ void operator()(const f32x4 (&acc)[2][2][4][2], const Unit& u, int wr, int wc, int fr, int fq) const {
        int row0 = u.pm * BM + wr * 64 + fr; asm volatile("" : "+v"(row0));
        bf16_t* base; int colt, ldc;
        if (MODE == 0) { base = b0 + (size_t)(u.pn >> 1) * stride; colt = (u.pn & 1) * 256; ldc = 512; }
        else if (MODE == 1) { const int t = u.pn >> 2; base = b0 + (size_t)(160 * t - 32 * t * (t - 1)) * (1u << 19); colt = (u.pn & 3) * 256; ldc = 1024; }
        else { base = b0; colt = (u.pn & 3) * 256; ldc = 1024; }
        const int col0 = colt + wc * 32 + 8 * fq;
#pragma unroll
        for (int ai = 0; ai < 2; ++ai)
#pragma unroll
            for (int m = 0; m < 4; ++m) { bf16_t* rowp = base + (size_t)(row0 + ai * HALF + m * 16) * ldc + col0;
#pragma unroll
                for (int bj = 0; bj < 2; ++bj) { f32x4 v0 = acc[ai][bj][m][0], v1 = acc[ai][bj][m][1];
                    if (MODE == 1) {
#pragma unroll
                        for (int j = 0; j < 4; ++j) { v0[j] = sigmoidf_(v0[j]); v1[j] = sigmoidf_(v1[j]); } }
                    u32x4 w; w.x = cvt_pk_bf16(v0[0], v0[1]); w.y = cvt_pk_bf16(v0[2], v0[3]); w.z = cvt_pk_bf16(v1[0], v1[1]); w.w = cvt_pk_bf16(v1[2], v1[3]);
                    *(GAS u32x4*)(rowp + bj * HALF) = w; } }
    }
};
template <bool FIRST> struct EpiMerge {
    static constexpr bool PERM = true, AFTER_DRAIN = false, CHAIN = false;
    bf16_t* Y; const bf16_t* G;
    __device__ __forceinline__ void operator()(const f32x4 (&acc)[2][2][4][2], const Unit& u, int wr, int wc, int fr, int fq) const {
        int row0 = u.pm * BM + wr * 64 + fr; asm volatile("" : "+v"(row0)); const int col0 = u.pn * BM + wc * 32 + 8 * fq;
#pragma unroll
        for (int ai = 0; ai < 2; ++ai) {
            u32x4 gv[4][2], yv[4][2];
#pragma unroll
            for (int m = 0; m < 4; ++m) { const size_t ro = (size_t)(row0 + ai * HALF + m * 16) * 1024 + col0;
#pragma unroll
                for (int bj = 0; bj < 2; ++bj) { gv[m][bj] = *(const GAS u32x4*)(G + ro + bj * HALF); if (!FIRST) yv[m][bj] = *(const GAS u32x4*)(Y + ro + bj * HALF); } }
            __builtin_amdgcn_sched_barrier(0);
#pragma unroll
            for (int m = 0; m < 4; ++m) { const size_t ro = (size_t)(row0 + ai * HALF + m * 16) * 1024 + col0;
#pragma unroll
                for (int bj = 0; bj < 2; ++bj) { const f32x4 v0 = acc[ai][bj][m][0], v1 = acc[ai][bj][m][1]; const u32x4 g = gv[m][bj];
                    float r[8] = { bflo(g.x) * v0[0], bfhi(g.x) * v0[1], bflo(g.y) * v0[2], bfhi(g.y) * v0[3], bflo(g.z) * v1[0], bfhi(g.z) * v1[1], bflo(g.w) * v1[2], bfhi(g.w) * v1[3] };
                    if (!FIRST) { const u32x4 y = yv[m][bj];
                        r[0] += bflo(y.x); r[1] += bfhi(y.x); r[2] += bflo(y.y); r[3] += bfhi(y.y); r[4] += bflo(y.z); r[5] += bfhi(y.z); r[6] += bflo(y.w); r[7] += bfhi(y.w); }
                    u32x4 w; w.x = cvt_pk_bf16(r[0], r[1]); w.y = cvt_pk_bf16(r[2], r[3]); w.z = cvt_pk_bf16(r[4], r[5]); w.w = cvt_pk_bf16(r[6], r[7]);
                    *(GAS u32x4*)(Y + ro + bj * HALF) = w; } }
            __builtin_amdgcn_sched_barrier(0); }
    }
};
struct EpiResid {
    static constexpr bool PERM = true, AFTER_DRAIN = false, CHAIN = false;
    const void* XS; bool xbf; bf16_t* OUT;
    __device__ __forceinline__ void operator()(const f32x4 (&acc)[2][2][4][2], const Unit& u, int wr, int wc, int fr, int fq) const {
        int row0 = u.pm * BM + wr * 64 + fr; asm volatile("" : "+v"(row0)); const int col0 = u.pn * BM + wc * 32 + 8 * fq;
#pragma unroll
        for (int ai = 0; ai < 2; ++ai) {
            f32x4 xa[4][2][2];
            if (xbf) {
#pragma unroll
                for (int m = 0; m < 4; ++m) { const size_t ro = (size_t)(row0 + ai * HALF + m * 16) * 1024 + col0;
#pragma unroll
                    for (int bj = 0; bj < 2; ++bj) { const u32x4 xv = *(const GAS u32x4*)((const bf16_t*)XS + ro + bj * HALF); xa[m][bj][0] = __builtin_bit_cast(f32x4, xv); } }
            } else {
#pragma unroll
                for (int m = 0; m < 4; ++m) { const size_t ro = (size_t)(row0 + ai * HALF + m * 16) * 1024 + col0;
#pragma unroll
                    for (int bj = 0; bj < 2; ++bj) { xa[m][bj][0] = *(const GAS f32x4*)((const float*)XS + ro + bj * HALF); xa[m][bj][1] = *(const GAS f32x4*)((const float*)XS + ro + bj * HALF + 4); } }
            }
            __builtin_amdgcn_sched_barrier(0);
#pragma unroll
            for (int m = 0; m < 4; ++m) { const size_t ro = (size_t)(row0 + ai * HALF + m * 16) * 1024 + col0;
#pragma unroll
                for (int bj = 0; bj < 2; ++bj) { f32x4 x0, x1;
                    if (xbf) { const u32x4 xv = __builtin_bit_cast(u32x4, xa[m][bj][0]); x0 = (f32x4){bflo(xv.x), bfhi(xv.x), bflo(xv.y), bfhi(xv.y)}; x1 = (f32x4){bflo(xv.z), bfhi(xv.z), bflo(xv.w), bfhi(xv.w)}; }
                    else { x0 = xa[m][bj][0]; x1 = xa[m][bj][1]; }
                    x0 = x0 + acc[ai][bj][m][0]; x1 = x1 + acc[ai][bj][m][1];
                    u32x4 w; w.x = cvt_pk_bf16(x0[0], x0[1]); w.y = cvt_pk_bf16(x0[2], x0[3]); w.z = cvt_pk_bf16(x1[0], x1[1]); w.w = cvt_pk_bf16(x1[2], x1[3]);
                    *(GAS u32x4*)(OUT + ro + bj * HALF) = w; } }
            __builtin_amdgcn_sched_barrier(0); }
    }
};
struct EpiSiluMul {
    static constexpr bool PERM = true, AFTER_DRAIN = false, CHAIN = false;
    bf16_t* O;
    __device__ __forceinline__ void operator()(const f32x4 (&acc)[2][2][4][2], const Unit& u, int wr, int wc, int fr, int fq) const {
        int row0 = u.pm * BM + wr * 64 + fr; asm volatile("" : "+v"(row0)); const int col0 = (u.pn & 1) * 128 + wc * 32 + 8 * fq;
#pragma unroll
        for (int ai = 0; ai < 2; ++ai)
#pragma unroll
            for (int m = 0; m < 4; ++m) { float r[8];
#pragma unroll
                for (int n = 0; n < 2; ++n)
#pragma unroll
                    for (int j = 0; j < 4; ++j) { const float g = acc[ai][0][m][n][j], up = acc[ai][1][m][n][j]; r[4 * n + j] = g * sigmoidf_(g) * up; }
                u32x4 w; w.x = cvt_pk_bf16(r[0], r[1]); w.y = cvt_pk_bf16(r[2], r[3]); w.z = cvt_pk_bf16(r[4], r[5]); w.w = cvt_pk_bf16(r[6], r[7]);
                *(GAS u32x4*)(O + (size_t)(row0 + ai * HALF + m * 16) * 256 + col0) = w; }
    }
};
template <int LOG_NCT> struct MoeOrder {
    int G, c, RT; const int* texp;
    __device__ __forceinline__ bool next(int i, Unit& u) const {
        const int L = i * G + c; const int rt = L >> LOG_NCT; if (rt >= RT) return false;
        const int e = __builtin_amdgcn_readfirstlane(texp[rt]); u.pm = rt; u.pn = (e << LOG_NCT) + (L & ((1 << LOG_NCT) - 1)); return true;
    }
    __device__ __forceinline__ void a_ready(const Unit&) const {}
    __device__ __forceinline__ void done(const Unit&) const {}
};
template <class Epi, class Sched, bool ALIGN_EPI = false, bool SP2 = false>
__device__ __forceinline__ void gemm_phase(PG8_LAS unsigned char* lds, const Gemm g, const Sched& S, const Epi& E, int tid_in) {
    int tid = tid_in; asm volatile("" : "+v"(tid));
    const int wid = __builtin_amdgcn_readfirstlane(tid >> 6), lane = tid & 63, wr = wid >> 2, wc = wid & 3, fr = lane & 15, fq = lane >> 4;
    const int K = g.K, nt = K / BK;
    unsigned voffA[2], voffB[2];
#pragma unroll
    for (int i = 0; i < 2; ++i) { int R, C; stage_rc(tid * 16 + i * 8192, R, C); const int Rb = Epi::PERM ? ((R & ~31) + perm32(R & 31)) : R;
        voffA[i] = (unsigned)(R * K + C) * 2u; voffB[i] = (unsigned)(Rb * K + C) * 2u; }
    const size_t kstep = (size_t)(BK * 2);
    const size_t hstep = (size_t)HALF * K * 2;
    const size_t tstep = 2 * hstep;
    const unsigned ldsw = (unsigned)wid * 1024u;
    const int aoff = lds_byte(wr * 64 + fr, fq * 8), boff = lds_byte(wc * 32 + fr, fq * 8);
#define PG8_SA(b, h) (((b) * 2 + (h)) * HTB)
#define PG8_SB(b, h) ((4 + (b) * 2 + (h)) * HTB)
#define PG8_STAGE(bufoff, gbase, voff) do { _Pragma("unroll") for (int _i = 0; _i < 2; ++_i) \
        __builtin_amdgcn_global_load_lds((const unsigned*)((const char*)(gbase) + (voff)[_i]), (PG8_LAS unsigned*)(lds + (bufoff) + ldsw + _i * 8192), 16, 0, 0); } while (0)
#define PG8_LDA(dst, b, h) do { _Pragma("unroll") for (int m = 0; m < 4; ++m) _Pragma("unroll") for (int k = 0; k < 2; ++k) dst[m][k] = *(const PG8_LAS bf16x8*)(lds + PG8_SA(b, h) + aoff + m * 2048 + k * 1024); } while (0)
#define PG8_LDB(dst, b, h) do { _Pragma("unroll") for (int n = 0; n < 2; ++n) _Pragma("unroll") for (int k = 0; k < 2; ++k) dst[n][k] = *(const PG8_LAS bf16x8*)(lds + PG8_SB(b, h) + boff + n * 2048 + k * 1024); } while (0)
#define PG8_MMA(ai, bj, At, Bt) do { __builtin_amdgcn_s_setprio(1); _Pragma("unroll") for (int m = 0; m < 4; ++m) _Pragma("unroll") for (int n = 0; n < 2; ++n) _Pragma("unroll") for (int k = 0; k < 2; ++k) \
        acc[ai][bj][m][n] = __builtin_amdgcn_mfma_f32_16x16x32_bf16(Bt[n][k], At[m][k], acc[ai][bj][m][n], 0, 0, 0); __builtin_amdgcn_s_setprio(0); } while (0)
#define PG8_WAIT_V(n) asm volatile("s_waitcnt vmcnt(" #n ")" ::: "memory")
#define PG8_WAIT_L(n) asm volatile("s_waitcnt lgkmcnt(" #n ")" ::: "memory")
#define PG8_BAR __builtin_amdgcn_s_barrier()
#define PG8_SCHED __builtin_amdgcn_sched_barrier(0)
    Unit cur, nxt; int ui = 0;
    if (!S.next(0, cur)) return;
    f32x4 acc[2][2][4][2];
#pragma unroll
    for (int a = 0; a < 2; ++a)
#pragma unroll
        for (int b = 0; b < 2; ++b)
#pragma unroll
            for (int m = 0; m < 4; ++m)
#pragma unroll
                for (int n = 0; n < 2; ++n) acc[a][b][m][n] = (f32x4){0.f, 0.f, 0.f, 0.f};
    bf16x8 At[4][2], B0[2][2], B1[2][2];
    const char* cA = (const char*)g.A + (size_t)cur.pm * tstep; const char* cB = (const char*)g.Bt + (size_t)cur.pn * tstep;
    S.a_ready(cur);
    if constexpr (SP2) {
        PG8_STAGE(PG8_SB(0, 0), cB, voffB); PG8_STAGE(PG8_SB(0, 1), cB + hstep, voffB); PG8_STAGE(PG8_SA(0, 0), cA, voffA); PG8_STAGE(PG8_SA(0, 1), cA + hstep, voffA);
        if (wr == 1) PG8_BAR;
        PG8_WAIT_V(2); PG8_BAR;
        PG8_STAGE(PG8_SB(1, 0), cB + kstep, voffB); PG8_STAGE(PG8_SA(1, 0), cA + kstep, voffA); PG8_STAGE(PG8_SB(1, 1), cB + hstep + kstep, voffB);
        PG8_WAIT_V(6); PG8_BAR;
    } else {
        PG8_STAGE(PG8_SB(0, 0), cB, voffB); PG8_STAGE(PG8_SA(0, 0), cA, voffA); PG8_STAGE(PG8_SB(0, 1), cB + hstep, voffB); PG8_STAGE(PG8_SA(0, 1), cA + hstep, voffA);
        if (wr == 1) PG8_BAR;
        PG8_WAIT_V(4); PG8_BAR;
        PG8_STAGE(PG8_SB(1, 0), cB + kstep, voffB); PG8_STAGE(PG8_SA(1, 0), cA + kstep, voffA); PG8_STAGE(PG8_SB(1, 1), cB + hstep + kstep, voffB);
        PG8_WAIT_V(6); PG8_BAR;
    }
    for (;;) {
        const bool has_next = S.next(ui + 1, nxt);
        const char* nA = has_next ? (const char*)g.A + (size_t)nxt.pm * tstep : cA; const char* nB = has_next ? (const char*)g.Bt + (size_t)nxt.pn * tstep : cB;
        for (int t = 0; t < nt; t += 2) {
            const bool last = (t == nt - 2);
            const char* a1 = cA + (size_t)(t + 1) * kstep;
            const char* a2 = last ? nA : cA + (size_t)(t + 2) * kstep; const char* b2 = last ? nB : cB + (size_t)(t + 2) * kstep;
            const char* a3 = a2 + kstep; const char* b3 = b2 + kstep;
            if (last && has_next) S.a_ready(nxt);
            if constexpr (SP2) {
            PG8_LDB(B0, 0, 0); PG8_LDB(B1, 0, 1); PG8_SCHED; PG8_LDA(At, 0, 0); PG8_STAGE(PG8_SA(1, 1), a1 + hstep, voffA);
            PG8_WAIT_V(8); PG8_WAIT_L(0); PG8_BAR; PG8_MMA(0, 0, At, B0); PG8_MMA(0, 1, At, B1); PG8_BAR; PG8_SCHED;
            PG8_LDA(At, 0, 1); PG8_STAGE(PG8_SB(0, 0), b2, voffB); PG8_STAGE(PG8_SB(0, 1), b2 + hstep, voffB); PG8_STAGE(PG8_SA(0, 0), a2, voffA);
            PG8_WAIT_V(8); PG8_WAIT_L(0); PG8_BAR; PG8_MMA(1, 0, At, B0); PG8_MMA(1, 1, At, B1); PG8_BAR; PG8_SCHED;
            PG8_LDB(B0, 1, 0); PG8_LDB(B1, 1, 1); PG8_SCHED; PG8_LDA(At, 1, 0); PG8_STAGE(PG8_SA(0, 1), a2 + hstep, voffA);
            PG8_WAIT_V(8); PG8_WAIT_L(0); PG8_BAR; PG8_MMA(0, 0, At, B0); PG8_MMA(0, 1, At, B1); PG8_BAR; PG8_SCHED;
            PG8_LDA(At, 1, 1); PG8_STAGE(PG8_SB(1, 0), b3, voffB); PG8_STAGE(PG8_SB(1, 1), b3 + hstep, voffB); PG8_STAGE(PG8_SA(1, 0), a3, voffA);
            PG8_WAIT_V(8); PG8_WAIT_L(0); PG8_BAR; PG8_MMA(1, 0, At, B0); PG8_MMA(1, 1, At, B1); PG8_BAR; PG8_SCHED;
            } else {
            PG8_LDB(B0, 0, 0); PG8_SCHED; PG8_LDA(At, 0, 0); PG8_STAGE(PG8_SA(1, 1), a1 + hstep, voffA);
            PG8_WAIT_L(8); PG8_BAR; PG8_WAIT_L(0); PG8_MMA(0, 0, At, B0); PG8_BAR; PG8_SCHED;
            PG8_LDB(B1, 0, 1); PG8_STAGE(PG8_SB(0, 0), b2, voffB);
            PG8_BAR; PG8_WAIT_L(0); PG8_MMA(0, 1, At, B1); PG8_BAR;
            PG8_LDA(At, 0, 1); PG8_STAGE(PG8_SA(0, 0), a2, voffA);
            PG8_BAR; PG8_WAIT_L(0); PG8_MMA(1, 0, At, B0); PG8_BAR; PG8_SCHED;
            PG8_STAGE(PG8_SB(0, 1), b2 + hstep, voffB);
            PG8_WAIT_V(6); PG8_BAR; PG8_MMA(1, 1, At, B1); PG8_BAR;
            PG8_LDB(B0, 1, 0); PG8_SCHED; PG8_LDA(At, 1, 0); PG8_STAGE(PG8_SA(0, 1), a2 + hstep, voffA);
            PG8_WAIT_L(8); PG8_BAR; PG8_WAIT_L(0); PG8_MMA(0, 0, At, B0); PG8_BAR; PG8_SCHED;
            PG8_LDB(B1, 1, 1); PG8_STAGE(PG8_SB(1, 0), b3, voffB);
            PG8_BAR; PG8_WAIT_L(0); PG8_MMA(0, 1, At, B1); PG8_BAR;
            PG8_LDA(At, 1, 1); PG8_STAGE(PG8_SA(1, 0), a3, voffA);
            PG8_BAR; PG8_WAIT_L(0); PG8_MMA(1, 0, At, B0); PG8_BAR; PG8_SCHED;
            PG8_STAGE(PG8_SB(1, 1), b3 + hstep, voffB);
            PG8_WAIT_V(6); PG8_BAR; PG8_MMA(1, 1, At, B1); PG8_BAR;
            }
        }
        if constexpr (ALIGN_EPI) { if (wr == 0) PG8_BAR; }
        if constexpr (!Epi::AFTER_DRAIN) { E(acc, cur, wr, wc, fr, fq); S.done(cur); }
        if (!has_next) break;
#pragma unroll
        for (int a = 0; a < 2; ++a)
#pragma unroll
            for (int b = 0; b < 2; ++b)
#pragma unroll
                for (int m = 0; m < 4; ++m)
#pragma unroll
                    for (int n = 0; n < 2; ++n) acc[a][b][m][n] = (f32x4){0.f, 0.f, 0.f, 0.f};
        cur = nxt; cA = nA; cB = nB; ++ui;
        if constexpr (ALIGN_EPI) { if (wr == 1) PG8_BAR; }
    }
    PG8_WAIT_V(0);
    if constexpr (!ALIGN_EPI) { if (wr == 0) PG8_BAR; }
    PG8_BAR;
    if constexpr (Epi::AFTER_DRAIN) { E.fused(acc, cur, wr, wc, fr, fq, lds, wid, lane); S.done(cur); }
#undef PG8_SA
#undef PG8_SB
#undef PG8_STAGE
#undef PG8_LDA
#undef PG8_LDB
#undef PG8_MMA
#undef PG8_WAIT_V
#undef PG8_WAIT_L
#undef PG8_BAR
#undef PG8_SCHED
}
}
constexpr int NTOK = 32768, SEQ = 8192, NB = 4, DM = 1024, INC = 8200;
constexpr float EPS = 1e-6f, LOG2E = 1.4426950408889634f;
constexpr size_t MiB = 1u << 20;
constexpr size_t WS_CTL = 0, CTL_ZERO_BYTES = 1 * MiB;
constexpr size_t WS_IG = 1 * MiB;
constexpr size_t WS_BC = 1 * MiB + 512 * 1024;
constexpr size_t WS_BLAST = 2 * MiB;
constexpr size_t WS_GMAX = 2 * MiB + 64 * 1024;
constexpr size_t WS_NUC = 3 * MiB;
constexpr size_t WS_TOKE = 4 * MiB;
constexpr size_t WS_TOKR = 4 * MiB + 256 * 1024;
constexpr size_t WS_TOKW = 4 * MiB + 512 * 1024;
constexpr size_t WS_TEXP = 5 * MiB;
constexpr size_t WS_HISTG = 5 * MiB + 64 * 1024;
constexpr size_t WS_TOKP = 6 * MiB;
constexpr size_t WS_WT1 = 8 * MiB;
constexpr size_t WS_WT2 = 18 * MiB;
constexpr size_t WS_PT = 24 * MiB;
constexpr size_t WS_WOT = 27 * MiB;
constexpr size_t WS_PROJ = 32 * MiB;
constexpr size_t PROJ_STRIDE = 32 * MiB;
constexpr size_t WS_HB = 352 * MiB;
constexpr size_t WS_O12 = 416 * MiB;
constexpr size_t WS_G0 = 32 * MiB, WS_G1 = 192 * MiB, WS_G2 = 288 * MiB;
constexpr size_t WS_H2 = 32 * MiB;
constexpr size_t WS_XS = 96 * MiB;
constexpr size_t WS_HE = 32 * MiB;
constexpr size_t WS_OSL = 96 * MiB;
constexpr size_t WS_W1T = 416 * MiB;
constexpr size_t WS_W2T = 448 * MiB;
constexpr size_t WS_XB1 = 256 * MiB;
constexpr size_t WS_NEED = 512 * MiB;
constexpr int PJ_AQ = 0, PJ_AK = 1, PJ_AV = 2, PJ_AO = 3, PJ_BQ = 4, PJ_BK = 5, PJ_BV = 6, PJ_CQ = 7, PJ_CK = 8, PJ_CV = 9;
constexpr int CW_TMO = 0, CW_CODE = 1;
constexpr int CW_BAR = 4096;
constexpr int CW_Q = 8192;
constexpr int CW_CNT = 12288;
constexpr int RING_BYTES = 131072;
constexpr int MISC_OFF = RING_BYTES;
constexpr int OFFS_OFF = RING_BYTES + 256;
constexpr int LDS_BYTES = 147456;
constexpr int NWAVES = 8, NTHR = 512;

#ifndef GAS
#define GAS __attribute__((address_space(1)))
#endif
#define LAS __attribute__((address_space(3)))
typedef unsigned short bf16;
typedef float f32x4 __attribute__((ext_vector_type(4)));
typedef float f32x16 __attribute__((ext_vector_type(16)));
typedef short bf16x8 __attribute__((ext_vector_type(8)));
typedef unsigned u32x4 __attribute__((ext_vector_type(4)));
typedef unsigned u32x2 __attribute__((ext_vector_type(2)));
typedef short s16x4 __attribute__((ext_vector_type(4)));
typedef GAS unsigned gu32;
#define RLX_AGENT __ATOMIC_RELAXED, __HIP_MEMORY_SCOPE_AGENT
#define LDS_WAIT() asm volatile("s_waitcnt lgkmcnt(0)" ::: "memory")
typedef float f32x2_t __attribute__((ext_vector_type(2))); typedef __bf16 bf16x2_t __attribute__((ext_vector_type(2)));
__device__ __forceinline__ unsigned pk2(float lo, float hi) { f32x2_t v = {lo, hi}; bf16x2_t b = __builtin_convertvector(v, bf16x2_t); return __builtin_bit_cast(unsigned, b); }
__device__ __forceinline__ float bflo(unsigned u) { return __builtin_bit_cast(float, u << 16); }
__device__ __forceinline__ float bfhi(unsigned u) { return __builtin_bit_cast(float, u & 0xffff0000u); }
__device__ __forceinline__ float sigm(float x) { return 1.f / (1.f + __expf(-x)); }
template <int O> __device__ __forceinline__ float xor_shfl(float v) {
    return __builtin_bit_cast(float, __builtin_amdgcn_ds_swizzle(__builtin_bit_cast(int, v), (O << 10) | 0x1f));
}
__device__ __forceinline__ float wave_sum(float v) {
    v += xor_shfl<1>(v); v += xor_shfl<2>(v); v += xor_shfl<4>(v); v += xor_shfl<8>(v); v += xor_shfl<16>(v);
    auto rr = __builtin_amdgcn_permlane32_swap(__float_as_uint(v), __float_as_uint(v), false, false);
    return __uint_as_float(rr[0]) + __uint_as_float(rr[1]);
}
__device__ __forceinline__ float wave_max(float v) {
    v = fmaxf(v, xor_shfl<1>(v)); v = fmaxf(v, xor_shfl<2>(v)); v = fmaxf(v, xor_shfl<4>(v)); v = fmaxf(v, xor_shfl<8>(v)); v = fmaxf(v, xor_shfl<16>(v));
    auto rr = __builtin_amdgcn_permlane32_swap(__float_as_uint(v), __float_as_uint(v), false, false);
    return fmaxf(__uint_as_float(rr[0]), __uint_as_float(rr[1]));
}
__device__ __forceinline__ float lane_up(float v, int lane, int o) {
    return __builtin_bit_cast(float, __builtin_amdgcn_ds_bpermute(((lane - o) & 63) << 2, __builtin_bit_cast(int, v)));
}
__device__ __forceinline__ float lane_get(float v, int src) {
    return __builtin_bit_cast(float, __builtin_amdgcn_readlane(__builtin_bit_cast(int, v), src));
}
__device__ __forceinline__ float pair_sum(float v) {
    auto rr = __builtin_amdgcn_permlane32_swap(__float_as_uint(v), __float_as_uint(v), false, false);
    return __uint_as_float(rr[0]) + __uint_as_float(rr[1]);
}
__device__ __forceinline__ float pair_max(float v) {
    auto rr = __builtin_amdgcn_permlane32_swap(__float_as_uint(v), __float_as_uint(v), false, false);
    return fmaxf(__uint_as_float(rr[0]), __uint_as_float(rr[1]));
}
__device__ __forceinline__ float max3f(float a, float b, float c) { float r; asm("v_max3_f32 %0, %1, %2, %3" : "=v"(r) : "v"(a), "v"(b), "v"(c)); return r; }
__device__ __forceinline__ int crow(int r, int hi) { return (r & 3) + 8 * (r >> 2) + 4 * hi; }
typedef short v4i16_t __attribute__((ext_vector_type(4)));
__device__ __forceinline__ s16x4 tr16(const LAS unsigned char* p) { return __builtin_bit_cast(s16x4, __builtin_amdgcn_ds_read_tr16_b64_v4i16((LAS v4i16_t*)p)); }
__device__ __forceinline__ bf16x8 cat8(s16x4 lo, s16x4 hi) { return (bf16x8){lo[0], lo[1], lo[2], lo[3], hi[0], hi[1], hi[2], hi[3]}; }
__device__ __forceinline__ f32x4 ldrow4(const void* base, bool isbf, size_t row, int idx) {
    if (isbf) { const u32x2 u = ((const GAS u32x2*)((const bf16*)base + row * 1024))[idx]; return (f32x4){bflo(u.x), bfhi(u.x), bflo(u.y), bfhi(u.y)}; }
    return ((const GAS f32x4*)((const float*)base + row * 1024))[idx];
}
#define MFMA32(a, b, c) __builtin_amdgcn_mfma_f32_32x32x16_bf16((a), (b), (c), 0, 0, 0)
#define XB_TMO      128
#define XB_XCNT(j)  (256  + 64 * (j))
#define XB_XSUB(j)  (1280 + 64 * (j))
#define XB_XGEN(j)  (2304 + 64 * (j))
#define XB_TOP      3328
#define XB_TOPGEN   3392
#define XCD_BAR_WORDS 3456
#define XB_SPIN_CAP (1u << 18)

__device__ __forceinline__ unsigned xb_ld(unsigned* p)              { return __hip_atomic_load(p, __ATOMIC_RELAXED, __HIP_MEMORY_SCOPE_AGENT); }
__device__ __forceinline__ unsigned xb_add(unsigned* p, unsigned v) { return __hip_atomic_fetch_add(p, v, __ATOMIC_RELAXED, __HIP_MEMORY_SCOPE_AGENT); }
__device__ __forceinline__ unsigned xb_xcc_id() { return (unsigned)__builtin_amdgcn_s_getreg((3 << 11) | 20) & 0xFu; }
#define XB_SPIN(cond, bar) do { unsigned _sp = 0; while (cond) { __builtin_amdgcn_s_sleep(1); \
    if ((++_sp & 255u) == 0u) { if (xb_ld(&(bar)[XB_TMO])) break; if (_sp > XB_SPIN_CAP) { atomicAdd(&(bar)[XB_TMO], 1u); break; } } } } while (0)

__device__ __forceinline__ int xb_lane() { int l; asm volatile("v_mbcnt_lo_u32_b32 %0, -1, 0\n\tv_mbcnt_hi_u32_b32 %0, -1, %0" : "=v"(l)); return l; }
struct XcdBarrier {
    int wv;
    unsigned* bar; unsigned x;
    volatile LAS unsigned* st;
};

__device__ __forceinline__ XcdBarrier xcd_barrier_post(unsigned* bar, volatile LAS unsigned* st, int wv) {
    XcdBarrier b; b.wv = wv; b.bar = bar; b.x = xb_xcc_id(); b.st = st;
    if (wv == 0 && xb_lane() == 0) (void)xb_add(&bar[XB_XCNT(b.x)], 1u);
    return b;
}
__device__ __forceinline__ void xcd_barrier_complete(unsigned* bar, unsigned x, unsigned& nloc, unsigned& nx) {
    const unsigned G = gridDim.x * gridDim.y * gridDim.z;
    unsigned sum, cnt, mine, sp = 0u;
    for (;;) {
        sum = 0u; cnt = 0u; mine = 0u;
#pragma unroll
        for (unsigned j = 0; j < 16; ++j) { const unsigned c = xb_ld(&bar[XB_XCNT(j)]); sum += c; cnt += (c > 0u) ? 1u : 0u; mine = (j == x) ? c : mine; }
        if (sum == G) break;
        __builtin_amdgcn_s_sleep(1);
        if ((++sp & 255u) == 0u) { if (xb_ld(&bar[XB_TMO])) break; if (sp > XB_SPIN_CAP) { atomicAdd(&bar[XB_TMO], 1u); break; } }
    }
    nloc = mine > 0u ? mine : 1u; nx = cnt > 0u ? cnt : 1u;
}

__device__ __forceinline__ void xcd_barrier(const XcdBarrier& b) {
    asm volatile("s_waitcnt vmcnt(0)" ::: "memory");
    __syncthreads();
    if (b.wv == 0 && xb_lane() == 0) {
        unsigned* bar = b.bar;
        __builtin_amdgcn_s_waitcnt(0);
        unsigned nloc = b.st[0], nx = b.st[1];
        if (nloc == 0u) { xcd_barrier_complete(bar, b.x, nloc, nx); b.st[0] = nloc; b.st[1] = nx; }
        const unsigned old = xb_add(&bar[XB_XSUB(b.x)], 1u);
        const unsigned gen = old / nloc;
        if (old + 1u == (gen + 1u) * nloc) {
            __builtin_amdgcn_fence(__ATOMIC_RELEASE, "agent");
            asm volatile("s_waitcnt vmcnt(0)" ::: "memory");
            const unsigned og = xb_add(&bar[XB_TOP], 1u);
            const unsigned tg = og / nx;
            if (og + 1u == (tg + 1u) * nx) xb_add(&bar[XB_TOPGEN], 1u);
            else XB_SPIN(xb_ld(&bar[XB_TOPGEN]) == tg, bar);
            __builtin_amdgcn_fence(__ATOMIC_ACQUIRE, "agent");
            xb_add(&bar[XB_XGEN(b.x)], 1u);
            asm volatile("s_waitcnt vmcnt(0)" ::: "memory");
        } else {
            XB_SPIN(xb_ld(&bar[XB_XGEN(b.x)]) == gen, bar);
            __builtin_amdgcn_fence(__ATOMIC_ACQUIRE, "agent");
            asm volatile("s_waitcnt vmcnt(0)" ::: "memory");
        }
    }
    __syncthreads();
}
struct Args {
    const float* in[23]; float* out; unsigned char* ws; int ph_lo, ph_hi;
};
struct Ctx {
    LAS unsigned char* lds; volatile LAS unsigned* MISC; gu32* ctl; unsigned char* ws;
    int tid, lane, wave, vcu, G;
};
template <class T> __device__ __forceinline__ T* wsp(const Ctx& C, size_t off) { return (T*)(C.ws + off); }
__device__ __forceinline__ bf16* proj(const Ctx& C, int j) { return (bf16*)(C.ws + WS_PROJ + (size_t)j * PROJ_STRIDE); }

__device__ __forceinline__ void transpose_item(const float* W, int ldn, int k0, int n0, bf16* WT, int Kdst, int drow0, LAS float* scr, int lane) {
    { const int c4 = lane & 7; const float* src = W + (size_t)(k0 + (lane >> 3)) * ldn + n0 + 4 * c4;
        f32x4 v[8];
#pragma unroll
        for (int i = 0; i < 8; ++i) v[i] = *(const GAS f32x4*)(src + (size_t)(8 * i) * ldn);
#pragma unroll
        for (int i = 0; i < 8; ++i) { LAS float* d = scr + ((lane >> 3) + 8 * i) * 33 + 4 * c4; d[0] = v[i].x; d[1] = v[i].y; d[2] = v[i].z; d[3] = v[i].w; } }
    LDS_WAIT(); asm volatile("" ::: "memory");
    const int c = lane & 7;
#pragma unroll
    for (int j = 0; j < 4; ++j) { const int n = (lane >> 3) + 8 * j; const LAS float* s = scr + (8 * c) * 33 + n;
        u32x4 o; o.x = pk2(s[0 * 33], s[1 * 33]); o.y = pk2(s[2 * 33], s[3 * 33]); o.z = pk2(s[4 * 33], s[5 * 33]); o.w = pk2(s[6 * 33], s[7 * 33]);
        *(GAS u32x4*)(WT + (size_t)(drow0 + n) * Kdst + k0 + 8 * c) = o; }
    LDS_WAIT(); asm volatile("" ::: "memory");
}
__device__ __forceinline__ void layer_weight_items(const Args& A, const Ctx& C, int layer) {
    LAS float* scr = (LAS float*)(C.lds + C.wave * 16384);
    const int gw = C.vcu * NWAVES + C.wave, NGW = C.G * NWAVES;
    const float* win = A.in[2] + (size_t)layer * DM * INC;
    constexpr int I1 = 16 * 160, I2 = 16 * 96, I3 = 3 * 8 * 32, I4 = 16 * 32;
    for (int it = gw; it < I1 + I2 + I3 + I4; it += NGW) {
        int r = it;
        if (r < I1) { const int nb = r % 160, kb = r / 160, nd = nb * 32, j = nd >> 9; const int sc = (j < 4 ? j * 512 : 2056 + (j - 4) * 512) + (nd & 511);
            transpose_item(win, INC, kb * 64, sc, wsp<bf16>(C, WS_WT1), 1024, nd, scr, C.lane); continue; } r -= I1;
        if (r < I2) { const int nb = r % 96, kb = r / 96; transpose_item(win, INC, kb * 64, 5128 + nb * 32, wsp<bf16>(C, WS_WT2), 1024, nb * 32, scr, C.lane); continue; } r -= I2;
        if (r < I3) { const int br = r / 256, q = r % 256, nb = q % 32, kb = q / 32;
            transpose_item(A.in[13] + (size_t)(layer * 3 + br) * 512 * 1024, 1024, kb * 64, nb * 32, wsp<bf16>(C, WS_PT) + (size_t)br * 1024 * 512, 512, nb * 32, scr, C.lane); continue; } r -= I3;
        { const int nb = r % 32, kb = r / 32; transpose_item(A.in[14] + (size_t)layer * 1024 * 1024, 1024, kb * 64, nb * 32, wsp<bf16>(C, WS_WOT), 1024, nb * 32, scr, C.lane); }
    }
}
__device__ __forceinline__ void moe_weight_items(const Args& A, const Ctx& C, int layer) {
    LAS float* scr = (LAS float*)(C.lds + C.wave * 16384);
    const int gw = C.vcu * NWAVES + C.wave, NGW = C.G * NWAVES;
    constexpr int I1 = 32 * 256, I2 = 32 * 128;
    for (int it = gw; it < I1 + I2; it += NGW) {
        int r = it;
        if (r < I1) { const int e = r >> 8, q = r & 255, mat = q >> 7, q2 = q & 127, nb = q2 & 7, kb = q2 >> 3, n0 = nb * 32;
            const float* src = (mat ? A.in[21] : A.in[20]) + (size_t)(layer * 32 + e) * 1024 * 256;
            transpose_item(src, 256, kb * 64, n0, wsp<bf16>(C, WS_W1T), 1024, e * 512 + (n0 >> 7) * 256 + mat * 128 + (n0 & 127), scr, C.lane); continue; } r -= I1;
        { const int e = r >> 7, q = r & 127, nb = q & 31, kb = q >> 5;
            transpose_item(A.in[22] + (size_t)(layer * 32 + e) * 256 * 1024, 1024, kb * 64, nb * 32, wsp<bf16>(C, WS_W2T), 256, e * 1024 + nb * 32, scr, C.lane); }
    }
}
__device__ __forceinline__ void phase0(const Args& A, const Ctx& C, int layer) {
    if (layer < 2) layer_weight_items(A, C, layer);
    __syncthreads();
    LAS float* WG = (LAS float*)(C.lds);
    LAS float* GL = (LAS float*)(C.lds + 32768);
    const int ll = layer < 2 ? layer : 0;
    const float* win = A.in[2] + (size_t)ll * DM * INC;
    if (layer < 2) { for (int i = C.tid; i < 8192; i += NTHR) WG[i] = win[(size_t)(i >> 3) * INC + 2048 + (i & 7)]; }
    __syncthreads();
    const float* g1 = A.in[1] + ll * 1024; const float* gb = A.in[5] + ll * 8;
    const void* xsrc = (layer == 0) ? (const void*)A.in[0] : (const void*)wsp<bf16>(C, WS_XB1); const bool xbf = layer > 0;
    const int* tokp = wsp<int>(C, WS_TOKP); const float* tokw = wsp<float>(C, WS_TOKW);
    const bf16* osl = wsp<bf16>(C, WS_OSL); bf16* hb = wsp<bf16>(C, WS_HB);
    for (int item = C.vcu; item < NTOK / 64; item += C.G) {
        const int row0 = item * 64;
        f32x4 vnx[4];
        {
#pragma unroll
            for (int j = 0; j < 4; ++j) vnx[j] = ldrow4(xsrc, xbf, (size_t)(row0 + C.wave * 8), C.lane + 64 * j); }
        for (int i = 0; i < 8; ++i) {
            const int rl = C.wave * 8 + i, row = row0 + rl;
            f32x4 v[4];
#pragma unroll
            for (int j = 0; j < 4; ++j) v[j] = vnx[j];
            if (i < 7) {
#pragma unroll
                for (int j = 0; j < 4; ++j) vnx[j] = ldrow4(xsrc, xbf, (size_t)(row + 1), C.lane + 64 * j); }
            if (layer > 0) {
                const float w0 = tokw[row * 2], w1 = tokw[row * 2 + 1];
                const size_t p0 = (size_t)tokp[row * 2], p1 = (size_t)tokp[row * 2 + 1];
                const GAS u32x2* o0 = (const GAS u32x2*)(osl + p0 * DM) + C.lane; const GAS u32x2* o1 = (const GAS u32x2*)(osl + p1 * DM) + C.lane;
#pragma unroll
                for (int j = 0; j < 4; ++j) { const u32x2 a = o0[64 * j], b = o1[64 * j];
                    v[j].x += w0 * bflo(a.x) + w1 * bflo(b.x); v[j].y += w0 * bfhi(a.x) + w1 * bfhi(b.x); v[j].z += w0 * bflo(a.y) + w1 * bflo(b.y); v[j].w += w0 * bfhi(a.y) + w1 * bfhi(b.y); }
                if (layer == 2) { GAS f32x4* xo = (GAS f32x4*)(A.out + (size_t)row * DM) + C.lane;
#pragma unroll
                    for (int j = 0; j < 4; ++j) xo[64 * j] = v[j]; }
                else { GAS u32x2* xo = (GAS u32x2*)((bf16*)A.out + (size_t)row * DM) + C.lane;
#pragma unroll
                    for (int j = 0; j < 4; ++j) { u32x2 o; o.x = pk2(v[j].x, v[j].y); o.y = pk2(v[j].z, v[j].w); xo[64 * j] = o; } }
            }
            if (layer < 2) {
                float ss = 0.f;
#pragma unroll
                for (int j = 0; j < 4; ++j) ss += (v[j].x * v[j].x + v[j].y * v[j].y) + (v[j].z * v[j].z + v[j].w * v[j].w);
                const float rstd = rsqrtf(wave_sum(ss) * (1.f / DM) + EPS);
                float gd[8];
#pragma unroll
                for (int q = 0; q < 8; ++q) gd[q] = 0.f;
                GAS u32x2* ho = (GAS u32x2*)(hb + (size_t)row * DM) + C.lane;
#pragma unroll
                for (int j = 0; j < 4; ++j) { const f32x4 g = ((const GAS f32x4*)g1)[64 * j + C.lane];
                    const f32x4 h = {v[j].x * rstd * g.x, v[j].y * rstd * g.y, v[j].z * rstd * g.z, v[j].w * rstd * g.w};
                    u32x2 o; o.x = pk2(h.x, h.y); o.y = pk2(h.z, h.w); ho[64 * j] = o;
                    const int k = 256 * j + 4 * C.lane;
#pragma unroll
                    for (int c = 0; c < 4; ++c) { const f32x4 wa = *(const LAS f32x4*)(WG + (k + c) * 8), wb = *(const LAS f32x4*)(WG + (k + c) * 8 + 4);
                        gd[0] += h[c] * wa.x; gd[1] += h[c] * wa.y; gd[2] += h[c] * wa.z; gd[3] += h[c] * wa.w; gd[4] += h[c] * wb.x; gd[5] += h[c] * wb.y; gd[6] += h[c] * wb.z; gd[7] += h[c] * wb.w; } }
                float gv;
                { const bool b1 = C.lane & 1, b2 = C.lane & 2, b3 = C.lane & 4; float a4[4], a2[2];
#pragma unroll
                    for (int q = 0; q < 4; ++q) { const float mine = b1 ? gd[q + 4] : gd[q], send = b1 ? gd[q] : gd[q + 4]; a4[q] = mine + xor_shfl<1>(send); }
#pragma unroll
                    for (int q = 0; q < 2; ++q) { const float mine = b2 ? a4[q + 2] : a4[q], send = b2 ? a4[q] : a4[q + 2]; a2[q] = mine + xor_shfl<2>(send); }
                    { const float mine = b3 ? a2[1] : a2[0], send = b3 ? a2[0] : a2[1]; gv = mine + xor_shfl<4>(send); }
                    gv += xor_shfl<8>(gv); gv += xor_shfl<16>(gv); gv = pair_sum(gv); }
                if (C.lane < 8) { const int q = 4 * (C.lane & 1) + 2 * ((C.lane >> 1) & 1) + ((C.lane >> 2) & 1);
                    const float val = gv + gb[q];
                    float r;
                    if (q < 4) r = 15.f * tanhf(val * (1.f / 15.f));
                    else r = (val < 0.f) ? (val - log1pf(expf(val))) : -log1pf(expf(-val));
                    GL[rl * 8 + q] = r; }
            }
        }
        if (layer < 2) {
            __syncthreads();
            if (C.wave < 4) { const int hh = C.wave, t = C.lane; const float lf = GL[t * 8 + 4 + hh], ig = GL[t * 8 + hh];
                float b = lf;
#pragma unroll
                for (int o = 1; o < 64; o <<= 1) { const float u = lane_up(b, t, o); if (t >= o) b += u; }
                const float bl = lane_get(b, 63); const float gm = wave_max(bl - b + ig);
                wsp<float>(C, WS_BC)[(size_t)(row0 + t) * 4 + hh] = b; wsp<float>(C, WS_IG)[(size_t)(row0 + t) * 4 + hh] = ig;
                if (t == 0) { const int bb = row0 / SEQ, c = (row0 % SEQ) / 64; wsp<float>(C, WS_BLAST)[(bb * 4 + hh) * 128 + c] = bl; wsp<float>(C, WS_GMAX)[(bb * 4 + hh) * 128 + c] = gm; } }
            __syncthreads();
        }
    }
}
__device__ __forceinline__ void mscan(const Ctx& C, int bh, LAS float* MV) {
    const float* bl = wsp<float>(C, WS_BLAST) + bh * 128; const float* gm = wsp<float>(C, WS_GMAX) + bh * 128; const int i = C.lane;
    const float a0 = bl[2 * i], g0 = gm[2 * i], a1 = bl[2 * i + 1], g1 = gm[2 * i + 1];
    float Aa = a0 + a1, Gg = fmaxf(g0 + a1, g1);
#pragma unroll
    for (int o = 1; o < 64; o <<= 1) { const float Ap = lane_up(Aa, i, o), Gp = lane_up(Gg, i, o); if (i >= o) { Gg = fmaxf(Gp + Aa, Gg); Aa = Ap + Aa; } }
    float Ax = lane_up(Aa, i, 1), Gx = lane_up(Gg, i, 1); if (i == 0) { Ax = 0.f; Gx = -INFINITY; }
    if (i == 0) MV[0] = 0.f;
    MV[2 * i + 1] = fmaxf(Ax + a0, fmaxf(Gx + a0, g0));
    MV[2 * i + 2] = fmaxf(Aa, Gg);
}
template <int ST> __device__ __forceinline__ void stage_conv(const Ctx& C, const bf16* src  , int row0, int seq0, const float* cw  , const float* cb, const LAS float* rs, float sc, LAS unsigned char* dst) {
#pragma unroll
    for (int i = 0; i < 2; ++i) { const int task = C.tid + NTHR * i, t = task >> 4, ch = task & 15;
        float y[8];
        { const f32x4 b0 = *(const GAS f32x4*)(cb + ch * 8), b1 = *(const GAS f32x4*)(cb + ch * 8 + 4); y[0] = b0.x; y[1] = b0.y; y[2] = b0.z; y[3] = b0.w; y[4] = b1.x; y[5] = b1.y; y[6] = b1.z; y[7] = b1.w; }
#pragma unroll
        for (int j = 0; j < 4; ++j) { const int row = row0 + t - j;
            if (row >= seq0) { const u32x4 u = *(const GAS u32x4*)(src + (size_t)row * 512 + ch * 8);
                const f32x4 w0 = *(const GAS f32x4*)(cw + j * 1024 + ch * 8), w1 = *(const GAS f32x4*)(cw + j * 1024 + ch * 8 + 4);
                y[0] += w0.x * bflo(u.x); y[1] += w0.y * bfhi(u.x); y[2] += w0.z * bflo(u.y); y[3] += w0.w * bfhi(u.y); y[4] += w1.x * bflo(u.z); y[5] += w1.y * bfhi(u.z); y[6] += w1.z * bflo(u.w); y[7] += w1.w * bfhi(u.w); } }
        const float s = (rs ? rs[t] : 1.f) * sc;
#pragma unroll
        for (int q = 0; q < 8; ++q) y[q] = y[q] * sigm(y[q]) * s;
        u32x4 o; o.x = pk2(y[0], y[1]); o.y = pk2(y[2], y[3]); o.z = pk2(y[4], y[5]); o.w = pk2(y[6], y[7]);
        *(LAS u32x4*)(dst + t * (ST * 2) + ch * 16) = o; }
}
template <int ST> __device__ __forceinline__ void stage_raw128(const Ctx& C, const bf16* src  , int row0, LAS unsigned char* dst) {
#pragma unroll
    for (int i = 0; i < 2; ++i) { const int task = C.tid + NTHR * i, t = task >> 4, ch = task & 15;
        *(LAS u32x4*)(dst + t * (ST * 2) + ch * 16) = *(const GAS u32x4*)(src + (size_t)(row0 + t) * 512 + ch * 8); }
}
__device__ __forceinline__ const LAS unsigned char* tr_addr(const LAS unsigned char* base, int stride_b, int r0, int c0, int lane) {
    return base + (r0 + ((lane & 15) >> 2)) * stride_b + (c0 + 16 * ((lane >> 4) & 1) + 4 * (lane & 3)) * 2;
}
constexpr int ML_MV = 0, ML_BC = 1024, ML_GS = 1280, ML_RS = 1536, ML_NV = 2048, ML_SC = 2560, ML_KT = 4608, ML_VT = ML_KT + 20480, ML_QT = ML_VT + 20480, ML_CT = ML_QT + 17408, ML_END = ML_CT + 34816, ML_OUT = ML_KT;
static_assert(ML_END <= RING_BYTES, "mLSTM LDS map");
__device__ __forceinline__ void mlstm_u_item(const Args& A, const Ctx& C0, int layer, int bh, int c, bool scan) {
    Ctx C = C0; asm volatile("" : "+v"(C.tid), "+v"(C.lane));
    LAS float* MV = (LAS float*)(C.lds + ML_MV); LAS float* RS = (LAS float*)(C.lds + ML_RS);
    LAS unsigned char* KT = C.lds + ML_KT; LAS unsigned char* VT = C.lds + ML_VT;
    const int b = bh >> 2, hh = bh & 3, row0 = b * SEQ + c * 64, seq0 = b * SEQ, lane = C.lane, hi = lane >> 5, r32 = lane & 31;
    if (scan) { if (C.wave == 0) mscan(C, bh, MV); __syncthreads(); }
    if (C.tid < 64) { const float bl = wsp<float>(C, WS_BLAST)[bh * 128 + c];
        RS[C.tid] = __expf(bl - wsp<float>(C, WS_BC)[(size_t)(row0 + C.tid) * 4 + hh] + wsp<float>(C, WS_IG)[(size_t)(row0 + C.tid) * 4 + hh] - MV[c + 1]); }
    __syncthreads();
    stage_conv<160>(C, proj(C, PJ_AK) + hh * 128, row0, seq0, A.in[3] + layer * 4096 + 512 + hh * 128, A.in[4] + layer * 1024 + 512 + hh * 128, RS, 0.08838834764831845f, KT);
    stage_raw128<160>(C, proj(C, PJ_AV) + hh * 128, row0, VT);
    __syncthreads();
    const int eb = C.wave >> 1, db0 = (C.wave & 1) * 2;
    f32x16 acc0 = {}, acc1 = {};
#pragma unroll
    for (int st = 0; st < 4; ++st) { const int t0 = 16 * st + 8 * hi;
        const bf16x8 af = cat8(tr16(tr_addr(VT, 320, t0, 32 * eb, lane)), tr16(tr_addr(VT, 320, t0 + 4, 32 * eb, lane)));
        const bf16x8 b0 = cat8(tr16(tr_addr(KT, 320, t0, 32 * db0, lane)), tr16(tr_addr(KT, 320, t0 + 4, 32 * db0, lane)));
        const bf16x8 b1 = cat8(tr16(tr_addr(KT, 320, t0, 32 * db0 + 32, lane)), tr16(tr_addr(KT, 320, t0 + 4, 32 * db0 + 32, lane)));
        acc0 = MFMA32(af, b0, acc0); acc1 = MFMA32(af, b1, acc1); }
    bf16* U = wsp<bf16>(C, WS_HB) + (size_t)(bh * 128 + c) * 16384;
    if (C.tid < 128) { float s = 0.f;
        for (int t = 0; t < 64; ++t) s += bflo((unsigned)*(const LAS bf16*)(KT + t * 320 + C.tid * 2));
        wsp<float>(C, WS_NUC)[(size_t)(bh * 128 + c) * 128 + C.tid] = s; }
    __syncthreads();
    { LAS bf16* US = (LAS bf16*)(C.lds + ML_KT);
#pragma unroll
        for (int r = 0; r < 16; ++r) { const int e = 32 * eb + crow(r, hi);
            US[e * 136 + 32 * db0 + r32] = (bf16)(pk2(acc0[r], 0.f) & 0xffffu); US[e * 136 + 32 * db0 + 32 + r32] = (bf16)(pk2(acc1[r], 0.f) & 0xffffu); }
        __syncthreads();
#pragma unroll
        for (int i = 0; i < 4; ++i) { const int task = C.tid + NTHR * i, e = task >> 4, ch = task & 15; *(GAS u32x4*)(U + e * 128 + ch * 8) = *(const LAS u32x4*)(US + e * 136 + ch * 8); } }
    __syncthreads();
}
__device__ __forceinline__ void qknorm_rows(const Args& A, const Ctx& C, int layer) {
    const int gw = C.vcu * NWAVES + C.wave, NGW = C.G * NWAVES, lane = C.lane;
    for (int it = gw; it < NTOK * 4; it += NGW) { const int which = it & 3, row = it >> 2;
        bf16* p = proj(C, which == 0 ? PJ_BQ : which == 1 ? PJ_BK : which == 2 ? PJ_CQ : PJ_CK) + (size_t)row * 512 + lane * 8;
        const float* g = (which < 2 ? A.in[7] : A.in[9]) + layer * 128 + (which & 1) * 64 + (lane & 7) * 8;
        const u32x4 u = *(const GAS u32x4*)p; const f32x4 g0 = *(const GAS f32x4*)g, g1 = *(const GAS f32x4*)(g + 4);
        float v[8] = {bflo(u.x), bfhi(u.x), bflo(u.y), bfhi(u.y), bflo(u.z), bfhi(u.z), bflo(u.w), bfhi(u.w)}; float ss = 0.f;
#pragma unroll
        for (int i = 0; i < 8; ++i) ss += v[i] * v[i];
        ss += xor_shfl<1>(ss); ss += xor_shfl<2>(ss); ss += xor_shfl<4>(ss);
        const float rinv = rsqrtf(ss * (1.f / 64.f) + EPS) * ((which & 1) ? 1.f : 0.125f * LOG2E);
        const u32x4 o = {pk2(v[0] * rinv * g0.x, v[1] * rinv * g0.y), pk2(v[2] * rinv * g0.z, v[3] * rinv * g0.w), pk2(v[4] * rinv * g1.x, v[5] * rinv * g1.y), pk2(v[6] * rinv * g1.z, v[7] * rinv * g1.w)};
        *(GAS u32x4*)p = o; }
}
__device__ __forceinline__ void mlstm_scan(const Ctx& C) {
    LAS float* MV = (LAS float*)(C.lds + ML_MV); LAS float* DEC = (LAS float*)(C.lds + ML_RS);
    for (int w = C.vcu; w < 256; w += C.G) { const int bh = w >> 4, sl = w & 15;
        if (C.wave == 0) mscan(C, bh, MV);
        __syncthreads();
        if (C.tid < 128) DEC[C.tid] = __expf(wsp<float>(C, WS_BLAST)[bh * 128 + C.tid] + MV[C.tid] - MV[C.tid + 1]);
        __syncthreads();
        GAS unsigned* p = (GAS unsigned*)(wsp<unsigned>(C, WS_HB) + (size_t)bh * 128 * 8192 + sl * 512 + C.tid);
        float s0 = 0.f, s1 = 0.f;
        for (int c0 = 0; c0 < 128; c0 += 16) { unsigned u[16];
#pragma unroll
            for (int q = 0; q < 16; ++q) u[q] = p[(size_t)(c0 + q) * 8192];
#pragma unroll
            for (int q = 0; q < 16; ++q) { p[(size_t)(c0 + q) * 8192] = pk2(s0, s1); const float d = DEC[c0 + q]; s0 = d * s0 + bflo(u[q]); s1 = d * s1 + bfhi(u[q]); } }
        if (sl == 0 && C.tid < 128) { GAS float* np = (GAS float*)(wsp<float>(C, WS_NUC) + (size_t)bh * 128 * 128 + C.tid); float s = 0.f;
            for (int c0 = 0; c0 < 128; c0 += 16) { float u[16];
#pragma unroll
                for (int q = 0; q < 16; ++q) u[q] = np[(c0 + q) * 128];
#pragma unroll
                for (int q = 0; q < 16; ++q) { np[(c0 + q) * 128] = s; s = DEC[c0 + q] * s + u[q]; } } }
        __syncthreads();
    }
}
__device__ __forceinline__ void mlstm_out_item(const Args& A, const Ctx& C0, int layer, int bh, int c, bool scan, bf16* habase = nullptr  ) {
    Ctx C = C0; asm volatile("" : "+v"(C.tid), "+v"(C.lane));
    LAS float* MV = (LAS float*)(C.lds + ML_MV); LAS float* BC = (LAS float*)(C.lds + ML_BC); LAS float* GS = (LAS float*)(C.lds + ML_GS); LAS float* NV = (LAS float*)(C.lds + ML_NV);
    LAS float* SC = (LAS float*)(C.lds + ML_SC) + C.wave * 64;
    LAS unsigned char* KT = C.lds + ML_KT; LAS unsigned char* VT = C.lds + ML_VT; LAS unsigned char* QT = C.lds + ML_QT; LAS unsigned char* CT = C.lds + ML_CT; LAS float* OUT = (LAS float*)(C.lds + ML_OUT);
    const int b = bh >> 2, hh = bh & 3, row0 = b * SEQ + c * 64, seq0 = b * SEQ, lane = C.lane, hi = lane >> 5, r32 = lane & 31;
    if (scan && C.wave == 0) mscan(C, bh, MV);
    if (C.tid >= 64 && C.tid < 128) { const int t = C.tid - 64; const float bc = wsp<float>(C, WS_BC)[(size_t)(row0 + t) * 4 + hh]; BC[t] = bc; GS[t] = wsp<float>(C, WS_IG)[(size_t)(row0 + t) * 4 + hh] - bc; }
    if (C.tid >= 128 && C.tid < 256) NV[C.tid - 128] = wsp<float>(C, WS_NUC)[(size_t)(bh * 128 + c) * 128 + C.tid - 128];
    stage_conv<136>(C, proj(C, PJ_AQ) + hh * 128, row0, seq0, A.in[3] + layer * 4096 + hh * 128, A.in[4] + layer * 1024 + hh * 128, nullptr, 1.f, QT);
    stage_conv<136>(C, proj(C, PJ_AK) + hh * 128, row0, seq0, A.in[3] + layer * 4096 + 512 + hh * 128, A.in[4] + layer * 1024 + 512 + hh * 128, nullptr, 0.08838834764831845f, KT);
    stage_raw128<160>(C, proj(C, PJ_AV) + hh * 128, row0, VT);
    { const bf16* cs = wsp<bf16>(C, WS_HB) + (size_t)(bh * 128 + c) * 16384;
#pragma unroll
        for (int i = 0; i < 4; ++i) { const int task = C.tid + NTHR * i, e = task >> 4, ch = task & 15; *(LAS u32x4*)(CT + e * 272 + ch * 16) = *(const GAS u32x4*)(cs + e * 128 + ch * 8); } }
    __syncthreads();
    const float mc = MV[c]; const int lb = C.wave >> 2, cb = C.wave & 3, lq = 32 * lb + r32; const float bl = BC[lq];
    bf16x8 qf[8];
#pragma unroll
    for (int st = 0; st < 8; ++st) qf[st] = *(const LAS bf16x8*)(QT + lq * 272 + (16 * st + 8 * hi) * 2);
    f32x16 p0 = {}, p1 = {};
#pragma unroll
    for (int st = 0; st < 8; ++st) p0 = MFMA32(*(const LAS bf16x8*)(KT + r32 * 272 + (16 * st + 8 * hi) * 2), qf[st], p0);
    if (lb == 1) {
#pragma unroll
        for (int st = 0; st < 8; ++st) p1 = MFMA32(*(const LAS bf16x8*)(KT + (32 + r32) * 272 + (16 * st + 8 * hi) * 2), qf[st], p1); }
    f32x16 d0, d1; float mt = bl + mc;
#pragma unroll
    for (int r = 0; r < 16; ++r) { const int s = crow(r, hi); d0[r] = (s <= lq) ? bl + GS[s] : -INFINITY; mt = fmaxf(mt, d0[r]); }
#pragma unroll
    for (int r = 0; r < 16; ++r) { const int s = 32 + crow(r, hi); d1[r] = (lb == 1 && s <= lq) ? bl + GS[s] : -INFINITY; mt = fmaxf(mt, d1[r]); }
    mt = pair_max(mt);
    float rs = 0.f;
#pragma unroll
    for (int r = 0; r < 16; ++r) { p0[r] *= __expf(d0[r] - mt); p1[r] *= __expf(d1[r] - mt); rs += p0[r] + p1[r]; }
    rs = pair_sum(rs);
    float qn = 0.f;
#pragma unroll
    for (int st = 0; st < 8; ++st) { const f32x4 n0 = *(const LAS f32x4*)(NV + 16 * st + 8 * hi), n1 = *(const LAS f32x4*)(NV + 16 * st + 8 * hi + 4); const u32x4 q = __builtin_bit_cast(u32x4, qf[st]);
        qn += bflo(q.x) * n0.x + bfhi(q.x) * n0.y + bflo(q.y) * n0.z + bfhi(q.y) * n0.w + bflo(q.z) * n1.x + bfhi(q.z) * n1.y + bflo(q.w) * n1.z + bfhi(q.w) * n1.w; }
    qn = pair_sum(qn);
    const float wi = __expf(bl + mc - mt), den = wi * qn + rs, dn = fmaxf(fabsf(den), __expf(-mt));
    SC[r32] = wi / dn; SC[32 + r32] = 1.f / dn;
    f32x16 acc1 = {}, acc2 = {};
#define PKF(P, B) (bf16x8)__builtin_bit_cast(bf16x8, ((u32x4){pk2(P[B], P[B + 1]), pk2(P[B + 2], P[B + 3]), pk2(P[B + 4], P[B + 5]), pk2(P[B + 6], P[B + 7])}))
#pragma unroll
    for (int s2 = 0; s2 < 2; ++s2) { const int k0 = 16 * s2;
        const bf16x8 vf = cat8(tr16(tr_addr(VT, 320, k0 + 4 * hi, 32 * cb, lane)), tr16(tr_addr(VT, 320, k0 + 8 + 4 * hi, 32 * cb, lane)));
        acc2 = MFMA32(s2 == 0 ? PKF(p0, 0) : PKF(p0, 8), vf, acc2); }
    if (lb == 1) {
#pragma unroll
        for (int s2 = 0; s2 < 2; ++s2) { const int k0 = 32 + 16 * s2;
            const bf16x8 vf = cat8(tr16(tr_addr(VT, 320, k0 + 4 * hi, 32 * cb, lane)), tr16(tr_addr(VT, 320, k0 + 8 + 4 * hi, 32 * cb, lane)));
            acc2 = MFMA32(s2 == 0 ? PKF(p1, 0) : PKF(p1, 8), vf, acc2); } }
#undef PKF
#pragma unroll
    for (int st = 0; st < 8; ++st) acc1 = MFMA32(qf[st], *(const LAS bf16x8*)(CT + (32 * cb + r32) * 272 + (16 * st + 8 * hi) * 2), acc1);
    __syncthreads();
#pragma unroll
    for (int r = 0; r < 16; ++r) { const int l_ = crow(r, hi); OUT[(32 * lb + l_) * 132 + 32 * cb + r32] = SC[l_] * acc1[r] + SC[32 + l_] * acc2[r]; }
    __syncthreads();
    { const int row = C.tid >> 3, seg = C.tid & 7; float v[16]; float ss = 0.f;
#pragma unroll
        for (int q = 0; q < 4; ++q) { const f32x4 x = *(const LAS f32x4*)(OUT + row * 132 + seg * 16 + 4 * q); v[4 * q] = x.x; v[4 * q + 1] = x.y; v[4 * q + 2] = x.z; v[4 * q + 3] = x.w; ss += (x.x * x.x + x.y * x.y) + (x.z * x.z + x.w * x.w); }
        ss += xor_shfl<1>(ss); ss += xor_shfl<2>(ss); ss += xor_shfl<4>(ss);
        const float rinv = rsqrtf(ss * (1.f / 128.f) + EPS);
        const float* gn = A.in[6] + layer * 512 + hh * 128 + seg * 16;
        const bf16* ao = proj(C, PJ_AO) + (size_t)(row0 + row) * 512 + hh * 128 + seg * 16;
        bf16* ha = (habase ? habase : proj(C, PJ_AV)) + (size_t)(row0 + row) * 512 + hh * 128 + seg * 16;
#pragma unroll
        for (int q = 0; q < 2; ++q) { const u32x4 a = *(const GAS u32x4*)(ao + 8 * q); const f32x4 g0 = *(const GAS f32x4*)(gn + 8 * q), g1 = *(const GAS f32x4*)(gn + 8 * q + 4); const float* vv = v + 8 * q;
            u32x4 o; o.x = pk2(vv[0] * rinv * g0.x * sigm(bflo(a.x)), vv[1] * rinv * g0.y * sigm(bfhi(a.x))); o.y = pk2(vv[2] * rinv * g0.z * sigm(bflo(a.y)), vv[3] * rinv * g0.w * sigm(bfhi(a.y)));
            o.z = pk2(vv[4] * rinv * g1.x * sigm(bflo(a.z)), vv[5] * rinv * g1.y * sigm(bfhi(a.z))); o.w = pk2(vv[6] * rinv * g1.z * sigm(bflo(a.w)), vv[7] * rinv * g1.w * sigm(bfhi(a.w)));
            *(GAS u32x4*)(ha + 8 * q) = o; } }
    __syncthreads();
}
constexpr int AT_TAB = 0, AT_SCR = 3072, AT_K = 5120;
template <int DV, bool ISC> __device__ __forceinline__ void attn_unit(const Args& A, const Ctx& C0, int layer, int b, int hs, int qblk, bf16* obase = nullptr  ) {
    Ctx C = C0; asm volatile("" : "+v"(C.tid), "+v"(C.lane));
    constexpr int KSTB = 144, VSTB = 2 * DV + 64, KB = 64 * KSTB, VB = 64 * VSTB, AT_V = AT_K + 4 * KB, NBLK = DV / 32;
    static_assert(AT_V + 4 * VB <= RING_BYTES, "attention LDS map");
    LAS float* TAB = (LAS float*)(C.lds + AT_TAB); LAS float* SCR = (LAS float*)(C.lds + AT_SCR) + C.wave * 64;
    const int lane = C.lane, hi = lane >> 5, r32 = lane & 31, tid = C.tid;
    const bf16 *Qp, *Kp, *Vp; bf16* Op; int pitchO; const float *gq, *gk; int hbias;
    if (ISC) { const int h = hs >> 1, wh = hs & 1; Qp = proj(C, PJ_CQ) + h * 128 + wh * 64; Kp = proj(C, PJ_CK) + h * 128 + wh * 64; Vp = proj(C, PJ_CV) + h * 128;
        Op = wsp<bf16>(C, WS_O12) + h * 256 + wh * 128; pitchO = 1024; gq = A.in[9] + layer * 128; gk = gq + 64; hbias = h; }
    else { Qp = proj(C, PJ_BQ) + hs * 64; Kp = proj(C, PJ_BK) + hs * 64; Vp = proj(C, PJ_BV) + hs * 64; Op = (obase ? obase : proj(C, PJ_BQ)) + hs * 64; pitchO = 512; gq = A.in[7] + layer * 128; gk = gq + 64; hbias = hs; }
    const size_t rowb = (size_t)b * SEQ;
    const int qs0 = qblk * 256 + C.wave * 32;
    for (int i = tid; i < 768; i += NTHR) { const int d = 703 - i; float v;
        if (ISC) { const int n = d < 0 ? -d : d; int bk = n < 8 ? n : n < 15 ? 8 : n < 27 ? 9 : n < 50 ? 10 : n < 91 ? 11 : n < 166 ? 12 : n < 305 ? 13 : n < 559 ? 14 : 15; if (d < 0) bk += 16; v = A.in[12][bk * 4 + hbias]; }
        else { const int dc = d < -256 ? -256 : d > 256 ? 256 : d; v = A.in[8][(size_t)layer * 513 * 8 + (dc + 256) * 8 + hbias]; }
        TAB[i] = v * LOG2E; }
    float MB;
    { const float gqm = wave_max(fabsf(gq[lane])), gkm = wave_max(fabsf(gk[lane]));
        float bm = 0.f;
        if (ISC) { bm = (lane < 32) ? fabsf(A.in[12][lane * 4 + hbias]) : 0.f; }
        else { for (int i = lane; i < 513; i += 64) bm = fmaxf(bm, fabsf(A.in[8][(size_t)layer * 513 * 8 + i * 8 + hbias])); }
        bm = wave_max(bm);
        MB = 64.f * (0.125f * LOG2E) * gqm * gkm * 1.02f + bm * LOG2E; }
    const float t15 = (ISC ? A.in[12][15 * 4 + hbias] * LOG2E : 0.f) - MB;
    bf16x8 qf[4];
    { float qv[32]; float ss = 0.f; const bf16* qrow = Qp + (rowb + qs0 + r32) * 512 + 8 * hi;
#pragma unroll
        for (int st = 0; st < 4; ++st) { const u32x4 u = *(const GAS u32x4*)(qrow + 16 * st);
            qv[8 * st] = bflo(u.x); qv[8 * st + 1] = bfhi(u.x); qv[8 * st + 2] = bflo(u.y); qv[8 * st + 3] = bfhi(u.y); qv[8 * st + 4] = bflo(u.z); qv[8 * st + 5] = bfhi(u.z); qv[8 * st + 6] = bflo(u.w); qv[8 * st + 7] = bfhi(u.w); }
#pragma unroll
        for (int i = 0; i < 32; ++i) ss += qv[i] * qv[i];
        ss = pair_sum(ss);
        const float rinv = rsqrtf(ss * (1.f / 64.f) + EPS) * (0.125f * LOG2E);
#pragma unroll
        for (int st = 0; st < 4; ++st) { const f32x4 g0 = *(const GAS f32x4*)(gq + 16 * st + 8 * hi) * *(const GAS f32x4*)(gk + 16 * st + 8 * hi), g1 = *(const GAS f32x4*)(gq + 16 * st + 8 * hi + 4) * *(const GAS f32x4*)(gk + 16 * st + 8 * hi + 4); const float* q = qv + 8 * st;
            const u32x4 o = {pk2(q[0] * rinv * g0.x, q[1] * rinv * g0.y), pk2(q[2] * rinv * g0.z, q[3] * rinv * g0.w), pk2(q[4] * rinv * g1.x, q[5] * rinv * g1.y), pk2(q[6] * rinv * g1.z, q[7] * rinv * g1.w)};
            qf[st] = __builtin_bit_cast(bf16x8, o); } }
    const int krow = tid >> 3, kch = tid & 7;
    const int jhi = qblk * 4 + 3, jlo = ISC ? 0 : (qblk * 4 - 8 < 0 ? 0 : qblk * 4 - 8), cqw = qblk * 4 + (C.wave >> 1);
    const bf16* ksrc = Kp + (rowb + krow) * 512 + kch * 8;
    u32x4 kregA, kregB, vregA[NBLK / 2], vregB[NBLK / 2];
#define AT_LOADT(j, KR, VR) do { KR = *(const GAS u32x4*)(ksrc + (size_t)(j) * 64 * 512); \
        if (DV == 128) { _Pragma("unroll") for (int i_ = 0; i_ < 2; ++i_) { const int idx = tid + NTHR * i_; VR[i_] = *(const GAS u32x4*)(Vp + (rowb + (size_t)(j) * 64 + (idx >> 4)) * 512 + (idx & 15) * 8); } } \
        else VR[0] = *(const GAS u32x4*)(Vp + (rowb + (size_t)(j) * 64 + krow) * 512 + kch * 8); } while (0)
    AT_LOADT(jlo, kregA, vregA); AT_LOADT(jlo + 1, kregB, vregB);
    float l = 0.f; f32x16 o[NBLK];
#pragma unroll
    for (int nb = 0; nb < NBLK; ++nb) o[nb] = f32x16{};
#define AT_VLOAD(F, nb_) do { _Pragma("unroll") for (int ks_ = 0; ks_ < 4; ++ks_) { F[2 * ks_] = tr16(vb_ + (16 * ks_) * VSTB + (nb_) * 64); F[2 * ks_ + 1] = tr16(vb_ + (16 * ks_ + 8) * VSTB + (nb_) * 64); } } while (0)
#define AT_STAGE(buf, KR, VR) do { \
        LAS unsigned char* KT = C.lds + AT_K + (buf) * KB; LAS unsigned char* VT = C.lds + AT_V + (buf) * VB; \
        { float kv[8] = {bflo(KR.x), bfhi(KR.x), bflo(KR.y), bfhi(KR.y), bflo(KR.z), bfhi(KR.z), bflo(KR.w), bfhi(KR.w)}; float ss = 0.f; \
            _Pragma("unroll") for (int i = 0; i < 8; ++i) ss += kv[i] * kv[i]; \
            ss += xor_shfl<1>(ss); ss += xor_shfl<2>(ss); ss += xor_shfl<4>(ss); \
            const float rinv = rsqrtf(ss * (1.f / 64.f) + EPS); \
            const u32x4 w = {pk2(kv[0] * rinv, kv[1] * rinv), pk2(kv[2] * rinv, kv[3] * rinv), pk2(kv[4] * rinv, kv[5] * rinv), pk2(kv[6] * rinv, kv[7] * rinv)}; \
            *(LAS u32x4*)(KT + krow * KSTB + kch * 16) = w; } \
        if (DV == 128) { _Pragma("unroll") for (int i_ = 0; i_ < 2; ++i_) { const int idx = tid + NTHR * i_; *(LAS u32x4*)(VT + (idx >> 4) * VSTB + (idx & 15) * 16) = VR[i_]; } } \
        else *(LAS u32x4*)(VT + krow * VSTB + kch * 16) = VR[0]; \
    } while (0)
#define AT_COMP(j, buf) do { \
        LAS unsigned char* KT = C.lds + AT_K + (buf) * KB; LAS unsigned char* VT = C.lds + AT_V + (buf) * VB; \
        const bool act = ((j) <= cqw) && (ISC || (j) >= cqw - 8); \
        if (act) { \
            f32x16 p0, p1; \
            const bool far = ISC && (qs0 - (64 * (j) + 63) >= 559); \
            if (far) { _Pragma("unroll") for (int r = 0; r < 16; ++r) { p0[r] = t15; p1[r] = t15; } } \
            else { const LAS float* tp = TAB + (703 - (qs0 + r32) + 64 * (j) + 4 * hi); \
                _Pragma("unroll") for (int r = 0; r < 16; ++r) { p0[r] = tp[(r & 3) + 8 * (r >> 2)] - MB; p1[r] = tp[32 + (r & 3) + 8 * (r >> 2)] - MB; } } \
            { bf16x8 kf[8]; \
                _Pragma("unroll") for (int st = 0; st < 4; ++st) { kf[2 * st] = *(const LAS bf16x8*)(KT + r32 * KSTB + (16 * st + 8 * hi) * 2); kf[2 * st + 1] = *(const LAS bf16x8*)(KT + (32 + r32) * KSTB + (16 * st + 8 * hi) * 2); } \
                __builtin_amdgcn_sched_barrier(0);        \
                _Pragma("unroll") for (int st = 0; st < 4; ++st) { p0 = MFMA32(kf[2 * st], qf[st], p0); p1 = MFMA32(kf[2 * st + 1], qf[st], p1); } } \
            float rs0 = 0.f, rs1 = 0.f, rs2 = 0.f, rs3 = 0.f;        \
            _Pragma("unroll") for (int r = 0; r < 16; r += 2) { p0[r] = __builtin_amdgcn_exp2f(p0[r]); p1[r] = __builtin_amdgcn_exp2f(p1[r]); p0[r + 1] = __builtin_amdgcn_exp2f(p0[r + 1]); p1[r + 1] = __builtin_amdgcn_exp2f(p1[r + 1]); \
                rs0 += p0[r]; rs1 += p1[r]; rs2 += p0[r + 1]; rs3 += p1[r + 1]; } \
            l += (rs0 + rs1) + (rs2 + rs3); \
            bf16x8 pw[4]; \
            pw[0] = PKF(p0, 0); pw[1] = PKF(p0, 8); pw[2] = PKF(p1, 0); pw[3] = PKF(p1, 8); \
            { s16x4 fa[8], fb[8]; const LAS unsigned char* vb_ = tr_addr(VT, VSTB, 4 * hi, 0, lane); \
                AT_VLOAD(fa, 0); \
                _Pragma("unroll") for (int nb = 0; nb < NBLK; nb += 2) { \
                    AT_VLOAD(fb, nb + 1); __builtin_amdgcn_sched_barrier(0); \
                    _Pragma("unroll") for (int ks = 0; ks < 4; ++ks) o[nb] = MFMA32(pw[ks], cat8(fa[2 * ks], fa[2 * ks + 1]), o[nb]); \
                    __builtin_amdgcn_sched_barrier(0); \
                    if (nb + 2 < NBLK) AT_VLOAD(fa, nb + 2); __builtin_amdgcn_sched_barrier(0); \
                    _Pragma("unroll") for (int ks = 0; ks < 4; ++ks) o[nb + 1] = MFMA32(pw[ks], cat8(fb[2 * ks], fb[2 * ks + 1]), o[nb + 1]); \
                    __builtin_amdgcn_sched_barrier(0); } } \
        } } while (0)
#define PKF(P, B) __builtin_bit_cast(bf16x8, ((u32x4){pk2(P[B], P[B + 1]), pk2(P[B + 2], P[B + 3]), pk2(P[B + 4], P[B + 5]), pk2(P[B + 6], P[B + 7])}))
    for (int j = jlo; j <= jhi; j += 2) { const int sb = (((j - jlo) >> 1) & 1) * 2;
        AT_STAGE(sb, kregA, vregA); AT_STAGE(sb + 1, kregB, vregB);
        __syncthreads();
        if (j + 2 <= jhi) { AT_LOADT(j + 2, kregA, vregA); AT_LOADT(j + 3, kregB, vregB); }
        AT_COMP(j, sb); AT_COMP(j + 1, sb + 1); }
#undef PKF
#undef AT_STAGE
#undef AT_COMP
#undef AT_VLOAD
#undef AT_LOADT
    l = pair_sum(l);
    SCR[32 + r32] = 1.f / l;
    bf16* orow = Op + (rowb + qs0) * pitchO;
#pragma unroll
    for (int r = 0; r < 16; ++r) { const int q = crow(r, hi); const float rl = SCR[32 + q];
#pragma unroll
        for (int nb = 0; nb < NBLK; ++nb) ((GAS bf16*)orow)[(size_t)q * pitchO + 32 * nb + r32] = (bf16)(pk2(o[nb][r] * rl, 0.f) & 0xffffu); }
    __syncthreads();
}
__device__ __forceinline__ void phase5(const Args& A, const Ctx& C, int layer) {
    const int gw = C.vcu * NWAVES + C.wave, NGW = C.G * NWAVES, lane = C.lane;
    const float lam_init = 0.8f - 0.6f * __expf(-0.3f * (float)layer);
    const float* cl = A.in[10] + layer * 256;
    const float lam = __expf(wave_sum(cl[lane] * cl[64 + lane])) - __expf(wave_sum(cl[128 + lane] * cl[192 + lane])) + lam_init;
    const float* gs = A.in[11] + layer * 128 + (lane & 15) * 8;
    const f32x4 gs0 = *(const GAS f32x4*)gs, gs1 = *(const GAS f32x4*)(gs + 4);
    const float post = 1.f - lam_init;
    const bf16* o12 = wsp<bf16>(C, WS_O12); bf16* hc = proj(C, PJ_CQ);
    const void* xsrc = (layer == 0) ? (const void*)A.in[0] : (const void*)A.out; const bool xbf = layer > 0;
    const float* g1 = A.in[1] + layer * 1024; bf16* hb = wsp<bf16>(C, WS_HB);
    for (int row = gw; row < NTOK; row += NGW) {
        { const int h = lane >> 4, e0 = (lane & 15) * 8;
            const u32x4 a = *(const GAS u32x4*)(o12 + (size_t)row * 1024 + h * 256 + e0), bq = *(const GAS u32x4*)(o12 + (size_t)row * 1024 + h * 256 + 128 + e0);
            float v[8] = {bflo(a.x) - lam * bflo(bq.x), bfhi(a.x) - lam * bfhi(bq.x), bflo(a.y) - lam * bflo(bq.y), bfhi(a.y) - lam * bfhi(bq.y), bflo(a.z) - lam * bflo(bq.z), bfhi(a.z) - lam * bfhi(bq.z), bflo(a.w) - lam * bflo(bq.w), bfhi(a.w) - lam * bfhi(bq.w)};
            float ss = 0.f;
#pragma unroll
            for (int i = 0; i < 8; ++i) ss += v[i] * v[i];
            ss += xor_shfl<1>(ss); ss += xor_shfl<2>(ss); ss += xor_shfl<4>(ss); ss += xor_shfl<8>(ss);
            const float rinv = rsqrtf(ss * (1.f / 128.f) + EPS) * post;
            const u32x4 o = {pk2(v[0] * rinv * gs0.x, v[1] * rinv * gs0.y), pk2(v[2] * rinv * gs0.z, v[3] * rinv * gs0.w), pk2(v[4] * rinv * gs1.x, v[5] * rinv * gs1.y), pk2(v[6] * rinv * gs1.z, v[7] * rinv * gs1.w)};
            *(GAS u32x4*)(hc + (size_t)row * 512 + h * 128 + e0) = o; }
        { f32x4 v[4]; float ss = 0.f;
#pragma unroll
            for (int j = 0; j < 4; ++j) { v[j] = ldrow4(xsrc, xbf, (size_t)row, lane + 64 * j); ss += (v[j].x * v[j].x + v[j].y * v[j].y) + (v[j].z * v[j].z + v[j].w * v[j].w); }
            const float rstd = rsqrtf(wave_sum(ss) * (1.f / DM) + EPS);
            GAS u32x2* ho = (GAS u32x2*)(hb + (size_t)row * DM) + lane;
#pragma unroll
            for (int j = 0; j < 4; ++j) { const f32x4 g = ((const GAS f32x4*)g1)[64 * j + lane]; u32x2 o; o.x = pk2(v[j].x * rstd * g.x, v[j].y * rstd * g.y); o.y = pk2(v[j].z * rstd * g.z, v[j].w * rstd * g.w); ho[64 * j] = o; } }
    }
}
constexpr int RT_RSTD = 0, RT_HT = 1024, RT_WT = RT_HT + 128 * 68 * 4, RT_LOG = RT_WT + 128 * 40 * 4, RT_HIST = RT_LOG + 64 * 37 * 4, RT_BASE = RT_HIST + 128, RT_SEL = RT_BASE + 128, RT_END = RT_SEL + 64 * 4 * 4, RT_RED = RT_HT;
static_assert(RT_END <= RING_BYTES && 4 * 64 * 40 * 4 <= RT_LOG - RT_HT, "routing LDS map");
__device__ __forceinline__ void phase9(const Args& A, const Ctx& C, int layer, bool dummy = false  ) {
    const size_t doff = dummy ? (476 * MiB) : 0;
    moe_weight_items(A, C, layer);
    __syncthreads();
    LAS float* RSTD = (LAS float*)(C.lds + RT_RSTD); LAS float* HT = (LAS float*)(C.lds + RT_HT); LAS float* WT = (LAS float*)(C.lds + RT_WT); LAS float* LOG = (LAS float*)(C.lds + RT_LOG); LAS float* RED = (LAS float*)(C.lds + RT_RED);
    LAS int* HIST = (LAS int*)(C.lds + RT_HIST); LAS int* BASE = (LAS int*)(C.lds + RT_BASE); LAS int* SEL = (LAS int*)(C.lds + RT_SEL);
    const float* g2 = A.in[15] + layer * 1024; const float* wg = A.in[16] + layer * 4096; const float* bg = A.in[17] + layer * 4; const float* wr = A.in[18] + layer * 32768; const float* br = A.in[19] + layer * 32;
    bf16* h2 = wsp<bf16>(C, dummy ? 128 * MiB : WS_H2); const bf16* xb1 = wsp<bf16>(C, WS_XB1); const int lane = C.lane, tid = C.tid, wv = C.wave;
    const int tg = tid & 15, cg = (tid >> 4) & 7, ks = tid >> 7;
    for (int item = C.vcu; item < NTOK / 64; item += C.G) {
        const int row0 = item * 64;
        if (tid < 32) HIST[tid] = 0;
        f32x4 vnx[4];
        {
#pragma unroll
            for (int j = 0; j < 4; ++j) vnx[j] = ldrow4(xb1, true, (size_t)(row0 + wv * 8), lane + 64 * j); }
        for (int i = 0; i < 8; ++i) { const int rl = wv * 8 + i, row = row0 + rl;
            f32x4 v[4]; float ss = 0.f;
#pragma unroll
            for (int j = 0; j < 4; ++j) { v[j] = vnx[j]; ss += (v[j].x * v[j].x + v[j].y * v[j].y) + (v[j].z * v[j].z + v[j].w * v[j].w); }
            if (i < 7) {
#pragma unroll
                for (int j = 0; j < 4; ++j) vnx[j] = ldrow4(xb1, true, (size_t)(row + 1), lane + 64 * j); }
            const float rstd = rsqrtf(wave_sum(ss) * (1.f / DM) + EPS);
            GAS u32x2* ho = (GAS u32x2*)(h2 + (size_t)row * DM) + lane;
#pragma unroll
            for (int j = 0; j < 4; ++j) { const f32x4 g = ((const GAS f32x4*)g2)[64 * j + lane]; u32x2 o; o.x = pk2(v[j].x * rstd * g.x, v[j].y * rstd * g.y); o.y = pk2(v[j].z * rstd * g.z, v[j].w * rstd * g.w); ho[64 * j] = o; }
            if (lane == 0) RSTD[rl] = rstd; }
        __syncthreads();
        float acc[4][4]; float accg[4];
#pragma unroll
        for (int a = 0; a < 4; ++a) { accg[a] = 0.f;
#pragma unroll
            for (int c = 0; c < 4; ++c) acc[a][c] = 0.f; }
        const int t_lo = lane & 15, k4 = 4 * wv + (lane >> 4), wk = tid >> 2, wpart = tid & 3;
        f32x4 xq[4], gq, wq0, wq1, wq2 = {0.f, 0.f, 0.f, 0.f};
#define RT_LOADCH(kc_) do { gq = *(const GAS f32x4*)(g2 + (kc_) * 128 + k4 * 4); \
            _Pragma("unroll") for (int i = 0; i < 4; ++i) xq[i] = ldrow4(xb1, true, (size_t)(row0 + 16 * i + t_lo), (kc_) * 32 + k4); \
            { const float* src = wr + (size_t)((kc_) * 128 + wk) * 32 + wpart * 8; wq0 = *(const GAS f32x4*)src; wq1 = *(const GAS f32x4*)(src + 4); } \
            if (wpart == 0) wq2 = *(const GAS f32x4*)(wg + (size_t)((kc_) * 128 + wk) * 4); } while (0)
        RT_LOADCH(0);
        for (int kc = 0; kc < 8; ++kc) {
#pragma unroll
            for (int i = 0; i < 4; ++i) { const int t = 16 * i + t_lo; const float rs = RSTD[t];
                HT[(k4 * 4 + 0) * 68 + t] = xq[i].x * rs * gq.x; HT[(k4 * 4 + 1) * 68 + t] = xq[i].y * rs * gq.y; HT[(k4 * 4 + 2) * 68 + t] = xq[i].z * rs * gq.z; HT[(k4 * 4 + 3) * 68 + t] = xq[i].w * rs * gq.w; }
            *(LAS f32x4*)(WT + wk * 40 + wpart * 8) = wq0; *(LAS f32x4*)(WT + wk * 40 + wpart * 8 + 4) = wq1;
            if (wpart == 0) *(LAS f32x4*)(WT + wk * 40 + 32) = wq2;
            __syncthreads();
            if (kc < 7) RT_LOADCH(kc + 1);
#pragma unroll 4
            for (int kk = 0; kk < 32; ++kk) { const int k = ks * 32 + kk;
                const f32x4 a = *(const LAS f32x4*)(HT + k * 68 + 4 * tg), w = *(const LAS f32x4*)(WT + k * 40 + 4 * cg); const float wgc = WT[k * 40 + 32 + (cg & 3)];
#pragma unroll
                for (int q = 0; q < 4; ++q) { acc[q][0] += a[q] * w.x; acc[q][1] += a[q] * w.y; acc[q][2] += a[q] * w.z; acc[q][3] += a[q] * w.w; accg[q] += a[q] * wgc; } }
            __syncthreads();
        }
#undef RT_LOADCH
#pragma unroll
        for (int q = 0; q < 4; ++q) { LAS float* rp = RED + (ks * 64 + 4 * tg + q) * 40; *(LAS f32x4*)(rp + 4 * cg) = (f32x4){acc[q][0], acc[q][1], acc[q][2], acc[q][3]}; if (cg < 4) rp[32 + cg] = accg[q]; }
        __syncthreads();
        { const int tok = tid & 63, cgr = tid >> 6;
#pragma unroll
            for (int c = 0; c < 4; ++c) { const int col = 4 * cgr + c; LOG[tok * 37 + col] = (RED[(0 * 64 + tok) * 40 + col] + RED[(1 * 64 + tok) * 40 + col]) + (RED[(2 * 64 + tok) * 40 + col] + RED[(3 * 64 + tok) * 40 + col]) + br[col]; }
            if (cgr < 4) { const int col = 32 + cgr; LOG[tok * 37 + col] = (RED[(0 * 64 + tok) * 40 + col] + RED[(1 * 64 + tok) * 40 + col]) + (RED[(2 * 64 + tok) * 40 + col] + RED[(3 * 64 + tok) * 40 + col]) + bg[cgr]; } }
        __syncthreads();
        if (tid < 64) { const LAS float* lg = LOG + tid * 37;
            int gi = 0; float gmx = lg[32];
#pragma unroll
            for (int q = 1; q < 4; ++q) if (lg[32 + q] > gmx) { gmx = lg[32 + q]; gi = q; }
            float gsum = 0.f;
#pragma unroll
            for (int q = 0; q < 4; ++q) gsum += __expf(lg[32 + q] - gmx);
            const float pg = 1.f / gsum;
            const LAS float* el = lg + gi * 8; int i0 = 0; float e0 = el[0];
#pragma unroll
            for (int q = 1; q < 8; ++q) if (el[q] > e0) { e0 = el[q]; i0 = q; }
            int i1 = -1; float e1 = -INFINITY;
#pragma unroll
            for (int q = 0; q < 8; ++q) if (q != i0 && el[q] > e1) { e1 = el[q]; i1 = q; }
            const float x1 = __expf(e1 - e0), w0 = pg / (1.f + x1), w1 = pg * x1 / (1.f + x1);
            const int ea = gi * 8 + i0, eb = gi * 8 + i1;
            const int ra = atomicAdd((int*)(HIST + ea), 1), rb = atomicAdd((int*)(HIST + eb), 1);
            SEL[tid * 4 + 0] = ea; SEL[tid * 4 + 1] = eb; SEL[tid * 4 + 2] = ra; SEL[tid * 4 + 3] = rb;
            wsp<float>(C, WS_TOKW + doff)[(size_t)(row0 + tid) * 2] = w0; wsp<float>(C, WS_TOKW + doff)[(size_t)(row0 + tid) * 2 + 1] = w1; }
        __syncthreads();
        if (tid < 32) wsp<int>(C, WS_HISTG + doff)[item * 32 + tid] = HIST[tid];
        if (tid < 64) { wsp<int>(C, WS_TOKE + doff)[(size_t)(row0 + tid) * 2] = SEL[tid * 4]; wsp<int>(C, WS_TOKE + doff)[(size_t)(row0 + tid) * 2 + 1] = SEL[tid * 4 + 1];
            wsp<int>(C, WS_TOKR + doff)[(size_t)(row0 + tid) * 2] = SEL[tid * 4 + 2]; wsp<int>(C, WS_TOKR + doff)[(size_t)(row0 + tid) * 2 + 1] = SEL[tid * 4 + 3]; }
        __syncthreads();
    }
}
constexpr int P10_H = 0, P10_SEG = 65536, P10_BASE = P10_SEG + 16 * 32 * 4, P10_TOT = P10_BASE + 16 * 32 * 4;
__device__ __forceinline__ void phase10(const Ctx& C, int layer) {
    LAS int* H = (LAS int*)(C.lds + P10_H); LAS int* SEG = (LAS int*)(C.lds + P10_SEG); LAS int* SBASE = (LAS int*)(C.lds + P10_BASE); LAS int* TOT = (LAS int*)(C.lds + P10_TOT);
    LAS int* OFFS = (LAS int*)(C.lds + OFFS_OFF);
    { const int* hg = wsp<int>(C, WS_HISTG);
        for (int i = C.tid; i < 16384 / 4; i += NTHR) *(LAS u32x4*)(H + 4 * i) = *(const GAS u32x4*)(hg + 4 * i);
        __syncthreads();
        const int e = C.tid & 31, sg = C.tid >> 5; int s = 0;
        for (int i = 0; i < 32; ++i) s += H[(sg * 32 + i) * 32 + e];
        SEG[sg * 32 + e] = s;
        __syncthreads();
        if (C.tid < 32) { int run = 0; for (int q = 0; q < 16; ++q) { SBASE[q * 32 + C.tid] = run; run += SEG[q * 32 + C.tid]; } TOT[C.tid] = run; }
        __syncthreads();
        int run = SBASE[sg * 32 + e];
        for (int i = 0; i < 32; ++i) { const int v = H[(sg * 32 + i) * 32 + e]; H[(sg * 32 + i) * 32 + e] = run; run += v; }
        if (C.tid == 0) { int o = 0; for (int q = 0; q < 32; ++q) { OFFS[q] = o; o += (TOT[q] + 255) & ~255; } OFFS[32] = o; }
        __syncthreads(); }
    if (blockIdx.x == 0) { int* texp = wsp<int>(C, WS_TEXP); const int RT = OFFS[32] >> 8;
        for (int rt = C.tid; rt < RT; rt += NTHR) { int e = 0;
            for (int q = 1; q < 32; ++q) if (rt * 256 >= OFFS[q]) e = q;
            texp[rt] = e; }
        if (C.tid == 0) texp[511] = RT; }
    const int gw = C.vcu * NWAVES + C.wave, NGW = C.G * NWAVES, lane = C.lane;
    const bf16* h2 = wsp<bf16>(C, WS_H2); bf16* xs = wsp<bf16>(C, WS_XS); const int* toke = wsp<int>(C, WS_TOKE); const int* tokr = wsp<int>(C, WS_TOKR); int* tokp = wsp<int>(C, WS_TOKP);
    for (int s = gw; s < NTOK * 2; s += NGW) { const int tok = s >> 1, e = toke[s]; const int ipos = OFFS[e] + H[(tok >> 6) * 32 + e] + tokr[s]; const size_t pos = (size_t)ipos;
        if (lane == 0) tokp[s] = ipos;
        const GAS u32x4* src = (const GAS u32x4*)(h2 + (size_t)tok * DM) + lane; GAS u32x4* dst = (GAS u32x4*)(xs + pos * DM) + lane;
        const u32x4 a = src[0], b = src[64]; dst[0] = a; dst[64] = b; }
}
constexpr int PH_PER_LAYER = 13, N_PHASES = 2 * PH_PER_LAYER + 1;
#ifndef MK_ONE_LAUNCH
#define MK_ONE_LAUNCH 1
#endif
#ifndef E2_ALIGN
#define E2_ALIGN false
#define E2_SP2 true
#endif
__global__ void __launch_bounds__(NTHR, 2) fwd(Args A) {
    extern __shared__ __attribute__((aligned(16))) unsigned char lds_raw[];
    Ctx C_;
    C_.lds = (LAS unsigned char*)lds_raw; C_.MISC = (volatile LAS unsigned*)(C_.lds + MISC_OFF);
    C_.tid = threadIdx.x; C_.lane = C_.tid & 63; C_.wave = __builtin_amdgcn_readfirstlane(C_.tid >> 6);
    C_.G = gridDim.x; { const int bx = blockIdx.x; C_.vcu = (C_.G % 8 == 0) ? (bx % 8) * (C_.G / 8) + bx / 8 : bx; }
    C_.ws = A.ws; C_.ctl = (gu32*)(A.ws + WS_CTL);
    for (int u = C_.tid; u < 128; u += NTHR) ((LAS unsigned*)(C_.lds + MISC_OFF))[u] = 0u;
    __syncthreads();
    const int lo = A.ph_lo, hi = A.ph_hi;
    const bool multi = (hi - lo) > 1;
    XcdBarrier bar; bar.wv = C_.wave; bar.bar = (unsigned*)(C_.ctl + CW_BAR); bar.x = 0; bar.st = nullptr;
    if (multi) bar = xcd_barrier_post((unsigned*)(C_.ctl + CW_BAR), C_.MISC + 8, C_.wave);
#ifndef PHASE_MASK
#define PHASE_MASK 0x1fff
#endif
#define HAS(k) (((PHASE_MASK) >> (k)) & 1)
#ifndef REPMASK
#define REPMASK 0
#endif
#ifndef REPCNT
#define REPCNT 2
#endif
#define NREP(k) ((((REPMASK) >> (k)) & 1) && layer == 0 ? REPCNT : 1)
#define IN(k) (lo <= (k) && (k) < hi)
#define SEAM(k) do { if (IN(k) && IN((k) + 1)) xcd_barrier(bar); } while (0)
#define FRESH() Ctx C = C_; C.lane = xb_lane(); C.tid = C_.wave * 64 + C.lane; asm volatile("" : "+s"(C.ws), "+s"(C.ctl), "+s"(C.vcu), "+s"(C.G))
    for (int layer = 0; layer < 3; ++layer) {
        const int pb = layer * PH_PER_LAYER;
        if (HAS(0) && IN(pb + 0)) for (int rep_ = 0; rep_ < NREP(0); ++rep_) { FRESH(); phase0(A, C, layer); }
        if (layer == 2) break;
        SEAM(pb + 0);
#ifdef XBAR_PROBE
        if (layer == 0 && IN(pb + 0) && IN(pb + 1)) { for (int q = 0; q < XBAR_PROBE; ++q) xcd_barrier(bar); }
#endif
        if (HAS(1) && IN(pb + 1)) for (int rep_ = 0; rep_ < NREP(1); ++rep_) { FRESH();
            pg8::Gemm g{wsp<bf16>(C, WS_HB), wsp<bf16>(C, WS_WT1), NTOK, 5120, 1024}; pg8::StaticOrder S; S.init(NTOK, 5120, C.G, (int)blockIdx.x);
            pg8::EpiOut<0> E{proj(C, 0), nullptr, nullptr, PROJ_STRIDE / 2};
            pg8::gemm_phase<pg8::EpiOut<0>, pg8::StaticOrder, true, true>(C.lds, g, S, E, C.tid);
        }
        SEAM(pb + 1);
        if (HAS(2) && IN(pb + 2)) for (int rep_ = 0; rep_ < NREP(2); ++rep_) { FRESH();  for (int g8 = C.vcu; g8 < 256; g8 += C.G) for (int i8 = 0; i8 < 8; ++i8) mlstm_u_item(A, C, layer, g8 >> 4, (g8 & 15) * 8 + i8, i8 == 0); }
        SEAM(pb + 2);
        if (HAS(3) && IN(pb + 3)) for (int rep_ = 0; rep_ < NREP(3); ++rep_) { FRESH(); mlstm_scan(C); }
        SEAM(pb + 3);
        if (HAS(4) && IN(pb + 4)) for (int rep_ = 0; rep_ < NREP(4); ++rep_) { FRESH();
            gu32* q0 = C.ctl + CW_Q + 64 * (layer * 4 + 0); gu32* q1 = C.ctl + CW_Q + 64 * (layer * 4 + 1); gu32* q2 = C.ctl + CW_Q + 64 * (layer * 4 + 2);
            for (int rc_ = 0; rc_ < NREP(13); ++rc_) {
                if (C.G == 256) { const int xg = C.vcu >> 5, r = C.vcu & 31;
                    for (int rd = 0; rd < 2; ++rd) { const int p = r + 32 * rd, bvh = xg * 4 + (p >> 4), pr = p & 15;
                        attn_unit<128, true>(A, C, layer, bvh >> 3, bvh & 7, 31 - pr); attn_unit<128, true>(A, C, layer, bvh >> 3, bvh & 7, pr); } }
                else { for (int it = C.vcu; it < 1024; it += C.G) attn_unit<128, true>(A, C, layer, (it & 31) >> 3, it & 7, 31 - (it >> 5)); } }
            for (int rc_ = NREP(15) - 1; rc_ >= 0; --rc_) { gu32* qq = rc_ ? C.ctl + CW_Q + 64 * (17 + 2 * rc_) : q2;
            for (;;) { if (C.tid == 0) C.MISC[0] = __hip_atomic_fetch_add(qq, 1u, RLX_AGENT); __syncthreads(); const int it = (int)C.MISC[0]; __syncthreads(); if (it >= 512) break;
                for (int i4 = 0; i4 < 4; ++i4) mlstm_out_item(A, C, layer, it >> 5, (it & 31) * 4 + i4, i4 == 0, rc_ ? wsp<bf16>(C, 480 * MiB) : nullptr); } }
            for (int rc_ = NREP(14) - 1; rc_ >= 0; --rc_) { gu32* qq = rc_ ? C.ctl + CW_Q + 64 * (16 + 2 * rc_) : q1;
            for (;;) { if (C.tid == 0) C.MISC[0] = __hip_atomic_fetch_add(qq, 1u, RLX_AGENT); __syncthreads(); const int it = (int)C.MISC[0]; __syncthreads(); if (it >= 1024) break;
                attn_unit<64, false>(A, C, layer, (it & 31) >> 3, it & 7, 31 - (it >> 5), rc_ ? wsp<bf16>(C, 480 * MiB) : nullptr); } }
        }
        SEAM(pb + 4);
        if (HAS(5) && IN(pb + 5)) for (int rep_ = 0; rep_ < NREP(5); ++rep_) { FRESH(); phase5(A, C, layer); }
        SEAM(pb + 5);
        if (HAS(6) && IN(pb + 6)) for (int rep_ = 0; rep_ < NREP(6); ++rep_) { FRESH();
            pg8::Gemm g{wsp<bf16>(C, WS_HB), wsp<bf16>(C, WS_WT2), NTOK, 3072, 1024}; pg8::StaticOrder S; S.init(NTOK, 3072, C.G, (int)blockIdx.x);
            pg8::EpiOut<1> E{wsp<bf16>(C, WS_G0), wsp<bf16>(C, WS_G1), wsp<bf16>(C, WS_G2), 0};
            pg8::gemm_phase<pg8::EpiOut<1>, pg8::StaticOrder, true, true>(C.lds, g, S, E, C.tid);
        }
        SEAM(pb + 6);
        if (HAS(7) && IN(pb + 7)) for (int rep_ = 0; rep_ < NREP(7); ++rep_) { FRESH();
            pg8::StaticOrder S; S.init(NTOK, 1024, C.G, (int)blockIdx.x); bf16* Y = wsp<bf16>(C, WS_O12);
            { pg8::Gemm g{proj(C, PJ_AV), wsp<bf16>(C, WS_PT), NTOK, 1024, 512}; pg8::EpiMerge<true> E{Y, wsp<bf16>(C, WS_G0)}; pg8::gemm_phase<pg8::EpiMerge<true>, pg8::StaticOrder, true, true>(C.lds, g, S, E, C.tid); }
            __syncthreads();
            { pg8::Gemm g{proj(C, PJ_BQ), wsp<bf16>(C, WS_PT) + 1024 * 512, NTOK, 1024, 512}; pg8::EpiMerge<false> E{Y, wsp<bf16>(C, WS_G1)}; pg8::gemm_phase<pg8::EpiMerge<false>, pg8::StaticOrder, true, true>(C.lds, g, S, E, C.tid); }
            __syncthreads();
            { pg8::Gemm g{proj(C, PJ_CQ), wsp<bf16>(C, WS_PT) + 2 * 1024 * 512, NTOK, 1024, 512}; pg8::EpiMerge<false> E{Y, wsp<bf16>(C, WS_G2)}; pg8::gemm_phase<pg8::EpiMerge<false>, pg8::StaticOrder, true, true>(C.lds, g, S, E, C.tid); }
        }
        SEAM(pb + 7);
        if (HAS(8) && IN(pb + 8)) for (int rep_ = 0; rep_ < NREP(8); ++rep_) { FRESH();
            pg8::Gemm g{wsp<bf16>(C, WS_O12), wsp<bf16>(C, WS_WOT), NTOK, 1024, 1024}; pg8::StaticOrder S; S.init(NTOK, 1024, C.G, (int)blockIdx.x);
            pg8::EpiResid E{layer == 0 ? (const void*)A.in[0] : (const void*)A.out, layer > 0, wsp<bf16>(C, WS_XB1)};
            pg8::gemm_phase<pg8::EpiResid, pg8::StaticOrder, true, true>(C.lds, g, S, E, C.tid);
        }
        SEAM(pb + 8);
        if (HAS(9) && IN(pb + 9)) for (int rep_ = 0; rep_ < NREP(9); ++rep_) { FRESH(); for (int r9 = 1; r9 < NREP(16); ++r9) { phase9(A, C, layer, true); __syncthreads(); } if (NREP(17) >= 2) { moe_weight_items(A, C, layer); __syncthreads(); } phase9(A, C, layer); }
        SEAM(pb + 9);
        if (HAS(10) && IN(pb + 10)) for (int rep_ = 0; rep_ < NREP(10); ++rep_) { FRESH(); phase10(C, layer); }
        SEAM(pb + 10);
        if (HAS(11) && IN(pb + 11)) for (int rep_ = 0; rep_ < NREP(11); ++rep_) { FRESH();
            const int* texp = wsp<int>(C, WS_TEXP); const int RT = __builtin_amdgcn_readfirstlane(texp[511]);
            pg8::Gemm g{wsp<bf16>(C, WS_XS), wsp<bf16>(C, WS_W1T), 73728, 32 * 512, 1024}; pg8::MoeOrder<1> S{C.G, C.vcu, RT, texp};
            pg8::EpiSiluMul E{wsp<bf16>(C, WS_HE)};
            pg8::gemm_phase<pg8::EpiSiluMul, pg8::MoeOrder<1>, true, true>(C.lds, g, S, E, C.tid);
        }
        SEAM(pb + 11);
        if (HAS(12) && IN(pb + 12)) for (int rep_ = 0; rep_ < NREP(12); ++rep_) { FRESH();
            const int* texp = wsp<int>(C, WS_TEXP); const int RT = __builtin_amdgcn_readfirstlane(texp[511]);
            pg8::Gemm g{wsp<bf16>(C, WS_HE), wsp<bf16>(C, WS_W2T), 73728, 32 * 1024, 256}; pg8::MoeOrder<2> S{C.G, C.vcu, RT, texp};
            pg8::EpiOut<2> E{wsp<bf16>(C, WS_OSL), nullptr, nullptr, 0};
            pg8::gemm_phase<pg8::EpiOut<2>, pg8::MoeOrder<2>, E2_ALIGN, E2_SP2>(C.lds, g, S, E, C.tid);
        }
        SEAM(pb + 12);
    }
#undef IN
#undef SEAM
}

extern "C" void kernel_launch(void* const* d_in, const int* in_sizes, int n_in, void* d_out, int out_size, void* d_ws, size_t ws_size, hipStream_t stream) {
    static int grid = 0;
    if (grid == 0) {
        if (n_in != 23 || out_size != NTOK * DM || ws_size < WS_NEED) { fprintf(stderr, "kernel_launch: unexpected shapes (n_in %d out %d ws %zu)\n", n_in, out_size, ws_size); grid = -1; return; }
        int dev = 0, cus = 0, per_cu = 0;
        if (hipGetDevice(&dev) != hipSuccess || hipDeviceGetAttribute(&cus, hipDeviceAttributeMultiprocessorCount, dev) != hipSuccess) { grid = -1; return; }
        if (hipFuncSetAttribute((const void*)fwd, hipFuncAttributeMaxDynamicSharedMemorySize, LDS_BYTES) != hipSuccess) { fprintf(stderr, "kernel_launch: hipFuncSetAttribute failed\n"); grid = -1; return; }
        if (hipOccupancyMaxActiveBlocksPerMultiprocessor(&per_cu, (const void*)fwd, NTHR, LDS_BYTES) != hipSuccess || per_cu < 1) fprintf(stderr, "kernel_launch: occupancy query says %d\n", per_cu);
        (void)hipGetLastError();
        grid = cus;
    }
    if (grid < 0) return;
    (void)hipMemsetAsync((char*)d_ws + WS_CTL, 0, CTL_ZERO_BYTES, stream);
    Args a{};
    for (int i = 0; i < 23; ++i) a.in[i] = (const float*)d_in[i];
    a.out = (float*)d_out; a.ws = (unsigned char*)d_ws;
#if MK_ONE_LAUNCH
    a.ph_lo = 0; a.ph_hi = N_PHASES;
    hipLaunchKernelGGL(fwd, dim3(grid), dim3(NTHR), LDS_BYTES, stream, a);
#else
    for (int p = 0; p < N_PHASES; ++p) { a.ph_lo = p; a.ph_hi = p + 1; hipLaunchKernelGGL(fwd, dim3(grid), dim3(NTHR), LDS_BYTES, stream, a); }
#endif
}
```

```cpp
#include <hip/hip_runtime.h>
#include <cstdio>
#include <cstdint>
#include <cmath>
namespace pg8 {
#define PG8_LAS __attribute__((address_space(3)))
typedef unsigned short bf16_t;
typedef short bf16x8 __attribute__((ext_vector_type(8)));
typedef float f32x4 __attribute__((ext_vector_type(4)));
typedef unsigned u32x4 __attribute__((ext_vector_type(4)));
constexpr int BM = 256, BK = 64, HALF = 128, HTB = HALF * BK * 2  , STAGE_BYTES = 8 * HTB, NXCD = 8, WGM = 8;

__host__ __device__ __forceinline__ int lds_byte(int r, int c) { const int st = (r >> 4) * 2 + (c >> 5), rr = r & 15, cc = c & 31, ob = rr * 64 + cc * 2; return st * 1024 + (ob ^ (((ob >> 9) & 1) << 5)); }
__host__ __device__ __forceinline__ void stage_rc(int b, int& R, int& C) { const int st = b / 1024, sb = b % 1024, swz = sb ^ (((sb >> 9) & 1) << 5); R = (st >> 1) * 16 + swz / 64; C = (st & 1) * 32 + (swz % 64) / 2; }
__host__ __device__ __forceinline__ int perm32(int rho) { const int n = rho >> 4, i = rho & 15; return 8 * (i >> 2) + 4 * n + (i & 3); }

struct Unit { int pm, pn; };
struct Gemm { const bf16_t* A; const bf16_t* Bt; int M, N, K; };

struct StaticOrder {
    int nM, nN, nwg, G, c;
    __host__ __device__ void init(int M, int N, int G_, int c_) { nM = M / BM; nN = N / BM; nwg = nM * nN; G = G_; c = c_; }
    __host__ __device__ bool next(int i, Unit& u) const {
        const long L = (long)i * G + c; if (L >= nwg) return false;
        int wgid = (int)L; { const int q = nwg / NXCD, r = nwg % NXCD, xcd = wgid % NXCD, off = wgid / NXCD; wgid = (xcd < r ? xcd * (q + 1) : r * (q + 1) + (xcd - r) * q) + off; }
        const int nig = WGM * nN, gid = wgid / nig, fm = gid * WGM, gsz = (nM - fm) < WGM ? (nM - fm) : WGM;
        u.pm = fm + ((wgid % nig) % gsz); u.pn = (wgid % nig) / gsz; return true;
    }
    __device__ __forceinline__ void a_ready(const Unit&) const {}
    __device__ __forceinline__ void done(const Unit&) const {}
};

__device__ __forceinline__ unsigned cvt_pk_bf16(float lo, float hi) { unsigned r; asm volatile("v_cvt_pk_bf16_f32 %0, %1, %2" : "=v"(r) : "v"(lo), "v"(hi)); return r; }
#ifndef GAS
#define GAS __attribute__((address_space(1)))
#endif
typedef float f32x2 __attribute__((ext_vector_type(2)));
__device__ __forceinline__ float bflo(unsigned u) { return __builtin_bit_cast(float, u << 16); }
__device__ __forceinline__ float bfhi(unsigned u) { return __builtin_bit_cast(float, u & 0xffff0000u); }
__device__ __forceinline__ float sigmoidf_(float x) { return 1.f / (1.f + __expf(-x)); }
template <int MODE> struct EpiOut {
    static constexpr bool PERM = true, AFTER_DRAIN = false, CHAIN = false;
    bf16_t* b0; bf16_t* b1; bf16_t* b2; size_t stride;
    __device__ __forceinline__ void operator()(const f32x4 (&acc)[2][2][4][2], const Unit& u, int wr, int wc, int fr, int fq) const {
        int row0 = u.pm * BM + wr * 64 + fr; asm volatile("" : "+v"(row0));
        bf16_t* base; int colt, ldc;
        if (MODE == 0) { base = b0 + (size_t)(u.pn >> 1) * stride; colt = (u.pn & 1) * 256; ldc = 512; }
        else if (MODE == 1) { const int t = u.pn >> 2; base = b0 + (size_t)(160 * t - 32 * t * (t - 1)) * (1u << 19); colt = (u.pn & 3) * 256; ldc = 1024; }
        else { base = b0; colt = (u.pn & 3) * 256; ldc = 1024; }
        const int col0 = colt + wc * 32 + 8 * fq;
#pragma unroll
        for (int ai = 0; ai < 2; ++ai)
#pragma unroll
            for (int m = 0; m < 4; ++m) { bf16_t* rowp = base + (size_t)(row0 + ai * HALF + m * 16) * ldc + col0;
#pragma unroll
                for (int bj = 0; bj < 2; ++bj) { f32x4 v0 = acc[ai][bj][m][0], v1 = acc[ai][bj][m][1];
                    if (MODE == 1) {
#pragma unroll
                        for (int j = 0; j < 4; ++j) { v0[j] = sigmoidf_(v0[j]); v1[j] = sigmoidf_(v1[j]); } }
                    u32x4 w; w.x = cvt_pk_bf16(v0[0], v0[1]); w.y = cvt_pk_bf16(v0[2], v0[3]); w.z = cvt_pk_bf16(v1[0], v1[1]); w.w = cvt_pk_bf16(v1[2], v1[3]);
                    *(GAS u32x4*)(rowp + bj * HALF) = w; } }
    }
};
template <bool FIRST> struct EpiMerge {
    static constexpr bool PERM = true, AFTER_DRAIN = false, CHAIN = false;
    bf16_t* Y; const bf16_t* G;
    __device__ __forceinline__ void operator()(const f32x4 (&acc)[2][2][4][2], const Unit& u, int wr, int wc, int fr, int fq) const {
        int row0 = u.pm * BM + wr * 64 + fr; asm volatile("" : "+v"(row0)); const int col0 = u.pn * BM + wc * 32 + 8 * fq;
#pragma unroll
        for (int ai = 0; ai < 2; ++ai)
#pragma unroll
            for (int m = 0; m < 4; ++m) { const size_t ro = (size_t)(row0 + ai * HALF + m * 16) * 1024 + col0;
#pragma unroll
                for (int bj = 0; bj < 2; ++bj) { const f32x4 v0 = acc[ai][bj][m][0], v1 = acc[ai][bj][m][1];
                    const u32x4 g = *(const GAS u32x4*)(G + ro + bj * HALF);
                    float r[8] = { bflo(g.x) * v0[0], bfhi(g.x) * v0[1], bflo(g.y) * v0[2], bfhi(g.y) * v0[3], bflo(g.z) * v1[0], bfhi(g.z) * v1[1], bflo(g.w) * v1[2], bfhi(g.w) * v1[3] };
                    if (!FIRST) { const u32x4 y = *(const GAS u32x4*)(Y + ro + bj * HALF);
                        r[0] += bflo(y.x); r[1] += bfhi(y.x); r[2] += bflo(y.y); r[3] += bfhi(y.y); r[4] += bflo(y.z); r[5] += bfhi(y.z); r[6] += bflo(y.w); r[7] += bfhi(y.w); }
                    u32x4 w; w.x = cvt_pk_bf16(r[0], r[1]); w.y = cvt_pk_bf16(r[2], r[3]); w.z = cvt_pk_bf16(r[4], r[5]); w.w = cvt_pk_bf16(r[6], r[7]);
                    *(GAS u32x4*)(Y + ro + bj * HALF) = w; } }
    }
};
struct EpiResid {
    static constexpr bool PERM = true, AFTER_DRAIN = false, CHAIN = false;
    const void* XS; bool xbf; bf16_t* OUT;
    __device__ __forceinline__ void operator()(const f32x4 (&acc)[2][2][4][2], const Unit& u, int wr, int wc, int fr, int fq) const {
        int row0 = u.pm * BM + wr * 64 + fr; asm volatile("" : "+v"(row0)); const int col0 = u.pn * BM + wc * 32 + 8 * fq;
#pragma unroll
        for (int ai = 0; ai < 2; ++ai)
#pragma unroll
            for (int m = 0; m < 4; ++m) { const size_t ro = (size_t)(row0 + ai * HALF + m * 16) * 1024 + col0;
#pragma unroll
                for (int bj = 0; bj < 2; ++bj) { f32x4 x0, x1;
                    if (xbf) { const u32x4 xv = *(const GAS u32x4*)((const bf16_t*)XS + ro + bj * HALF); x0 = (f32x4){bflo(xv.x), bfhi(xv.x), bflo(xv.y), bfhi(xv.y)}; x1 = (f32x4){bflo(xv.z), bfhi(xv.z), bflo(xv.w), bfhi(xv.w)}; }
                    else { x0 = *(const GAS f32x4*)((const float*)XS + ro + bj * HALF); x1 = *(const GAS f32x4*)((const float*)XS + ro + bj * HALF + 4); }
                    x0 = x0 + acc[ai][bj][m][0]; x1 = x1 + acc[ai][bj][m][1];
                    u32x4 w; w.x = cvt_pk_bf16(x0[0], x0[1]); w.y = cvt_pk_bf16(x0[2], x0[3]); w.z = cvt_pk_bf16(x1[0], x1[1]); w.w = cvt_pk_bf16(x1[2], x1[3]);
                    *(GAS u32x4*)(OUT + ro + bj * HALF) = w; } }
    }
};
struct EpiSiluMul {
    static constexpr bool PERM = true, AFTER_DRAIN = false, CHAIN = false;
    bf16_t* O;
    __device__ __forceinline__ void operator()(const f32x4 (&acc)[2][2][4][2], const Unit& u, int wr, int wc, int fr, int fq) const {
        int row0 = u.pm * BM + wr * 64 + fr; asm volatile("" : "+v"(row0)); const int col0 = (u.pn & 1) * 128 + wc * 32 + 8 * fq;
#pragma unroll
        for (int ai = 0; ai < 2; ++ai)
#pragma unroll
            for (int m = 0; m < 4; ++m) { float r[8];
#pragma unroll
                for (int n = 0; n < 2; ++n)
#pragma unroll
                    for (int j = 0; j < 4; ++j) { const float g = acc[ai][0][m][n][j], up = acc[ai][1][m][n][j]; r[4 * n + j] = g * sigmoidf_(g) * up; }
                u32x4 w; w.x = cvt_pk_bf16(r[0], r[1]); w.y = cvt_pk_bf16(r[2], r[3]); w.z = cvt_pk_bf16(r[4], r[5]); w.w = cvt_pk_bf16(r[6], r[7]);
                *(GAS u32x4*)(O + (size_t)(row0 + ai * HALF + m * 16) * 256 + col0) = w; }
    }
};
template <int LOG_NCT> struct MoeOrder {
    int G, c, RT; const int* texp;
    __device__ __forceinline__ bool next(int i, Unit& u) const {
        const int L = i * G + c; const int rt = L >> LOG_NCT; if (rt >= RT) return false;
        const int e = __builtin_amdgcn_readfirstlane(texp[rt]); u.pm = rt; u.pn = (e << LOG_NCT) + (L & ((1 << LOG_NCT) - 1)); return true;
    }
    __device__ __forceinline__ void a_ready(const Unit&) const {}
    __device__ __forceinline__ void done(const Unit&) const {}
};
template <class Epi, class Sched, bool ALIGN_EPI = false, bool SP2 = false>
__device__ __forceinline__ void gemm_phase(PG8_LAS unsigned char* lds, const Gemm g, const Sched& S, const Epi& E, int tid_in) {
    int tid = tid_in; asm volatile("" : "+v"(tid));
    const int wid = __builtin_amdgcn_readfirstlane(tid >> 6), lane = tid & 63, wr = wid >> 2, wc = wid & 3, fr = lane & 15, fq = lane >> 4;
    const int K = g.K, nt = K / BK;
    unsigned voffA[2], voffB[2];
#pragma unroll
    for (int i = 0; i < 2; ++i) { int R, C; stage_rc(tid * 16 + i * 8192, R, C); const int Rb = Epi::PERM ? ((R & ~31) + perm32(R & 31)) : R;
        voffA[i] = (unsigned)(R * K + C) * 2u; voffB[i] = (unsigned)(Rb * K + C) * 2u; }
    const size_t kstep = (size_t)(BK * 2);
    const size_t hstep = (size_t)HALF * K * 2;
    const size_t tstep = 2 * hstep;
    const unsigned ldsw = (unsigned)wid * 1024u;
    const int aoff = lds_byte(wr * 64 + fr, fq * 8), boff = lds_byte(wc * 32 + fr, fq * 8);
#define PG8_SA(b, h) (((b) * 2 + (h)) * HTB)
#define PG8_SB(b, h) ((4 + (b) * 2 + (h)) * HTB)
#define PG8_STAGE(bufoff, gbase, voff) do { _Pragma("unroll") for (int _i = 0; _i < 2; ++_i) \
        __builtin_amdgcn_global_load_lds((const unsigned*)((const char*)(gbase) + (voff)[_i]), (PG8_LAS unsigned*)(lds + (bufoff) + ldsw + _i * 8192), 16, 0, 0); } while (0)
#define PG8_LDA(dst, b, h) do { _Pragma("unroll") for (int m = 0; m < 4; ++m) _Pragma("unroll") for (int k = 0; k < 2; ++k) dst[m][k] = *(const PG8_LAS bf16x8*)(lds + PG8_SA(b, h) + aoff + m * 2048 + k * 1024); } while (0)
#define PG8_LDB(dst, b, h) do { _Pragma("unroll") for (int n = 0; n < 2; ++n) _Pragma("unroll") for (int k = 0; k < 2; ++k) dst[n][k] = *(const PG8_LAS bf16x8*)(lds + PG8_SB(b, h) + boff + n * 2048 + k * 1024); } while (0)
#define PG8_MMA(ai, bj, At, Bt) do { __builtin_amdgcn_s_setprio(1); _Pragma("unroll") for (int m = 0; m < 4; ++m) _Pragma("unroll") for (int n = 0; n < 2; ++n) _Pragma("unroll") for (int k = 0; k < 2; ++k) \
        acc[ai][bj][m][n] = __builtin_amdgcn_mfma_f32_16x16x32_bf16(Bt[n][k], At[m][k], acc[ai][bj][m][n], 0, 0, 0); __builtin_amdgcn_s_setprio(0); } while (0)
#define PG8_WAIT_V(n) asm volatile("s_waitcnt vmcnt(" #n ")" ::: "memory")
#define PG8_WAIT_L(n) asm volatile("s_waitcnt lgkmcnt(" #n ")" ::: "memory")
#define PG8_BAR __builtin_amdgcn_s_barrier()
#define PG8_SCHED __builtin_amdgcn_sched_barrier(0)
    Unit cur, nxt; int ui = 0;
    if (!S.next(0, cur)) return;
    f32x4 acc[2][2][4][2];
#pragma unroll
    for (int a = 0; a < 2; ++a)
#pragma unroll
        for (int b = 0; b < 2; ++b)
#pragma unroll
            for (int m = 0; m < 4; ++m)
#pragma unroll
                for (int n = 0; n < 2; ++n) acc[a][b][m][n] = (f32x4){0.f, 0.f, 0.f, 0.f};
    bf16x8 At[4][2], B0[2][2], B1[2][2];
    const char* cA = (const char*)g.A + (size_t)cur.pm * tstep; const char* cB = (const char*)g.Bt + (size_t)cur.pn * tstep;
    S.a_ready(cur);
    if constexpr (SP2) {
        PG8_STAGE(PG8_SB(0, 0), cB, voffB); PG8_STAGE(PG8_SB(0, 1), cB + hstep, voffB); PG8_STAGE(PG8_SA(0, 0), cA, voffA); PG8_STAGE(PG8_SA(0, 1), cA + hstep, voffA);
        if (wr == 1) PG8_BAR;
        PG8_WAIT_V(2); PG8_BAR;
        PG8_STAGE(PG8_SB(1, 0), cB + kstep, voffB); PG8_STAGE(PG8_SA(1, 0), cA + kstep, voffA); PG8_STAGE(PG8_SB(1, 1), cB + hstep + kstep, voffB);
        PG8_WAIT_V(6); PG8_BAR;
    } else {
        PG8_STAGE(PG8_SB(0, 0), cB, voffB); PG8_STAGE(PG8_SA(0, 0), cA, voffA); PG8_STAGE(PG8_SB(0, 1), cB + hstep, voffB); PG8_STAGE(PG8_SA(0, 1), cA + hstep, voffA);
        if (wr == 1) PG8_BAR;
        PG8_WAIT_V(4); PG8_BAR;
        PG8_STAGE(PG8_SB(1, 0), cB + kstep, voffB); PG8_STAGE(PG8_SA(1, 0), cA + kstep, voffA); PG8_STAGE(PG8_SB(1, 1), cB + hstep + kstep, voffB);
        PG8_WAIT_V(6); PG8_BAR;
    }
    for (;;) {
        const bool has_next = S.next(ui + 1, nxt);
        const char* nA = has_next ? (const char*)g.A + (size_t)nxt.pm * tstep : cA; const char* nB = has_next ? (const char*)g.Bt + (size_t)nxt.pn * tstep : cB;
        for (int t = 0; t < nt; t += 2) {
            const bool last = (t == nt - 2);
            const char* a1 = cA + (size_t)(t + 1) * kstep;
            const char* a2 = last ? nA : cA + (size_t)(t + 2) * kstep; const char* b2 = last ? nB : cB + (size_t)(t + 2) * kstep;
            const char* a3 = a2 + kstep; const char* b3 = b2 + kstep;
            if (last && has_next) S.a_ready(nxt);
            if constexpr (SP2) {
            PG8_LDB(B0, 0, 0); PG8_LDB(B1, 0, 1); PG8_SCHED; PG8_LDA(At, 0, 0); PG8_STAGE(PG8_SA(1, 1), a1 + hstep, voffA);
            PG8_WAIT_V(8); PG8_WAIT_L(0); PG8_BAR; PG8_MMA(0, 0, At, B0); PG8_MMA(0, 1, At, B1); PG8_BAR; PG8_SCHED;
            PG8_LDA(At, 0, 1); PG8_STAGE(PG8_SB(0, 0), b2, voffB); PG8_STAGE(PG8_SB(0, 1), b2 + hstep, voffB); PG8_STAGE(PG8_SA(0, 0), a2, voffA);
            PG8_WAIT_V(8); PG8_WAIT_L(0); PG8_BAR; PG8_MMA(1, 0, At, B0); PG8_MMA(1, 1, At, B1); PG8_BAR; PG8_SCHED;
            PG8_LDB(B0, 1, 0); PG8_LDB(B1, 1, 1); PG8_SCHED; PG8_LDA(At, 1, 0); PG8_STAGE(PG8_SA(0, 1), a2 + hstep, voffA);
            PG8_WAIT_V(8); PG8_WAIT_L(0); PG8_BAR; PG8_MMA(0, 0, At, B0); PG8_MMA(0, 1, At, B1); PG8_BAR; PG8_SCHED;
            PG8_LDA(At, 1, 1); PG8_STAGE(PG8_SB(1, 0), b3, voffB); PG8_STAGE(PG8_SB(1, 1), b3 + hstep, voffB); PG8_STAGE(PG8_SA(1, 0), a3, voffA);
            PG8_WAIT_V(8); PG8_WAIT_L(0); PG8_BAR; PG8_MMA(1, 0, At, B0); PG8_MMA(1, 1, At, B1); PG8_BAR; PG8_SCHED;
            } else {
            PG8_LDB(B0, 0, 0); PG8_SCHED; PG8_LDA(At, 0, 0); PG8_STAGE(PG8_SA(1, 1), a1 + hstep, voffA);
            PG8_WAIT_L(8); PG8_BAR; PG8_WAIT_L(0); PG8_MMA(0, 0, At, B0); PG8_BAR; PG8_SCHED;
            PG8_LDB(B1, 0, 1); PG8_STAGE(PG8_SB(0, 0), b2, voffB);
            PG8_BAR; PG8_WAIT_L(0); PG8_MMA(0, 1, At, B1); PG8_BAR;
            PG8_LDA(At, 0, 1); PG8_STAGE(PG8_SA(0, 0), a2, voffA);
            PG8_BAR; PG8_WAIT_L(0); PG8_MMA(1, 0, At, B0); PG8_BAR; PG8_SCHED;
            PG8_STAGE(PG8_SB(0, 1), b2 + hstep, voffB);
            PG8_WAIT_V(6); PG8_BAR; PG8_MMA(1, 1, At, B1); PG8_BAR;
            PG8_LDB(B0, 1, 0); PG8_SCHED; PG8_LDA(At, 1, 0); PG8_STAGE(PG8_SA(0, 1), a2 + hstep, voffA);
            PG8_WAIT_L(8); PG8_BAR; PG8_WAIT_L(0); PG8_MMA(0, 0, At, B0); PG8_BAR; PG8_SCHED;
            PG8_LDB(B1, 1, 1); PG8_STAGE(PG8_SB(1, 0), b3, voffB);
            PG8_BAR; PG8_WAIT_L(0); PG8_MMA(0, 1, At, B1); PG8_BAR;
            PG8_LDA(At, 1, 1); PG8_STAGE(PG8_SA(1, 0), a3, voffA);
            PG8_BAR; PG8_WAIT_L(0); PG8_MMA(1, 0, At, B0); PG8_BAR; PG8_SCHED;
            PG8_STAGE(PG8_SB(1, 1), b3 + hstep, voffB);
            PG8_WAIT_V(6); PG8_BAR; PG8_MMA(1, 1, At, B1); PG8_BAR;
            }
        }
        if constexpr (ALIGN_EPI) { if (wr == 0) PG8_BAR; }
        if constexpr (!Epi::AFTER_DRAIN) { E(acc, cur, wr, wc, fr, fq); S.done(cur); }
        if (!has_next) break;
#pragma unroll
        for (int a = 0; a < 2; ++a)
#pragma unroll
            for (int b = 0; b < 2; ++b)
#pragma unroll
                for (int m = 0; m < 4; ++m)
#pragma unroll
                    for (int n = 0; n < 2; ++n) acc[a][b][m][n] = (f32x4){0.f, 0.f, 0.f, 0.f};
        cur = nxt; cA = nA; cB = nB; ++ui;
        if constexpr (ALIGN_EPI) { if (wr == 1) PG8_BAR; }
    }
    PG8_WAIT_V(0);
    if constexpr (!ALIGN_EPI) { if (wr == 0) PG8_BAR; }
    PG8_BAR;
    if constexpr (Epi::AFTER_DRAIN) { E.fused(acc, cur, wr, wc, fr, fq, lds, wid, lane); S.done(cur); }
#undef PG8_SA
#undef PG8_SB
#undef PG8_STAGE
#undef PG8_LDA
#undef PG8_LDB
#undef PG8_MMA
#undef PG8_WAIT_V
#undef PG8_WAIT_L
#undef PG8_BAR
#undef PG8_SCHED
}
}
constexpr int NTOK = 32768, SEQ = 8192, NB = 4, DM = 1024, INC = 8200;
constexpr float EPS = 1e-6f, LOG2E = 1.4426950408889634f;
constexpr size_t MiB = 1u << 20;
constexpr size_t WS_CTL = 0, CTL_ZERO_BYTES = 128 * 1024;
constexpr size_t WS_IG = 1 * MiB;
constexpr size_t WS_BC = 1 * MiB + 512 * 1024;
constexpr size_t WS_BLAST = 2 * MiB;
constexpr size_t WS_GMAX = 2 * MiB + 64 * 1024;
constexpr size_t WS_NUC = 3 * MiB;
constexpr size_t WS_TOKE = 4 * MiB;
constexpr size_t WS_TOKR = 4 * MiB + 256 * 1024;
constexpr size_t WS_TOKW = 4 * MiB + 512 * 1024;
constexpr size_t WS_TEXP = 5 * MiB;
constexpr size_t WS_HISTG = 5 * MiB + 64 * 1024;
constexpr size_t WS_TOKP = 6 * MiB;
constexpr size_t WS_WT1 = 8 * MiB;
constexpr size_t WS_WT2 = 18 * MiB;
constexpr size_t WS_PT = 24 * MiB;
constexpr size_t WS_WOT = 27 * MiB;
constexpr size_t WS_PROJ = 32 * MiB;
constexpr size_t PROJ_STRIDE = 32 * MiB;
constexpr size_t WS_HB = 352 * MiB;
constexpr size_t WS_O12 = 416 * MiB;
constexpr size_t WS_G0 = 32 * MiB, WS_G1 = 192 * MiB, WS_G2 = 288 * MiB;
constexpr size_t WS_H2 = 32 * MiB;
constexpr size_t WS_XS = 96 * MiB;
constexpr size_t WS_HE = 32 * MiB;
constexpr size_t WS_OSL = 96 * MiB;
constexpr size_t WS_W1T = 416 * MiB;
constexpr size_t WS_W2T = 448 * MiB;
constexpr size_t WS_XB1 = 256 * MiB;
constexpr size_t WS_NEED = 512 * MiB;
constexpr int PJ_AQ = 0, PJ_AK = 1, PJ_AV = 2, PJ_AO = 3, PJ_BQ = 4, PJ_BK = 5, PJ_BV = 6, PJ_CQ = 7, PJ_CK = 8, PJ_CV = 9;
constexpr int CW_TMO = 0, CW_CODE = 1;
constexpr int CW_BAR = 4096;
constexpr int CW_Q = 8192;
constexpr int CW_CNT = 12288;
constexpr int RING_BYTES = 131072;
constexpr int MISC_OFF = RING_BYTES;
constexpr int OFFS_OFF = RING_BYTES + 256;
constexpr int LDS_BYTES = 147456;
constexpr int NWAVES = 8, NTHR = 512;

#ifndef GAS
#define GAS __attribute__((address_space(1)))
#endif
#define LAS __attribute__((address_space(3)))
typedef unsigned short bf16;
typedef float f32x4 __attribute__((ext_vector_type(4)));
typedef float f32x16 __attribute__((ext_vector_type(16)));
typedef short bf16x8 __attribute__((ext_vector_type(8)));
typedef unsigned u32x4 __attribute__((ext_vector_type(4)));
typedef unsigned u32x2 __attribute__((ext_vector_type(2)));
typedef short s16x4 __attribute__((ext_vector_type(4)));
typedef GAS unsigned gu32;
#define RLX_AGENT __ATOMIC_RELAXED, __HIP_MEMORY_SCOPE_AGENT
#define LDS_WAIT() asm volatile("s_waitcnt lgkmcnt(0)" ::: "memory")
typedef float f32x2_t __attribute__((ext_vector_type(2))); typedef __bf16 bf16x2_t __attribute__((ext_vector_type(2)));
__device__ __forceinline__ unsigned pk2(float lo, float hi) { f32x2_t v = {lo, hi}; bf16x2_t b = __builtin_convertvector(v, bf16x2_t); return __builtin_bit_cast(unsigned, b); }
__device__ __forceinline__ float bflo(unsigned u) { return __builtin_bit_cast(float, u << 16); }
__device__ __forceinline__ float bfhi(unsigned u) { return __builtin_bit_cast(float, u & 0xffff0000u); }
__device__ __forceinline__ float sigm(float x) { return 1.f / (1.f + __expf(-x)); }
template <int O> __device__ __forceinline__ float xor_shfl(float v) {
    return __builtin_bit_cast(float, __builtin_amdgcn_ds_swizzle(__builtin_bit_cast(int, v), (O << 10) | 0x1f));
}
__device__ __forceinline__ float wave_sum(float v) {
    v += xor_shfl<1>(v); v += xor_shfl<2>(v); v += xor_shfl<4>(v); v += xor_shfl<8>(v); v += xor_shfl<16>(v);
    auto rr = __builtin_amdgcn_permlane32_swap(__float_as_uint(v), __float_as_uint(v), false, false);
    return __uint_as_float(rr[0]) + __uint_as_float(rr[1]);
}
__device__ __forceinline__ float wave_max(float v) {
    v = fmaxf(v, xor_shfl<1>(v)); v = fmaxf(v, xor_shfl<2>(v)); v = fmaxf(v, xor_shfl<4>(v)); v = fmaxf(v, xor_shfl<8>(v)); v = fmaxf(v, xor_shfl<16>(v));
    auto rr = __builtin_amdgcn_permlane32_swap(__float_as_uint(v), __float_as_uint(v), false, false);
    return fmaxf(__uint_as_float(rr[0]), __uint_as_float(rr[1]));
}
__device__ __forceinline__ float lane_up(float v, int lane, int o) {
    return __builtin_bit_cast(float, __builtin_amdgcn_ds_bpermute(((lane - o) & 63) << 2, __builtin_bit_cast(int, v)));
}
__device__ __forceinline__ float lane_get(float v, int src) {
    return __builtin_bit_cast(float, __builtin_amdgcn_readlane(__builtin_bit_cast(int, v), src));
}
__device__ __forceinline__ float pair_sum(float v) {
    auto rr = __builtin_amdgcn_permlane32_swap(__float_as_uint(v), __float_as_uint(v), false, false);
    return __uint_as_float(rr[0]) + __uint_as_float(rr[1]);
}
__device__ __forceinline__ float pair_max(float v) {
    auto rr = __builtin_amdgcn_permlane32_swap(__float_as_uint(v), __float_as_uint(v), false, false);
    return fmaxf(__uint_as_float(rr[0]), __uint_as_float(rr[1]));
}
__device__ __forceinline__ float max3f(float a, float b, float c) { float r; asm("v_max3_f32 %0, %1, %2, %3" : "=v"(r) : "v"(a), "v"(b), "v"(c)); return r; }
__device__ __forceinline__ int crow(int r, int hi) { return (r & 3) + 8 * (r >> 2) + 4 * hi; }
typedef short v4i16_t __attribute__((ext_vector_type(4)));
__device__ __forceinline__ s16x4 tr16(const LAS unsigned char* p) { return __builtin_bit_cast(s16x4, __builtin_amdgcn_ds_read_tr16_b64_v4i16((LAS v4i16_t*)p)); }
__device__ __forceinline__ bf16x8 cat8(s16x4 lo, s16x4 hi) { return (bf16x8){lo[0], lo[1], lo[2], lo[3], hi[0], hi[1], hi[2], hi[3]}; }
__device__ __forceinline__ f32x4 ldrow4(const void* base, bool isbf, size_t row, int idx) {
    if (isbf) { const u32x2 u = ((const GAS u32x2*)((const bf16*)base + row * 1024))[idx]; return (f32x4){bflo(u.x), bfhi(u.x), bflo(u.y), bfhi(u.y)}; }
    return ((const GAS f32x4*)((const float*)base + row * 1024))[idx];
}
#define MFMA32(a, b, c) __builtin_amdgcn_mfma_f32_32x32x16_bf16((a), (b), (c), 0, 0, 0)
#define XB_TMO      128
#define XB_XCNT(j)  (256  + 64 * (j))
#define XB_XSUB(j)  (1280 + 64 * (j))
#define XB_XGEN(j)  (2304 + 64 * (j))
#define XB_TOP      3328
#define XB_TOPGEN   3392
#define XCD_BAR_WORDS 3456
#define XB_SPIN_CAP (1u << 18)

__device__ __forceinline__ unsigned xb_ld(unsigned* p)              { return __hip_atomic_load(p, __ATOMIC_RELAXED, __HIP_MEMORY_SCOPE_AGENT); }
__device__ __forceinline__ unsigned xb_add(unsigned* p, unsigned v) { return __hip_atomic_fetch_add(p, v, __ATOMIC_RELAXED, __HIP_MEMORY_SCOPE_AGENT); }
__device__ __forceinline__ unsigned xb_xcc_id() { return (unsigned)__builtin_amdgcn_s_getreg((3 << 11) | 20) & 0xFu; }
#define XB_SPIN(cond, bar) do { unsigned _sp = 0; while (cond) { __builtin_amdgcn_s_sleep(1); \
    if ((++_sp & 255u) == 0u) { if (xb_ld(&(bar)[XB_TMO])) break; if (_sp > XB_SPIN_CAP) { atomicAdd(&(bar)[XB_TMO], 1u); break; } } } } while (0)

__device__ __forceinline__ int xb_lane() { int l; asm volatile("v_mbcnt_lo_u32_b32 %0, -1, 0\n\tv_mbcnt_hi_u32_b32 %0, -1, %0" : "=v"(l)); return l; }
struct XcdBarrier {
    int wv;
    unsigned* bar; unsigned x;
    volatile LAS unsigned* st;
};

__device__ __forceinline__ XcdBarrier xcd_barrier_post(unsigned* bar, volatile LAS unsigned* st, int wv) {
    XcdBarrier b; b.wv = wv; b.bar = bar; b.x = xb_xcc_id(); b.st = st;
    if (wv == 0 && xb_lane() == 0) (void)xb_add(&bar[XB_XCNT(b.x)], 1u);
    return b;
}
__device__ __forceinline__ void xcd_barrier_complete(unsigned* bar, unsigned x, unsigned& nloc, unsigned& nx) {
    const unsigned G = gridDim.x * gridDim.y * gridDim.z;
    unsigned sum, cnt, mine, sp = 0u;
    for (;;) {
        sum = 0u; cnt = 0u; mine = 0u;
#pragma unroll
        for (unsigned j = 0; j < 16; ++j) { const unsigned c = xb_ld(&bar[XB_XCNT(j)]); sum += c; cnt += (c > 0u) ? 1u : 0u; mine = (j == x) ? c : mine; }
        if (sum == G) break;
        __builtin_amdgcn_s_sleep(1);
        if ((++sp & 255u) == 0u) { if (xb_ld(&bar[XB_TMO])) break; if (sp > XB_SPIN_CAP) { atomicAdd(&bar[XB_TMO], 1u); break; } }
    }
    nloc = mine > 0u ? mine : 1u; nx = cnt > 0u ? cnt : 1u;
}

__device__ __forceinline__ void xcd_barrier(const XcdBarrier& b) {
    asm volatile("s_waitcnt vmcnt(0)" ::: "memory");
    __syncthreads();
    if (b.wv == 0 && xb_lane() == 0) {
        unsigned* bar = b.bar;
        __builtin_amdgcn_s_waitcnt(0);
        unsigned nloc = b.st[0], nx = b.st[1];
        if (nloc == 0u) { xcd_barrier_complete(bar, b.x, nloc, nx); b.st[0] = nloc; b.st[1] = nx; }
        const unsigned old = xb_add(&bar[XB_XSUB(b.x)], 1u);
        const unsigned gen = old / nloc;
        if (old + 1u == (gen + 1u) * nloc) {
            __builtin_amdgcn_fence(__ATOMIC_RELEASE, "agent");
            asm volatile("s_waitcnt vmcnt(0)" ::: "memory");
            const unsigned og = xb_add(&bar[XB_TOP], 1u);
            const unsigned tg = og / nx;
            if (og + 1u == (tg + 1u) * nx) xb_add(&bar[XB_TOPGEN], 1u);
            else XB_SPIN(xb_ld(&bar[XB_TOPGEN]) == tg, bar);
            __builtin_amdgcn_fence(__ATOMIC_ACQUIRE, "agent");
            xb_add(&bar[XB_XGEN(b.x)], 1u);
            asm volatile("s_waitcnt vmcnt(0)" ::: "memory");
        } else {
            XB_SPIN(xb_ld(&bar[XB_XGEN(b.x)]) == gen, bar);
            __builtin_amdgcn_fence(__ATOMIC_ACQUIRE, "agent");
            asm volatile("s_waitcnt vmcnt(0)" ::: "memory");
        }
    }
    __syncthreads();
}
struct Args {
    const float* in[23]; float* out; unsigned char* ws; int ph_lo, ph_hi;
};
struct Ctx {
    LAS unsigned char* lds; volatile LAS unsigned* MISC; gu32* ctl; unsigned char* ws;
    int tid, lane, wave, vcu, G;
};
template <class T> __device__ __forceinline__ T* wsp(const Ctx& C, size_t off) { return (T*)(C.ws + off); }
__device__ __forceinline__ bf16* proj(const Ctx& C, int j) { return (bf16*)(C.ws + WS_PROJ + (size_t)j * PROJ_STRIDE); }

__device__ __forceinline__ void transpose_item(const float* W, int ldn, int k0, int n0, bf16* WT, int Kdst, int drow0, LAS float* scr, int lane) {
    { const int c4 = lane & 7; const float* src = W + (size_t)(k0 + (lane >> 3)) * ldn + n0 + 4 * c4;
        f32x4 v[8];
#pragma unroll
        for (int i = 0; i < 8; ++i) v[i] = *(const GAS f32x4*)(src + (size_t)(8 * i) * ldn);
#pragma unroll
        for (int i = 0; i < 8; ++i) { LAS float* d = scr + ((lane >> 3) + 8 * i) * 33 + 4 * c4; d[0] = v[i].x; d[1] = v[i].y; d[2] = v[i].z; d[3] = v[i].w; } }
    LDS_WAIT(); asm volatile("" ::: "memory");
    const int c = lane & 7;
#pragma unroll
    for (int j = 0; j < 4; ++j) { const int n = (lane >> 3) + 8 * j; const LAS float* s = scr + (8 * c) * 33 + n;
        u32x4 o; o.x = pk2(s[0 * 33], s[1 * 33]); o.y = pk2(s[2 * 33], s[3 * 33]); o.z = pk2(s[4 * 33], s[5 * 33]); o.w = pk2(s[6 * 33], s[7 * 33]);
        *(GAS u32x4*)(WT + (size_t)(drow0 + n) * Kdst + k0 + 8 * c) = o; }
    LDS_WAIT(); asm volatile("" ::: "memory");
}
__device__ __forceinline__ void layer_weight_items(const Args& A, const Ctx& C, int layer) {
    LAS float* scr = (LAS float*)(C.lds + C.wave * 16384);
    const int gw = C.vcu * NWAVES + C.wave, NGW = C.G * NWAVES;
    const float* win = A.in[2] + (size_t)layer * DM * INC;
    constexpr int I1 = 16 * 160, I2 = 16 * 96, I3 = 3 * 8 * 32, I4 = 16 * 32;
    for (int it = gw; it < I1 + I2 + I3 + I4; it += NGW) {
        int r = it;
        if (r < I1) { const int nb = r % 160, kb = r / 160, nd = nb * 32, j = nd >> 9; const int sc = (j < 4 ? j * 512 : 2056 + (j - 4) * 512) + (nd & 511);
            transpose_item(win, INC, kb * 64, sc, wsp<bf16>(C, WS_WT1), 1024, nd, scr, C.lane); continue; } r -= I1;
        if (r < I2) { const int nb = r % 96, kb = r / 96; transpose_item(win, INC, kb * 64, 5128 + nb * 32, wsp<bf16>(C, WS_WT2), 1024, nb * 32, scr, C.lane); continue; } r -= I2;
        if (r < I3) { const int br = r / 256, q = r % 256, nb = q % 32, kb = q / 32;
            transpose_item(A.in[13] + (size_t)(layer * 3 + br) * 512 * 1024, 1024, kb * 64, nb * 32, wsp<bf16>(C, WS_PT) + (size_t)br * 1024 * 512, 512, nb * 32, scr, C.lane); continue; } r -= I3;
        { const int nb = r % 32, kb = r / 32; transpose_item(A.in[14] + (size_t)layer * 1024 * 1024, 1024, kb * 64, nb * 32, wsp<bf16>(C, WS_WOT), 1024, nb * 32, scr, C.lane); }
    }
}
__device__ __forceinline__ void moe_weight_items(const Args& A, const Ctx& C, int layer) {
    LAS float* scr = (LAS float*)(C.lds + C.wave * 16384);
    const int gw = C.vcu * NWAVES + C.wave, NGW = C.G * NWAVES;
    constexpr int I1 = 32 * 256, I2 = 32 * 128;
    for (int it = gw; it < I1 + I2; it += NGW) {
        int r = it;
        if (r < I1) { const int e = r >> 8, q = r & 255, mat = q >> 7, q2 = q & 127, nb = q2 & 7, kb = q2 >> 3, n0 = nb * 32;
            const float* src = (mat ? A.in[21] : A.in[20]) + (size_t)(layer * 32 + e) * 1024 * 256;
            transpose_item(src, 256, kb * 64, n0, wsp<bf16>(C, WS_W1T), 1024, e * 512 + (n0 >> 7) * 256 + mat * 128 + (n0 & 127), scr, C.lane); continue; } r -= I1;
        { const int e = r >> 7, q = r & 127, nb = q & 31, kb = q >> 5;
            transpose_item(A.in[22] + (size_t)(layer * 32 + e) * 256 * 1024, 1024, kb * 64, nb * 32, wsp<bf16>(C, WS_W2T), 256, e * 1024 + nb * 32, scr, C.lane); }
    }
}
__device__ __forceinline__ void phase0(const Args& A, const Ctx& C, int layer) {
    if (layer < 2) layer_weight_items(A, C, layer);
    __syncthreads();
    LAS float* WG = (LAS float*)(C.lds);
    LAS float* GL = (LAS float*)(C.lds + 32768);
    const int ll = layer < 2 ? layer : 0;
    const float* win = A.in[2] + (size_t)ll * DM * INC;
    if (layer < 2) { for (int i = C.tid; i < 8192; i += NTHR) WG[i] = win[(size_t)(i >> 3) * INC + 2048 + (i & 7)]; }
    __syncthreads();
    const float* g1 = A.in[1] + ll * 1024; const float* gb = A.in[5] + ll * 8;
    const void* xsrc = (layer == 0) ? (const void*)A.in[0] : (const void*)wsp<bf16>(C, WS_XB1); const bool xbf = layer > 0;
    const int* tokp = wsp<int>(C, WS_TOKP); const float* tokw = wsp<float>(C, WS_TOKW);
    const bf16* osl = wsp<bf16>(C, WS_OSL); bf16* hb = (bf16*)A.out + (size_t)NTOK * DM;
    for (int item = C.vcu; item < NTOK / 64; item += C.G) {
        const int row0 = item * 64;
        f32x4 vnx[4];
        {
#pragma unroll
            for (int j = 0; j < 4; ++j) vnx[j] = ldrow4(xsrc, xbf, (size_t)(row0 + C.wave * 8), C.lane + 64 * j); }
        for (int i = 0; i < 8; ++i) {
            const int rl = C.wave * 8 + i, row = row0 + rl;
            f32x4 v[4];
#pragma unroll
            for (int j = 0; j < 4; ++j) v[j] = vnx[j];
            if (i < 7) {
#pragma unroll
                for (int j = 0; j < 4; ++j) vnx[j] = ldrow4(xsrc, xbf, (size_t)(row + 1), C.lane + 64 * j); }
            if (layer > 0) {
                const float w0 = tokw[row * 2], w1 = tokw[row * 2 + 1];
                const size_t p0 = (size_t)tokp[row * 2], p1 = (size_t)tokp[row * 2 + 1];
                const GAS u32x2* o0 = (const GAS u32x2*)(osl + p0 * DM) + C.lane; const GAS u32x2* o1 = (const GAS u32x2*)(osl + p1 * DM) + C.lane;
#pragma unroll
                for (int j = 0; j < 4; ++j) { const u32x2 a = o0[64 * j], b = o1[64 * j];
                    v[j].x += w0 * bflo(a.x) + w1 * bflo(b.x); v[j].y += w0 * bfhi(a.x) + w1 * bfhi(b.x); v[j].z += w0 * bflo(a.y) + w1 * bflo(b.y); v[j].w += w0 * bfhi(a.y) + w1 * bfhi(b.y); }
                if (layer == 2) { GAS f32x4* xo = (GAS f32x4*)(A.out + (size_t)row * DM) + C.lane;
#pragma unroll
                    for (int j = 0; j < 4; ++j) xo[64 * j] = v[j]; }
                else { GAS u32x2* xo = (GAS u32x2*)((bf16*)A.out + (size_t)row * DM) + C.lane;
#pragma unroll
                    for (int j = 0; j < 4; ++j) { u32x2 o; o.x = pk2(v[j].x, v[j].y); o.y = pk2(v[j].z, v[j].w); xo[64 * j] = o; } }
            }
            if (layer < 2) {
                float ss = 0.f;
#pragma unroll
                for (int j = 0; j < 4; ++j) ss += (v[j].x * v[j].x + v[j].y * v[j].y) + (v[j].z * v[j].z + v[j].w * v[j].w);
                const float rstd = rsqrtf(wave_sum(ss) * (1.f / DM) + EPS);
                float gd[8];
#pragma unroll
                for (int q = 0; q < 8; ++q) gd[q] = 0.f;
                GAS u32x2* ho = (GAS u32x2*)(hb + (size_t)row * DM) + C.lane;
#pragma unroll
                for (int j = 0; j < 4; ++j) { const f32x4 g = ((const GAS f32x4*)g1)[64 * j + C.lane];
                    const f32x4 h = {v[j].x * rstd * g.x, v[j].y * rstd * g.y, v[j].z * rstd * g.z, v[j].w * rstd * g.w};
                    u32x2 o; o.x = pk2(h.x, h.y); o.y = pk2(h.z, h.w); ho[64 * j] = o;
                    const int k = 256 * j + 4 * C.lane;
#pragma unroll
                    for (int c = 0; c < 4; ++c) { const f32x4 wa = *(const LAS f32x4*)(WG + (k + c) * 8), wb = *(const LAS f32x4*)(WG + (k + c) * 8 + 4);
                        gd[0] += h[c] * wa.x; gd[1] += h[c] * wa.y; gd[2] += h[c] * wa.z; gd[3] += h[c] * wa.w; gd[4] += h[c] * wb.x; gd[5] += h[c] * wb.y; gd[6] += h[c] * wb.z; gd[7] += h[c] * wb.w; } }
                float gv;
                { const bool b1 = C.lane & 1, b2 = C.lane & 2, b3 = C.lane & 4; float a4[4], a2[2];
#pragma unroll
                    for (int q = 0; q < 4; ++q) { const float mine = b1 ? gd[q + 4] : gd[q], send = b1 ? gd[q] : gd[q + 4]; a4[q] = mine + xor_shfl<1>(send); }
#pragma unroll
                    for (int q = 0; q < 2; ++q) { const float mine = b2 ? a4[q + 2] : a4[q], send = b2 ? a4[q] : a4[q + 2]; a2[q] = mine + xor_shfl<2>(send); }
                    { const float mine = b3 ? a2[1] : a2[0], send = b3 ? a2[0] : a2[1]; gv = mine + xor_shfl<4>(send); }
                    gv += xor_shfl<8>(gv); gv += xor_shfl<16>(gv); gv = pair_sum(gv); }
                if (C.lane < 8) { const int q = 4 * (C.lane & 1) + 2 * ((C.lane >> 1) & 1) + ((C.lane >> 2) & 1);
                    const float val = gv + gb[q];
                    float r;
                    if (q < 4) r = 15.f * tanhf(val * (1.f / 15.f));
                    else r = (val < 0.f) ? (val - log1pf(expf(val))) : -log1pf(expf(-val));
                    GL[rl * 8 + q] = r; }
            }
        }
        if (layer < 2) {
            __syncthreads();
            if (C.wave < 4) { const int hh = C.wave, t = C.lane; const float lf = GL[t * 8 + 4 + hh], ig = GL[t * 8 + hh];
                float b = lf;
#pragma unroll
                for (int o = 1; o < 64; o <<= 1) { const float u = lane_up(b, t, o); if (t >= o) b += u; }
                const float bl = lane_get(b, 63); const float gm = wave_max(bl - b + ig);
                wsp<float>(C, WS_BC)[(size_t)(row0 + t) * 4 + hh] = b; wsp<float>(C, WS_IG)[(size_t)(row0 + t) * 4 + hh] = ig;
                if (t == 0) { const int bb = row0 / SEQ, c = (row0 % SEQ) / 64; wsp<float>(C, WS_BLAST)[(bb * 4 + hh) * 128 + c] = bl; wsp<float>(C, WS_GMAX)[(bb * 4 + hh) * 128 + c] = gm; } }
            __syncthreads();
        }
    }
}
__device__ __forceinline__ void mscan(const Ctx& C, int bh, LAS float* MV) {
    const float* bl = wsp<float>(C, WS_BLAST) + bh * 128; const float* gm = wsp<float>(C, WS_GMAX) + bh * 128; const int i = C.lane;
    const float a0 = bl[2 * i], g0 = gm[2 * i], a1 = bl[2 * i + 1], g1 = gm[2 * i + 1];
    float Aa = a0 + a1, Gg = fmaxf(g0 + a1, g1);
#pragma unroll
    for (int o = 1; o < 64; o <<= 1) { const float Ap = lane_up(Aa, i, o), Gp = lane_up(Gg, i, o); if (i >= o) { Gg = fmaxf(Gp + Aa, Gg); Aa = Ap + Aa; } }
    float Ax = lane_up(Aa, i, 1), Gx = lane_up(Gg, i, 1); if (i == 0) { Ax = 0.f; Gx = -INFINITY; }
    if (i == 0) MV[0] = 0.f;
    MV[2 * i + 1] = fmaxf(Ax + a0, fmaxf(Gx + a0, g0));
    MV[2 * i + 2] = fmaxf(Aa, Gg);
}
template <int ST> __device__ __forceinline__ void stage_conv(const Ctx& C, const bf16* src  , int row0, int seq0, const float* cw  , const float* cb, const LAS float* rs, float sc, LAS unsigned char* dst) {
#pragma unroll
    for (int i = 0; i < 2; ++i) { const int task = C.tid + NTHR * i, t = task >> 4, ch = task & 15;
        float y[8];
        { const f32x4 b0 = *(const GAS f32x4*)(cb + ch * 8), b1 = *(const GAS f32x4*)(cb + ch * 8 + 4); y[0] = b0.x; y[1] = b0.y; y[2] = b0.z; y[3] = b0.w; y[4] = b1.x; y[5] = b1.y; y[6] = b1.z; y[7] = b1.w; }
#pragma unroll
        for (int j = 0; j < 4; ++j) { const int row = row0 + t - j;
            if (row >= seq0) { const u32x4 u = *(const GAS u32x4*)(src + (size_t)row * 512 + ch * 8);
                const f32x4 w0 = *(const GAS f32x4*)(cw + j * 1024 + ch * 8), w1 = *(const GAS f32x4*)(cw + j * 1024 + ch * 8 + 4);
                y[0] += w0.x * bflo(u.x); y[1] += w0.y * bfhi(u.x); y[2] += w0.z * bflo(u.y); y[3] += w0.w * bfhi(u.y); y[4] += w1.x * bflo(u.z); y[5] += w1.y * bfhi(u.z); y[6] += w1.z * bflo(u.w); y[7] += w1.w * bfhi(u.w); } }
        const float s = (rs ? rs[t] : 1.f) * sc;
#pragma unroll
        for (int q = 0; q < 8; ++q) y[q] = y[q] * sigm(y[q]) * s;
        u32x4 o; o.x = pk2(y[0], y[1]); o.y = pk2(y[2], y[3]); o.z = pk2(y[4], y[5]); o.w = pk2(y[6], y[7]);
        *(LAS u32x4*)(dst + t * (ST * 2) + ch * 16) = o; }
}
template <int ST> __device__ __forceinline__ void stage_raw128(const Ctx& C, const bf16* src  , int row0, LAS unsigned char* dst) {
#pragma unroll
    for (int i = 0; i < 2; ++i) { const int task = C.tid + NTHR * i, t = task >> 4, ch = task & 15;
        *(LAS u32x4*)(dst + t * (ST * 2) + ch * 16) = *(const GAS u32x4*)(src + (size_t)(row0 + t) * 512 + ch * 8); }
}
__device__ __forceinline__ const LAS unsigned char* tr_addr(const LAS unsigned char* base, int stride_b, int r0, int c0, int lane) {
    return base + (r0 + ((lane & 15) >> 2)) * stride_b + (c0 + 16 * ((lane >> 4) & 1) + 4 * (lane & 3)) * 2;
}
constexpr int ML_MV = 0, ML_BC = 1024, ML_GS = 1280, ML_RS = 1536, ML_NV = 2048, ML_SC = 2560, ML_KT = 4608, ML_VT = ML_KT + 20480, ML_QT = ML_VT + 20480, ML_CT = ML_QT + 17408, ML_END = ML_CT + 34816, ML_OUT = ML_KT;
static_assert(ML_END <= RING_BYTES, "mLSTM LDS map");
__device__ __forceinline__ void mlstm_u_item(const Args& A, const Ctx& C0, int layer, int bh, int c, bool scan) {
    Ctx C = C0; asm volatile("" : "+v"(C.tid), "+v"(C.lane));
    LAS float* MV = (LAS float*)(C.lds + ML_MV); LAS float* RS = (LAS float*)(C.lds + ML_RS);
    LAS unsigned char* KT = C.lds + ML_KT; LAS unsigned char* VT = C.lds + ML_VT;
    const int b = bh >> 2, hh = bh & 3, row0 = b * SEQ + c * 64, seq0 = b * SEQ, lane = C.lane, hi = lane >> 5, r32 = lane & 31;
    if (scan) { if (C.wave == 0) mscan(C, bh, MV); __syncthreads(); }
    if (C.tid < 64) { const float bl = wsp<float>(C, WS_BLAST)[bh * 128 + c];
        RS[C.tid] = __expf(bl - wsp<float>(C, WS_BC)[(size_t)(row0 + C.tid) * 4 + hh] + wsp<float>(C, WS_IG)[(size_t)(row0 + C.tid) * 4 + hh] - MV[c + 1]); }
    __syncthreads();
    stage_conv<160>(C, proj(C, PJ_AK) + hh * 128, row0, seq0, A.in[3] + layer * 4096 + 512 + hh * 128, A.in[4] + layer * 1024 + 512 + hh * 128, RS, 0.08838834764831845f, KT);
    stage_raw128<160>(C, proj(C, PJ_AV) + hh * 128, row0, VT);
    __syncthreads();
    const int eb = C.wave >> 1, db0 = (C.wave & 1) * 2;
    f32x16 acc0 = {}, acc1 = {};
#pragma unroll
    for (int st = 0; st < 4; ++st) { const int t0 = 16 * st + 8 * hi;
        const bf16x8 af = cat8(tr16(tr_addr(VT, 320, t0, 32 * eb, lane)), tr16(tr_addr(VT, 320, t0 + 4, 32 * eb, lane)));
        const bf16x8 b0 = cat8(tr16(tr_addr(KT, 320, t0, 32 * db0, lane)), tr16(tr_addr(KT, 320, t0 + 4, 32 * db0, lane)));
        const bf16x8 b1 = cat8(tr16(tr_addr(KT, 320, t0, 32 * db0 + 32, lane)), tr16(tr_addr(KT, 320, t0 + 4, 32 * db0 + 32, lane)));
        acc0 = MFMA32(af, b0, acc0); acc1 = MFMA32(af, b1, acc1); }
    bf16* U = wsp<bf16>(C, WS_HB) + (size_t)(bh * 128 + c) * 16384;
    if (C.tid < 128) { float s = 0.f;
        for (int t = 0; t < 64; ++t) s += bflo((unsigned)*(const LAS bf16*)(KT + t * 320 + C.tid * 2));
        wsp<float>(C, WS_NUC)[(size_t)(bh * 128 + c) * 128 + C.tid] = s; }
    __syncthreads();
    { LAS bf16* US = (LAS bf16*)(C.lds + ML_KT);
#pragma unroll
        for (int r = 0; r < 16; ++r) { const int e = 32 * eb + crow(r, hi);
            US[e * 136 + 32 * db0 + r32] = (bf16)(pk2(acc0[r], 0.f) & 0xffffu); US[e * 136 + 32 * db0 + 32 + r32] = (bf16)(pk2(acc1[r], 0.f) & 0xffffu); }
        __syncthreads();
#pragma unroll
        for (int i = 0; i < 4; ++i) { const int task = C.tid + NTHR * i, e = task >> 4, ch = task & 15; *(GAS u32x4*)(U + e * 128 + ch * 8) = *(const LAS u32x4*)(US + e * 136 + ch * 8); } }
    __syncthreads();
}
__device__ __forceinline__ void qknorm_rows(const Args& A, const Ctx& C, int layer) {
    const int gw = C.vcu * NWAVES + C.wave, NGW = C.G * NWAVES, lane = C.lane;
    for (int it = gw; it < NTOK * 4; it += NGW) { const int which = it & 3, row = it >> 2;
        bf16* p = proj(C, which == 0 ? PJ_BQ : which == 1 ? PJ_BK : which == 2 ? PJ_CQ : PJ_CK) + (size_t)row * 512 + lane * 8;
        const float* g = (which < 2 ? A.in[7] : A.in[9]) + layer * 128 + (which & 1) * 64 + (lane & 7) * 8;
        const u32x4 u = *(const GAS u32x4*)p; const f32x4 g0 = *(const GAS f32x4*)g, g1 = *(const GAS f32x4*)(g + 4);
        float v[8] = {bflo(u.x), bfhi(u.x), bflo(u.y), bfhi(u.y), bflo(u.z), bfhi(u.z), bflo(u.w), bfhi(u.w)}; float ss = 0.f;
#pragma unroll
        for (int i = 0; i < 8; ++i) ss += v[i] * v[i];
        ss += xor_shfl<1>(ss); ss += xor_shfl<2>(ss); ss += xor_shfl<4>(ss);
        const float rinv = rsqrtf(ss * (1.f / 64.f) + EPS) * ((which & 1) ? 1.f : 0.125f * LOG2E);
        const u32x4 o = {pk2(v[0] * rinv * g0.x, v[1] * rinv * g0.y), pk2(v[2] * rinv * g0.z, v[3] * rinv * g0.w), pk2(v[4] * rinv * g1.x, v[5] * rinv * g1.y), pk2(v[6] * rinv * g1.z, v[7] * rinv * g1.w)};
        *(GAS u32x4*)p = o; }
}
__device__ __forceinline__ void mlstm_scan(const Ctx& C) {
    LAS float* MV = (LAS float*)(C.lds + ML_MV); LAS float* DEC = (LAS float*)(C.lds + ML_RS);
    for (int w = C.vcu; w < 256; w += C.G) { const int bh = w >> 4, sl = w & 15;
        if (C.wave == 0) mscan(C, bh, MV);
        __syncthreads();
        if (C.tid < 128) DEC[C.tid] = __expf(wsp<float>(C, WS_BLAST)[bh * 128 + C.tid] + MV[C.tid] - MV[C.tid + 1]);
        __syncthreads();
        GAS unsigned* p = (GAS unsigned*)(wsp<unsigned>(C, WS_HB) + (size_t)bh * 128 * 8192 + sl * 512 + C.tid);
        float s0 = 0.f, s1 = 0.f;
        for (int c0 = 0; c0 < 128; c0 += 16) { unsigned u[16];
#pragma unroll
            for (int q = 0; q < 16; ++q) u[q] = p[(size_t)(c0 + q) * 8192];
#pragma unroll
            for (int q = 0; q < 16; ++q) { p[(size_t)(c0 + q) * 8192] = pk2(s0, s1); const float d = DEC[c0 + q]; s0 = d * s0 + bflo(u[q]); s1 = d * s1 + bfhi(u[q]); } }
        if (sl == 0 && C.tid < 128) { GAS float* np = (GAS float*)(wsp<float>(C, WS_NUC) + (size_t)bh * 128 * 128 + C.tid); float s = 0.f;
            for (int c0 = 0; c0 < 128; c0 += 16) { float u[16];
#pragma unroll
                for (int q = 0; q < 16; ++q) u[q] = np[(c0 + q) * 128];
#pragma unroll
                for (int q = 0; q < 16; ++q) { np[(c0 + q) * 128] = s; s = DEC[c0 + q] * s + u[q]; } } }
        __syncthreads();
    }
}
__device__ __forceinline__ void mlstm_out_item(const Args& A, const Ctx& C0, int layer, int bh, int c, bool scan, bf16* habase = nullptr  ) {
    Ctx C = C0; asm volatile("" : "+v"(C.tid), "+v"(C.lane));
    LAS float* MV = (LAS float*)(C.lds + ML_MV); LAS float* BC = (LAS float*)(C.lds + ML_BC); LAS float* GS = (LAS float*)(C.lds + ML_GS); LAS float* NV = (LAS float*)(C.lds + ML_NV);
    LAS float* SC = (LAS float*)(C.lds + ML_SC) + C.wave * 64;
    LAS unsigned char* KT = C.lds + ML_KT; LAS unsigned char* VT = C.lds + ML_VT; LAS unsigned char* QT = C.lds + ML_QT; LAS unsigned char* CT = C.lds + ML_CT; LAS float* OUT = (LAS float*)(C.lds + ML_OUT);
    const int b = bh >> 2, hh = bh & 3, row0 = b * SEQ + c * 64, seq0 = b * SEQ, lane = C.lane, hi = lane >> 5, r32 = lane & 31;
    if (scan && C.wave == 0) mscan(C, bh, MV);
    if (C.tid >= 64 && C.tid < 128) { const int t = C.tid - 64; const float bc = wsp<float>(C, WS_BC)[(size_t)(row0 + t) * 4 + hh]; BC[t] = bc; GS[t] = wsp<float>(C, WS_IG)[(size_t)(row0 + t) * 4 + hh] - bc; }
    if (C.tid >= 128 && C.tid < 256) NV[C.tid - 128] = wsp<float>(C, WS_NUC)[(size_t)(bh * 128 + c) * 128 + C.tid - 128];
    stage_conv<136>(C, proj(C, PJ_AQ) + hh * 128, row0, seq0, A.in[3] + layer * 4096 + hh * 128, A.in[4] + layer * 1024 + hh * 128, nullptr, 1.f, QT);
    stage_conv<136>(C, proj(C, PJ_AK) + hh * 128, row0, seq0, A.in[3] + layer * 4096 + 512 + hh * 128, A.in[4] + layer * 1024 + 512 + hh * 128, nullptr, 0.08838834764831845f, KT);
    stage_raw128<160>(C, proj(C, PJ_AV) + hh * 128, row0, VT);
    { const bf16* cs = wsp<bf16>(C, WS_HB) + (size_t)(bh * 128 + c) * 16384;
#pragma unroll
        for (int i = 0; i < 4; ++i) { const int task = C.tid + NTHR * i, e = task >> 4, ch = task & 15; *(LAS u32x4*)(CT + e * 272 + ch * 16) = *(const GAS u32x4*)(cs + e * 128 + ch * 8); } }
    __syncthreads();
    const float mc = MV[c]; const int lb = C.wave >> 2, cb = C.wave & 3, lq = 32 * lb + r32; const float bl = BC[lq];
    bf16x8 qf[8];
#pragma unroll
    for (int st = 0; st < 8; ++st) qf[st] = *(const LAS bf16x8*)(QT + lq * 272 + (16 * st + 8 * hi) * 2);
    f32x16 p0 = {}, p1 = {};
#pragma unroll
    for (int st = 0; st < 8; ++st) p0 = MFMA32(*(const LAS bf16x8*)(KT + r32 * 272 + (16 * st + 8 * hi) * 2), qf[st], p0);
    if (lb == 1) {
#pragma unroll
        for (int st = 0; st < 8; ++st) p1 = MFMA32(*(const LAS bf16x8*)(KT + (32 + r32) * 272 + (16 * st + 8 * hi) * 2), qf[st], p1); }
    f32x16 d0, d1; float mt = bl + mc;
#pragma unroll
    for (int r = 0; r < 16; ++r) { const int s = crow(r, hi); d0[r] = (s <= lq) ? bl + GS[s] : -INFINITY; mt = fmaxf(mt, d0[r]); }
#pragma unroll
    for (int r = 0; r < 16; ++r) { const int s = 32 + crow(r, hi); d1[r] = (lb == 1 && s <= lq) ? bl + GS[s] : -INFINITY; mt = fmaxf(mt, d1[r]); }
    mt = pair_max(mt);
    float rs = 0.f;
#pragma unroll
    for (int r = 0; r < 16; ++r) { p0[r] *= __expf(d0[r] - mt); p1[r] *= __expf(d1[r] - mt); rs += p0[r] + p1[r]; }
    rs = pair_sum(rs);
    float qn = 0.f;
#pragma unroll
    for (int st = 0; st < 8; ++st) { const f32x4 n0 = *(const LAS f32x4*)(NV + 16 * st + 8 * hi), n1 = *(const LAS f32x4*)(NV + 16 * st + 8 * hi + 4); const u32x4 q = __builtin_bit_cast(u32x4, qf[st]);
        qn += bflo(q.x) * n0.x + bfhi(q.x) * n0.y + bflo(q.y) * n0.z + bfhi(q.y) * n0.w + bflo(q.z) * n1.x + bfhi(q.z) * n1.y + bflo(q.w) * n1.z + bfhi(q.w) * n1.w; }
    qn = pair_sum(qn);
    const float wi = __expf(bl + mc - mt), den = wi * qn + rs, dn = fmaxf(fabsf(den), __expf(-mt));
    SC[r32] = wi / dn; SC[32 + r32] = 1.f / dn;
    f32x16 acc1 = {}, acc2 = {};
#define PKF(P, B) (bf16x8)__builtin_bit_cast(bf16x8, ((u32x4){pk2(P[B], P[B + 1]), pk2(P[B + 2], P[B + 3]), pk2(P[B + 4], P[B + 5]), pk2(P[B + 6], P[B + 7])}))
#pragma unroll
    for (int s2 = 0; s2 < 2; ++s2) { const int k0 = 16 * s2;
        const bf16x8 vf = cat8(tr16(tr_addr(VT, 320, k0 + 4 * hi, 32 * cb, lane)), tr16(tr_addr(VT, 320, k0 + 8 + 4 * hi, 32 * cb, lane)));
        acc2 = MFMA32(s2 == 0 ? PKF(p0, 0) : PKF(p0, 8), vf, acc2); }
    if (lb == 1) {
#pragma unroll
        for (int s2 = 0; s2 < 2; ++s2) { const int k0 = 32 + 16 * s2;
            const bf16x8 vf = cat8(tr16(tr_addr(VT, 320, k0 + 4 * hi, 32 * cb, lane)), tr16(tr_addr(VT, 320, k0 + 8 + 4 * hi, 32 * cb, lane)));
            acc2 = MFMA32(s2 == 0 ? PKF(p1, 0) : PKF(p1, 8), vf, acc2); } }
#undef PKF
#pragma unroll
    for (int st = 0; st < 8; ++st) acc1 = MFMA32(qf[st], *(const LAS bf16x8*)(CT + (32 * cb + r32) * 272 + (16 * st + 8 * hi) * 2), acc1);
    __syncthreads();
#pragma unroll
    for (int r = 0; r < 16; ++r) { const int l_ = crow(r, hi); OUT[(32 * lb + l_) * 132 + 32 * cb + r32] = SC[l_] * acc1[r] + SC[32 + l_] * acc2[r]; }
    __syncthreads();
    { const int row = C.tid >> 3, seg = C.tid & 7; float v[16]; float ss = 0.f;
#pragma unroll
        for (int q = 0; q < 4; ++q) { const f32x4 x = *(const LAS f32x4*)(OUT + row * 132 + seg * 16 + 4 * q); v[4 * q] = x.x; v[4 * q + 1] = x.y; v[4 * q + 2] = x.z; v[4 * q + 3] = x.w; ss += (x.x * x.x + x.y * x.y) + (x.z * x.z + x.w * x.w); }
        ss += xor_shfl<1>(ss); ss += xor_shfl<2>(ss); ss += xor_shfl<4>(ss);
        const float rinv = rsqrtf(ss * (1.f / 128.f) + EPS);
        const float* gn = A.in[6] + layer * 512 + hh * 128 + seg * 16;
        const bf16* ao = proj(C, PJ_AO) + (size_t)(row0 + row) * 512 + hh * 128 + seg * 16;
        bf16* ha = (habase ? habase : proj(C, PJ_AV)) + (size_t)(row0 + row) * 512 + hh * 128 + seg * 16;
#pragma unroll
        for (int q = 0; q < 2; ++q) { const u32x4 a = *(const GAS u32x4*)(ao + 8 * q); const f32x4 g0 = *(const GAS f32x4*)(gn + 8 * q), g1 = *(const GAS f32x4*)(gn + 8 * q + 4); const float* vv = v + 8 * q;
            u32x4 o; o.x = pk2(vv[0] * rinv * g0.x * sigm(bflo(a.x)), vv[1] * rinv * g0.y * sigm(bfhi(a.x))); o.y = pk2(vv[2] * rinv * g0.z * sigm(bflo(a.y)), vv[3] * rinv * g0.w * sigm(bfhi(a.y)));
            o.z = pk2(vv[4] * rinv * g1.x * sigm(bflo(a.z)), vv[5] * rinv * g1.y * sigm(bfhi(a.z))); o.w = pk2(vv[6] * rinv * g1.z * sigm(bflo(a.w)), vv[7] * rinv * g1.w * sigm(bfhi(a.w)));
            *(GAS u32x4*)(ha + 8 * q) = o; } }
    __syncthreads();
}
constexpr int AT_TAB = 0, AT_SCR = 3072, AT_K = 5120;
template <int DV, bool ISC> __device__ __forceinline__ void attn_unit(const Args& A, const Ctx& C0, int layer, int b, int hs, int qblk, bf16* obase = nullptr  ) {
    Ctx C = C0; asm volatile("" : "+v"(C.tid), "+v"(C.lane));
    constexpr int KSTB = 144, VSTB = 2 * DV + 64, KB = 64 * KSTB, VB = 64 * VSTB, AT_V = AT_K + 4 * KB, NBLK = DV / 32;
    static_assert(AT_V + 4 * VB <= RING_BYTES, "attention LDS map");
    LAS float* TAB = (LAS float*)(C.lds + AT_TAB); LAS float* SCR = (LAS float*)(C.lds + AT_SCR) + C.wave * 64;
    const int lane = C.lane, hi = lane >> 5, r32 = lane & 31, tid = C.tid;
    const bf16 *Qp, *Kp, *Vp; bf16* Op; int pitchO; const float *gq, *gk; int hbias;
    if (ISC) { const int h = hs >> 1, wh = hs & 1; Qp = proj(C, PJ_CQ) + h * 128 + wh * 64; Kp = proj(C, PJ_CK) + h * 128 + wh * 64; Vp = proj(C, PJ_CV) + h * 128;
        Op = wsp<bf16>(C, WS_O12) + h * 256 + wh * 128; pitchO = 1024; gq = A.in[9] + layer * 128; gk = gq + 64; hbias = h; }
    else { Qp = proj(C, PJ_BQ) + hs * 64; Kp = proj(C, PJ_BK) + hs * 64; Vp = proj(C, PJ_BV) + hs * 64; Op = (obase ? obase : proj(C, PJ_BQ)) + hs * 64; pitchO = 512; gq = A.in[7] + layer * 128; gk = gq + 64; hbias = hs; }
    const size_t rowb = (size_t)b * SEQ;
    const int qs0 = qblk * 256 + C.wave * 32;
    for (int i = tid; i < 768; i += NTHR) { const int d = 703 - i; float v;
        if (ISC) { const int n = d < 0 ? -d : d; int bk = n < 8 ? n : n < 15 ? 8 : n < 27 ? 9 : n < 50 ? 10 : n < 91 ? 11 : n < 166 ? 12 : n < 305 ? 13 : n < 559 ? 14 : 15; if (d < 0) bk += 16; v = A.in[12][bk * 4 + hbias]; }
        else { const int dc = d < -256 ? -256 : d > 256 ? 256 : d; v = A.in[8][(size_t)layer * 513 * 8 + (dc + 256) * 8 + hbias]; }
        TAB[i] = v * LOG2E; }
    float MB;
    { const float gqm = wave_max(fabsf(gq[lane])), gkm = wave_max(fabsf(gk[lane]));
        float bm = 0.f;
        if (ISC) { bm = (lane < 32) ? fabsf(A.in[12][lane * 4 + hbias]) : 0.f; }
        else { for (int i = lane; i < 513; i += 64) bm = fmaxf(bm, fabsf(A.in[8][(size_t)layer * 513 * 8 + i * 8 + hbias])); }
        bm = wave_max(bm);
        MB = 64.f * (0.125f * LOG2E) * gqm * gkm * 1.02f + bm * LOG2E; }
    const float t15 = (ISC ? A.in[12][15 * 4 + hbias] * LOG2E : 0.f) - MB;
    bf16x8 qf[4];
    { float qv[32]; float ss = 0.f; const bf16* qrow = Qp + (rowb + qs0 + r32) * 512 + 8 * hi;
#pragma unroll
        for (int st = 0; st < 4; ++st) { const u32x4 u = *(const GAS u32x4*)(qrow + 16 * st);
            qv[8 * st] = bflo(u.x); qv[8 * st + 1] = bfhi(u.x); qv[8 * st + 2] = bflo(u.y); qv[8 * st + 3] = bfhi(u.y); qv[8 * st + 4] = bflo(u.z); qv[8 * st + 5] = bfhi(u.z); qv[8 * st + 6] = bflo(u.w); qv[8 * st + 7] = bfhi(u.w); }
#pragma unroll
        for (int i = 0; i < 32; ++i) ss += qv[i] * qv[i];
        ss = pair_sum(ss);
        const float rinv = rsqrtf(ss * (1.f / 64.f) + EPS) * (0.125f * LOG2E);
#pragma unroll
        for (int st = 0; st < 4; ++st) { const f32x4 g0 = *(const GAS f32x4*)(gq + 16 * st + 8 * hi) * *(const GAS f32x4*)(gk + 16 * st + 8 * hi), g1 = *(const GAS f32x4*)(gq + 16 * st + 8 * hi + 4) * *(const GAS f32x4*)(gk + 16 * st + 8 * hi + 4); const float* q = qv + 8 * st;
            const u32x4 o = {pk2(q[0] * rinv * g0.x, q[1] * rinv * g0.y), pk2(q[2] * rinv * g0.z, q[3] * rinv * g0.w), pk2(q[4] * rinv * g1.x, q[5] * rinv * g1.y), pk2(q[6] * rinv * g1.z, q[7] * rinv * g1.w)};
            qf[st] = __builtin_bit_cast(bf16x8, o); } }
    const int krow = tid >> 3, kch = tid & 7;
    const int jhi = qblk * 4 + 3, jlo = ISC ? 0 : (qblk * 4 - 8 < 0 ? 0 : qblk * 4 - 8), cqw = qblk * 4 + (C.wave >> 1);
    const bf16* ksrc = Kp + (rowb + krow) * 512 + kch * 8;
    u32x4 kregA, kregB, vregA[NBLK / 2], vregB[NBLK / 2];
#define AT_LOADT(j, KR, VR) do { KR = *(const GAS u32x4*)(ksrc + (size_t)(j) * 64 * 512); \
        if (DV == 128) { _Pragma("unroll") for (int i_ = 0; i_ < 2; ++i_) { const int idx = tid + NTHR * i_; VR[i_] = *(const GAS u32x4*)(Vp + (rowb + (size_t)(j) * 64 + (idx >> 4)) * 512 + (idx & 15) * 8); } } \
        else VR[0] = *(const GAS u32x4*)(Vp + (rowb + (size_t)(j) * 64 + krow) * 512 + kch * 8); } while (0)
    AT_LOADT(jlo, kregA, vregA); AT_LOADT(jlo + 1, kregB, vregB);
    float l = 0.f; f32x16 o[NBLK];
#pragma unroll
    for (int nb = 0; nb < NBLK; ++nb) o[nb] = f32x16{};
#define AT_VLOAD(F, nb_) do { _Pragma("unroll") for (int ks_ = 0; ks_ < 4; ++ks_) { F[2 * ks_] = tr16(vb_ + (16 * ks_) * VSTB + (nb_) * 64); F[2 * ks_ + 1] = tr16(vb_ + (16 * ks_ + 8) * VSTB + (nb_) * 64); } } while (0)
#define AT_STAGE(buf, KR, VR) do { \
        LAS unsigned char* KT = C.lds + AT_K + (buf) * KB; LAS unsigned char* VT = C.lds + AT_V + (buf) * VB; \
        { float kv[8] = {bflo(KR.x), bfhi(KR.x), bflo(KR.y), bfhi(KR.y), bflo(KR.z), bfhi(KR.z), bflo(KR.w), bfhi(KR.w)}; float ss = 0.f; \
            _Pragma("unroll") for (int i = 0; i < 8; ++i) ss += kv[i] * kv[i]; \
            ss += xor_shfl<1>(ss); ss += xor_shfl<2>(ss); ss += xor_shfl<4>(ss); \
            const float rinv = rsqrtf(ss * (1.f / 64.f) + EPS); \
            const u32x4 w = {pk2(kv[0] * rinv, kv[1] * rinv), pk2(kv[2] * rinv, kv[3] * rinv), pk2(kv[4] * rinv, kv[5] * rinv), pk2(kv[6] * rinv, kv[7] * rinv)}; \
            *(LAS u32x4*)(KT + krow * KSTB + kch * 16) = w; } \
        if (DV == 128) { _Pragma("unroll") for (int i_ = 0; i_ < 2; ++i_) { const int idx = tid + NTHR * i_; *(LAS u32x4*)(VT + (idx >> 4) * VSTB + (idx & 15) * 16) = VR[i_]; } } \
        else *(LAS u32x4*)(VT + krow * VSTB + kch * 16) = VR[0]; \
    } while (0)
#define AT_COMP(j, buf) do { \
        LAS unsigned char* KT = C.lds + AT_K + (buf) * KB; LAS unsigned char* VT = C.lds + AT_V + (buf) * VB; \
        const bool act = ((j) <= cqw) && (ISC || (j) >= cqw - 8); \
        if (act) { \
            f32x16 p0, p1; \
            const bool far = ISC && (qs0 - (64 * (j) + 63) >= 559); \
            if (far) { _Pragma("unroll") for (int r = 0; r < 16; ++r) { p0[r] = t15; p1[r] = t15; } } \
            else { const LAS float* tp = TAB + (703 - (qs0 + r32) + 64 * (j) + 4 * hi); \
                _Pragma("unroll") for (int r = 0; r < 16; ++r) { p0[r] = tp[(r & 3) + 8 * (r >> 2)] - MB; p1[r] = tp[32 + (r & 3) + 8 * (r >> 2)] - MB; } } \
            { bf16x8 kf[8]; \
                _Pragma("unroll") for (int st = 0; st < 4; ++st) { kf[2 * st] = *(const LAS bf16x8*)(KT + r32 * KSTB + (16 * st + 8 * hi) * 2); kf[2 * st + 1] = *(const LAS bf16x8*)(KT + (32 + r32) * KSTB + (16 * st + 8 * hi) * 2); } \
                __builtin_amdgcn_sched_barrier(0);        \
                _Pragma("unroll") for (int st = 0; st < 4; ++st) { p0 = MFMA32(kf[2 * st], qf[st], p0); p1 = MFMA32(kf[2 * st + 1], qf[st], p1); } } \
            float rs0 = 0.f, rs1 = 0.f, rs2 = 0.f, rs3 = 0.f;        \
            _Pragma("unroll") for (int r = 0; r < 16; r += 2) { p0[r] = __builtin_amdgcn_exp2f(p0[r]); p1[r] = __builtin_amdgcn_exp2f(p1[r]); p0[r + 1] = __builtin_amdgcn_exp2f(p0[r + 1]); p1[r + 1] = __builtin_amdgcn_exp2f(p1[r + 1]); \
                rs0 += p0[r]; rs1 += p1[r]; rs2 += p0[r + 1]; rs3 += p1[r + 1]; } \
            l += (rs0 + rs1) + (rs2 + rs3); \
            bf16x8 pw[4]; \
            pw[0] = PKF(p0, 0); pw[1] = PKF(p0, 8); pw[2] = PKF(p1, 0); pw[3] = PKF(p1, 8); \
            { s16x4 fa[8], fb[8]; const LAS unsigned char* vb_ = tr_addr(VT, VSTB, 4 * hi, 0, lane); \
                AT_VLOAD(fa, 0); \
                _Pragma("unroll") for (int nb = 0; nb < NBLK; nb += 2) { \
                    AT_VLOAD(fb, nb + 1); __builtin_amdgcn_sched_barrier(0); \
                    _Pragma("unroll") for (int ks = 0; ks < 4; ++ks) o[nb] = MFMA32(pw[ks], cat8(fa[2 * ks], fa[2 * ks + 1]), o[nb]); \
                    __builtin_amdgcn_sched_barrier(0); \
                    if (nb + 2 < NBLK) AT_VLOAD(fa, nb + 2); __builtin_amdgcn_sched_barrier(0); \
                    _Pragma("unroll") for (int ks = 0; ks < 4; ++ks) o[nb + 1] = MFMA32(pw[ks], cat8(fb[2 * ks], fb[2 * ks + 1]), o[nb + 1]); \
                    __builtin_amdgcn_sched_barrier(0); } } \
        } } while (0)
#define PKF(P, B) __builtin_bit_cast(bf16x8, ((u32x4){pk2(P[B], P[B + 1]), pk2(P[B + 2], P[B + 3]), pk2(P[B + 4], P[B + 5]), pk2(P[B + 6], P[B + 7])}))
    for (int j = jlo; j <= jhi; j += 2) { const int sb = (((j - jlo) >> 1) & 1) * 2;
        AT_STAGE(sb, kregA, vregA); AT_STAGE(sb + 1, kregB, vregB);
        __syncthreads();
        if (j + 2 <= jhi) { AT_LOADT(j + 2, kregA, vregA); AT_LOADT(j + 3, kregB, vregB); }
        AT_COMP(j, sb); AT_COMP(j + 1, sb + 1); }
#undef PKF
#undef AT_STAGE
#undef AT_COMP
#undef AT_VLOAD
#undef AT_LOADT
    l = pair_sum(l);
    SCR[32 + r32] = 1.f / l;
    bf16* orow = Op + (rowb + qs0) * pitchO;
#pragma unroll
    for (int r = 0; r < 16; ++r) { const int q = crow(r, hi); const float rl = SCR[32 + q];
#pragma unroll
        for (int nb = 0; nb < NBLK; ++nb) ((GAS bf16*)orow)[(size_t)q * pitchO + 32 * nb + r32] = (bf16)(pk2(o[nb][r] * rl, 0.f) & 0xffffu); }
    __syncthreads();
}
__device__ __forceinline__ void phase5(const Args& A, const Ctx& C, int layer) {
    const int gw = C.vcu * NWAVES + C.wave, NGW = C.G * NWAVES, lane = C.lane;
    const float lam_init = 0.8f - 0.6f * __expf(-0.3f * (float)layer);
    const float* cl = A.in[10] + layer * 256;
    const float lam = __expf(wave_sum(cl[lane] * cl[64 + lane])) - __expf(wave_sum(cl[128 + lane] * cl[192 + lane])) + lam_init;
    const float* gs = A.in[11] + layer * 128 + (lane & 15) * 8;
    const f32x4 gs0 = *(const GAS f32x4*)gs, gs1 = *(const GAS f32x4*)(gs + 4);
    const float post = 1.f - lam_init;
    const bf16* o12 = wsp<bf16>(C, WS_O12); bf16* hc = proj(C, PJ_CQ);
    for (int row = gw; row < NTOK; row += NGW) {
        { const int h = lane >> 4, e0 = (lane & 15) * 8;
            const u32x4 a = *(const GAS u32x4*)(o12 + (size_t)row * 1024 + h * 256 + e0), bq = *(const GAS u32x4*)(o12 + (size_t)row * 1024 + h * 256 + 128 + e0);
            float v[8] = {bflo(a.x) - lam * bflo(bq.x), bfhi(a.x) - lam * bfhi(bq.x), bflo(a.y) - lam * bflo(bq.y), bfhi(a.y) - lam * bfhi(bq.y), bflo(a.z) - lam * bflo(bq.z), bfhi(a.z) - lam * bfhi(bq.z), bflo(a.w) - lam * bflo(bq.w), bfhi(a.w) - lam * bfhi(bq.w)};
            float ss = 0.f;
#pragma unroll
            for (int i = 0; i < 8; ++i) ss += v[i] * v[i];
            ss += xor_shfl<1>(ss); ss += xor_shfl<2>(ss); ss += xor_shfl<4>(ss); ss += xor_shfl<8>(ss);
            const float rinv = rsqrtf(ss * (1.f / 128.f) + EPS) * post;
            const u32x4 o = {pk2(v[0] * rinv * gs0.x, v[1] * rinv * gs0.y), pk2(v[2] * rinv * gs0.z, v[3] * rinv * gs0.w), pk2(v[4] * rinv * gs1.x, v[5] * rinv * gs1.y), pk2(v[6] * rinv * gs1.z, v[7] * rinv * gs1.w)};
            *(GAS u32x4*)(hc + (size_t)row * 512 + h * 128 + e0) = o; }
    }
}
constexpr int RT_RSTD = 0, RT_HT = 1024, RT_WT = RT_HT + 128 * 68 * 4, RT_LOG = RT_WT + 128 * 40 * 4, RT_HIST = RT_LOG + 64 * 37 * 4, RT_BASE = RT_HIST + 128, RT_SEL = RT_BASE + 128, RT_END = RT_SEL + 64 * 4 * 4, RT_RED = RT_HT;
static_assert(RT_END <= RING_BYTES && 4 * 64 * 40 * 4 <= RT_LOG - RT_HT, "routing LDS map");
__device__ __forceinline__ void phase9(const Args& A, const Ctx& C, int layer, bool dummy = false  ) {
    const size_t doff = dummy ? (476 * MiB) : 0;
    moe_weight_items(A, C, layer);
    __syncthreads();
    LAS float* RSTD = (LAS float*)(C.lds + RT_RSTD); LAS float* HT = (LAS float*)(C.lds + RT_HT); LAS float* WT = (LAS float*)(C.lds + RT_WT); LAS float* LOG = (LAS float*)(C.lds + RT_LOG); LAS float* RED = (LAS float*)(C.lds + RT_RED);
    LAS int* HIST = (LAS int*)(C.lds + RT_HIST); LAS int* BASE = (LAS int*)(C.lds + RT_BASE); LAS int* SEL = (LAS int*)(C.lds + RT_SEL);
    const float* g2 = A.in[15] + layer * 1024; const float* wg = A.in[16] + layer * 4096; const float* bg = A.in[17] + layer * 4; const float* wr = A.in[18] + layer * 32768; const float* br = A.in[19] + layer * 32;
    bf16* h2 = wsp<bf16>(C, dummy ? 128 * MiB : WS_H2); const bf16* xb1 = wsp<bf16>(C, WS_XB1); const int lane = C.lane, tid = C.tid, wv = C.wave;
    const int tg = tid & 15, cg = (tid >> 4) & 7, ks = tid >> 7;
    for (int item = C.vcu; item < NTOK / 64; item += C.G) {
        const int row0 = item * 64;
        if (tid < 32) HIST[tid] = 0;
        f32x4 vnx[4];
        {
#pragma unroll
            for (int j = 0; j < 4; ++j) vnx[j] = ldrow4(xb1, true, (size_t)(row0 + wv * 8), lane + 64 * j); }
        for (int i = 0; i < 8; ++i) { const int rl = wv * 8 + i, row = row0 + rl;
            f32x4 v[4]; float ss = 0.f;
#pragma unroll
            for (int j = 0; j < 4; ++j) { v[j] = vnx[j]; ss += (v[j].x * v[j].x + v[j].y * v[j].y) + (v[j].z * v[j].z + v[j].w * v[j].w); }
            if (i < 7) {
#pragma unroll
                for (int j = 0; j < 4; ++j) vnx[j] = ldrow4(xb1, true, (size_t)(row + 1), lane + 64 * j); }
            const float rstd = rsqrtf(wave_sum(ss) * (1.f / DM) + EPS);
            GAS u32x2* ho = (GAS u32x2*)(h2 + (size_t)row * DM) + lane;
#pragma unroll
            for (int j = 0; j < 4; ++j) { const f32x4 g = ((const GAS f32x4*)g2)[64 * j + lane]; u32x2 o; o.x = pk2(v[j].x * rstd * g.x, v[j].y * rstd * g.y); o.y = pk2(v[j].z * rstd * g.z, v[j].w * rstd * g.w); ho[64 * j] = o; }
            if (lane == 0) RSTD[rl] = rstd; }
        __syncthreads();
        float acc[4][4]; float accg[4];
#pragma unroll
        for (int a = 0; a < 4; ++a) { accg[a] = 0.f;
#pragma unroll
            for (int c = 0; c < 4; ++c) acc[a][c] = 0.f; }
        const int t_lo = lane & 15, k4 = 4 * wv + (lane >> 4), wk = tid >> 2, wpart = tid & 3;
        f32x4 xq[4], gq, wq0, wq1, wq2 = {0.f, 0.f, 0.f, 0.f};
#define RT_LOADCH(kc_) do { gq = *(const GAS f32x4*)(g2 + (kc_) * 128 + k4 * 4); \
            _Pragma("unroll") for (int i = 0; i < 4; ++i) xq[i] = ldrow4(xb1, true, (size_t)(row0 + 16 * i + t_lo), (kc_) * 32 + k4); \
            { const float* src = wr + (size_t)((kc_) * 128 + wk) * 32 + wpart * 8; wq0 = *(const GAS f32x4*)src; wq1 = *(const GAS f32x4*)(src + 4); } \
            if (wpart == 0) wq2 = *(const GAS f32x4*)(wg + (size_t)((kc_) * 128 + wk) * 4); } while (0)
        RT_LOADCH(0);
        for (int kc = 0; kc < 8; ++kc) {
#pragma unroll
            for (int i = 0; i < 4; ++i) { const int t = 16 * i + t_lo; const float rs = RSTD[t];
                HT[(k4 * 4 + 0) * 68 + t] = xq[i].x * rs * gq.x; HT[(k4 * 4 + 1) * 68 + t] = xq[i].y * rs * gq.y; HT[(k4 * 4 + 2) * 68 + t] = xq[i].z * rs * gq.z; HT[(k4 * 4 + 3) * 68 + t] = xq[i].w * rs * gq.w; }
            *(LAS f32x4*)(WT + wk * 40 + wpart * 8) = wq0; *(LAS f32x4*)(WT + wk * 40 + wpart * 8 + 4) = wq1;
            if (wpart == 0) *(LAS f32x4*)(WT + wk * 40 + 32) = wq2;
            __syncthreads();
            if (kc < 7) RT_LOADCH(kc + 1);
#pragma unroll 4
            for (int kk = 0; kk < 32; ++kk) { const int k = ks * 32 + kk;
                const f32x4 a = *(const LAS f32x4*)(HT + k * 68 + 4 * tg), w = *(const LAS f32x4*)(WT + k * 40 + 4 * cg); const float wgc = WT[k * 40 + 32 + (cg & 3)];
#pragma unroll
                for (int q = 0; q < 4; ++q) { acc[q][0] += a[q] * w.x; acc[q][1] += a[q] * w.y; acc[q][2] += a[q] * w.z; acc[q][3] += a[q] * w.w; accg[q] += a[q] * wgc; } }
            __syncthreads();
        }
#undef RT_LOADCH
#pragma unroll
        for (int q = 0; q < 4; ++q) { LAS float* rp = RED + (ks * 64 + 4 * tg + q) * 40; *(LAS f32x4*)(rp + 4 * cg) = (f32x4){acc[q][0], acc[q][1], acc[q][2], acc[q][3]}; if (cg < 4) rp[32 + cg] = accg[q]; }
        __syncthreads();
        { const int tok = tid & 63, cgr = tid >> 6;
#pragma unroll
            for (int c = 0; c < 4; ++c) { const int col = 4 * cgr + c; LOG[tok * 37 + col] = (RED[(0 * 64 + tok) * 40 + col] + RED[(1 * 64 + tok) * 40 + col]) + (RED[(2 * 64 + tok) * 40 + col] + RED[(3 * 64 + tok) * 40 + col]) + br[col]; }
            if (cgr < 4) { const int col = 32 + cgr; LOG[tok * 37 + col] = (RED[(0 * 64 + tok) * 40 + col] + RED[(1 * 64 + tok) * 40 + col]) + (RED[(2 * 64 + tok) * 40 + col] + RED[(3 * 64 + tok) * 40 + col]) + bg[cgr]; } }
        __syncthreads();
        if (tid < 64) { const LAS float* lg = LOG + tid * 37;
            int gi = 0; float gmx = lg[32];
#pragma unroll
            for (int q = 1; q < 4; ++q) if (lg[32 + q] > gmx) { gmx = lg[32 + q]; gi = q; }
            float gsum = 0.f;
#pragma unroll
            for (int q = 0; q < 4; ++q) gsum += __expf(lg[32 + q] - gmx);
            const float pg = 1.f / gsum;
            const LAS float* el = lg + gi * 8; int i0 = 0; float e0 = el[0];
#pragma unroll
            for (int q = 1; q < 8; ++q) if (el[q] > e0) { e0 = el[q]; i0 = q; }
            int i1 = -1; float e1 = -INFINITY;
#pragma unroll
            for (int q = 0; q < 8; ++q) if (q != i0 && el[q] > e1) { e1 = el[q]; i1 = q; }
            const float x1 = __expf(e1 - e0), w0 = pg / (1.f + x1), w1 = pg * x1 / (1.f + x1);
            const int ea = gi * 8 + i0, eb = gi * 8 + i1;
            const int ra = atomicAdd((int*)(HIST + ea), 1), rb = atomicAdd((int*)(HIST + eb), 1);
            SEL[tid * 4 + 0] = ea; SEL[tid * 4 + 1] = eb; SEL[tid * 4 + 2] = ra; SEL[tid * 4 + 3] = rb;
            wsp<float>(C, WS_TOKW + doff)[(size_t)(row0 + tid) * 2] = w0; wsp<float>(C, WS_TOKW + doff)[(size_t)(row0 + tid) * 2 + 1] = w1; }
        __syncthreads();
        if (tid < 32) wsp<int>(C, WS_HISTG + doff)[item * 32 + tid] = HIST[tid];
        if (tid < 64) { wsp<int>(C, WS_TOKE + doff)[(size_t)(row0 + tid) * 2] = SEL[tid * 4]; wsp<int>(C, WS_TOKE + doff)[(size_t)(row0 + tid) * 2 + 1] = SEL[tid * 4 + 1];
            wsp<int>(C, WS_TOKR + doff)[(size_t)(row0 + tid) * 2] = SEL[tid * 4 + 2]; wsp<int>(C, WS_TOKR + doff)[(size_t)(row0 + tid) * 2 + 1] = SEL[tid * 4 + 3]; }
        __syncthreads();
    }
}
constexpr int P10_H = 0, P10_SEG = 65536, P10_BASE = P10_SEG + 16 * 32 * 4, P10_TOT = P10_BASE + 16 * 32 * 4;
__device__ __forceinline__ void phase10(const Ctx& C, int layer) {
    LAS int* H = (LAS int*)(C.lds + P10_H); LAS int* SEG = (LAS int*)(C.lds + P10_SEG); LAS int* SBASE = (LAS int*)(C.lds + P10_BASE); LAS int* TOT = (LAS int*)(C.lds + P10_TOT);
    LAS int* OFFS = (LAS int*)(C.lds + OFFS_OFF);
    { const int* hg = wsp<int>(C, WS_HISTG);
        for (int i = C.tid; i < 16384 / 4; i += NTHR) *(LAS u32x4*)(H + 4 * i) = *(const GAS u32x4*)(hg + 4 * i);
        __syncthreads();
        const int e = C.tid & 31, sg = C.tid >> 5; int s = 0;
        for (int i = 0; i < 32; ++i) s += H[(sg * 32 + i) * 32 + e];
        SEG[sg * 32 + e] = s;
        __syncthreads();
        if (C.tid < 32) { int run = 0; for (int q = 0; q < 16; ++q) { SBASE[q * 32 + C.tid] = run; run += SEG[q * 32 + C.tid]; } TOT[C.tid] = run; }
        __syncthreads();
        int run = SBASE[sg * 32 + e];
        for (int i = 0; i < 32; ++i) { const int v = H[(sg * 32 + i) * 32 + e]; H[(sg * 32 + i) * 32 + e] = run; run += v; }
        if (C.tid == 0) { int o = 0; for (int q = 0; q < 32; ++q) { OFFS[q] = o; o += (TOT[q] + 255) & ~255; } OFFS[32] = o; }
        __syncthreads(); }
    if (blockIdx.x == 0) { int* texp = wsp<int>(C, WS_TEXP); const int RT = OFFS[32] >> 8;
        for (int rt = C.tid; rt < RT; rt += NTHR) { int e = 0;
            for (int q = 1; q < 32; ++q) if (rt * 256 >= OFFS[q]) e = q;
            texp[rt] = e; }
        if (C.tid == 0) texp[511] = RT; }
    const int gw = C.vcu * NWAVES + C.wave, NGW = C.G * NWAVES, lane = C.lane;
    const bf16* h2 = wsp<bf16>(C, WS_H2); bf16* xs = wsp<bf16>(C, WS_XS); const int* toke = wsp<int>(C, WS_TOKE); const int* tokr = wsp<int>(C, WS_TOKR); int* tokp = wsp<int>(C, WS_TOKP);
    for (int s = gw; s < NTOK * 2; s += NGW) { const int tok = s >> 1, e = toke[s]; const int ipos = OFFS[e] + H[(tok >> 6) * 32 + e] + tokr[s]; const size_t pos = (size_t)ipos;
        if (lane == 0) tokp[s] = ipos;
        const GAS u32x4* src = (const GAS u32x4*)(h2 + (size_t)tok * DM) + lane; GAS u32x4* dst = (GAS u32x4*)(xs + pos * DM) + lane;
        const u32x4 a = src[0], b = src[64]; dst[0] = a; dst[64] = b; }
}
constexpr int PH_PER_LAYER = 13, N_PHASES = 2 * PH_PER_LAYER + 1;
#ifndef MK_ONE_LAUNCH
#define MK_ONE_LAUNCH 1
#endif
#ifndef E2_ALIGN
#define E2_ALIGN false
#define E2_SP2 true
#endif
__global__ void __launch_bounds__(NTHR, 2) fwd(Args A) {
    extern __shared__ __attribute__((aligned(16))) unsigned char lds_raw[];
    Ctx C_;
    C_.lds = (LAS unsigned char*)lds_raw; C_.MISC = (volatile LAS unsigned*)(C_.lds + MISC_OFF);
    C_.tid = threadIdx.x; C_.lane = C_.tid & 63; C_.wave = __builtin_amdgcn_readfirstlane(C_.tid >> 6);
    C_.G = gridDim.x; { const int bx = blockIdx.x; C_.vcu = (C_.G % 8 == 0) ? (bx % 8) * (C_.G / 8) + bx / 8 : bx; }
    C_.ws = A.ws; C_.ctl = (gu32*)(A.ws + WS_CTL);
    for (int u = C_.tid; u < 128; u += NTHR) ((LAS unsigned*)(C_.lds + MISC_OFF))[u] = 0u;
    __syncthreads();
    const int lo = A.ph_lo, hi = A.ph_hi;
    const bool multi = (hi - lo) > 1;
    XcdBarrier bar; bar.wv = C_.wave; bar.bar = (unsigned*)(C_.ctl + CW_BAR); bar.x = 0; bar.st = nullptr;
    if (multi) bar = xcd_barrier_post((unsigned*)(C_.ctl + CW_BAR), C_.MISC + 8, C_.wave);
#ifndef PHASE_MASK
#define PHASE_MASK 0x1fff
#endif
#define HAS(k) (((PHASE_MASK) >> (k)) & 1)
#ifndef REPMASK
#define REPMASK 0
#endif
#ifndef REPCNT
#define REPCNT 2
#endif
#define NREP(k) ((((REPMASK) >> (k)) & 1) && layer == 0 ? REPCNT : 1)
#define IN(k) (lo <= (k) && (k) < hi)
#define SEAM(k) do { if (IN(k) && IN((k) + 1)) xcd_barrier(bar); } while (0)
#define FRESH() Ctx C = C_; C.lane = xb_lane(); C.tid = C_.wave * 64 + C.lane; asm volatile("" : "+s"(C.ws), "+s"(C.ctl), "+s"(C.vcu), "+s"(C.G))
    for (int layer = 0; layer < 3; ++layer) {
        const int pb = layer * PH_PER_LAYER;
        if (HAS(0) && IN(pb + 0)) for (int rep_ = 0; rep_ < NREP(0); ++rep_) { FRESH(); phase0(A, C, layer); }
        if (layer == 2) break;
        SEAM(pb + 0);
#ifdef XBAR_PROBE
        if (layer == 0 && IN(pb + 0) && IN(pb + 1)) { for (int q = 0; q < XBAR_PROBE; ++q) xcd_barrier(bar); }
#endif
        if (HAS(1) && IN(pb + 1)) for (int rep_ = 0; rep_ < NREP(1); ++rep_) { FRESH();
            pg8::Gemm g{(bf16*)A.out + (size_t)NTOK * DM, wsp<bf16>(C, WS_WT1), NTOK, 5120, 1024}; pg8::StaticOrder S; S.init(NTOK, 5120, C.G, (int)blockIdx.x);
            pg8::EpiOut<0> E{proj(C, 0), nullptr, nullptr, PROJ_STRIDE / 2};
            pg8::gemm_phase<pg8::EpiOut<0>, pg8::StaticOrder, true, true>(C.lds, g, S, E, C.tid);
        }
        SEAM(pb + 1);
        if (HAS(2) && IN(pb + 2)) for (int rep_ = 0; rep_ < NREP(2); ++rep_) { FRESH();  for (int g8 = C.vcu; g8 < 256; g8 += C.G) for (int i8 = 0; i8 < 8; ++i8) mlstm_u_item(A, C, layer, g8 >> 4, (g8 & 15) * 8 + i8, i8 == 0); }
        SEAM(pb + 2);
        if (HAS(3) && IN(pb + 3)) for (int rep_ = 0; rep_ < NREP(3); ++rep_) { FRESH(); mlstm_scan(C); }
        SEAM(pb + 3);
        if (HAS(4) && IN(pb + 4)) for (int rep_ = 0; rep_ < NREP(4); ++rep_) { FRESH();
            gu32* q0 = C.ctl + CW_Q + 64 * (layer * 4 + 0); gu32* q1 = C.ctl + CW_Q + 64 * (layer * 4 + 1); gu32* q2 = C.ctl + CW_Q + 64 * (layer * 4 + 2);
            for (int rc_ = 0; rc_ < NREP(13); ++rc_) {
                if (C.G == 256) { const int xg = C.vcu >> 5, r = C.vcu & 31;
                    for (int rd = 0; rd < 2; ++rd) { const int p = r + 32 * rd, bvh = xg * 4 + (p >> 4), pr = p & 15;
                        attn_unit<128, true>(A, C, layer, bvh >> 3, bvh & 7, 31 - pr); attn_unit<128, true>(A, C, layer, bvh >> 3, bvh & 7, pr); } }
                else { for (int it = C.vcu; it < 1024; it += C.G) attn_unit<128, true>(A, C, layer, (it & 31) >> 3, it & 7, 31 - (it >> 5)); } }
            for (int rc_ = NREP(15) - 1; rc_ >= 0; --rc_) { gu32* qq = rc_ ? C.ctl + CW_Q + 64 * (17 + 2 * rc_) : q2;
            for (;;) { if (C.tid == 0) C.MISC[0] = __hip_atomic_fetch_add(qq, 1u, RLX_AGENT); __syncthreads(); const int it = (int)C.MISC[0]; __syncthreads(); if (it >= 512) break;
                for (int i4 = 0; i4 < 4; ++i4) mlstm_out_item(A, C, layer, it >> 5, (it & 31) * 4 + i4, i4 == 0, rc_ ? wsp<bf16>(C, 480 * MiB) : nullptr); } }
            for (int rc_ = NREP(14) - 1; rc_ >= 0; --rc_) { gu32* qq = rc_ ? C.ctl + CW_Q + 64 * (16 + 2 * rc_) : q1;
            for (;;) { if (C.tid == 0) C.MISC[0] = __hip_atomic_fetch_add(qq, 1u, RLX_AGENT); __syncthreads(); const int it = (int)C.MISC[0]; __syncthreads(); if (it >= 1024) break;
                attn_unit<64, false>(A, C, layer, (it & 31) >> 3, it & 7, 31 - (it >> 5), rc_ ? wsp<bf16>(C, 480 * MiB) : nullptr); } }
        }
        SEAM(pb + 4);
        if (HAS(5) && IN(pb + 5)) for (int rep_ = 0; rep_ < NREP(5); ++rep_) { FRESH(); phase5(A, C, layer); }
        SEAM(pb + 5);
        if (HAS(6) && IN(pb + 6)) for (int rep_ = 0; rep_ < NREP(6); ++rep_) { FRESH();
            pg8::Gemm g{(bf16*)A.out + (size_t)NTOK * DM, wsp<bf16>(C, WS_WT2), NTOK, 3072, 1024}; pg8::StaticOrder S; S.init(NTOK, 3072, C.G, (int)blockIdx.x);
            pg8::EpiOut<1> E{wsp<bf16>(C, WS_G0), wsp<bf16>(C, WS_G1), wsp<bf16>(C, WS_G2), 0};
            pg8::gemm_phase<pg8::EpiOut<1>, pg8::StaticOrder, true, true>(C.lds, g, S, E, C.tid);
        }
        SEAM(pb + 6);
        if (HAS(7) && IN(pb + 7)) for (int rep_ = 0; rep_ < NREP(7); ++rep_) { FRESH();
            pg8::StaticOrder S; S.init(NTOK, 1024, C.G, (int)blockIdx.x); bf16* Y = wsp<bf16>(C, WS_O12);
            { pg8::Gemm g{proj(C, PJ_AV), wsp<bf16>(C, WS_PT), NTOK, 1024, 512}; pg8::EpiMerge<true> E{Y, wsp<bf16>(C, WS_G0)}; pg8::gemm_phase<pg8::EpiMerge<true>, pg8::StaticOrder, true, true>(C.lds, g, S, E, C.tid); }
            __syncthreads();
            { pg8::Gemm g{proj(C, PJ_BQ), wsp<bf16>(C, WS_PT) + 1024 * 512, NTOK, 1024, 512}; pg8::EpiMerge<false> E{Y, wsp<bf16>(C, WS_G1)}; pg8::gemm_phase<pg8::EpiMerge<false>, pg8::StaticOrder, true, true>(C.lds, g, S, E, C.tid); }
            __syncthreads();
            { pg8::Gemm g{proj(C, PJ_CQ), wsp<bf16>(C, WS_PT) + 2 * 1024 * 512, NTOK, 1024, 512}; pg8::EpiMerge<false> E{Y, wsp<bf16>(C, WS_G2)}; pg8::gemm_phase<pg8::EpiMerge<false>, pg8::StaticOrder, true, true>(C.lds, g, S, E, C.tid); }
        }
        SEAM(pb + 7);
        if (HAS(8) && IN(pb + 8)) for (int rep_ = 0; rep_ < NREP(8); ++rep_) { FRESH();
            pg8::Gemm g{wsp<bf16>(C, WS_O12), wsp<bf16>(C, WS_WOT), NTOK, 1024, 1024}; pg8::StaticOrder S; S.init(NTOK, 1024, C.G, (int)blockIdx.x);
            pg8::EpiResid E{layer == 0 ? (const void*)A.in[0] : (const void*)A.out, layer > 0, wsp<bf16>(C, WS_XB1)};
            pg8::gemm_phase<pg8::EpiResid, pg8::StaticOrder, true, true>(C.lds, g, S, E, C.tid);
        }
        SEAM(pb + 8);
        if (HAS(9) && IN(pb + 9)) for (int rep_ = 0; rep_ < NREP(9); ++rep_) { FRESH(); for (int r9 = 1; r9 < NREP(16); ++r9) { phase9(A, C, layer, true); __syncthreads(); } if (NREP(17) >= 2) { moe_weight_items(A, C, layer); __syncthreads(); } phase9(A, C, layer); }
        SEAM(pb + 9);
        if (HAS(10) && IN(pb + 10)) for (int rep_ = 0; rep_ < NREP(10); ++rep_) { FRESH(); phase10(C, layer); }
        SEAM(pb + 10);
        if (HAS(11) && IN(pb + 11)) for (int rep_ = 0; rep_ < NREP(11); ++rep_) { FRESH();
            const int* texp = wsp<int>(C, WS_TEXP); const int RT = __builtin_amdgcn_readfirstlane(texp[511]);
            pg8::Gemm g{wsp<bf16>(C, WS_XS), wsp<bf16>(C, WS_W1T), 73728, 32 * 512, 1024}; pg8::MoeOrder<1> S{C.G, C.vcu, RT, texp};
            pg8::EpiSiluMul E{wsp<bf16>(C, WS_HE)};
            pg8::gemm_phase<pg8::EpiSiluMul, pg8::MoeOrder<1>, true, true>(C.lds, g, S, E, C.tid);
        }
        SEAM(pb + 11);
        if (HAS(12) && IN(pb + 12)) for (int rep_ = 0; rep_ < NREP(12); ++rep_) { FRESH();
            const int* texp = wsp<int>(C, WS_TEXP); const int RT = __builtin_amdgcn_readfirstlane(texp[511]);
            pg8::Gemm g{wsp<bf16>(C, WS_HE), wsp<bf16>(C, WS_W2T), 73728, 32 * 1024, 256}; pg8::MoeOrder<2> S{C.G, C.vcu, RT, texp};
            pg8::EpiOut<2> E{wsp<bf16>(C, WS_OSL), nullptr, nullptr, 0};
            pg8::gemm_phase<pg8::EpiOut<2>, pg8::MoeOrder<2>, E2_ALIGN, E2_SP2>(C.lds, g, S, E, C.tid);
        }
        SEAM(pb + 12);
    }
#undef IN
#undef SEAM
}

extern "C" void kernel_launch(void* const* d_in, const int* in_sizes, int n_in, void* d_out, int out_size, void* d_ws, size_t ws_size, hipStream_t stream) {
    static int grid = 0;
    if (grid == 0) {
        if (n_in != 23 || out_size != NTOK * DM || ws_size < WS_NEED) { fprintf(stderr, "kernel_launch: unexpected shapes (n_in %d out %d ws %zu)\n", n_in, out_size, ws_size); grid = -1; return; }
        int dev = 0, cus = 0, per_cu = 0;
        if (hipGetDevice(&dev) != hipSuccess || hipDeviceGetAttribute(&cus, hipDeviceAttributeMultiprocessorCount, dev) != hipSuccess) { grid = -1; return; }
        if (hipFuncSetAttribute((const void*)fwd, hipFuncAttributeMaxDynamicSharedMemorySize, LDS_BYTES) != hipSuccess) { fprintf(stderr, "kernel_launch: hipFuncSetAttribute failed\n"); grid = -1; return; }
        if (hipOccupancyMaxActiveBlocksPerMultiprocessor(&per_cu, (const void*)fwd, NTHR, LDS_BYTES) != hipSuccess || per_cu < 1) fprintf(stderr, "kernel_launch: occupancy query says %d\n", per_cu);
        (void)hipGetLastError();
        grid = cus;
    }
    if (grid < 0) return;
    (void)hipMemsetAsync((char*)d_ws + WS_CTL, 0, CTL_ZERO_BYTES, stream);
    Args a{};
    for (int i = 0; i < 23; ++i) a.in[i] = (const float*)d_in[i];
    a.out = (float*)d_out; a.ws = (unsigned char*)d_ws;
#if MK_ONE_LAUNCH
    a.ph_lo = 0; a.ph_hi = N_PHASES;
    hipLaunchKernelGGL(fwd, dim3(grid), dim3(NTHR), LDS_BYTES, stream, a);
#else
    for (int p = 0; p < N_PHASES; ++p) { a.ph_lo = p; a.ph_hi = p + 1; hipLaunchKernelGGL(fwd, dim3(grid), dim3(NTHR), LDS_BYTES, stream, a); }
#endif
}
```

```cpp
#include <hip/hip_runtime.h>
#include <cstdio>
#include <cstdint>
#include <cmath>
namespace pg8 {
#define PG8_LAS __attribute__((address_space(3)))
typedef unsigned short bf16_t;
typedef short bf16x8 __attribute__((ext_vector_type(8)));
typedef float f32x4 __attribute__((ext_vector_type(4)));
typedef unsigned u32x4 __attribute__((ext_vector_type(4)));
constexpr int BM = 256, BK = 64, HALF = 128, HTB = HALF * BK * 2  , STAGE_BYTES = 8 * HTB, NXCD = 8, WGM = 8;

__host__ __device__ __forceinline__ int lds_byte(int r, int c) { const int st = (r >> 4) * 2 + (c >> 5), rr = r & 15, cc = c & 31, ob = rr * 64 + cc * 2; return st * 1024 + (ob ^ (((ob >> 9) & 1) << 5)); }
__host__ __device__ __forceinline__ void stage_rc(int b, int& R, int& C) { const int st = b / 1024, sb = b % 1024, swz = sb ^ (((sb >> 9) & 1) << 5); R = (st >> 1) * 16 + swz / 64; C = (st & 1) * 32 + (swz % 64) / 2; }
__host__ __device__ __forceinline__ int perm32(int rho) { const int n = rho >> 4, i = rho & 15; return 8 * (i >> 2) + 4 * n + (i & 3); }

struct Unit { int pm, pn; };
struct Gemm { const bf16_t* A; const bf16_t* Bt; int M, N, K; };

struct StaticOrder {
    int nM, nN, nwg, G, c;
    __host__ __device__ void init(int M, int N, int G_, int c_) { nM = M / BM; nN = N / BM; nwg = nM * nN; G = G_; c = c_; }
    __host__ __device__ bool next(int i, Unit& u) const {
        const long L = (long)i * G + c; if (L >= nwg) return false;
        int wgid = (int)L; { const int q = nwg / NXCD, r = nwg % NXCD, xcd = wgid % NXCD, off = wgid / NXCD; wgid = (xcd < r ? xcd * (q + 1) : r * (q + 1) + (xcd - r) * q) + off; }
        const int nig = WGM * nN, gid = wgid / nig, fm = gid * WGM, gsz = (nM - fm) < WGM ? (nM - fm) : WGM;
        u.pm = fm + ((wgid % nig) % gsz); u.pn = (wgid % nig) / gsz; return true;
    }
    __device__ __forceinline__ void a_ready(const Unit&) const {}
    __device__ __forceinline__ void done(const Unit&) const {}
};

__device__ __forceinline__ unsigned cvt_pk_bf16(float lo, float hi) { unsigned r; asm volatile("v_cvt_pk_bf16_f32 %0, %1, %2" : "=v"(r) : "v"(lo), "v"(hi)); return r; }
#ifndef GAS
#define GAS __attribute__((address_space(1)))
#endif
typedef float f32x2 __attribute__((ext_vector_type(2)));
__device__ __forceinline__ float bflo(unsigned u) { return __builtin_bit_cast(float, u << 16); }
__device__ __forceinline__ float bfhi(unsigned u) { return __builtin_bit_cast(float, u & 0xffff0000u); }
__device__ __forceinline__ float sigmoidf_(float x) { return 1.f / (1.f + __expf(-x)); }
template <int MODE> struct EpiOut {
    static constexpr bool PERM = true, AFTER_DRAIN = false, CHAIN = false;
    bf16_t* b0; bf16_t* b1; bf16_t* b2; size_t stride;
    __device__ __forceinline__ void operator()(const f32x4 (&acc)[2][2][4][2], const Unit& u, int wr, int wc, int fr, int fq) const {
        int row0 = u.pm * BM + wr * 64 + fr; asm volatile("" : "+v"(row0));
        bf16_t* base; int colt, ldc;
        if (MODE == 0) { base = b0 + (size_t)(u.pn >> 1) * stride; colt = (u.pn & 1) * 256; ldc = 512; }
        else if (MODE == 1) { const int t = u.pn >> 2; base = b0 + (size_t)(160 * t - 32 * t * (t - 1)) * (1u << 19); colt = (u.pn & 3) * 256; ldc = 1024; }
        else { base = b0; colt = (u.pn & 3) * 256; ldc = 1024; }
        const int col0 = colt + wc * 32 + 8 * fq;
#pragma unroll
        for (int ai = 0; ai < 2; ++ai)
#pragma unroll
            for (int m = 0; m < 4; ++m) { bf16_t* rowp = base + (size_t)(row0 + ai * HALF + m * 16) * ldc + col0;
#pragma unroll
                for (int bj = 0; bj < 2; ++bj) { f32x4 v0 = acc[ai][bj][m][0], v1 = acc[ai][bj][m][1];
                    if (MODE == 1) {
#pragma unroll
                        for (int j = 0; j < 4; ++j) { v0[j] = sigmoidf_(v0[j]); v1[j] = sigmoidf_(v1[j]); } }
                    u32x4 w; w.x = cvt_pk_bf16(v0[0], v0[1]); w.y = cvt_pk_bf16(v0[2], v0[3]); w.z = cvt_pk_bf16(v1[0], v1[1]); w.w = cvt_pk_bf16(v1[2], v1[3]);
                    *(GAS u32x4*)(rowp + bj * HALF) = w; } }
    }
};
template <bool FIRST> struct EpiMerge {
    static constexpr bool PERM = true, AFTER_DRAIN = false, CHAIN = false;
    bf16_t* Y; const bf16_t* G;
    __device__ __forceinline__ void operator()(const f32x4 (&acc)[2][2][4][2], const Unit& u, int wr, int wc, int fr, int fq) const {
        int row0 = u.pm * BM + wr * 64 + fr; asm volatile("" : "+v"(row0)); const int col0 = u.pn * BM + wc * 32 + 8 * fq;
#pragma unroll
        for (int ai = 0; ai < 2; ++ai)
#pragma unroll
            for (int m = 0; m < 4; ++m) { const size_t ro = (size_t)(row0 + ai * HALF + m * 16) * 1024 + col0;
#pragma unroll
                for (int bj = 0; bj < 2; ++bj) { const f32x4 v0 = acc[ai][bj][m][0], v1 = acc[ai][bj][m][1];
                    const u32x4 g = *(const GAS u32x4*)(G + ro + bj * HALF);
                    float r[8] = { bflo(g.x) * v0[0], bfhi(g.x) * v0[1], bflo(g.y) * v0[2], bfhi(g.y) * v0[3], bflo(g.z) * v1[0], bfhi(g.z) * v1[1], bflo(g.w) * v1[2], bfhi(g.w) * v1[3] };
                    if (!FIRST) { const u32x4 y = *(const GAS u32x4*)(Y + ro + bj * HALF);
                        r[0] += bflo(y.x); r[1] += bfhi(y.x); r[2] += bflo(y.y); r[3] += bfhi(y.y); r[4] += bflo(y.z); r[5] += bfhi(y.z); r[6] += bflo(y.w); r[7] += bfhi(y.w); }
                    u32x4 w; w.x = cvt_pk_bf16(r[0], r[1]); w.y = cvt_pk_bf16(r[2], r[3]); w.z = cvt_pk_bf16(r[4], r[5]); w.w = cvt_pk_bf16(r[6], r[7]);
                    *(GAS u32x4*)(Y + ro + bj * HALF) = w; } }
    }
};
struct EpiResid {
    static constexpr bool PERM = true, AFTER_DRAIN = false, CHAIN = false;
    const void* XS; bool xbf; bf16_t* OUT;
    __device__ __forceinline__ void operator()(const f32x4 (&acc)[2][2][4][2], const Unit& u, int wr, int wc, int fr, int fq) const {
        int row0 = u.pm * BM + wr * 64 + fr; asm volatile("" : "+v"(row0)); const int col0 = u.pn * BM + wc * 32 + 8 * fq;
#pragma unroll
        for (int ai = 0; ai < 2; ++ai)
#pragma unroll
            for (int m = 0; m < 4; ++m) { const size_t ro = (size_t)(row0 + ai * HALF + m * 16) * 1024 + col0;
#pragma unroll
                for (int bj = 0; bj < 2; ++bj) { f32x4 x0, x1;
                    if (xbf) { const u32x4 xv = *(const GAS u32x4*)((const bf16_t*)XS + ro + bj * HALF); x0 = (f32x4){bflo(xv.x), bfhi(xv.x), bflo(xv.y), bfhi(xv.y)}; x1 = (f32x4){bflo(xv.z), bfhi(xv.z), bflo(xv.w), bfhi(xv.w)}; }
                    else { x0 = *(const GAS f32x4*)((const float*)XS + ro + bj * HALF); x1 = *(const GAS f32x4*)((const float*)XS + ro + bj * HALF + 4); }
                    x0 = x0 + acc[ai][bj][m][0]; x1 = x1 + acc[ai][bj][m][1];
                    u32x4 w; w.x = cvt_pk_bf16(x0[0], x0[1]); w.y = cvt_pk_bf16(x0[2], x0[3]); w.z = cvt_pk_bf16(x1[0], x1[1]); w.w = cvt_pk_bf16(x1[2], x1[3]);
                    *(GAS u32x4*)(OUT + ro + bj * HALF) = w; } }
    }
};
struct EpiSiluMul {
    static constexpr bool PERM = true, AFTER_DRAIN = false, CHAIN = false;
    bf16_t* O;
    __device__ __forceinline__ void operator()(const f32x4 (&acc)[2][2][4][2], const Unit& u, int wr, int wc, int fr, int fq) const {
        int row0 = u.pm * BM + wr * 64 + fr; asm volatile("" : "+v"(row0)); const int col0 = (u.pn & 1) * 128 + wc * 32 + 8 * fq;
#pragma unroll
        for (int ai = 0; ai < 2; ++ai)
#pragma unroll
            for (int m = 0; m < 4; ++m) { float r[8];
#pragma unroll
                for (int n = 0; n < 2; ++n)
#pragma unroll
                    for (int j = 0; j < 4; ++j) { const float g = acc[ai][0][m][n][j], up = acc[ai][1][m][n][j]; r[4 * n + j] = g * sigmoidf_(g) * up; }
                u32x4 w; w.x = cvt_pk_bf16(r[0], r[1]); w.y = cvt_pk_bf16(r[2], r[3]); w.z = cvt_pk_bf16(r[4], r[5]); w.w = cvt_pk_bf16(r[6], r[7]);
                *(GAS u32x4*)(O + (size_t)(row0 + ai * HALF + m * 16) * 256 + col0) = w; }
    }
};
template <int LOG_NCT> struct MoeOrder {
    int G, c, RT; const int* texp;
    __device__ __forceinline__ bool next(int i, Unit& u) const {
        const int L = i * G + c; const int rt = L >> LOG_NCT; if (rt >= RT) return false;
        const int e = __builtin_amdgcn_readfirstlane(texp[rt]); u.pm = rt; u.pn = (e << LOG_NCT) + (L & ((1 << LOG_NCT) - 1)); return true;
    }
    __device__ __forceinline__ void a_ready(const Unit&) const {}
    __device__ __forceinline__ void done(const Unit&) const {}
};
template <class Epi, class Sched, bool ALIGN_EPI = false, bool SP2 = false>
__device__ __forceinline__ void gemm_phase(PG8_LAS unsigned char* lds, const Gemm g, const Sched& S, const Epi& E, int tid_in) {
    int tid = tid_in; asm volatile("" : "+v"(tid));
    const int wid = __builtin_amdgcn_readfirstlane(tid >> 6), lane = tid & 63, wr = wid >> 2, wc = wid & 3, fr = lane & 15, fq = lane >> 4;
    const int K = g.K, nt = K / BK;
    unsigned voffA[2], voffB[2];
#pragma unroll
    for (int i = 0; i < 2; ++i) { int R, C; stage_rc(tid * 16 + i * 8192, R, C); const int Rb = Epi::PERM ? ((R & ~31) + perm32(R & 31)) : R;
        voffA[i] = (unsigned)(R * K + C) * 2u; voffB[i] = (unsigned)(Rb * K + C) * 2u; }
    const size_t kstep = (size_t)(BK * 2);
    const size_t hstep = (size_t)HALF * K * 2;
    const size_t tstep = 2 * hstep;
    const unsigned ldsw = (unsigned)wid * 1024u;
    const int aoff = lds_byte(wr * 64 + fr, fq * 8), boff = lds_byte(wc * 32 + fr, fq * 8);
#define PG8_SA(b, h) (((b) * 2 + (h)) * HTB)
#define PG8_SB(b, h) ((4 + (b) * 2 + (h)) * HTB)
#define PG8_STAGE(bufoff, gbase, voff) do { _Pragma("unroll") for (int _i = 0; _i < 2; ++_i) \
        __builtin_amdgcn_global_load_lds((const unsigned*)((const char*)(gbase) + (voff)[_i]), (PG8_LAS unsigned*)(lds + (bufoff) + ldsw + _i * 8192), 16, 0, 0); } while (0)
#define PG8_LDA(dst, b, h) do { _Pragma("unroll") for (int m = 0; m < 4; ++m) _Pragma("unroll") for (int k = 0; k < 2; ++k) dst[m][k] = *(const PG8_LAS bf16x8*)(lds + PG8_SA(b, h) + aoff + m * 2048 + k * 1024); } while (0)
#define PG8_LDB(dst, b, h) do { _Pragma("unroll") for (int n = 0; n < 2; ++n) _Pragma("unroll") for (int k = 0; k < 2; ++k) dst[n][k] = *(const PG8_LAS bf16x8*)(lds + PG8_SB(b, h) + boff + n * 2048 + k * 1024); } while (0)
#define PG8_MMA(ai, bj, At, Bt) do { __builtin_amdgcn_s_setprio(1); _Pragma("unroll") for (int m = 0; m < 4; ++m) _Pragma("unroll") for (int n = 0; n < 2; ++n) _Pragma("unroll") for (int k = 0; k < 2; ++k) \
        acc[ai][bj][m][n] = __builtin_amdgcn_mfma_f32_16x16x32_bf16(Bt[n][k], At[m][k], acc[ai][bj][m][n], 0, 0, 0); __builtin_amdgcn_s_setprio(0); } while (0)
#define PG8_WAIT_V(n) asm volatile("s_waitcnt vmcnt(" #n ")" ::: "memory")
#define PG8_WAIT_L(n) asm volatile("s_waitcnt lgkmcnt(" #n ")" ::: "memory")
#define PG8_BAR __builtin_amdgcn_s_barrier()
#define PG8_SCHED __builtin_amdgcn_sched_barrier(0)
    Unit cur, nxt; int ui = 0;
    if (!S.next(0, cur)) return;
    f32x4 acc[2][2][4][2];
#pragma unroll
    for (int a = 0; a < 2; ++a)
#pragma unroll
        for (int b = 0; b < 2; ++b)
#pragma unroll
            for (int m = 0; m < 4; ++m)
#pragma unroll
                for (int n = 0; n < 2; ++n) acc[a][b][m][n] = (f32x4){0.f, 0.f, 0.f, 0.f};
    bf16x8 At[4][2], B0[2][2], B1[2][2];
    const char* cA = (const char*)g.A + (size_t)cur.pm * tstep; const char* cB = (const char*)g.Bt + (size_t)cur.pn * tstep;
    S.a_ready(cur);
    if constexpr (SP2) {
        PG8_STAGE(PG8_SB(0, 0), cB, voffB); PG8_STAGE(PG8_SB(0, 1), cB + hstep, voffB); PG8_STAGE(PG8_SA(0, 0), cA, voffA); PG8_STAGE(PG8_SA(0, 1), cA + hstep, voffA);
        if (wr == 1) PG8_BAR;
        PG8_WAIT_V(2); PG8_BAR;
        PG8_STAGE(PG8_SB(1, 0), cB + kstep, voffB); PG8_STAGE(PG8_SA(1, 0), cA + kstep, voffA); PG8_STAGE(PG8_SB(1, 1), cB + hstep + kstep, voffB);
        PG8_WAIT_V(6); PG8_BAR;
    } else {
        PG8_STAGE(PG8_SB(0, 0), cB, voffB); PG8_STAGE(PG8_SA(0, 0), cA, voffA); PG8_STAGE(PG8_SB(0, 1), cB + hstep, voffB); PG8_STAGE(PG8_SA(0, 1), cA + hstep, voffA);
        if (wr == 1) PG8_BAR;
        PG8_WAIT_V(4); PG8_BAR;
        PG8_STAGE(PG8_SB(1, 0), cB + kstep, voffB); PG8_STAGE(PG8_SA(1, 0), cA + kstep, voffA); PG8_STAGE(PG8_SB(1, 1), cB + hstep + kstep, voffB);
        PG8_WAIT_V(6); PG8_BAR;
    }
    for (;;) {
        const bool has_next = S.next(ui + 1, nxt);
        const char* nA = has_next ? (const char*)g.A + (size_t)nxt.pm * tstep : cA; const char* nB = has_next ? (const char*)g.Bt + (size_t)nxt.pn * tstep : cB;
        for (int t = 0; t < nt; t += 2) {
            const bool last = (t == nt - 2);
            const char* a1 = cA + (size_t)(t + 1) * kstep;
            const char* a2 = last ? nA : cA + (size_t)(t + 2) * kstep; const char* b2 = last ? nB : cB + (size_t)(t + 2) * kstep;
            const char* a3 = a2 + kstep; const char* b3 = b2 + kstep;
            if (last && has_next) S.a_ready(nxt);
            if constexpr (SP2) {
            PG8_LDB(B0, 0, 0); PG8_LDB(B1, 0, 1); PG8_SCHED; PG8_LDA(At, 0, 0); PG8_STAGE(PG8_SA(1, 1), a1 + hstep, voffA);
            PG8_WAIT_V(8); PG8_WAIT_L(0); PG8_BAR; PG8_MMA(0, 0, At, B0); PG8_MMA(0, 1, At, B1); PG8_BAR; PG8_SCHED;
            PG8_LDA(At, 0, 1); PG8_STAGE(PG8_SB(0, 0), b2, voffB); PG8_STAGE(PG8_SB(0, 1), b2 + hstep, voffB); PG8_STAGE(PG8_SA(0, 0), a2, voffA);
            PG8_WAIT_V(8); PG8_WAIT_L(0); PG8_BAR; PG8_MMA(1, 0, At, B0); PG8_MMA(1, 1, At, B1); PG8_BAR; PG8_SCHED;
            PG8_LDB(B0, 1, 0); PG8_LDB(B1, 1, 1); PG8_SCHED; PG8_LDA(At, 1, 0); PG8_STAGE(PG8_SA(0, 1), a2 + hstep, voffA);
            PG8_WAIT_V(8); PG8_WAIT_L(0); PG8_BAR; PG8_MMA(0, 0, At, B0); PG8_MMA(0, 1, At, B1); PG8_BAR; PG8_SCHED;
            PG8_LDA(At, 1, 1); PG8_STAGE(PG8_SB(1, 0), b3, voffB); PG8_STAGE(PG8_SB(1, 1), b3 + hstep, voffB); PG8_STAGE(PG8_SA(1, 0), a3, voffA);
            PG8_WAIT_V(8); PG8_WAIT_L(0); PG8_BAR; PG8_MMA(1, 0, At, B0); PG8_MMA(1, 1, At, B1); PG8_BAR; PG8_SCHED;
            } else {
            PG8_LDB(B0, 0, 0); PG8_SCHED; PG8_LDA(At, 0, 0); PG8_STAGE(PG8_SA(1, 1), a1 + hstep, voffA);
            PG8_WAIT_L(8); PG8_BAR; PG8_WAIT_L(0); PG8_MMA(0, 0, At, B0); PG8_BAR; PG8_SCHED;
            PG8_LDB(B1, 0, 1); PG8_STAGE(PG8_SB(0, 0), b2, voffB);
            PG8_BAR; PG8_WAIT_L(0); PG8_MMA(0, 1, At, B1); PG8_BAR;
            PG8_LDA(At, 0, 1); PG8_STAGE(PG8_SA(0, 0), a2, voffA);
            PG8_BAR; PG8_WAIT_L(0); PG8_MMA(1, 0, At, B0); PG8_BAR; PG8_SCHED;
            PG8_STAGE(PG8_SB(0, 1), b2 + hstep, voffB);
            PG8_WAIT_V(6); PG8_BAR; PG8_MMA(1, 1, At, B1); PG8_BAR;
            PG8_LDB(B0, 1, 0); PG8_SCHED; PG8_LDA(At, 1, 0); PG8_STAGE(PG8_SA(0, 1), a2 + hstep, voffA);
            PG8_WAIT_L(8); PG8_BAR; PG8_WAIT_L(0); PG8_MMA(0, 0, At, B0); PG8_BAR; PG8_SCHED;
            PG8_LDB(B1, 1, 1); PG8_STAGE(PG8_SB(1, 0), b3, voffB);
            PG8_BAR; PG8_WAIT_L(0); PG8_MMA(0, 1, At, B1); PG8_BAR;
            PG8_LDA(At, 1, 1); PG8_STAGE(PG8_SA(1, 0), a3, voffA);
            PG8_BAR; PG8_WAIT_L(0); PG8_MMA(1, 0, At, B0); PG8_BAR; PG8_SCHED;
            PG8_STAGE(PG8_SB(1, 1), b3 + hstep, voffB);
            PG8_WAIT_V(6); PG8_BAR; PG8_MMA(1, 1, At, B1); PG8_BAR;
            }
        }
        if constexpr (ALIGN_EPI) { if (wr == 0) PG8_BAR; }
        if constexpr (!Epi::AFTER_DRAIN) { E(acc, cur, wr, wc, fr, fq); S.done(cur); }
        if (!has_next) break;
#pragma unroll
        for (int a = 0; a < 2; ++a)
#pragma unroll
            for (int b = 0; b < 2; ++b)
#pragma unroll
                for (int m = 0; m < 4; ++m)
#pragma unroll
                    for (int n = 0; n < 2; ++n) acc[a][b][m][n] = (f32x4){0.f, 0.f, 0.f, 0.f};
        cur = nxt; cA = nA; cB = nB; ++ui;
        if constexpr (ALIGN_EPI) { if (wr == 1) PG8_BAR; }
    }
    PG8_WAIT_V(0);
    if constexpr (!ALIGN_EPI) { if (wr == 0) PG8_BAR; }
    PG8_BAR;
    if constexpr (Epi::AFTER_DRAIN) { E.fused(acc, cur, wr, wc, fr, fq, lds, wid, lane); S.done(cur); }
#undef PG8_SA
#undef PG8_SB
#undef PG8_STAGE
#undef PG8_LDA
#undef PG8_LDB
#undef PG8_MMA
#undef PG8_WAIT_V
#undef PG8_WAIT_L
#undef PG8_BAR
#undef PG8_SCHED
}
}
constexpr int NTOK = 32768, SEQ = 8192, NB = 4, DM = 1024, INC = 8200;
constexpr float EPS = 1e-6f, LOG2E = 1.4426950408889634f;
constexpr size_t MiB = 1u << 20;
constexpr size_t WS_CTL = 0, CTL_ZERO_BYTES = 128 * 1024;
constexpr size_t WS_IG = 1 * MiB;
constexpr size_t WS_BC = 1 * MiB + 512 * 1024;
constexpr size_t WS_BLAST = 2 * MiB;
constexpr size_t WS_GMAX = 2 * MiB + 64 * 1024;
constexpr size_t WS_NUC = 3 * MiB;
constexpr size_t WS_TOKE = 4 * MiB;
constexpr size_t WS_TOKR = 4 * MiB + 256 * 1024;
constexpr size_t WS_TOKW = 4 * MiB + 512 * 1024;
constexpr size_t WS_TEXP = 5 * MiB;
constexpr size_t WS_HISTG = 5 * MiB + 64 * 1024;
constexpr size_t WS_TOKP = 6 * MiB;
constexpr size_t WS_WT1 = 8 * MiB;
constexpr size_t WS_WT2 = 18 * MiB;
constexpr size_t WS_PT = 24 * MiB;
constexpr size_t WS_WOT = 27 * MiB;
constexpr size_t WS_PROJ = 32 * MiB;
constexpr size_t PROJ_STRIDE = 32 * MiB;
constexpr size_t WS_HB = 352 * MiB;
constexpr size_t WS_O12 = 416 * MiB;
constexpr size_t WS_G0 = 32 * MiB, WS_G1 = 192 * MiB, WS_G2 = 288 * MiB;
constexpr size_t WS_H2 = 32 * MiB;
constexpr size_t WS_XS = 96 * MiB;
constexpr size_t WS_HE = 32 * MiB;
constexpr size_t WS_OSL = 96 * MiB;
constexpr size_t WS_W1T = 416 * MiB;
constexpr size_t WS_W2T = 448 * MiB;
constexpr size_t WS_XB1 = 256 * MiB;
constexpr size_t WS_NEED = 512 * MiB;
constexpr int PJ_AQ = 0, PJ_AK = 1, PJ_AV = 2, PJ_AO = 3, PJ_BQ = 4, PJ_BK = 5, PJ_BV = 6, PJ_CQ = 7, PJ_CK = 8, PJ_CV = 9;
constexpr int CW_TMO = 0, CW_CODE = 1;
constexpr int CW_BAR = 4096;
constexpr int CW_Q = 8192;
constexpr int CW_CNT = 12288;
constexpr int RING_BYTES = 131072;
constexpr int MISC_OFF = RING_BYTES;
constexpr int OFFS_OFF = RING_BYTES + 256;
constexpr int LDS_BYTES = 147456;
constexpr int NWAVES = 8, NTHR = 512;

#ifndef GAS
#define GAS __attribute__((address_space(1)))
#endif
#define LAS __attribute__((address_space(3)))
typedef unsigned short bf16;
typedef float f32x4 __attribute__((ext_vector_type(4)));
typedef float f32x16 __attribute__((ext_vector_type(16)));
typedef short bf16x8 __attribute__((ext_vector_type(8)));
typedef unsigned u32x4 __attribute__((ext_vector_type(4)));
typedef unsigned u32x2 __attribute__((ext_vector_type(2)));
typedef short s16x4 __attribute__((ext_vector_type(4)));
typedef GAS unsigned gu32;
#define RLX_AGENT __ATOMIC_RELAXED, __HIP_MEMORY_SCOPE_AGENT
#define LDS_WAIT() asm volatile("s_waitcnt lgkmcnt(0)" ::: "memory")
typedef float f32x2_t __attribute__((ext_vector_type(2))); typedef __bf16 bf16x2_t __attribute__((ext_vector_type(2)));
__device__ __forceinline__ unsigned pk2(float lo, float hi) { f32x2_t v = {lo, hi}; bf16x2_t b = __builtin_convertvector(v, bf16x2_t); return __builtin_bit_cast(unsigned, b); }
__device__ __forceinline__ float bflo(unsigned u) { return __builtin_bit_cast(float, u << 16); }
__device__ __forceinline__ float bfhi(unsigned u) { return __builtin_bit_cast(float, u & 0xffff0000u); }
__device__ __forceinline__ float sigm(float x) { return 1.f / (1.f + __expf(-x)); }
template <int O> __device__ __forceinline__ float xor_shfl(float v) {
    return __builtin_bit_cast(float, __builtin_amdgcn_ds_swizzle(__builtin_bit_cast(int, v), (O << 10) | 0x1f));
}
__device__ __forceinline__ float wave_sum(float v) {
    v += xor_shfl<1>(v); v += xor_shfl<2>(v); v += xor_shfl<4>(v); v += xor_shfl<8>(v); v += xor_shfl<16>(v);
    auto rr = __builtin_amdgcn_permlane32_swap(__float_as_uint(v), __float_as_uint(v), false, false);
    return __uint_as_float(rr[0]) + __uint_as_float(rr[1]);
}
__device__ __forceinline__ float wave_max(float v) {
    v = fmaxf(v, xor_shfl<1>(v)); v = fmaxf(v, xor_shfl<2>(v)); v = fmaxf(v, xor_shfl<4>(v)); v = fmaxf(v, xor_shfl<8>(v)); v = fmaxf(v, xor_shfl<16>(v));
    auto rr = __builtin_amdgcn_permlane32_swap(__float_as_uint(v), __float_as_uint(v), false, false);
    return fmaxf(__uint_as_float(rr[0]), __uint_as_float(rr[1]));
}
__device__ __forceinline__ float lane_up(float v, int lane, int o) {
    return __builtin_bit_cast(float, __builtin_amdgcn_ds_bpermute(((lane - o) & 63) << 2, __builtin_bit_cast(int, v)));
}
__device__ __forceinline__ float lane_get(float v, int src) {
    return __builtin_bit_cast(float, __builtin_amdgcn_readlane(__builtin_bit_cast(int, v), src));
}
__device__ __forceinline__ float pair_sum(float v) {
    auto rr = __builtin_amdgcn_permlane32_swap(__float_as_uint(v), __float_as_uint(v), false, false);
    return __uint_as_float(rr[0]) + __uint_as_float(rr[1]);
}
__device__ __forceinline__ float pair_max(float v) {
    auto rr = __builtin_amdgcn_permlane32_swap(__float_as_uint(v), __float_as_uint(v), false, false);
    return fmaxf(__uint_as_float(rr[0]), __uint_as_float(rr[1]));
}
__device__ __forceinline__ float max3f(float a, float b, float c) { float r; asm("v_max3_f32 %0, %1, %2, %3" : "=v"(r) : "v"(a), "v"(b), "v"(c)); return r; }
__device__ __forceinline__ int crow(int r, int hi) { return (r & 3) + 8 * (r >> 2) + 4 * hi; }
typedef short v4i16_t __attribute__((ext_vector_type(4)));
__device__ __forceinline__ s16x4 tr16(const LAS unsigned char* p) { return __builtin_bit_cast(s16x4, __builtin_amdgcn_ds_read_tr16_b64_v4i16((LAS v4i16_t*)p)); }
__device__ __forceinline__ bf16x8 cat8(s16x4 lo, s16x4 hi) { return (bf16x8){lo[0], lo[1], lo[2], lo[3], hi[0], hi[1], hi[2], hi[3]}; }
__device__ __forceinline__ f32x4 ldrow4(const void* base, bool isbf, size_t row, int idx) {
    if (isbf) { const u32x2 u = ((const GAS u32x2*)((const bf16*)base + row * 1024))[idx]; return (f32x4){bflo(u.x), bfhi(u.x), bflo(u.y), bfhi(u.y)}; }
    return ((const GAS f32x4*)((const float*)base + row * 1024))[idx];
}
#define MFMA32(a, b, c) __builtin_amdgcn_mfma_f32_32x32x16_bf16((a), (b), (c), 0, 0, 0)
#define XB_TMO      128
#define XB_XCNT(j)  (256  + 64 * (j))
#define XB_XSUB(j)  (1280 + 64 * (j))
#define XB_XGEN(j)  (2304 + 64 * (j))
#define XB_TOP      3328
#define XB_TOPGEN   3392
#define XCD_BAR_WORDS 3456
#define XB_SPIN_CAP (1u << 18)

__device__ __forceinline__ unsigned xb_ld(unsigned* p)              { return __hip_atomic_load(p, __ATOMIC_RELAXED, __HIP_MEMORY_SCOPE_AGENT); }
__device__ __forceinline__ unsigned xb_add(unsigned* p, unsigned v) { return __hip_atomic_fetch_add(p, v, __ATOMIC_RELAXED, __HIP_MEMORY_SCOPE_AGENT); }
__device__ __forceinline__ unsigned xb_xcc_id() { return (unsigned)__builtin_amdgcn_s_getreg((3 << 11) | 20) & 0xFu; }
#define XB_SPIN(cond, bar) do { unsigned _sp = 0; while (cond) { __builtin_amdgcn_s_sleep(1); \
    if ((++_sp & 255u) == 0u) { if (xb_ld(&(bar)[XB_TMO])) break; if (_sp > XB_SPIN_CAP) { atomicAdd(&(bar)[XB_TMO], 1u); break; } } } } while (0)

__device__ __forceinline__ int xb_lane() { int l; asm volatile("v_mbcnt_lo_u32_b32 %0, -1, 0\n\tv_mbcnt_hi_u32_b32 %0, -1, %0" : "=v"(l)); return l; }
struct XcdBarrier {
    int wv;
    unsigned* bar; unsigned x;
    volatile LAS unsigned* st;
};

__device__ __forceinline__ XcdBarrier xcd_barrier_post(unsigned* bar, volatile LAS unsigned* st, int wv) {
    XcdBarrier b; b.wv = wv; b.bar = bar; b.x = xb_xcc_id(); b.st = st;
    if (wv == 0 && xb_lane() == 0) (void)xb_add(&bar[XB_XCNT(b.x)], 1u);
    return b;
}
__device__ __forceinline__ void xcd_barrier_complete(unsigned* bar, unsigned x, unsigned& nloc, unsigned& nx) {
    const unsigned G = gridDim.x * gridDim.y * gridDim.z;
    unsigned sum, cnt, mine, sp = 0u;
    for (;;) {
        sum = 0u; cnt = 0u; mine = 0u;
#pragma unroll
        for (unsigned j = 0; j < 16; ++j) { const unsigned c = xb_ld(&bar[XB_XCNT(j)]); sum += c; cnt += (c > 0u) ? 1u : 0u; mine = (j == x) ? c : mine; }
        if (sum == G) break;
        __builtin_amdgcn_s_sleep(1);
        if ((++sp & 255u) == 0u) { if (xb_ld(&bar[XB_TMO])) break; if (sp > XB_SPIN_CAP) { atomicAdd(&bar[XB_TMO], 1u); break; } }
    }
    nloc = mine > 0u ? mine : 1u; nx = cnt > 0u ? cnt : 1u;
}

__device__ __forceinline__ void xcd_barrier(const XcdBarrier& b) {
    asm volatile("s_waitcnt vmcnt(0)" ::: "memory");
    __syncthreads();
    if (b.wv == 0 && xb_lane() == 0) {
        unsigned* bar = b.bar;
        __builtin_amdgcn_s_waitcnt(0);
        unsigned nloc = b.st[0], nx = b.st[1];
        if (nloc == 0u) { xcd_barrier_complete(bar, b.x, nloc, nx); b.st[0] = nloc; b.st[1] = nx; }
        const unsigned old = xb_add(&bar[XB_XSUB(b.x)], 1u);
        const unsigned gen = old / nloc;
        if (old + 1u == (gen + 1u) * nloc) {
            __builtin_amdgcn_fence(__ATOMIC_RELEASE, "agent");
            asm volatile("s_waitcnt vmcnt(0)" ::: "memory");
            const unsigned og = xb_add(&bar[XB_TOP], 1u);
            const unsigned tg = og / nx;
            if (og + 1u == (tg + 1u) * nx) xb_add(&bar[XB_TOPGEN], 1u);
            else XB_SPIN(xb_ld(&bar[XB_TOPGEN]) == tg, bar);
            __builtin_amdgcn_fence(__ATOMIC_ACQUIRE, "agent");
            xb_add(&bar[XB_XGEN(b.x)], 1u);
            asm volatile("s_waitcnt vmcnt(0)" ::: "memory");
        } else {
            XB_SPIN(xb_ld(&bar[XB_XGEN(b.x)]) == gen, bar);
            __builtin_amdgcn_fence(__ATOMIC_ACQUIRE, "agent");
            asm volatile("s_waitcnt vmcnt(0)" ::: "memory");
        }
    }
    __syncthreads();
}
struct Args {
    const float* in[23]; float* out; unsigned char* ws; int ph_lo, ph_hi;
};
struct Ctx {
    LAS unsigned char* lds; volatile LAS unsigned* MISC; gu32* ctl; unsigned char* ws;
    int tid, lane, wave, vcu, G;
};
template <class T> __device__ __forceinline__ T* wsp(const Ctx& C, size_t off) { return (T*)(C.ws + off); }
__device__ __forceinline__ bf16* proj(const Ctx& C, int j) { return (bf16*)(C.ws + WS_PROJ + (size_t)j * PROJ_STRIDE); }

__device__ __forceinline__ void transpose_item(const float* W, int ldn, int k0, int n0, bf16* WT, int Kdst, int drow0, LAS float* scr, int lane) {
    { const int c4 = lane & 7; const float* src = W + (size_t)(k0 + (lane >> 3)) * ldn + n0 + 4 * c4;
        f32x4 v[8];
#pragma unroll
        for (int i = 0; i < 8; ++i) v[i] = *(const GAS f32x4*)(src + (size_t)(8 * i) * ldn);
#pragma unroll
        for (int i = 0; i < 8; ++i) { LAS float* d = scr + ((lane >> 3) + 8 * i) * 33 + 4 * c4; d[0] = v[i].x; d[1] = v[i].y; d[2] = v[i].z; d[3] = v[i].w; } }
    LDS_WAIT(); asm volatile("" ::: "memory");
    const int c = lane & 7;
#pragma unroll
    for (int j = 0; j < 4; ++j) { const int n = (lane >> 3) + 8 * j; const LAS float* s = scr + (8 * c) * 33 + n;
        u32x4 o; o.x = pk2(s[0 * 33], s[1 * 33]); o.y = pk2(s[2 * 33], s[3 * 33]); o.z = pk2(s[4 * 33], s[5 * 33]); o.w = pk2(s[6 * 33], s[7 * 33]);
        *(GAS u32x4*)(WT + (size_t)(drow0 + n) * Kdst + k0 + 8 * c) = o; }
    LDS_WAIT(); asm volatile("" ::: "memory");
}
__device__ __forceinline__ void layer_weight_items(const Args& A, const Ctx& C, int layer) {
    LAS float* scr = (LAS float*)(C.lds + C.wave * 16384);
    const int gw = C.vcu * NWAVES + C.wave, NGW = C.G * NWAVES;
    const float* win = A.in[2] + (size_t)layer * DM * INC;
    constexpr int I1 = 16 * 160, I2 = 16 * 96, I3 = 3 * 8 * 32, I4 = 16 * 32;
    for (int it = gw; it < I1 + I2 + I3 + I4; it += NGW) {
        int r = it;
        if (r < I1) { const int nb = r % 160, kb = r / 160, nd = nb * 32, j = nd >> 9; const int sc = (j < 4 ? j * 512 : 2056 + (j - 4) * 512) + (nd & 511);
            transpose_item(win, INC, kb * 64, sc, wsp<bf16>(C, WS_WT1), 1024, nd, scr, C.lane); continue; } r -= I1;
        if (r < I2) { const int nb = r % 96, kb = r / 96; transpose_item(win, INC, kb * 64, 5128 + nb * 32, wsp<bf16>(C, WS_WT2), 1024, nb * 32, scr, C.lane); continue; } r -= I2;
        if (r < I3) { const int br = r / 256, q = r % 256, nb = q % 32, kb = q / 32;
            transpose_item(A.in[13] + (size_t)(layer * 3 + br) * 512 * 1024, 1024, kb * 64, nb * 32, wsp<bf16>(C, WS_PT) + (size_t)br * 1024 * 512, 512, nb * 32, scr, C.lane); continue; } r -= I3;
        { const int nb = r % 32, kb = r / 32; transpose_item(A.in[14] + (size_t)layer * 1024 * 1024, 1024, kb * 64, nb * 32, wsp<bf16>(C, WS_WOT), 1024, nb * 32, scr, C.lane); }
    }
}
__device__ __forceinline__ void moe_weight_items(const Args& A, const Ctx& C, int layer) {
    LAS float* scr = (LAS float*)(C.lds + C.wave * 16384);
    const int gw = C.vcu * NWAVES + C.wave, NGW = C.G * NWAVES;
    constexpr int I1 = 32 * 256, I2 = 32 * 128;
    for (int it = gw; it < I1 + I2; it += NGW) {
        int r = it;
        if (r < I1) { const int e = r >> 8, q = r & 255, mat = q >> 7, q2 = q & 127, nb = q2 & 7, kb = q2 >> 3, n0 = nb * 32;
            const float* src = (mat ? A.in[21] : A.in[20]) + (size_t)(layer * 32 + e) * 1024 * 256;
            transpose_item(src, 256, kb * 64, n0, wsp<bf16>(C, WS_W1T), 1024, e * 512 + (n0 >> 7) * 256 + mat * 128 + (n0 & 127), scr, C.lane); continue; } r -= I1;
        { const int e = r >> 7, q = r & 127, nb = q & 31, kb = q >> 5;
            transpose_item(A.in[22] + (size_t)(layer * 32 + e) * 256 * 1024, 1024, kb * 64, nb * 32, wsp<bf16>(C, WS_W2T), 256, e * 1024 + nb * 32, scr, C.lane); }
    }
}
__device__ __forceinline__ void phase0(const Args& A, const Ctx& C, int layer) {
    if (layer < 2) layer_weight_items(A, C, layer);
    __syncthreads();
    LAS float* WG = (LAS float*)(C.lds);
    LAS float* GL = (LAS float*)(C.lds + 32768);
    const int ll = layer < 2 ? layer : 0;
    const float* win = A.in[2] + (size_t)ll * DM * INC;
    if (layer < 2) { for (int i = C.tid; i < 8192; i += NTHR) WG[i] = win[(size_t)(i >> 3) * INC + 2048 + (i & 7)]; }
    __syncthreads();
    const float* g1 = A.in[1] + ll * 1024; const float* gb = A.in[5] + ll * 8;
    const void* xsrc = (layer == 0) ? (const void*)A.in[0] : (const void*)wsp<bf16>(C, WS_XB1); const bool xbf = layer > 0;
    const int* tokp = wsp<int>(C, WS_TOKP); const float* tokw = wsp<float>(C, WS_TOKW);
    const bf16* osl = wsp<bf16>(C, WS_OSL); bf16* hb = (bf16*)A.out + (size_t)NTOK * DM;
    for (int item = C.vcu; item < NTOK / 64; item += C.G) {
        const int row0 = item * 64;
        f32x4 vnx[4];
        {
#pragma unroll
            for (int j = 0; j < 4; ++j) vnx[j] = ldrow4(xsrc, xbf, (size_t)(row0 + C.wave * 8), C.lane + 64 * j); }
        for (int i = 0; i < 8; ++i) {
            const int rl = C.wave * 8 + i, row = row0 + rl;
            f32x4 v[4];
#pragma unroll
            for (int j = 0; j < 4; ++j) v[j] = vnx[j];
            if (i < 7) {
#pragma unroll
                for (int j = 0; j < 4; ++j) vnx[j] = ldrow4(xsrc, xbf, (size_t)(row + 1), C.lane + 64 * j); }
            if (layer > 0) {
                const float w0 = tokw[row * 2], w1 = tokw[row * 2 + 1];
                const size_t p0 = (size_t)tokp[row * 2], p1 = (size_t)tokp[row * 2 + 1];
                const GAS u32x2* o0 = (const GAS u32x2*)(osl + p0 * DM) + C.lane; const GAS u32x2* o1 = (const GAS u32x2*)(osl + p1 * DM) + C.lane;
#pragma unroll
                for (int j = 0; j < 4; ++j) { const u32x2 a = o0[64 * j], b = o1[64 * j];
                    v[j].x += w0 * bflo(a.x) + w1 * bflo(b.x); v[j].y += w0 * bfhi(a.x) + w1 * bfhi(b.x); v[j].z += w0 * bflo(a.y) + w1 * bflo(b.y); v[j].w += w0 * bfhi(a.y) + w1 * bfhi(b.y); }
                if (layer == 2) { GAS f32x4* xo = (GAS f32x4*)(A.out + (size_t)row * DM) + C.lane;
#pragma unroll
                    for (int j = 0; j < 4; ++j) xo[64 * j] = v[j]; }
                else { GAS u32x2* xo = (GAS u32x2*)((bf16*)A.out + (size_t)row * DM) + C.lane;
#pragma unroll
                    for (int j = 0; j < 4; ++j) { u32x2 o; o.x = pk2(v[j].x, v[j].y); o.y = pk2(v[j].z, v[j].w); xo[64 * j] = o; } }
            }
            if (layer < 2) {
                float ss = 0.f;
#pragma unroll
                for (int j = 0; j < 4; ++j) ss += (v[j].x * v[j].x + v[j].y * v[j].y) + (v[j].z * v[j].z + v[j].w * v[j].w);
                const float rstd = rsqrtf(wave_sum(ss) * (1.f / DM) + EPS);
                float gd[8];
#pragma unroll
                for (int q = 0; q < 8; ++q) gd[q] = 0.f;
                GAS u32x2* ho = (GAS u32x2*)(hb + (size_t)row * DM) + C.lane;
#pragma unroll
                for (int j = 0; j < 4; ++j) { const f32x4 g = ((const GAS f32x4*)g1)[64 * j + C.lane];
                    const f32x4 h = {v[j].x * rstd * g.x, v[j].y * rstd * g.y, v[j].z * rstd * g.z, v[j].w * rstd * g.w};
                    u32x2 o; o.x = pk2(h.x, h.y); o.y = pk2(h.z, h.w); ho[64 * j] = o;
                    const int k = 256 * j + 4 * C.lane;
#pragma unroll
                    for (int c = 0; c < 4; ++c) { const f32x4 wa = *(const LAS f32x4*)(WG + (k + c) * 8), wb = *(const LAS f32x4*)(WG + (k + c) * 8 + 4);
                        gd[0] += h[c] * wa.x; gd[1] += h[c] * wa.y; gd[2] += h[c] * wa.z; gd[3] += h[c] * wa.w; gd[4] += h[c] * wb.x; gd[5] += h[c] * wb.y; gd[6] += h[c] * wb.z; gd[7] += h[c] * wb.w; } }
                float gv;
                { const bool b1 = C.lane & 1, b2 = C.lane & 2, b3 = C.lane & 4; float a4[4], a2[2];
#pragma unroll
                    for (int q = 0; q < 4; ++q) { const float mine = b1 ? gd[q + 4] : gd[q], send = b1 ? gd[q] : gd[q + 4]; a4[q] = mine + xor_shfl<1>(send); }
#pragma unroll
                    for (int q = 0; q < 2; ++q) { const float mine = b2 ? a4[q + 2] : a4[q], send = b2 ? a4[q] : a4[q + 2]; a2[q] = mine + xor_shfl<2>(send); }
                    { const float mine = b3 ? a2[1] : a2[0], send = b3 ? a2[0] : a2[1]; gv = mine + xor_shfl<4>(send); }
                    gv += xor_shfl<8>(gv); gv += xor_shfl<16>(gv); gv = pair_sum(gv); }
                if (C.lane < 8) { const int q = 4 * (C.lane & 1) + 2 * ((C.lane >> 1) & 1) + ((C.lane >> 2) & 1);
                    const float val = gv + gb[q];
                    float r;
                    if (q < 4) r = 15.f * tanhf(val * (1.f / 15.f));
                    else r = (val < 0.f) ? (val - log1pf(expf(val))) : -log1pf(expf(-val));
                    GL[rl * 8 + q] = r; }
            }
        }
        if (layer < 2) {
            __syncthreads();
            if (C.wave < 4) { const int hh = C.wave, t = C.lane; const float lf = GL[t * 8 + 4 + hh], ig = GL[t * 8 + hh];
                float b = lf;
#pragma unroll
                for (int o = 1; o < 64; o <<= 1) { const float u = lane_up(b, t, o); if (t >= o) b += u; }
                const float bl = lane_get(b, 63); const float gm = wave_max(bl - b + ig);
                wsp<float>(C, WS_BC)[(size_t)(row0 + t) * 4 + hh] = b; wsp<float>(C, WS_IG)[(size_t)(row0 + t) * 4 + hh] = ig;
                if (t == 0) { const int bb = row0 / SEQ, c = (row0 % SEQ) / 64; wsp<float>(C, WS_BLAST)[(bb * 4 + hh) * 128 + c] = bl; wsp<float>(C, WS_GMAX)[(bb * 4 + hh) * 128 + c] = gm; } }
            __syncthreads();
        }
    }
}
__device__ __forceinline__ void mscan(const Ctx& C, int bh, LAS float* MV) {
    const float* bl = wsp<float>(C, WS_BLAST) + bh * 128; const float* gm = wsp<float>(C, WS_GMAX) + bh * 128; const int i = C.lane;
    const float a0 = bl[2 * i], g0 = gm[2 * i], a1 = bl[2 * i + 1], g1 = gm[2 * i + 1];
    float Aa = a0 + a1, Gg = fmaxf(g0 + a1, g1);
#pragma unroll
    for (int o = 1; o < 64; o <<= 1) { const float Ap = lane_up(Aa, i, o), Gp = lane_up(Gg, i, o); if (i >= o) { Gg = fmaxf(Gp + Aa, Gg); Aa = Ap + Aa; } }
    float Ax = lane_up(Aa, i, 1), Gx = lane_up(Gg, i, 1); if (i == 0) { Ax = 0.f; Gx = -INFINITY; }
    if (i == 0) MV[0] = 0.f;
    MV[2 * i + 1] = fmaxf(Ax + a0, fmaxf(Gx + a0, g0));
    MV[2 * i + 2] = fmaxf(Aa, Gg);
}
template <int ST> __device__ __forceinline__ void stage_conv(const Ctx& C, const bf16* src  , int row0, int seq0, const float* cw  , const float* cb, const LAS float* rs, float sc, LAS unsigned char* dst) {
#pragma unroll
    for (int i = 0; i < 2; ++i) { const int task = C.tid + NTHR * i, t = task >> 4, ch = task & 15;
        float y[8];
        { const f32x4 b0 = *(const GAS f32x4*)(cb + ch * 8), b1 = *(const GAS f32x4*)(cb + ch * 8 + 4); y[0] = b0.x; y[1] = b0.y; y[2] = b0.z; y[3] = b0.w; y[4] = b1.x; y[5] = b1.y; y[6] = b1.z; y[7] = b1.w; }
#pragma unroll
        for (int j = 0; j < 4; ++j) { const int row = row0 + t - j;
            if (row >= seq0) { const u32x4 u = *(const GAS u32x4*)(src + (size_t)row * 512 + ch * 8);
                const f32x4 w0 = *(const GAS f32x4*)(cw + j * 1024 + ch * 8), w1 = *(const GAS f32x4*)(cw + j * 1024 + ch * 8 + 4);
                y[0] += w0.x * bflo(u.x); y[1] += w0.y * bfhi(u.x); y[2] += w0.z * bflo(u.y); y[3] += w0.w * bfhi(u.y); y[4] += w1.x * bflo(u.z); y[5] += w1.y * bfhi(u.z); y[6] += w1.z * bflo(u.w); y[7] += w1.w * bfhi(u.w); } }
        const float s = (rs ? rs[t] : 1.f) * sc;
#pragma unroll
        for (int q = 0; q < 8; ++q) y[q] = y[q] * sigm(y[q]) * s;
        u32x4 o; o.x = pk2(y[0], y[1]); o.y = pk2(y[2], y[3]); o.z = pk2(y[4], y[5]); o.w = pk2(y[6], y[7]);
        *(LAS u32x4*)(dst + t * (ST * 2) + ch * 16) = o; }
}
template <int ST> __device__ __forceinline__ void stage_raw128(const Ctx& C, const bf16* src  , int row0, LAS unsigned char* dst) {
#pragma unroll
    for (int i = 0; i < 2; ++i) { const int task = C.tid + NTHR * i, t = task >> 4, ch = task & 15;
        *(LAS u32x4*)(dst + t * (ST * 2) + ch * 16) = *(const GAS u32x4*)(src + (size_t)(row0 + t) * 512 + ch * 8); }
}
__device__ __forceinline__ const LAS unsigned char* tr_addr(const LAS unsigned char* base, int stride_b, int r0, int c0, int lane) {
    return base + (r0 + ((lane & 15) >> 2)) * stride_b + (c0 + 16 * ((lane >> 4) & 1) + 4 * (lane & 3)) * 2;
}
constexpr int ML_MV = 0, ML_BC = 1024, ML_GS = 1280, ML_RS = 1536, ML_NV = 2048, ML_SC = 2560, ML_KT = 4608, ML_VT = ML_KT + 20480, ML_QT = ML_VT + 20480, ML_CT = ML_QT + 17408, ML_END = ML_CT + 34816, ML_OUT = ML_KT;
static_assert(ML_END <= RING_BYTES, "mLSTM LDS map");
__device__ __forceinline__ void mlstm_u_item(const Args& A, const Ctx& C0, int layer, int bh, int c, bool scan) {
    Ctx C = C0; asm volatile("" : "+v"(C.tid), "+v"(C.lane));
    LAS float* MV = (LAS float*)(C.lds + ML_MV); LAS float* RS = (LAS float*)(C.lds + ML_RS);
    LAS unsigned char* KT = C.lds + ML_KT; LAS unsigned char* VT = C.lds + ML_VT;
    const int b = bh >> 2, hh = bh & 3, row0 = b * SEQ + c * 64, seq0 = b * SEQ, lane = C.lane, hi = lane >> 5, r32 = lane & 31;
    if (scan) { if (C.wave == 0) mscan(C, bh, MV); __syncthreads(); }
    if (C.tid < 64) { const float bl = wsp<float>(C, WS_BLAST)[bh * 128 + c];
        RS[C.tid] = __expf(bl - wsp<float>(C, WS_BC)[(size_t)(row0 + C.tid) * 4 + hh] + wsp<float>(C, WS_IG)[(size_t)(row0 + C.tid) * 4 + hh] - MV[c + 1]); }
    __syncthreads();
    stage_conv<160>(C, proj(C, PJ_AK) + hh * 128, row0, seq0, A.in[3] + layer * 4096 + 512 + hh * 128, A.in[4] + layer * 1024 + 512 + hh * 128, RS, 0.08838834764831845f, KT);
    stage_raw128<160>(C, proj(C, PJ_AV) + hh * 128, row0, VT);
    __syncthreads();
    const int eb = C.wave >> 1, db0 = (C.wave & 1) * 2;
    f32x16 acc0 = {}, acc1 = {};
#pragma unroll
    for (int st = 0; st < 4; ++st) { const int t0 = 16 * st + 8 * hi;
        const bf16x8 af = cat8(tr16(tr_addr(VT, 320, t0, 32 * eb, lane)), tr16(tr_addr(VT, 320, t0 + 4, 32 * eb, lane)));
        const bf16x8 b0 = cat8(tr16(tr_addr(KT, 320, t0, 32 * db0, lane)), tr16(tr_addr(KT, 320, t0 + 4, 32 * db0, lane)));
        const bf16x8 b1 = cat8(tr16(tr_addr(KT, 320, t0, 32 * db0 + 32, lane)), tr16(tr_addr(KT, 320, t0 + 4, 32 * db0 + 32, lane)));
        acc0 = MFMA32(af, b0, acc0); acc1 = MFMA32(af, b1, acc1); }
    bf16* U = wsp<bf16>(C, WS_HB) + (size_t)(bh * 128 + c) * 16384;
    if (C.tid < 128) { float s = 0.f;
        for (int t = 0; t < 64; ++t) s += bflo((unsigned)*(const LAS bf16*)(KT + t * 320 + C.tid * 2));
        wsp<float>(C, WS_NUC)[(size_t)(bh * 128 + c) * 128 + C.tid] = s; }
    __syncthreads();
    { LAS bf16* US = (LAS bf16*)(C.lds + ML_KT);
#pragma unroll
        for (int r = 0; r < 16; ++r) { const int e = 32 * eb + crow(r, hi);
            US[e * 136 + 32 * db0 + r32] = (bf16)(pk2(acc0[r], 0.f) & 0xffffu); US[e * 136 + 32 * db0 + 32 + r32] = (bf16)(pk2(acc1[r], 0.f) & 0xffffu); }
        __syncthreads();
#pragma unroll
        for (int i = 0; i < 4; ++i) { const int task = C.tid + NTHR * i, e = task >> 4, ch = task & 15; *(GAS u32x4*)(U + e * 128 + ch * 8) = *(const LAS u32x4*)(US + e * 136 + ch * 8); } }
    __syncthreads();
}
__device__ __forceinline__ void qknorm_rows(const Args& A, const Ctx& C, int layer) {
    const int gw = C.vcu * NWAVES + C.wave, NGW = C.G * NWAVES, lane = C.lane;
    for (int it = gw; it < NTOK * 4; it += NGW) { const int which = it & 3, row = it >> 2;
        bf16* p = proj(C, which == 0 ? PJ_BQ : which == 1 ? PJ_BK : which == 2 ? PJ_CQ : PJ_CK) + (size_t)row * 512 + lane * 8;
        const float* g = (which < 2 ? A.in[7] : A.in[9]) + layer * 128 + (which & 1) * 64 + (lane & 7) * 8;
        const u32x4 u = *(const GAS u32x4*)p; const f32x4 g0 = *(const GAS f32x4*)g, g1 = *(const GAS f32x4*)(g + 4);
        float v[8] = {bflo(u.x), bfhi(u.x), bflo(u.y), bfhi(u.y), bflo(u.z), bfhi(u.z), bflo(u.w), bfhi(u.w)}; float ss = 0.f;
#pragma unroll
        for (int i = 0; i < 8; ++i) ss += v[i] * v[i];
        ss += xor_shfl<1>(ss); ss += xor_shfl<2>(ss); ss += xor_shfl<4>(ss);
        const float rinv = rsqrtf(ss * (1.f / 64.f) + EPS) * ((which & 1) ? 1.f : 0.125f * LOG2E);
        const u32x4 o = {pk2(v[0] * rinv * g0.x, v[1] * rinv * g0.y), pk2(v[2] * rinv * g0.z, v[3] * rinv * g0.w), pk2(v[4] * rinv * g1.x, v[5] * rinv * g1.y), pk2(v[6] * rinv * g1.z, v[7] * rinv * g1.w)};
        *(GAS u32x4*)p = o; }
}
__device__ __forceinline__ void mlstm_scan(const Ctx& C) {
    LAS float* MV = (LAS float*)(C.lds + ML_MV); LAS float* DEC = (LAS float*)(C.lds + ML_RS);
    for (int w = C.vcu; w < 256; w += C.G) { const int bh = w >> 4, sl = w & 15;
        if (C.wave == 0) mscan(C, bh, MV);
        __syncthreads();
        if (C.tid < 128) DEC[C.tid] = __expf(wsp<float>(C, WS_BLAST)[bh * 128 + C.tid] + MV[C.tid] - MV[C.tid + 1]);
        __syncthreads();
        GAS unsigned* p = (GAS unsigned*)(wsp<unsigned>(C, WS_HB) + (size_t)bh * 128 * 8192 + sl * 512 + C.tid);
        float s0 = 0.f, s1 = 0.f;
        for (int c0 = 0; c0 < 128; c0 += 16) { unsigned u[16];
#pragma unroll
            for (int q = 0; q < 16; ++q) u[q] = p[(size_t)(c0 + q) * 8192];
#pragma unroll
            for (int q = 0; q < 16; ++q) { p[(size_t)(c0 + q) * 8192] = pk2(s0, s1); const float d = DEC[c0 + q]; s0 = d * s0 + bflo(u[q]); s1 = d * s1 + bfhi(u[q]); } }
        if (sl == 0 && C.tid < 128) { GAS float* np = (GAS float*)(wsp<float>(C, WS_NUC) + (size_t)bh * 128 * 128 + C.tid); float s = 0.f;
            for (int c0 = 0; c0 < 128; c0 += 16) { float u[16];
#pragma unroll
                for (int q = 0; q < 16; ++q) u[q] = np[(c0 + q) * 128];
#pragma unroll
                for (int q = 0; q < 16; ++q) { np[(c0 + q) * 128] = s; s = DEC[c0 + q] * s + u[q]; } } }
        __syncthreads();
    }
}
__device__ __forceinline__ void mlstm_out_item(const Args& A, const Ctx& C0, int layer, int bh, int c, bool scan, bf16* habase = nullptr  ) {
    Ctx C = C0; asm volatile("" : "+v"(C.tid), "+v"(C.lane));
    LAS float* MV = (LAS float*)(C.lds + ML_MV); LAS float* BC = (LAS float*)(C.lds + ML_BC); LAS float* GS = (LAS float*)(C.lds + ML_GS); LAS float* NV = (LAS float*)(C.lds + ML_NV);
    LAS float* SC = (LAS float*)(C.lds + ML_SC) + C.wave * 64;
    LAS unsigned char* KT = C.lds + ML_KT; LAS unsigned char* VT = C.lds + ML_VT; LAS unsigned char* QT = C.lds + ML_QT; LAS unsigned char* CT = C.lds + ML_CT; LAS float* OUT = (LAS float*)(C.lds + ML_OUT);
    const int b = bh >> 2, hh = bh & 3, row0 = b * SEQ + c * 64, seq0 = b * SEQ, lane = C.lane, hi = lane >> 5, r32 = lane & 31;
    if (scan && C.wave == 0) mscan(C, bh, MV);
    if (C.tid >= 64 && C.tid < 128) { const int t = C.tid - 64; const float bc = wsp<float>(C, WS_BC)[(size_t)(row0 + t) * 4 + hh]; BC[t] = bc; GS[t] = wsp<float>(C, WS_IG)[(size_t)(row0 + t) * 4 + hh] - bc; }
    if (C.tid >= 128 && C.tid < 256) NV[C.tid - 128] = wsp<float>(C, WS_NUC)[(size_t)(bh * 128 + c) * 128 + C.tid - 128];
    stage_conv<136>(C, proj(C, PJ_AQ) + hh * 128, row0, seq0, A.in[3] + layer * 4096 + hh * 128, A.in[4] + layer * 1024 + hh * 128, nullptr, 1.f, QT);
    stage_conv<136>(C, proj(C, PJ_AK) + hh * 128, row0, seq0, A.in[3] + layer * 4096 + 512 + hh * 128, A.in[4] + layer * 1024 + 512 + hh * 128, nullptr, 0.08838834764831845f, KT);
    stage_raw128<160>(C, proj(C, PJ_AV) + hh * 128, row0, VT);
    { const bf16* cs = wsp<bf16>(C, WS_HB) + (size_t)(bh * 128 + c) * 16384;
#pragma unroll
        for (int i = 0; i < 4; ++i) { const int task = C.tid + NTHR * i, e = task >> 4, ch = task & 15; *(LAS u32x4*)(CT + e * 272 + ch * 16) = *(const GAS u32x4*)(cs + e * 128 + ch * 8); } }
    __syncthreads();
    const float mc = MV[c]; const int lb = C.wave >> 2, cb = C.wave & 3, lq = 32 * lb + r32; const float bl = BC[lq];
    bf16x8 qf[8];
#pragma unroll
    for (int st = 0; st < 8; ++st) qf[st] = *(const LAS bf16x8*)(QT + lq * 272 + (16 * st + 8 * hi) * 2);
    f32x16 p0 = {}, p1 = {};
#pragma unroll
    for (int st = 0; st < 8; ++st) p0 = MFMA32(*(const LAS bf16x8*)(KT + r32 * 272 + (16 * st + 8 * hi) * 2), qf[st], p0);
    if (lb == 1) {
#pragma unroll
        for (int st = 0; st < 8; ++st) p1 = MFMA32(*(const LAS bf16x8*)(KT + (32 + r32) * 272 + (16 * st + 8 * hi) * 2), qf[st], p1); }
    f32x16 d0, d1; float mt = bl + mc;
#pragma unroll
    for (int r = 0; r < 16; ++r) { const int s = crow(r, hi); d0[r] = (s <= lq) ? bl + GS[s] : -INFINITY; mt = fmaxf(mt, d0[r]); }
#pragma unroll
    for (int r = 0; r < 16; ++r) { const int s = 32 + crow(r, hi); d1[r] = (lb == 1 && s <= lq) ? bl + GS[s] : -INFINITY; mt = fmaxf(mt, d1[r]); }
    mt = pair_max(mt);
    float rs = 0.f;
#pragma unroll
    for (int r = 0; r < 16; ++r) { p0[r] *= __expf(d0[r] - mt); p1[r] *= __expf(d1[r] - mt); rs += p0[r] + p1[r]; }
    rs = pair_sum(rs);
    float qn = 0.f;
#pragma unroll
    for (int st = 0; st < 8; ++st) { const f32x4 n0 = *(const LAS f32x4*)(NV + 16 * st + 8 * hi), n1 = *(const LAS f32x4*)(NV + 16 * st + 8 * hi + 4); const u32x4 q = __builtin_bit_cast(u32x4, qf[st]);
        qn += bflo(q.x) * n0.x + bfhi(q.x) * n0.y + bflo(q.y) * n0.z + bfhi(q.y) * n0.w + bflo(q.z) * n1.x + bfhi(q.z) * n1.y + bflo(q.w) * n1.z + bfhi(q.w) * n1.w; }
    qn = pair_sum(qn);
    const float wi = __expf(bl + mc - mt), den = wi * qn + rs, dn = fmaxf(fabsf(den), __expf(-mt));
    SC[r32] = wi / dn; SC[32 + r32] = 1.f / dn;
    f32x16 acc1 = {}, acc2 = {};
#define PKF(P, B) (bf16x8)__builtin_bit_cast(bf16x8, ((u32x4){pk2(P[B], P[B + 1]), pk2(P[B + 2], P[B + 3]), pk2(P[B + 4], P[B + 5]), pk2(P[B + 6], P[B + 7])}))
#pragma unroll
    for (int s2 = 0; s2 < 2; ++s2) { const int k0 = 16 * s2;
        const bf16x8 vf = cat8(tr16(tr_addr(VT, 320, k0 + 4 * hi, 32 * cb, lane)), tr16(tr_addr(VT, 320, k0 + 8 + 4 * hi, 32 * cb, lane)));
        acc2 = MFMA32(s2 == 0 ? PKF(p0, 0) : PKF(p0, 8), vf, acc2); }
    if (lb == 1) {
#pragma unroll
        for (int s2 = 0; s2 < 2; ++s2) { const int k0 = 32 + 16 * s2;
            const bf16x8 vf = cat8(tr16(tr_addr(VT, 320, k0 + 4 * hi, 32 * cb, lane)), tr16(tr_addr(VT, 320, k0 + 8 + 4 * hi, 32 * cb, lane)));
            acc2 = MFMA32(s2 == 0 ? PKF(p1, 0) : PKF(p1, 8), vf, acc2); } }
#undef PKF
#pragma unroll
    for (int st = 0; st < 8; ++st) acc1 = MFMA32(qf[st], *(const LAS bf16x8*)(CT + (32 * cb + r32) * 272 + (16 * st + 8 * hi) * 2), acc1);
    __syncthreads();
#pragma unroll
    for (int r = 0; r < 16; ++r) { const int l_ = crow(r, hi); OUT[(32 * lb + l_) * 132 + 32 * cb + r32] = SC[l_] * acc1[r] + SC[32 + l_] * acc2[r]; }
    __syncthreads();
    { const int row = C.tid >> 3, seg = C.tid & 7; float v[16]; float ss = 0.f;
#pragma unroll
        for (int q = 0; q < 4; ++q) { const f32x4 x = *(const LAS f32x4*)(OUT + row * 132 + seg * 16 + 4 * q); v[4 * q] = x.x; v[4 * q + 1] = x.y; v[4 * q + 2] = x.z; v[4 * q + 3] = x.w; ss += (x.x * x.x + x.y * x.y) + (x.z * x.z + x.w * x.w); }
        ss += xor_shfl<1>(ss); ss += xor_shfl<2>(ss); ss += xor_shfl<4>(ss);
        const float rinv = rsqrtf(ss * (1.f / 128.f) + EPS);
        const float* gn = A.in[6] + layer * 512 + hh * 128 + seg * 16;
        const bf16* ao = proj(C, PJ_AO) + (size_t)(row0 + row) * 512 + hh * 128 + seg * 16;
        bf16* ha = (habase ? habase : proj(C, PJ_AV)) + (size_t)(row0 + row) * 512 + hh * 128 + seg * 16;
#pragma unroll
        for (int q = 0; q < 2; ++q) { const u32x4 a = *(const GAS u32x4*)(ao + 8 * q); const f32x4 g0 = *(const GAS f32x4*)(gn + 8 * q), g1 = *(const GAS f32x4*)(gn + 8 * q + 4); const float* vv = v + 8 * q;
            u32x4 o; o.x = pk2(vv[0] * rinv * g0.x * sigm(bflo(a.x)), vv[1] * rinv * g0.y * sigm(bfhi(a.x))); o.y = pk2(vv[2] * rinv * g0.z * sigm(bflo(a.y)), vv[3] * rinv * g0.w * sigm(bfhi(a.y)));
            o.z = pk2(vv[4] * rinv * g1.x * sigm(bflo(a.z)), vv[5] * rinv * g1.y * sigm(bfhi(a.z))); o.w = pk2(vv[6] * rinv * g1.z * sigm(bflo(a.w)), vv[7] * rinv * g1.w * sigm(bfhi(a.w)));
            *(GAS u32x4*)(ha + 8 * q) = o; } }
    __syncthreads();
}
constexpr int AT_TAB = 0, AT_SCR = 3072, AT_K = 5120;
template <int DV, bool ISC> __device__ __forceinline__ void attn_unit(const Args& A, const Ctx& C0, int layer, int b, int hs, int qblk, bf16* obase = nullptr  ) {
    Ctx C = C0; asm volatile("" : "+v"(C.tid), "+v"(C.lane));
    constexpr int KSTB = 144, VSTB = 2 * DV + 64, KB = 64 * KSTB, VB = 64 * VSTB, AT_V = AT_K + 4 * KB, NBLK = DV / 32;
    static_assert(AT_V + 4 * VB <= RING_BYTES, "attention LDS map");
    LAS float* TAB = (LAS float*)(C.lds + AT_TAB); LAS float* SCR = (LAS float*)(C.lds + AT_SCR) + C.wave * 64;
    const int lane = C.lane, hi = lane >> 5, r32 = lane & 31, tid = C.tid;
    const bf16 *Qp, *Kp, *Vp; bf16* Op; int pitchO; const float *gq, *gk; int hbias;
    if (ISC) { const int h = hs >> 1, wh = hs & 1; Qp = proj(C, PJ_CQ) + h * 128 + wh * 64; Kp = proj(C, PJ_CK) + h * 128 + wh * 64; Vp = proj(C, PJ_CV) + h * 128;
        Op = wsp<bf16>(C, WS_O12) + h * 256 + wh * 128; pitchO = 1024; gq = A.in[9] + layer * 128; gk = gq + 64; hbias = h; }
    else { Qp = proj(C, PJ_BQ) + hs * 64; Kp = proj(C, PJ_BK) + hs * 64; Vp = proj(C, PJ_BV) + hs * 64; Op = (obase ? obase : proj(C, PJ_BQ)) + hs * 64; pitchO = 512; gq = A.in[7] + layer * 128; gk = gq + 64; hbias = hs; }
    const size_t rowb = (size_t)b * SEQ;
    const int qs0 = qblk * 256 + C.wave * 32;
    for (int i = tid; i < 768; i += NTHR) { const int d = 703 - i; float v;
        if (ISC) { const int n = d < 0 ? -d : d; int bk = n < 8 ? n : n < 15 ? 8 : n < 27 ? 9 : n < 50 ? 10 : n < 91 ? 11 : n < 166 ? 12 : n < 305 ? 13 : n < 559 ? 14 : 15; if (d < 0) bk += 16; v = A.in[12][bk * 4 + hbias]; }
        else { const int dc = d < -256 ? -256 : d > 256 ? 256 : d; v = A.in[8][(size_t)layer * 513 * 8 + (dc + 256) * 8 + hbias]; }
        TAB[i] = v * LOG2E; }
    float MB;
    { const float gqm = wave_max(fabsf(gq[lane])), gkm = wave_max(fabsf(gk[lane]));
        float bm = 0.f;
        if (ISC) { bm = (lane < 32) ? fabsf(A.in[12][lane * 4 + hbias]) : 0.f; }
        else { for (int i = lane; i < 513; i += 64) bm = fmaxf(bm, fabsf(A.in[8][(size_t)layer * 513 * 8 + i * 8 + hbias])); }
        bm = wave_max(bm);
        MB = 64.f * (0.125f * LOG2E) * gqm * gkm * 1.02f + bm * LOG2E; }
    const float t15 = (ISC ? A.in[12][15 * 4 + hbias] * LOG2E : 0.f) - MB;
    bf16x8 qf[4];
    { float qv[32]; float ss = 0.f; const bf16* qrow = Qp + (rowb + qs0 + r32) * 512 + 8 * hi;
#pragma unroll
        for (int st = 0; st < 4; ++st) { const u32x4 u = *(const GAS u32x4*)(qrow + 16 * st);
            qv[8 * st] = bflo(u.x); qv[8 * st + 1] = bfhi(u.x); qv[8 * st + 2] = bflo(u.y); qv[8 * st + 3] = bfhi(u.y); qv[8 * st + 4] = bflo(u.z); qv[8 * st + 5] = bfhi(u.z); qv[8 * st + 6] = bflo(u.w); qv[8 * st + 7] = bfhi(u.w); }
#pragma unroll
        for (int i = 0; i < 32; ++i) ss += qv[i] * qv[i];
        ss = pair_sum(ss);
        const float rinv = rsqrtf(ss * (1.f / 64.f) + EPS) * (0.125f * LOG2E);
#pragma unroll
        for (int st = 0; st < 4; ++st) { const f32x4 g0 = *(const GAS f32x4*)(gq + 16 * st + 8 * hi) * *(const GAS f32x4*)(gk + 16 * st + 8 * hi), g1 = *(const GAS f32x4*)(gq + 16 * st + 8 * hi + 4) * *(const GAS f32x4*)(gk + 16 * st + 8 * hi + 4); const float* q = qv + 8 * st;
            const u32x4 o = {pk2(q[0] * rinv * g0.x, q[1] * rinv * g0.y), pk2(q[2] * rinv * g0.z, q[3] * rinv * g0.w), pk2(q[4] * rinv * g1.x, q[5] * rinv * g1.y), pk2(q[6] * rinv * g1.z, q[7] * rinv * g1.w)};
            qf[st] = __builtin_bit_cast(bf16x8, o); } }
    const int krow = tid >> 3, kch = tid & 7;
    const int jhi = qblk * 4 + 3, jlo = ISC ? 0 : (qblk * 4 - 8 < 0 ? 0 : qblk * 4 - 8), cqw = qblk * 4 + (C.wave >> 1);
    const bf16* ksrc = Kp + (rowb + krow) * 512 + kch * 8;
    u32x4 kregA, kregB, vregA[NBLK / 2], vregB[NBLK / 2];
#define AT_LOADT(j, KR, VR) do { KR = *(const GAS u32x4*)(ksrc + (size_t)(j) * 64 * 512); \
        if (DV == 128) { _Pragma("unroll") for (int i_ = 0; i_ < 2; ++i_) { const int idx = tid + NTHR * i_; VR[i_] = *(const GAS u32x4*)(Vp + (rowb + (size_t)(j) * 64 + (idx >> 4)) * 512 + (idx & 15) * 8); } } \
        else VR[0] = *(const GAS u32x4*)(Vp + (rowb + (size_t)(j) * 64 + krow) * 512 + kch * 8); } while (0)
    AT_LOADT(jlo, kregA, vregA); AT_LOADT(jlo + 1, kregB, vregB);
    float l = 0.f; f32x16 o[NBLK];
#pragma unroll
    for (int nb = 0; nb < NBLK; ++nb) o[nb] = f32x16{};
#define AT_VLOAD(F, nb_) do { _Pragma("unroll") for (int ks_ = 0; ks_ < 4; ++ks_) { F[2 * ks_] = tr16(vb_ + (16 * ks_) * VSTB + (nb_) * 64); F[2 * ks_ + 1] = tr16(vb_ + (16 * ks_ + 8) * VSTB + (nb_) * 64); } } while (0)
#define AT_STAGE(buf, KR, VR) do { \
        LAS unsigned char* KT = C.lds + AT_K + (buf) * KB; LAS unsigned char* VT = C.lds + AT_V + (buf) * VB; \
        { float kv[8] = {bflo(KR.x), bfhi(KR.x), bflo(KR.y), bfhi(KR.y), bflo(KR.z), bfhi(KR.z), bflo(KR.w), bfhi(KR.w)}; float ss = 0.f; \
            _Pragma("unroll") for (int i = 0; i < 8; ++i) ss += kv[i] * kv[i]; \
            ss += xor_shfl<1>(ss); ss += xor_shfl<2>(ss); ss += xor_shfl<4>(ss); \
            const float rinv = rsqrtf(ss * (1.f / 64.f) + EPS); \
            const u32x4 w = {pk2(kv[0] * rinv, kv[1] * rinv), pk2(kv[2] * rinv, kv[3] * rinv), pk2(kv[4] * rinv, kv[5] * rinv), pk2(kv[6] * rinv, kv[7] * rinv)}; \
            *(LAS u32x4*)(KT + krow * KSTB + kch * 16) = w; } \
        if (DV == 128) { _Pragma("unroll") for (int i_ = 0; i_ < 2; ++i_) { const int idx = tid + NTHR * i_; *(LAS u32x4*)(VT + (idx >> 4) * VSTB + (idx & 15) * 16) = VR[i_]; } } \
        else *(LAS u32x4*)(VT + krow * VSTB + kch * 16) = VR[0]; \
    } while (0)
#define AT_COMP(j, buf) do { \
        LAS unsigned char* KT = C.lds + AT_K + (buf) * KB; LAS unsigned char* VT = C.lds + AT_V + (buf) * VB; \
        const bool act = ((j) <= cqw) && (ISC || (j) >= cqw - 8); \
        if (act) { \
            f32x16 p0, p1; \
            const bool far = ISC && (qs0 - (64 * (j) + 63) >= 559); \
            if (far) { _Pragma("unroll") for (int r = 0; r < 16; ++r) { p0[r] = t15; p1[r] = t15; } } \
            else { const LAS float* tp = TAB + (703 - (qs0 + r32) + 64 * (j) + 4 * hi); \
                _Pragma("unroll") for (int r = 0; r < 16; ++r) { p0[r] = tp[(r & 3) + 8 * (r >> 2)] - MB; p1[r] = tp[32 + (r & 3) + 8 * (r >> 2)] - MB; } } \
            { bf16x8 kf[8]; \
                _Pragma("unroll") for (int st = 0; st < 4; ++st) { kf[2 * st] = *(const LAS bf16x8*)(KT + r32 * KSTB + (16 * st + 8 * hi) * 2); kf[2 * st + 1] = *(const LAS bf16x8*)(KT + (32 + r32) * KSTB + (16 * st + 8 * hi) * 2); } \
                __builtin_amdgcn_sched_barrier(0);        \
                _Pragma("unroll") for (int st = 0; st < 4; ++st) { p0 = MFMA32(kf[2 * st], qf[st], p0); p1 = MFMA32(kf[2 * st + 1], qf[st], p1); } } \
            float rs0 = 0.f, rs1 = 0.f, rs2 = 0.f, rs3 = 0.f;        \
            _Pragma("unroll") for (int r = 0; r < 16; r += 2) { p0[r] = __builtin_amdgcn_exp2f(p0[r]); p1[r] = __builtin_amdgcn_exp2f(p1[r]); p0[r + 1] = __builtin_amdgcn_exp2f(p0[r + 1]); p1[r + 1] = __builtin_amdgcn_exp2f(p1[r + 1]); \
                rs0 += p0[r]; rs1 += p1[r]; rs2 += p0[r + 1]; rs3 += p1[r + 1]; } \
            l += (rs0 + rs1) + (rs2 + rs3); \
            bf16x8 pw[4]; \
            pw[0] = PKF(p0, 0); pw[1] = PKF(p0, 8); pw[2] = PKF(p1, 0); pw[3] = PKF(p1, 8); \
            { s16x4 fa[8], fb[8]; const LAS unsigned char* vb_ = tr_addr(VT, VSTB, 4 * hi, 0, lane); \
                AT_VLOAD(fa, 0); \
                _Pragma("unroll") for (int nb = 0; nb < NBLK; nb += 2) { \
                    AT_VLOAD(fb, nb + 1); __builtin_amdgcn_sched_barrier(0); \
                    _Pragma("unroll") for (int ks = 0; ks < 4; ++ks) o[nb] = MFMA32(pw[ks], cat8(fa[2 * ks], fa[2 * ks + 1]), o[nb]); \
                    __builtin_amdgcn_sched_barrier(0); \
                    if (nb + 2 < NBLK) AT_VLOAD(fa, nb + 2); __builtin_amdgcn_sched_barrier(0); \
                    _Pragma("unroll") for (int ks = 0; ks < 4; ++ks) o[nb + 1] = MFMA32(pw[ks], cat8(fb[2 * ks], fb[2 * ks + 1]), o[nb + 1]); \
                    __builtin_amdgcn_sched_barrier(0); } } \
        } } while (0)
#define PKF(P, B) __builtin_bit_cast(bf16x8, ((u32x4){pk2(P[B], P[B + 1]), pk2(P[B + 2], P[B + 3]), pk2(P[B + 4], P[B + 5]), pk2(P[B + 6], P[B + 7])}))
    for (int j = jlo; j <= jhi; j += 2) { const int sb = (((j - jlo) >> 1) & 1) * 2;
        AT_STAGE(sb, kregA, vregA); AT_STAGE(sb + 1, kregB, vregB);
        __syncthreads();
        if (j + 2 <= jhi) { AT_LOADT(j + 2, kregA, vregA); AT_LOADT(j + 3, kregB, vregB); }
        AT_COMP(j, sb); AT_COMP(j + 1, sb + 1); }
#undef PKF
#undef AT_STAGE
#undef AT_COMP
#undef AT_VLOAD
#undef AT_LOADT
    l = pair_sum(l);
    SCR[32 + r32] = 1.f / l;
    bf16* orow = Op + (rowb + qs0) * pitchO;
#pragma unroll
    for (int r = 0; r < 16; ++r) { const int q = crow(r, hi); const float rl = SCR[32 + q];
#pragma unroll
        for (int nb = 0; nb < NBLK; ++nb) ((GAS bf16*)orow)[(size_t)q * pitchO + 32 * nb + r32] = (bf16)(pk2(o[nb][r] * rl, 0.f) & 0xffffu); }
    __syncthreads();
}
__device__ __forceinline__ void phase5(const Args& A, const Ctx& C, int layer) {
    const int gw = C.vcu * NWAVES + C.wave, NGW = C.G * NWAVES, lane = C.lane;
    const float lam_init = 0.8f - 0.6f * __expf(-0.3f * (float)layer);
    const float* cl = A.in[10] + layer * 256;
    const float lam = __expf(wave_sum(cl[lane] * cl[64 + lane])) - __expf(wave_sum(cl[128 + lane] * cl[192 + lane])) + lam_init;
    const float* gs = A.in[11] + layer * 128 + (lane & 15) * 8;
    const f32x4 gs0 = *(const GAS f32x4*)gs, gs1 = *(const GAS f32x4*)(gs + 4);
    const float post = 1.f - lam_init;
    const bf16* o12 = wsp<bf16>(C, WS_O12); bf16* hc = proj(C, PJ_CQ);
    for (int row = gw; row < NTOK; row += NGW) {
        { const int h = lane >> 4, e0 = (lane & 15) * 8;
            const u32x4 a = *(const GAS u32x4*)(o12 + (size_t)row * 1024 + h * 256 + e0), bq = *(const GAS u32x4*)(o12 + (size_t)row * 1024 + h * 256 + 128 + e0);
            float v[8] = {bflo(a.x) - lam * bflo(bq.x), bfhi(a.x) - lam * bfhi(bq.x), bflo(a.y) - lam * bflo(bq.y), bfhi(a.y) - lam * bfhi(bq.y), bflo(a.z) - lam * bflo(bq.z), bfhi(a.z) - lam * bfhi(bq.z), bflo(a.w) - lam * bflo(bq.w), bfhi(a.w) - lam * bfhi(bq.w)};
            float ss = 0.f;
#pragma unroll
            for (int i = 0; i < 8; ++i) ss += v[i] * v[i];
            ss += xor_shfl<1>(ss); ss += xor_shfl<2>(ss); ss += xor_shfl<4>(ss); ss += xor_shfl<8>(ss);
            const float rinv = rsqrtf(ss * (1.f / 128.f) + EPS) * post;
            const u32x4 o = {pk2(v[0] * rinv * gs0.x, v[1] * rinv * gs0.y), pk2(v[2] * rinv * gs0.z, v[3] * rinv * gs0.w), pk2(v[4] * rinv * gs1.x, v[5] * rinv * gs1.y), pk2(v[6] * rinv * gs1.z, v[7] * rinv * gs1.w)};
            *(GAS u32x4*)(hc + (size_t)row * 512 + h * 128 + e0) = o; }
    }
}
constexpr int RT_RSTD = 0, RT_HT = 1024, RT_WT = RT_HT + 128 * 68 * 4, RT_LOG = RT_WT + 128 * 40 * 4, RT_HIST = RT_LOG + 64 * 37 * 4, RT_BASE = RT_HIST + 128, RT_SEL = RT_BASE + 128, RT_END = RT_SEL + 64 * 4 * 4, RT_RED = RT_HT;
static_assert(RT_END <= RING_BYTES && 4 * 64 * 40 * 4 <= RT_LOG - RT_HT, "routing LDS map");
__device__ __forceinline__ void phase9(const Args& A, const Ctx& C, int layer, bool dummy = false  ) {
    const size_t doff = dummy ? (476 * MiB) : 0;
    moe_weight_items(A, C, layer);
    __syncthreads();
    LAS float* RSTD = (LAS float*)(C.lds + RT_RSTD); LAS float* HT = (LAS float*)(C.lds + RT_HT); LAS float* WT = (LAS float*)(C.lds + RT_WT); LAS float* LOG = (LAS float*)(C.lds + RT_LOG); LAS float* RED = (LAS float*)(C.lds + RT_RED);
    LAS int* HIST = (LAS int*)(C.lds + RT_HIST); LAS int* BASE = (LAS int*)(C.lds + RT_BASE); LAS int* SEL = (LAS int*)(C.lds + RT_SEL);
    const float* g2 = A.in[15] + layer * 1024; const float* wg = A.in[16] + layer * 4096; const float* bg = A.in[17] + layer * 4; const float* wr = A.in[18] + layer * 32768; const float* br = A.in[19] + layer * 32;
    bf16* h2 = wsp<bf16>(C, dummy ? 128 * MiB : WS_H2); const bf16* xb1 = wsp<bf16>(C, WS_XB1); const int lane = C.lane, tid = C.tid, wv = C.wave;
    const int tg = tid & 15, cg = (tid >> 4) & 7, ks = tid >> 7;
    for (int item = C.vcu; item < NTOK / 64; item += C.G) {
        const int row0 = item * 64;
        if (tid < 32) HIST[tid] = 0;
        f32x4 vnx[4];
        {
#pragma unroll
            for (int j = 0; j < 4; ++j) vnx[j] = ldrow4(xb1, true, (size_t)(row0 + wv * 8), lane + 64 * j); }
        for (int i = 0; i < 8; ++i) { const int rl = wv * 8 + i, row = row0 + rl;
            f32x4 v[4]; float ss = 0.f;
#pragma unroll
            for (int j = 0; j < 4; ++j) { v[j] = vnx[j]; ss += (v[j].x * v[j].x + v[j].y * v[j].y) + (v[j].z * v[j].z + v[j].w * v[j].w); }
            if (i < 7) {
#pragma unroll
                for (int j = 0; j < 4; ++j) vnx[j] = ldrow4(xb1, true, (size_t)(row + 1), lane + 64 * j); }
            const float rstd = rsqrtf(wave_sum(ss) * (1.f / DM) + EPS);
            GAS u32x2* ho = (GAS u32x2*)(h2 + (size_t)row * DM) + lane;
#pragma unroll
            for (int j = 0; j < 4; ++j) { const f32x4 g = ((const GAS f32x4*)g2)[64 * j + lane]; u32x2 o; o.x = pk2(v[j].x * rstd * g.x, v[j].y * rstd * g.y); o.y = pk2(v[j].z * rstd * g.z, v[j].w * rstd * g.w); ho[64 * j] = o; }
            if (lane == 0) RSTD[rl] = rstd; }
        __syncthreads();
        float acc[4][4]; float accg[4];
#pragma unroll
        for (int a = 0; a < 4; ++a) { accg[a] = 0.f;
#pragma unroll
            for (int c = 0; c < 4; ++c) acc[a][c] = 0.f; }
        const int t_lo = lane & 15, k4 = 4 * wv + (lane >> 4), wk = tid >> 2, wpart = tid & 3;
        f32x4 xq[4], gq, wq0, wq1, wq2 = {0.f, 0.f, 0.f, 0.f};
#define RT_LOADCH(kc_) do { gq = *(const GAS f32x4*)(g2 + (kc_) * 128 + k4 * 4); \
            _Pragma("unroll") for (int i = 0; i < 4; ++i) xq[i] = ldrow4(xb1, true, (size_t)(row0 + 16 * i + t_lo), (kc_) * 32 + k4); \
            { const float* src = wr + (size_t)((kc_) * 128 + wk) * 32 + wpart * 8; wq0 = *(const GAS f32x4*)src; wq1 = *(const GAS f32x4*)(src + 4); } \
            if (wpart == 0) wq2 = *(const GAS f32x4*)(wg + (size_t)((kc_) * 128 + wk) * 4); } while (0)
        RT_LOADCH(0);
        for (int kc = 0; kc < 8; ++kc) {
#pragma unroll
            for (int i = 0; i < 4; ++i) { const int t = 16 * i + t_lo; const float rs = RSTD[t];
                HT[(k4 * 4 + 0) * 68 + t] = xq[i].x * rs * gq.x; HT[(k4 * 4 + 1) * 68 + t] = xq[i].y * rs * gq.y; HT[(k4 * 4 + 2) * 68 + t] = xq[i].z * rs * gq.z; HT[(k4 * 4 + 3) * 68 + t] = xq[i].w * rs * gq.w; }
            *(LAS f32x4*)(WT + wk * 40 + wpart * 8) = wq0; *(LAS f32x4*)(WT + wk * 40 + wpart * 8 + 4) = wq1;
            if (wpart == 0) *(LAS f32x4*)(WT + wk * 40 + 32) = wq2;
            __syncthreads();
            if (kc < 7) RT_LOADCH(kc + 1);
#pragma unroll 4
            for (int kk = 0; kk < 32; ++kk) { const int k = ks * 32 + kk;
                const f32x4 a = *(const LAS f32x4*)(HT + k * 68 + 4 * tg), w = *(const LAS f32x4*)(WT + k * 40 + 4 * cg); const float wgc = WT[k * 40 + 32 + (cg & 3)];
#pragma unroll
                for (int q = 0; q < 4; ++q) { acc[q][0] += a[q] * w.x; acc[q][1] += a[q] * w.y; acc[q][2] += a[q] * w.z; acc[q][3] += a[q] * w.w; accg[q] += a[q] * wgc; } }
            __syncthreads();
        }
#undef RT_LOADCH
#pragma unroll
        for (int q = 0; q < 4; ++q) { LAS float* rp = RED + (ks * 64 + 4 * tg + q) * 40; *(LAS f32x4*)(rp + 4 * cg) = (f32x4){acc[q][0], acc[q][1], acc[q][2], acc[q][3]}; if (cg < 4) rp[32 + cg] = accg[q]; }
        __syncthreads();
        { const int tok = tid & 63, cgr = tid >> 6;
#pragma unroll
            for (int c = 0; c < 4; ++c) { const int col = 4 * cgr + c; LOG[tok * 37 + col] = (RED[(0 * 64 + tok) * 40 + col] + RED[(1 * 64 + tok) * 40 + col]) + (RED[(2 * 64 + tok) * 40 + col] + RED[(3 * 64 + tok) * 40 + col]) + br[col]; }
            if (cgr < 4) { const int col = 32 + cgr; LOG[tok * 37 + col] = (RED[(0 * 64 + tok) * 40 + col] + RED[(1 * 64 + tok) * 40 + col]) + (RED[(2 * 64 + tok) * 40 + col] + RED[(3 * 64 + tok) * 40 + col]) + bg[cgr]; } }
        __syncthreads();
        if (tid < 64) { const LAS float* lg = LOG + tid * 37;
            int gi = 0; float gmx = lg[32];
#pragma unroll
            for (int q = 1; q < 4; ++q) if (lg[32 + q] > gmx) { gmx = lg[32 + q]; gi = q; }
            float gsum = 0.f;
#pragma unroll
            for (int q = 0; q < 4; ++q) gsum += __expf(lg[32 + q] - gmx);
            const float pg = 1.f / gsum;
            const LAS float* el = lg + gi * 8; int i0 = 0; float e0 = el[0];
#pragma unroll
            for (int q = 1; q < 8; ++q) if (el[q] > e0) { e0 = el[q]; i0 = q; }
            int i1 = -1; float e1 = -INFINITY;
#pragma unroll
            for (int q = 0; q < 8; ++q) if (q != i0 && el[q] > e1) { e1 = el[q]; i1 = q; }
            const float x1 = __expf(e1 - e0), w0 = pg / (1.f + x1), w1 = pg * x1 / (1.f + x1);
            const int ea = gi * 8 + i0, eb = gi * 8 + i1;
            const int ra = atomicAdd((int*)(HIST + ea), 1), rb = atomicAdd((int*)(HIST + eb), 1);
            SEL[tid * 4 + 0] = ea; SEL[tid * 4 + 1] = eb; SEL[tid * 4 + 2] = ra; SEL[tid * 4 + 3] = rb;
            wsp<float>(C, WS_TOKW + doff)[(size_t)(row0 + tid) * 2] = w0; wsp<float>(C, WS_TOKW + doff)[(size_t)(row0 + tid) * 2 + 1] = w1; }
        __syncthreads();
        if (tid < 32) wsp<int>(C, WS_HISTG + doff)[item * 32 + tid] = HIST[tid];
        if (tid < 64) { wsp<int>(C, WS_TOKE + doff)[(size_t)(row0 + tid) * 2] = SEL[tid * 4]; wsp<int>(C, WS_TOKE + doff)[(size_t)(row0 + tid) * 2 + 1] = SEL[tid * 4 + 1];
            wsp<int>(C, WS_TOKR + doff)[(size_t)(row0 + tid) * 2] = SEL[tid * 4 + 2]; wsp<int>(C, WS_TOKR + doff)[(size_t)(row0 + tid) * 2 + 1] = SEL[tid * 4 + 3]; }
        __syncthreads();
    }
}
constexpr int P10_H = 0, P10_SEG = 65536, P10_BASE = P10_SEG + 16 * 32 * 4, P10_TOT = P10_BASE + 16 * 32 * 4;
__device__ __forceinline__ void phase10(const Ctx& C, int layer) {
    LAS int* H = (LAS int*)(C.lds + P10_H); LAS int* SEG = (LAS int*)(C.lds + P10_SEG); LAS int* SBASE = (LAS int*)(C.lds + P10_BASE); LAS int* TOT = (LAS int*)(C.lds + P10_TOT);
    LAS int* OFFS = (LAS int*)(C.lds + OFFS_OFF);
    { const int* hg = wsp<int>(C, WS_HISTG);
        for (int i = C.tid; i < 16384 / 4; i += NTHR) *(LAS u32x4*)(H + 4 * i) = *(const GAS u32x4*)(hg + 4 * i);
        __syncthreads();
        const int e = C.tid & 31, sg = C.tid >> 5; int s = 0;
        for (int i = 0; i < 32; ++i) s += H[(sg * 32 + i) * 32 + e];
        SEG[sg * 32 + e] = s;
        __syncthreads();
        if (C.tid < 32) { int run = 0; for (int q = 0; q < 16; ++q) { SBASE[q * 32 + C.tid] = run; run += SEG[q * 32 + C.tid]; } TOT[C.tid] = run; }
        __syncthreads();
        int run = SBASE[sg * 32 + e];
        for (int i = 0; i < 32; ++i) { const int v = H[(sg * 32 + i) * 32 + e]; H[(sg * 32 + i) * 32 + e] = run; run += v; }
        if (C.tid == 0) { int o = 0; for (int q = 0; q < 32; ++q) { OFFS[q] = o; o += (TOT[q] + 255) & ~255; } OFFS[32] = o; }
        __syncthreads(); }
    if (blockIdx.x == 0) { int* texp = wsp<int>(C, WS_TEXP); const int RT = OFFS[32] >> 8;
        for (int rt = C.tid; rt < RT; rt += NTHR) { int e = 0;
            for (int q = 1; q < 32; ++q) if (rt * 256 >= OFFS[q]) e = q;
            texp[rt] = e; }
        if (C.tid == 0) texp[511] = RT; }
    const int gw = C.vcu * NWAVES + C.wave, NGW = C.G * NWAVES, lane = C.lane;
    const bf16* h2 = wsp<bf16>(C, WS_H2); bf16* xs = wsp<bf16>(C, WS_XS); const int* toke = wsp<int>(C, WS_TOKE); const int* tokr = wsp<int>(C, WS_TOKR); int* tokp = wsp<int>(C, WS_TOKP);
    for (int s = gw; s < NTOK * 2; s += NGW) { const int tok = s >> 1, e = toke[s]; const int ipos = OFFS[e] + H[(tok >> 6) * 32 + e] + tokr[s]; const size_t pos = (size_t)ipos;
        if (lane == 0) tokp[s] = ipos;
        const GAS u32x4* src = (const GAS u32x4*)(h2 + (size_t)tok * DM) + lane; GAS u32x4* dst = (GAS u32x4*)(xs + pos * DM) + lane;
        const u32x4 a = src[0], b = src[64]; dst[0] = a; dst[64] = b; }
}
constexpr int PH_PER_LAYER = 13, N_PHASES = 2 * PH_PER_LAYER + 1;
#ifndef MK_ONE_LAUNCH
#define MK_ONE_LAUNCH 1
#endif
#ifndef E2_ALIGN
#define E2_ALIGN false
#define E2_SP2 true
#endif
__global__ void __launch_bounds__(NTHR, 2) fwd(Args A) {
    extern __shared__ __attribute__((aligned(16))) unsigned char lds_raw[];
    Ctx C_;
    C_.lds = (LAS unsigned char*)lds_raw; C_.MISC = (volatile LAS unsigned*)(C_.lds + MISC_OFF);
    C_.tid = threadIdx.x; C_.lane = C_.tid & 63; C_.wave = __builtin_amdgcn_readfirstlane(C_.tid >> 6);
    C_.G = gridDim.x; { const int bx = blockIdx.x; C_.vcu = (C_.G % 8 == 0) ? (bx % 8) * (C_.G / 8) + bx / 8 : bx; }
    C_.ws = A.ws; C_.ctl = (gu32*)(A.ws + WS_CTL);
    for (int u = C_.tid; u < 128; u += NTHR) ((LAS unsigned*)(C_.lds + MISC_OFF))[u] = 0u;
    __syncthreads();
    const int lo = A.ph_lo, hi = A.ph_hi;
    const bool multi = (hi - lo) > 1;
    XcdBarrier bar; bar.wv = C_.wave; bar.bar = (unsigned*)(C_.ctl + CW_BAR); bar.x = 0; bar.st = nullptr;
    if (multi) bar = xcd_barrier_post((unsigned*)(C_.ctl + CW_BAR), C_.MISC + 8, C_.wave);
#ifndef PHASE_MASK
#define PHASE_MASK 0x1fff
#endif
#define HAS(k) (((PHASE_MASK) >> (k)) & 1)
#ifndef REPMASK
#define REPMASK 0
#endif
#ifndef REPCNT
#define REPCNT 2
#endif
#define NREP(k) ((((REPMASK) >> (k)) & 1) && layer == 0 ? REPCNT : 1)
#define IN(k) (lo <= (k) && (k) < hi)
#define SEAM(k) do { if (IN(k) && IN((k) + 1)) xcd_barrier(bar); } while (0)
#define FRESH() Ctx C = C_; C.lane = xb_lane(); C.tid = C_.wave * 64 + C.lane; asm volatile("" : "+s"(C.ws), "+s"(C.ctl), "+s"(C.vcu), "+s"(C.G))
    for (int layer = 0; layer < 3; ++layer) {
        const int pb = layer * PH_PER_LAYER;
        if (HAS(0) && IN(pb + 0)) for (int rep_ = 0; rep_ < NREP(0); ++rep_) { FRESH(); phase0(A, C, layer); }
        if (layer == 2) break;
        SEAM(pb + 0);
#ifdef XBAR_PROBE
        if (layer == 0 && IN(pb + 0) && IN(pb + 1)) { for (int q = 0; q < XBAR_PROBE; ++q) xcd_barrier(bar); }
#endif
        if (HAS(1) && IN(pb + 1)) for (int rep_ = 0; rep_ < NREP(1); ++rep_) { FRESH();
            pg8::Gemm g{(bf16*)A.out + (size_t)NTOK * DM, wsp<bf16>(C, WS_WT1), NTOK, 5120, 1024}; pg8::StaticOrder S; S.init(NTOK, 5120, C.G, (int)blockIdx.x);
            pg8::EpiOut<0> E{proj(C, 0), nullptr, nullptr, PROJ_STRIDE / 2};
            pg8::gemm_phase<pg8::EpiOut<0>, pg8::StaticOrder, true, true>(C.lds, g, S, E, C.tid);
        }
        SEAM(pb + 1);
        if (HAS(2) && IN(pb + 2)) for (int rep_ = 0; rep_ < NREP(2); ++rep_) { FRESH();  for (int g8 = C.vcu; g8 < 256; g8 += C.G) for (int i8 = 0; i8 < 8; ++i8) mlstm_u_item(A, C, layer, g8 >> 4, (g8 & 15) * 8 + i8, i8 == 0); }
        SEAM(pb + 2);
        if (HAS(3) && IN(pb + 3)) for (int rep_ = 0; rep_ < NREP(3); ++rep_) { FRESH(); mlstm_scan(C); }
        SEAM(pb + 3);
        if (HAS(4) && IN(pb + 4)) for (int rep_ = 0; rep_ < NREP(4); ++rep_) { FRESH();
            gu32* q0 = C.ctl + CW_Q + 64 * (layer * 4 + 0); gu32* q1 = C.ctl + CW_Q + 64 * (layer * 4 + 1); gu32* q2 = C.ctl + CW_Q + 64 * (layer * 4 + 2);
            for (int rc_ = 0; rc_ < NREP(13); ++rc_) {
                if (C.G == 256) { const int xg = C.vcu >> 5, r = C.vcu & 31;
                    for (int rd = 0; rd < 2; ++rd) { const int p = r + 32 * rd, bvh = xg * 4 + (p >> 4), pr = p & 15;
                        attn_unit<128, true>(A, C, layer, bvh >> 3, bvh & 7, 31 - pr); attn_unit<128, true>(A, C, layer, bvh >> 3, bvh & 7, pr); } }
                else { for (int it = C.vcu; it < 1024; it += C.G) attn_unit<128, true>(A, C, layer, (it & 31) >> 3, it & 7, 31 - (it >> 5)); } }
            for (int rc_ = NREP(15) - 1; rc_ >= 0; --rc_) { gu32* qq = rc_ ? C.ctl + CW_Q + 64 * (17 + 2 * rc_) : q2;
            for (;;) { if (C.tid == 0) C.MISC[0] = __hip_atomic_fetch_add(qq, 1u, RLX_AGENT); __syncthreads(); const int it = (int)C.MISC[0]; __syncthreads(); if (it >= 512) break;
                for (int i4 = 0; i4 < 4; ++i4) mlstm_out_item(A, C, layer, it >> 5, (it & 31) * 4 + i4, i4 == 0, rc_ ? wsp<bf16>(C, 480 * MiB) : nullptr); } }
            for (int rc_ = NREP(14) - 1; rc_ >= 0; --rc_) { gu32* qq = rc_ ? C.ctl + CW_Q + 64 * (16 + 2 * rc_) : q1;
            for (;;) { if (C.tid == 0) C.MISC[0] = __hip_atomic_fetch_add(qq, 1u, RLX_AGENT); __syncthreads(); const int it = (int)C.MISC[0]; __syncthreads(); if (it >= 1024) break;
                attn_unit<64, false>(A, C, layer, (it & 31) >> 3, it & 7, 31 - (it >> 5), rc_ ? wsp<bf16>(C, 480 * MiB) : nullptr); } }
        }
        SEAM(pb + 4);
        if (HAS(6) && IN(pb + 6)) for (int rep_ = 0; rep_ < NREP(6); ++rep_) { FRESH();
            if (rep_ == 0) phase5(A, C, layer);
            pg8::Gemm g{(bf16*)A.out + (size_t)NTOK * DM, wsp<bf16>(C, WS_WT2), NTOK, 3072, 1024}; pg8::StaticOrder S; S.init(NTOK, 3072, C.G, (int)blockIdx.x);
            pg8::EpiOut<1> E{wsp<bf16>(C, WS_G0), wsp<bf16>(C, WS_G1), wsp<bf16>(C, WS_G2), 0};
            pg8::gemm_phase<pg8::EpiOut<1>, pg8::StaticOrder, true, true>(C.lds, g, S, E, C.tid);
        }
        SEAM(pb + 6);
        if (HAS(7) && IN(pb + 7)) for (int rep_ = 0; rep_ < NREP(7); ++rep_) { FRESH();
            pg8::StaticOrder S; S.init(NTOK, 1024, C.G, (int)blockIdx.x); bf16* Y = wsp<bf16>(C, WS_O12);
            { pg8::Gemm g{proj(C, PJ_AV), wsp<bf16>(C, WS_PT), NTOK, 1024, 512}; pg8::EpiMerge<true> E{Y, wsp<bf16>(C, WS_G0)}; pg8::gemm_phase<pg8::EpiMerge<true>, pg8::StaticOrder, true, true>(C.lds, g, S, E, C.tid); }
            __syncthreads();
            { pg8::Gemm g{proj(C, PJ_BQ), wsp<bf16>(C, WS_PT) + 1024 * 512, NTOK, 1024, 512}; pg8::EpiMerge<false> E{Y, wsp<bf16>(C, WS_G1)}; pg8::gemm_phase<pg8::EpiMerge<false>, pg8::StaticOrder, true, true>(C.lds, g, S, E, C.tid); }
            __syncthreads();
            { pg8::Gemm g{proj(C, PJ_CQ), wsp<bf16>(C, WS_PT) + 2 * 1024 * 512, NTOK, 1024, 512}; pg8::EpiMerge<false> E{Y, wsp<bf16>(C, WS_G2)}; pg8::gemm_phase<pg8::EpiMerge<false>, pg8::StaticOrder, true, true>(C.lds, g, S, E, C.tid); }
        }
        SEAM(pb + 7);
        if (HAS(8) && IN(pb + 8)) for (int rep_ = 0; rep_ < NREP(8); ++rep_) { FRESH();
            pg8::Gemm g{wsp<bf16>(C, WS_O12), wsp<bf16>(C, WS_WOT), NTOK, 1024, 1024}; pg8::StaticOrder S; S.init(NTOK, 1024, C.G, (int)blockIdx.x);
            pg8::EpiResid E{layer == 0 ? (const void*)A.in[0] : (const void*)A.out, layer > 0, wsp<bf16>(C, WS_XB1)};
            pg8::gemm_phase<pg8::EpiResid, pg8::StaticOrder, true, true>(C.lds, g, S, E, C.tid);
        }
        SEAM(pb + 8);
        if (HAS(9) && IN(pb + 9)) for (int rep_ = 0; rep_ < NREP(9); ++rep_) { FRESH(); for (int r9 = 1; r9 < NREP(16); ++r9) { phase9(A, C, layer, true); __syncthreads(); } if (NREP(17) >= 2) { moe_weight_items(A, C, layer); __syncthreads(); } phase9(A, C, layer); }
        SEAM(pb + 9);
        if (HAS(10) && IN(pb + 10)) for (int rep_ = 0; rep_ < NREP(10); ++rep_) { FRESH(); phase10(C, layer); }
        SEAM(pb + 10);
        if (HAS(11) && IN(pb + 11)) for (int rep_ = 0; rep_ < NREP(11); ++rep_) { FRESH();
            const int* texp = wsp<int>(C, WS_TEXP); const int RT = __builtin_amdgcn_readfirstlane(texp[511]);
            pg8::Gemm g{wsp<bf16>(C, WS_XS), wsp<bf16>(C, WS_W1T), 73728, 32 * 512, 1024}; pg8::MoeOrder<1> S{C.G, C.vcu, RT, texp};
            pg8::EpiSiluMul E{wsp<bf16>(C, WS_HE)};
            pg8::gemm_phase<pg8::EpiSiluMul, pg8::MoeOrder<1>, true, true>(C.lds, g, S, E, C.tid);
        }
        SEAM(pb + 11);
        if (HAS(12) && IN(pb + 12)) for (int rep_ = 0; rep_ < NREP(12); ++rep_) { FRESH();
            const int* texp = wsp<int>(C, WS_TEXP); const int RT = __builtin_amdgcn_readfirstlane(texp[511]);
            pg8::Gemm g{wsp<bf16>(C, WS_HE), wsp<bf16>(C, WS_W2T), 73728, 32 * 1024, 256}; pg8::MoeOrder<2> S{C.G, C.vcu, RT, texp};
            pg8::EpiOut<2> E{wsp<bf16>(C, WS_OSL), nullptr, nullptr, 0};
            pg8::gemm_phase<pg8::EpiOut<2>, pg8::MoeOrder<2>, E2_ALIGN, E2_SP2>(C.lds, g, S, E, C.tid);
        }
        SEAM(pb + 12);
    }
#undef IN
#undef SEAM
}

extern "C" void kernel_launch(void* const* d_in, const int* in_sizes, int n_in, void* d_out, int out_size, void* d_ws, size_t ws_size, hipStream_t stream) {
    static int grid = 0;
    if (grid == 0) {
        if (n_in != 23 || out_size != NTOK * DM || ws_size < WS_NEED) { fprintf(stderr, "kernel_launch: unexpected shapes (n_in %d out %d ws %zu)\n", n_in, out_size, ws_size); grid = -1; return; }
        int dev = 0, cus = 0, per_cu = 0;
        if (hipGetDevice(&dev) != hipSuccess || hipDeviceGetAttribute(&cus, hipDeviceAttributeMultiprocessorCount, dev) != hipSuccess) { grid = -1; return; }
        if (hipFuncSetAttribute((const void*)fwd, hipFuncAttributeMaxDynamicSharedMemorySize, LDS_BYTES) != hipSuccess) { fprintf(stderr, "kernel_launch: hipFuncSetAttribute failed\n"); grid = -1; return; }
        if (hipOccupancyMaxActiveBlocksPerMultiprocessor(&per_cu, (const void*)fwd, NTHR, LDS_BYTES) != hipSuccess || per_cu < 1) fprintf(stderr, "kernel_launch: occupancy query says %d\n", per_cu);
        (void)hipGetLastError();
        grid = cus;
    }
    if (grid < 0) return;
    (void)hipMemsetAsync((char*)d_ws + WS_CTL, 0, CTL_ZERO_BYTES, stream);
    Args a{};
    for (int i = 0; i < 23; ++i) a.in[i] = (const float*)d_in[i];
    a.out = (float*)d_out; a.ws = (unsigned char*)d_ws;
#if MK_ONE_LAUNCH
    a.ph_lo = 0; a.ph_hi = N_PHASES;
    hipLaunchKernelGGL(fwd, dim3(grid), dim3(NTHR), LDS_BYTES, stream, a);
#else
    for (int p = 0; p < N_PHASES; ++p) { a.ph_lo = p; a.ph_hi = p + 1; hipLaunchKernelGGL(fwd, dim3(grid), dim3(NTHR), LDS_BYTES, stream, a); }
#endif
}
```

```cpp
#include <hip/hip_runtime.h>
#include <cstdio>
#include <cstdint>
#include <cmath>
namespace pg8 {
#define PG8_LAS __attribute__((address_space(3)))
typedef unsigned short bf16_t;
typedef short bf16x8 __attribute__((ext_vector_type(8)));
typedef float f32x4 __attribute__((ext_vector_type(4)));
typedef unsigned u32x4 __attribute__((ext_vector_type(4)));
constexpr int BM = 256, BK = 64, HALF = 128, HTB = HALF * BK * 2  , STAGE_BYTES = 8 * HTB, NXCD = 8, WGM = 8;

__host__ __device__ __forceinline__ int lds_byte(int r, int c) { const int st = (r >> 4) * 2 + (c >> 5), rr = r & 15, cc = c & 31, ob = rr * 64 + cc * 2; return st * 1024 + (ob ^ (((ob >> 9) & 1) << 5)); }
__host__ __device__ __forceinline__ void stage_rc(int b, int& R, int& C) { const int st = b / 1024, sb = b % 1024, swz = sb ^ (((sb >> 9) & 1) << 5); R = (st >> 1) * 16 + swz / 64; C = (st & 1) * 32 + (swz % 64) / 2; }
__host__ __device__ __forceinline__ int perm32(int rho) { const int n = rho >> 4, i = rho & 15; return 8 * (i >> 2) + 4 * n + (i & 3); }

struct Unit { int pm, pn; };
struct Gemm { const bf16_t* A; const bf16_t* Bt; int M, N, K; };

struct StaticOrder {
    int nM, nN, nwg, G, c;
    __host__ __device__ void init(int M, int N, int G_, int c_) { nM = M / BM; nN = N / BM; nwg = nM * nN; G = G_; c = c_; }
    __host__ __device__ bool next(int i, Unit& u) const {
        const long L = (long)i * G + c; if (L >= nwg) return false;
        int wgid = (int)L; { const int q = nwg / NXCD, r = nwg % NXCD, xcd = wgid % NXCD, off = wgid / NXCD; wgid = (xcd < r ? xcd * (q + 1) : r * (q + 1) + (xcd - r) * q) + off; }
        const int nig = WGM * nN, gid = wgid / nig, fm = gid * WGM, gsz = (nM - fm) < WGM ? (nM - fm) : WGM;
        u.pm = fm + ((wgid % nig) % gsz); u.pn = (wgid % nig) / gsz; return true;
    }
    __device__ __forceinline__ void a_ready(const Unit&) const {}
    __device__ __forceinline__ void done(const Unit&) const {}
};

__device__ __forceinline__ unsigned cvt_pk_bf16(float lo, float hi) { unsigned r; asm volatile("v_cvt_pk_bf16_f32 %0, %1, %2" : "=v"(r) : "v"(lo), "v"(hi)); return r; }
#ifndef GAS
#define GAS __attribute__((address_space(1)))
#endif
typedef float f32x2 __attribute__((ext_vector_type(2)));
__device__ __forceinline__ float bflo(unsigned u) { return __builtin_bit_cast(float, u << 16); }
__device__ __forceinline__ float bfhi(unsigned u) { return __builtin_bit_cast(float, u & 0xffff0000u); }
__device__ __forceinline__ float sigmoidf_(float x) { return 1.f / (1.f + __expf(-x)); }
template <int MODE> struct EpiOut {
    static constexpr bool PERM = true, AFTER_DRAIN = false, CHAIN = false;
    bf16_t* b0; bf16_t* b1; bf16_t* b2; size_t stride;
    __device__ __forceinline__ void operator()(const f32x4 (&acc)[2][2][4][2], const Unit& u, int wr, int wc, int fr, int fq) const {
        int row0 = u.pm * BM + wr * 64 + fr; asm volatile("" : "+v"(row0));
        bf16_t* base; int colt, ldc;
        if (MODE == 0) { base = b0 + (size_t)(u.pn >> 1) * stride; colt = (u.pn & 1) * 256; ldc = 512; }
        else if (MODE == 1) { const int t = u.pn >> 2; base = b0 + (size_t)(160 * t - 32 * t * (t - 1)) * (1u << 19); colt = (u.pn & 3) * 256; ldc = 1024; }
        else { base = b0; colt = (u.pn & 3) * 256; ldc = 1024; }
        const int col0 = colt + wc * 32 + 8 * fq;
#pragma unroll
        for (int ai = 0; ai < 2; ++ai)
#pragma unroll
            for (int m = 0; m < 4; ++m) { bf16_t* rowp = base + (size_t)(row0 + ai * HALF + m * 16) * ldc + col0;
#pragma unroll
                for (int bj = 0; bj < 2; ++bj) { f32x4 v0 = acc[ai][bj][m][0], v1 = acc[ai][bj][m][1];
                    if (MODE == 1) {
#pragma unroll
                        for (int j = 0; j < 4; ++j) { v0[j] = sigmoidf_(v0[j]); v1[j] = sigmoidf_(v1[j]); } }
                    u32x4 w; w.x = cvt_pk_bf16(v0[0], v0[1]); w.y = cvt_pk_bf16(v0[2], v0[3]); w.z = cvt_pk_bf16(v1[0], v1[1]); w.w = cvt_pk_bf16(v1[2], v1[3]);
                    *(GAS u32x4*)(rowp + bj * HALF) = w; } }
    }
};
template <bool FIRST> struct EpiMerge {
    static constexpr bool PERM = true, AFTER_DRAIN = false, CHAIN = false;
    bf16_t* Y; const bf16_t* G;
    __device__ __forceinline__ void operator()(const f32x4 (&acc)[2][2][4][2], const Unit& u, int wr, int wc, int fr, int fq) const {
        int row0 = u.pm * BM + wr * 64 + fr; asm volatile("" : "+v"(row0)); const int col0 = u.pn * BM + wc * 32 + 8 * fq;
#pragma unroll
        for (int ai = 0; ai < 2; ++ai)
#pragma unroll
            for (int m = 0; m < 4; ++m) { const size_t ro = (size_t)(row0 + ai * HALF + m * 16) * 1024 + col0;
#pragma unroll
                for (int bj = 0; bj < 2; ++bj) { const f32x4 v0 = acc[ai][bj][m][0], v1 = acc[ai][bj][m][1];
                    const u32x4 g = *(const GAS u32x4*)(G + ro + bj * HALF);
                    float r[8] = { bflo(g.x) * v0[0], bfhi(g.x) * v0[1], bflo(g.y) * v0[2], bfhi(g.y) * v0[3], bflo(g.z) * v1[0], bfhi(g.z) * v1[1], bflo(g.w) * v1[2], bfhi(g.w) * v1[3] };
                    if (!FIRST) { const u32x4 y = *(const GAS u32x4*)(Y + ro + bj * HALF);
                        r[0] += bflo(y.x); r[1] += bfhi(y.x); r[2] += bflo(y.y); r[3] += bfhi(y.y); r[4] += bflo(y.z); r[5] += bfhi(y.z); r[6] += bflo(y.w); r[7] += bfhi(y.w); }
                    u32x4 w; w.x = cvt_pk_bf16(r[0], r[1]); w.y = cvt_pk_bf16(r[2], r[3]); w.z = cvt_pk_bf16(r[4], r[5]); w.w = cvt_pk_bf16(r[6], r[7]);
                    *(GAS u32x4*)(Y + ro + bj * HALF) = w; } }
    }
};
struct EpiResid {
    static constexpr bool PERM = true, AFTER_DRAIN = false, CHAIN = false;
    const void* XS; bool xbf; bf16_t* OUT;
    __device__ __forceinline__ void operator()(const f32x4 (&acc)[2][2][4][2], const Unit& u, int wr, int wc, int fr, int fq) const {
        int row0 = u.pm * BM + wr * 64 + fr; asm volatile("" : "+v"(row0)); const int col0 = u.pn * BM + wc * 32 + 8 * fq;
#pragma unroll
        for (int ai = 0; ai < 2; ++ai)
#pragma unroll
            for (int m = 0; m < 4; ++m) { const size_t ro = (size_t)(row0 + ai * HALF + m * 16) * 1024 + col0;
#pragma unroll
                for (int bj = 0; bj < 2; ++bj) { f32x4 x0, x1;
                    if (xbf) { const u32x4 xv = *(const GAS u32x4*)((const bf16_t*)XS + ro + bj * HALF); x0 = (f32x4){bflo(xv.x), bfhi(xv.x), bflo(xv.y), bfhi(xv.y)}; x1 = (f32x4){bflo(xv.z), bfhi(xv.z), bflo(xv.w), bfhi(xv.w)}; }
                    else { x0 = *(const GAS f32x4*)((const float*)XS + ro + bj * HALF); x1 = *(const GAS f32x4*)((const float*)XS + ro + bj * HALF + 4); }
                    x0 = x0 + acc[ai][bj][m][0]; x1 = x1 + acc[ai][bj][m][1];
                    u32x4 w; w.x = cvt_pk_bf16(x0[0], x0[1]); w.y = cvt_pk_bf16(x0[2], x0[3]); w.z = cvt_pk_bf16(x1[0], x1[1]); w.w = cvt_pk_bf16(x1[2], x1[3]);
                    *(GAS u32x4*)(OUT + ro + bj * HALF) = w; } }
    }
};
struct EpiSiluMul {
    static constexpr bool PERM = true, AFTER_DRAIN = false, CHAIN = false;
    bf16_t* O;
    __device__ __forceinline__ void operator()(const f32x4 (&acc)[2][2][4][2], const Unit& u, int wr, int wc, int fr, int fq) const {
        int row0 = u.pm * BM + wr * 64 + fr; asm volatile("" : "+v"(row0)); const int col0 = (u.pn & 1) * 128 + wc * 32 + 8 * fq;
#pragma unroll
        for (int ai = 0; ai < 2; ++ai)
#pragma unroll
            for (int m = 0; m < 4; ++m) { float r[8];
#pragma unroll
                for (int n = 0; n < 2; ++n)
#pragma unroll
                    for (int j = 0; j < 4; ++j) { const float g = acc[ai][0][m][n][j], up = acc[ai][1][m][n][j]; r[4 * n + j] = g * sigmoidf_(g) * up; }
                u32x4 w; w.x = cvt_pk_bf16(r[0], r[1]); w.y = cvt_pk_bf16(r[2], r[3]); w.z = cvt_pk_bf16(r[4], r[5]); w.w = cvt_pk_bf16(r[6], r[7]);
                *(GAS u32x4*)(O + (size_t)(row0 + ai * HALF + m * 16) * 256 + col0) = w; }
    }
};
template <int LOG_NCT> struct MoeOrder {
    int G, c, RT; const int* texp;
    __device__ __forceinline__ bool next(int i, Unit& u) const {
        const int L = i * G + c; const int rt = L >> LOG_NCT; if (rt >= RT) return false;
        const int e = __builtin_amdgcn_readfirstlane(texp[rt]); u.pm = rt; u.pn = (e << LOG_NCT) + (L & ((1 << LOG_NCT) - 1)); return true;
    }
    __device__ __forceinline__ void a_ready(const Unit&) const {}
    __device__ __forceinline__ void done(const Unit&) const {}
};
template <class Epi, class Sched, bool ALIGN_EPI = false, bool SP2 = false>
__device__ __forceinline__ void gemm_phase(PG8_LAS unsigned char* lds, const Gemm g, const Sched& S, const Epi& E, int tid_in) {
    int tid = tid_in; asm volatile("" : "+v"(tid));
    const int wid = __builtin_amdgcn_readfirstlane(tid >> 6), lane = tid & 63, wr = wid >> 2, wc = wid & 3, fr = lane & 15, fq = lane >> 4;
    const int K = g.K, nt = K / BK;
    unsigned voffA[2], voffB[2];
#pragma unroll
    for (int i = 0; i < 2; ++i) { int R, C; stage_rc(tid * 16 + i * 8192, R, C); const int Rb = Epi::PERM ? ((R & ~31) + perm32(R & 31)) : R;
        voffA[i] = (unsigned)(R * K + C) * 2u; voffB[i] = (unsigned)(Rb * K + C) * 2u; }
    const size_t kstep = (size_t)(BK * 2);
    const size_t hstep = (size_t)HALF * K * 2;
    const size_t tstep = 2 * hstep;
    const unsigned ldsw = (unsigned)wid * 1024u;
    const int aoff = lds_byte(wr * 64 + fr, fq * 8), boff = lds_byte(wc * 32 + fr, fq * 8);
#define PG8_SA(b, h) (((b) * 2 + (h)) * HTB)
#define PG8_SB(b, h) ((4 + (b) * 2 + (h)) * HTB)
#define PG8_STAGE(bufoff, gbase, voff) do { _Pragma("unroll") for (int _i = 0; _i < 2; ++_i) \
        __builtin_amdgcn_global_load_lds((const unsigned*)((const char*)(gbase) + (voff)[_i]), (PG8_LAS unsigned*)(lds + (bufoff) + ldsw + _i * 8192), 16, 0, 0); } while (0)
#define PG8_LDA(dst, b, h) do { _Pragma("unroll") for (int m = 0; m < 4; ++m) _Pragma("unroll") for (int k = 0; k < 2; ++k) dst[m][k] = *(const PG8_LAS bf16x8*)(lds + PG8_SA(b, h) + aoff + m * 2048 + k * 1024); } while (0)
#define PG8_LDB(dst, b, h) do { _Pragma("unroll") for (int n = 0; n < 2; ++n) _Pragma("unroll") for (int k = 0; k < 2; ++k) dst[n][k] = *(const PG8_LAS bf16x8*)(lds + PG8_SB(b, h) + boff + n * 2048 + k * 1024); } while (0)
#define PG8_MMA(ai, bj, At, Bt) do { __builtin_amdgcn_s_setprio(1); _Pragma("unroll") for (int m = 0; m < 4; ++m) _Pragma("unroll") for (int n = 0; n < 2; ++n) _Pragma("unroll") for (int k = 0; k < 2; ++k) \
        acc[ai][bj][m][n] = __builtin_amdgcn_mfma_f32_16x16x32_bf16(Bt[n][k], At[m][k], acc[ai][bj][m][n], 0, 0, 0); __builtin_amdgcn_s_setprio(0); } while (0)
#define PG8_WAIT_V(n) asm volatile("s_waitcnt vmcnt(" #n ")" ::: "memory")
#define PG8_WAIT_L(n) asm volatile("s_waitcnt lgkmcnt(" #n ")" ::: "memory")
#define PG8_BAR __builtin_amdgcn_s_barrier()
#define PG8_SCHED __builtin_amdgcn_sched_barrier(0)
    Unit cur, nxt; int ui = 0;
    if (!S.next(0, cur)) return;
    f32x4 acc[2][2][4][2];
#pragma unroll
    for (int a = 0; a < 2; ++a)
#pragma unroll
        for (int b = 0; b < 2; ++b)
#pragma unroll
            for (int m = 0; m < 4; ++m)
#pragma unroll
                for (int n = 0; n < 2; ++n) acc[a][b][m][n] = (f32x4){0.f, 0.f, 0.f, 0.f};
    bf16x8 At[4][2], B0[2][2], B1[2][2];
    const char* cA = (const char*)g.A + (size_t)cur.pm * tstep; const char* cB = (const char*)g.Bt + (size_t)cur.pn * tstep;
    S.a_ready(cur);
    if constexpr (SP2) {
        PG8_STAGE(PG8_SB(0, 0), cB, voffB); PG8_STAGE(PG8_SB(0, 1), cB + hstep, voffB); PG8_STAGE(PG8_SA(0, 0), cA, voffA); PG8_STAGE(PG8_SA(0, 1), cA + hstep, voffA);
        if (wr == 1) PG8_BAR;
        PG8_WAIT_V(2); PG8_BAR;
        PG8_STAGE(PG8_SB(1, 0), cB + kstep, voffB); PG8_STAGE(PG8_SA(1, 0), cA + kstep, voffA); PG8_STAGE(PG8_SB(1, 1), cB + hstep + kstep, voffB);
        PG8_WAIT_V(6); PG8_BAR;
    } else {
        PG8_STAGE(PG8_SB(0, 0), cB, voffB); PG8_STAGE(PG8_SA(0, 0), cA, voffA); PG8_STAGE(PG8_SB(0, 1), cB + hstep, voffB); PG8_STAGE(PG8_SA(0, 1), cA + hstep, voffA);
        if (wr == 1) PG8_BAR;
        PG8_WAIT_V(4); PG8_BAR;
        PG8_STAGE(PG8_SB(1, 0), cB + kstep, voffB); PG8_STAGE(PG8_SA(1, 0), cA + kstep, voffA); PG8_STAGE(PG8_SB(1, 1), cB + hstep + kstep, voffB);
        PG8_WAIT_V(6); PG8_BAR;
    }
    for (;;) {
        const bool has_next = S.next(ui + 1, nxt);
        const char* nA = has_next ? (const char*)g.A + (size_t)nxt.pm * tstep : cA; const char* nB = has_next ? (const char*)g.Bt + (size_t)nxt.pn * tstep : cB;
        for (int t = 0; t < nt; t += 2) {
            const bool last = (t == nt - 2);
            const char* a1 = cA + (size_t)(t + 1) * kstep;
            const char* a2 = last ? nA : cA + (size_t)(t + 2) * kstep; const char* b2 = last ? nB : cB + (size_t)(t + 2) * kstep;
            const char* a3 = a2 + kstep; const char* b3 = b2 + kstep;
            if (last && has_next) S.a_ready(nxt);
            if constexpr (SP2) {
            PG8_LDB(B0, 0, 0); PG8_LDB(B1, 0, 1); PG8_SCHED; PG8_LDA(At, 0, 0); PG8_STAGE(PG8_SA(1, 1), a1 + hstep, voffA);
            PG8_WAIT_V(8); PG8_WAIT_L(0); PG8_BAR; PG8_MMA(0, 0, At, B0); PG8_MMA(0, 1, At, B1); PG8_BAR; PG8_SCHED;
            PG8_LDA(At, 0, 1); PG8_STAGE(PG8_SB(0, 0), b2, voffB); PG8_STAGE(PG8_SB(0, 1), b2 + hstep, voffB); PG8_STAGE(PG8_SA(0, 0), a2, voffA);
            PG8_WAIT_V(8); PG8_WAIT_L(0); PG8_BAR; PG8_MMA(1, 0, At, B0); PG8_MMA(1, 1, At, B1); PG8_BAR; PG8_SCHED;
            PG8_LDB(B0, 1, 0); PG8_LDB(B1, 1, 1); PG8_SCHED; PG8_LDA(At, 1, 0); PG8_STAGE(PG8_SA(0, 1), a2 + hstep, voffA);
            PG8_WAIT_V(8); PG8_WAIT_L(0); PG8_BAR; PG8_MMA(0, 0, At, B0); PG8_MMA(0, 1, At, B1); PG8_BAR; PG8_SCHED;
            PG8_LDA(At, 1, 1); PG8_STAGE(PG8_SB(1, 0), b3, voffB); PG8_STAGE(PG8_SB(1, 1), b3 + hstep, voffB); PG8_STAGE(PG8_SA(1, 0), a3, voffA);
            PG8_WAIT_V(8); PG8_WAIT_L(0); PG8_BAR; PG8_MMA(1, 0, At, B0); PG8_MMA(1, 1, At, B1); PG8_BAR; PG8_SCHED;
            } else {
            PG8_LDB(B0, 0, 0); PG8_SCHED; PG8_LDA(At, 0, 0); PG8_STAGE(PG8_SA(1, 1), a1 + hstep, voffA);
            PG8_WAIT_L(8); PG8_BAR; PG8_WAIT_L(0); PG8_MMA(0, 0, At, B0); PG8_BAR; PG8_SCHED;
            PG8_LDB(B1, 0, 1); PG8_STAGE(PG8_SB(0, 0), b2, voffB);
            PG8_BAR; PG8_WAIT_L(0); PG8_MMA(0, 1, At, B1); PG8_BAR;
            PG8_LDA(At, 0, 1); PG8_STAGE(PG8_SA(0, 0), a2, voffA);
            PG8_BAR; PG8_WAIT_L(0); PG8_MMA(1, 0, At, B0); PG8_BAR; PG8_SCHED;
            PG8_STAGE(PG8_SB(0, 1), b2 + hstep, voffB);
            PG8_WAIT_V(6); PG8_BAR; PG8_MMA(1, 1, At, B1); PG8_BAR;
            PG8_LDB(B0, 1, 0); PG8_SCHED; PG8_LDA(At, 1, 0); PG8_STAGE(PG8_SA(0, 1), a2 + hstep, voffA);
            PG8_WAIT_L(8); PG8_BAR; PG8_WAIT_L(0); PG8_MMA(0, 0, At, B0); PG8_BAR; PG8_SCHED;
            PG8_LDB(B1, 1, 1); PG8_STAGE(PG8_SB(1, 0), b3, voffB);
            PG8_BAR; PG8_WAIT_L(0); PG8_MMA(0, 1, At, B1); PG8_BAR;
            PG8_LDA(At, 1, 1); PG8_STAGE(PG8_SA(1, 0), a3, voffA);
            PG8_BAR; PG8_WAIT_L(0); PG8_MMA(1, 0, At, B0); PG8_BAR; PG8_SCHED;
            PG8_STAGE(PG8_SB(1, 1), b3 + hstep, voffB);
            PG8_WAIT_V(6); PG8_BAR; PG8_MMA(1, 1, At, B1); PG8_BAR;
            }
        }
        if constexpr (ALIGN_EPI) { if (wr == 0) PG8_BAR; }
        if constexpr (!Epi::AFTER_DRAIN) { E(acc, cur, wr, wc, fr, fq); S.done(cur); }
        if (!has_next) break;
#pragma unroll
        for (int a = 0; a < 2; ++a)
#pragma unroll
            for (int b = 0; b < 2; ++b)
#pragma unroll
                for (int m = 0; m < 4; ++m)
#pragma unroll
                    for (int n = 0; n < 2; ++n) acc[a][b][m][n] = (f32x4){0.f, 0.f, 0.f, 0.f};
        cur = nxt; cA = nA; cB = nB; ++ui;
        if constexpr (ALIGN_EPI) { if (wr == 1) PG8_BAR; }
    }
    PG8_WAIT_V(0);
    if constexpr (!ALIGN_EPI) { if (wr == 0) PG8_BAR; }
    PG8_BAR;
    if constexpr (Epi::AFTER_DRAIN) { E.fused(acc, cur, wr, wc, fr, fq, lds, wid, lane); S.done(cur); }
#undef PG8_SA
#undef PG8_SB
#undef PG8_STAGE
#undef PG8_LDA
#undef PG8_LDB
#undef PG8_MMA
#undef PG8_WAIT_V
#undef PG8_WAIT_L
#undef PG8_BAR
#undef PG8_SCHED
}
}
constexpr int NTOK = 32768, SEQ = 8192, NB = 4, DM = 1024, INC = 8200;
constexpr float EPS = 1e-6f, LOG2E = 1.4426950408889634f;
constexpr size_t MiB = 1u << 20;
constexpr size_t WS_CTL = 0, CTL_ZERO_BYTES = 128 * 1024;
constexpr size_t WS_IG = 1 * MiB;
constexpr size_t WS_BC = 1 * MiB + 512 * 1024;
constexpr size_t WS_BLAST = 2 * MiB;
constexpr size_t WS_GMAX = 2 * MiB + 64 * 1024;
constexpr size_t WS_NUC = 3 * MiB;
constexpr size_t WS_TOKE = 4 * MiB;
constexpr size_t WS_TOKR = 4 * MiB + 256 * 1024;
constexpr size_t WS_TOKW = 4 * MiB + 512 * 1024;
constexpr size_t WS_TEXP = 5 * MiB;
constexpr size_t WS_HISTG = 5 * MiB + 64 * 1024;
constexpr size_t WS_TOKP = 6 * MiB;
constexpr size_t WS_WT1 = 8 * MiB;
constexpr size_t WS_WT2 = 18 * MiB;
constexpr size_t WS_PT = 24 * MiB;
constexpr size_t WS_WOT = 27 * MiB;
constexpr size_t WS_PROJ = 32 * MiB;
constexpr size_t PROJ_STRIDE = 32 * MiB;
constexpr size_t WS_HB = 352 * MiB;
constexpr size_t WS_O12 = 416 * MiB;
constexpr size_t WS_G0 = 32 * MiB, WS_G1 = 192 * MiB, WS_G2 = 288 * MiB;
constexpr size_t WS_H2 = 32 * MiB;
constexpr size_t WS_XS = 96 * MiB;
constexpr size_t WS_HE = 32 * MiB;
constexpr size_t WS_OSL = 96 * MiB;
constexpr size_t WS_W1T = 416 * MiB;
constexpr size_t WS_W2T = 448 * MiB;
constexpr size_t WS_XB1 = 256 * MiB;
constexpr size_t WS_NEED = 512 * MiB;
constexpr int PJ_AQ = 0, PJ_AK = 1, PJ_AV = 2, PJ_AO = 3, PJ_BQ = 4, PJ_BK = 5, PJ_BV = 6, PJ_CQ = 7, PJ_CK = 8, PJ_CV = 9;
constexpr int CW_TMO = 0, CW_CODE = 1;
constexpr int CW_BAR = 4096;
constexpr int CW_Q = 8192;
constexpr int CW_CNT = 12288;
constexpr int RING_BYTES = 131072;
constexpr int MISC_OFF = RING_BYTES;
constexpr int OFFS_OFF = RING_BYTES + 256;
constexpr int LDS_BYTES = 147456;
constexpr int NWAVES = 8, NTHR = 512;

#ifndef GAS
#define GAS __attribute__((address_space(1)))
#endif
#define LAS __attribute__((address_space(3)))
typedef unsigned short bf16;
typedef float f32x4 __attribute__((ext_vector_type(4)));
typedef float f32x16 __attribute__((ext_vector_type(16)));
typedef short bf16x8 __attribute__((ext_vector_type(8)));
typedef unsigned u32x4 __attribute__((ext_vector_type(4)));
typedef unsigned u32x2 __attribute__((ext_vector_type(2)));
typedef short s16x4 __attribute__((ext_vector_type(4)));
typedef GAS unsigned gu32;
#define RLX_AGENT __ATOMIC_RELAXED, __HIP_MEMORY_SCOPE_AGENT
#define LDS_WAIT() asm volatile("s_waitcnt lgkmcnt(0)" ::: "memory")
typedef float f32x2_t __attribute__((ext_vector_type(2))); typedef __bf16 bf16x2_t __attribute__((ext_vector_type(2)));
__device__ __forceinline__ unsigned pk2(float lo, float hi) { f32x2_t v = {lo, hi}; bf16x2_t b = __builtin_convertvector(v, bf16x2_t); return __builtin_bit_cast(unsigned, b); }
__device__ __forceinline__ float bflo(unsigned u) { return __builtin_bit_cast(float, u << 16); }
__device__ __forceinline__ float bfhi(unsigned u) { return __builtin_bit_cast(float, u & 0xffff0000u); }
__device__ __forceinline__ float sigm(float x) { return 1.f / (1.f + __expf(-x)); }
template <int O> __device__ __forceinline__ float xor_shfl(float v) {
    return __builtin_bit_cast(float, __builtin_amdgcn_ds_swizzle(__builtin_bit_cast(int, v), (O << 10) | 0x1f));
}
__device__ __forceinline__ float wave_sum(float v) {
    v += xor_shfl<1>(v); v += xor_shfl<2>(v); v += xor_shfl<4>(v); v += xor_shfl<8>(v); v += xor_shfl<16>(v);
    auto rr = __builtin_amdgcn_permlane32_swap(__float_as_uint(v), __float_as_uint(v), false, false);
    return __uint_as_float(rr[0]) + __uint_as_float(rr[1]);
}
__device__ __forceinline__ float wave_max(float v) {
    v = fmaxf(v, xor_shfl<1>(v)); v = fmaxf(v, xor_shfl<2>(v)); v = fmaxf(v, xor_shfl<4>(v)); v = fmaxf(v, xor_shfl<8>(v)); v = fmaxf(v, xor_shfl<16>(v));
    auto rr = __builtin_amdgcn_permlane32_swap(__float_as_uint(v), __float_as_uint(v), false, false);
    return fmaxf(__uint_as_float(rr[0]), __uint_as_float(rr[1]));
}
__device__ __forceinline__ float lane_up(float v, int lane, int o) {
    return __builtin_bit_cast(float, __builtin_amdgcn_ds_bpermute(((lane - o) & 63) << 2, __builtin_bit_cast(int, v)));
}
__device__ __forceinline__ float lane_get(float v, int src) {
    return __builtin_bit_cast(float, __builtin_amdgcn_readlane(__builtin_bit_cast(int, v), src));
}
__device__ __forceinline__ float pair_sum(float v) {
    auto rr = __builtin_amdgcn_permlane32_swap(__float_as_uint(v), __float_as_uint(v), false, false);
    return __uint_as_float(rr[0]) + __uint_as_float(rr[1]);
}
__device__ __forceinline__ float pair_max(float v) {
    auto rr = __builtin_amdgcn_permlane32_swap(__float_as_uint(v), __float_as_uint(v), false, false);
    return fmaxf(__uint_as_float(rr[0]), __uint_as_float(rr[1]));
}
__device__ __forceinline__ float max3f(float a, float b, float c) { float r; asm("v_max3_f32 %0, %1, %2, %3" : "=v"(r) : "v"(a), "v"(b), "v"(c)); return r; }
__device__ __forceinline__ int crow(int r, int hi) { return (r & 3) + 8 * (r >> 2) + 4 * hi; }
typedef short v4i16_t __attribute__((ext_vector_type(4)));
__device__ __forceinline__ s16x4 tr16(const LAS unsigned char* p) { return __builtin_bit_cast(s16x4, __builtin_amdgcn_ds_read_tr16_b64_v4i16((LAS v4i16_t*)p)); }
__device__ __forceinline__ bf16x8 cat8(s16x4 lo, s16x4 hi) { return (bf16x8){lo[0], lo[1], lo[2], lo[3], hi[0], hi[1], hi[2], hi[3]}; }
__device__ __forceinline__ f32x4 ldrow4(const void* base, bool isbf, size_t row, int idx) {
    if (isbf) { const u32x2 u = ((const GAS u32x2*)((const bf16*)base + row * 1024))[idx]; return (f32x4){bflo(u.x), bfhi(u.x), bflo(u.y), bfhi(u.y)}; }
    return ((const GAS f32x4*)((const float*)base + row * 1024))[idx];
}
#define MFMA32(a, b, c) __builtin_amdgcn_mfma_f32_32x32x16_bf16((a), (b), (c), 0, 0, 0)
#define XB_TMO      128
#define XB_XCNT(j)  (256  + 64 * (j))
#define XB_XSUB(j)  (1280 + 64 * (j))
#define XB_XGEN(j)  (2304 + 64 * (j))
#define XB_TOP      3328
#define XB_TOPGEN   3392
#define XCD_BAR_WORDS 3456
#define XB_SPIN_CAP (1u << 18)

__device__ __forceinline__ unsigned xb_ld(unsigned* p)              { return __hip_atomic_load(p, __ATOMIC_RELAXED, __HIP_MEMORY_SCOPE_AGENT); }
__device__ __forceinline__ unsigned xb_add(unsigned* p, unsigned v) { return __hip_atomic_fetch_add(p, v, __ATOMIC_RELAXED, __HIP_MEMORY_SCOPE_AGENT); }
__device__ __forceinline__ unsigned xb_xcc_id() { return (unsigned)__builtin_amdgcn_s_getreg((3 << 11) | 20) & 0xFu; }
#define XB_SPIN(cond, bar) do { unsigned _sp = 0; while (cond) { __builtin_amdgcn_s_sleep(1); \
    if ((++_sp & 255u) == 0u) { if (xb_ld(&(bar)[XB_TMO])) break; if (_sp > XB_SPIN_CAP) { atomicAdd(&(bar)[XB_TMO], 1u); break; } } } } while (0)

__device__ __forceinline__ int xb_lane() { int l; asm volatile("v_mbcnt_lo_u32_b32 %0, -1, 0\n\tv_mbcnt_hi_u32_b32 %0, -1, %0" : "=v"(l)); return l; }
struct XcdBarrier {
    int wv;
    unsigned* bar; unsigned x;
    volatile LAS unsigned* st;
};

__device__ __forceinline__ XcdBarrier xcd_barrier_post(unsigned* bar, volatile LAS unsigned* st, int wv) {
    XcdBarrier b; b.wv = wv; b.bar = bar; b.x = xb_xcc_id(); b.st = st;
    if (wv == 0 && xb_lane() == 0) (void)xb_add(&bar[XB_XCNT(b.x)], 1u);
    return b;
}
__device__ __forceinline__ void xcd_barrier_complete(unsigned* bar, unsigned x, unsigned& nloc, unsigned& nx) {
    const unsigned G = gridDim.x * gridDim.y * gridDim.z;
    unsigned sum, cnt, mine, sp = 0u;
    for (;;) {
        sum = 0u; cnt = 0u; mine = 0u;
#pragma unroll
        for (unsigned j = 0; j < 16; ++j) { const unsigned c = xb_ld(&bar[XB_XCNT(j)]); sum += c; cnt += (c > 0u) ? 1u : 0u; mine = (j == x) ? c : mine; }
        if (sum == G) break;
        __builtin_amdgcn_s_sleep(1);
        if ((++sp & 255u) == 0u) { if (xb_ld(&bar[XB_TMO])) break; if (sp > XB_SPIN_CAP) { atomicAdd(&bar[XB_TMO], 1u); break; } }
    }
    nloc = mine > 0u ? mine : 1u; nx = cnt > 0u ? cnt : 1u;
}

__device__ __forceinline__ void xcd_barrier(const XcdBarrier& b) {
    asm volatile("s_waitcnt vmcnt(0)" ::: "memory");
    __syncthreads();
    if (b.wv == 0 && xb_lane() == 0) {
        unsigned* bar = b.bar;
        __builtin_amdgcn_s_waitcnt(0);
        unsigned nloc = b.st[0], nx = b.st[1];
        if (nloc == 0u) { xcd_barrier_complete(bar, b.x, nloc, nx); b.st[0] = nloc; b.st[1] = nx; }
        const unsigned old = xb_add(&bar[XB_XSUB(b.x)], 1u);
        const unsigned gen = old / nloc;
        if (old + 1u == (gen + 1u) * nloc) {
            __builtin_amdgcn_fence(__ATOMIC_RELEASE, "agent");
            asm volatile("s_waitcnt vmcnt(0)" ::: "memory");
            const unsigned og = xb_add(&bar[XB_TOP], 1u);
            const unsigned tg = og / nx;
            if (og + 1u == (tg + 1u) * nx) xb_add(&bar[XB_TOPGEN], 1u);
            else XB_SPIN(xb_ld(&bar[XB_TOPGEN]) == tg, bar);
            __builtin_amdgcn_fence(__ATOMIC_ACQUIRE, "agent");
            xb_add(&bar[XB_XGEN(b.x)], 1u);
            asm volatile("s_waitcnt vmcnt(0)" ::: "memory");
        } else {
            XB_SPIN(xb_ld(&bar[XB_XGEN(b.x)]) == gen, bar);
            __builtin_amdgcn_fence(__ATOMIC_ACQUIRE, "agent");
            asm volatile("s_waitcnt vmcnt(0)" ::: "memory");
        }
    }
    __syncthreads();
}
struct Args {
    const float* in[23]; float* out; unsigned char* ws; int ph_lo, ph_hi;
};
struct Ctx {
    LAS unsigned char* lds; volatile LAS unsigned* MISC; gu32* ctl; unsigned char* ws;
    int tid, lane, wave, vcu, G;
};
template <class T> __device__ __forceinline__ T* wsp(const Ctx& C, size_t off) { return (T*)(C.ws + off); }
__device__ __forceinline__ bf16* proj(const Ctx& C, int j) { return (bf16*)(C.ws + WS_PROJ + (size_t)j * PROJ_STRIDE); }

__device__ __forceinline__ void transpose_item(const float* W, int ldn, int k0, int n0, bf16* WT, int Kdst, int drow0, LAS float* scr, int lane) {
    { const int c4 = lane & 7; const float* src = W + (size_t)(k0 + (lane >> 3)) * ldn + n0 + 4 * c4;
        f32x4 v[8];
#pragma unroll
        for (int i = 0; i < 8; ++i) v[i] = *(const GAS f32x4*)(src + (size_t)(8 * i) * ldn);
#pragma unroll
        for (int i = 0; i < 8; ++i) { LAS float* d = scr + ((lane >> 3) + 8 * i) * 33 + 4 * c4; d[0] = v[i].x; d[1] = v[i].y; d[2] = v[i].z; d[3] = v[i].w; } }
    LDS_WAIT(); asm volatile("" ::: "memory");
    const int c = lane & 7;
#pragma unroll
    for (int j = 0; j < 4; ++j) { const int n = (lane >> 3) + 8 * j; const LAS float* s = scr + (8 * c) * 33 + n;
        u32x4 o; o.x = pk2(s[0 * 33], s[1 * 33]); o.y = pk2(s[2 * 33], s[3 * 33]); o.z = pk2(s[4 * 33], s[5 * 33]); o.w = pk2(s[6 * 33], s[7 * 33]);
        *(GAS u32x4*)(WT + (size_t)(drow0 + n) * Kdst + k0 + 8 * c) = o; }
    LDS_WAIT(); asm volatile("" ::: "memory");
}
__device__ __forceinline__ void layer_weight_items(const Args& A, const Ctx& C, int layer) {
    LAS float* scr = (LAS float*)(C.lds + C.wave * 16384);
    const int gw = C.vcu * NWAVES + C.wave, NGW = C.G * NWAVES;
    const float* win = A.in[2] + (size_t)layer * DM * INC;
    constexpr int I1 = 16 * 160, I2 = 16 * 96, I3 = 3 * 8 * 32, I4 = 16 * 32;
    for (int it = gw; it < I1 + I2 + I3 + I4; it += NGW) {
        int r = it;
        if (r < I1) { const int nb = r % 160, kb = r / 160, nd = nb * 32, j = nd >> 9; const int sc = (j < 4 ? j * 512 : 2056 + (j - 4) * 512) + (nd & 511);
            transpose_item(win, INC, kb * 64, sc, wsp<bf16>(C, WS_WT1), 1024, nd, scr, C.lane); continue; } r -= I1;
        if (r < I2) { const int nb = r % 96, kb = r / 96; transpose_item(win, INC, kb * 64, 5128 + nb * 32, wsp<bf16>(C, WS_WT2), 1024, nb * 32, scr, C.lane); continue; } r -= I2;
        if (r < I3) { const int br = r / 256, q = r % 256, nb = q % 32, kb = q / 32;
            transpose_item(A.in[13] + (size_t)(layer * 3 + br) * 512 * 1024, 1024, kb * 64, nb * 32, wsp<bf16>(C, WS_PT) + (size_t)br * 1024 * 512, 512, nb * 32, scr, C.lane); continue; } r -= I3;
        { const int nb = r % 32, kb = r / 32; transpose_item(A.in[14] + (size_t)layer * 1024 * 1024, 1024, kb * 64, nb * 32, wsp<bf16>(C, WS_WOT), 1024, nb * 32, scr, C.lane); }
    }
}
__device__ __forceinline__ void moe_weight_items(const Args& A, const Ctx& C, int layer) {
    LAS float* scr = (LAS float*)(C.lds + C.wave * 16384);
    const int gw = C.vcu * NWAVES + C.wave, NGW = C.G * NWAVES;
    constexpr int I1 = 32 * 256, I2 = 32 * 128;
    for (int it = gw; it < I1 + I2; it += NGW) {
        int r = it;
        if (r < I1) { const int e = r >> 8, q = r & 255, mat = q >> 7, q2 = q & 127, nb = q2 & 7, kb = q2 >> 3, n0 = nb * 32;
            const float* src = (mat ? A.in[21] : A.in[20]) + (size_t)(layer * 32 + e) * 1024 * 256;
            transpose_item(src, 256, kb * 64, n0, wsp<bf16>(C, WS_W1T), 1024, e * 512 + (n0 >> 7) * 256 + mat * 128 + (n0 & 127), scr, C.lane); continue; } r -= I1;
        { const int e = r >> 7, q = r & 127, nb = q & 31, kb = q >> 5;
            transpose_item(A.in[22] + (size_t)(layer * 32 + e) * 256 * 1024, 1024, kb * 64, nb * 32, wsp<bf16>(C, WS_W2T), 256, e * 1024 + nb * 32, scr, C.lane); }
    }
}
__device__ __forceinline__ void phase0(const Args& A, const Ctx& C, int layer) {
    if (layer < 2) layer_weight_items(A, C, layer);
    __syncthreads();
    LAS float* WG = (LAS float*)(C.lds);
    LAS float* GL = (LAS float*)(C.lds + 32768);
    const int ll = layer < 2 ? layer : 0;
    const float* win = A.in[2] + (size_t)ll * DM * INC;
    if (layer < 2) { for (int i = C.tid; i < 8192; i += NTHR) WG[i] = win[(size_t)(i >> 3) * INC + 2048 + (i & 7)]; }
    __syncthreads();
    const float* g1 = A.in[1] + ll * 1024; const float* gb = A.in[5] + ll * 8;
    const void* xsrc = (layer == 0) ? (const void*)A.in[0] : (const void*)wsp<bf16>(C, WS_XB1); const bool xbf = layer > 0;
    const int* tokp = wsp<int>(C, WS_TOKP); const float* tokw = wsp<float>(C, WS_TOKW);
    const bf16* osl = wsp<bf16>(C, WS_OSL); bf16* hb = (bf16*)A.out + (size_t)NTOK * DM;
    for (int item = C.vcu; item < NTOK / 64; item += C.G) {
        const int row0 = item * 64;
        f32x4 vnx[4]; u32x2 onx0[4] = {}, onx1[4] = {}; float nw0 = 0.f, nw1 = 0.f, nnw0 = 0.f, nnw1 = 0.f; int nnp0 = 0, nnp1 = 0;
        { const int r0 = row0 + C.wave * 8;
#pragma unroll
            for (int j = 0; j < 4; ++j) vnx[j] = ldrow4(xsrc, xbf, (size_t)r0, C.lane + 64 * j);
            if (layer > 0) { nw0 = tokw[r0 * 2]; nw1 = tokw[r0 * 2 + 1]; const size_t p0 = (size_t)tokp[r0 * 2], p1 = (size_t)tokp[r0 * 2 + 1];
                nnw0 = tokw[r0 * 2 + 2]; nnw1 = tokw[r0 * 2 + 3]; nnp0 = tokp[r0 * 2 + 2]; nnp1 = tokp[r0 * 2 + 3];
                const GAS u32x2* o0 = (const GAS u32x2*)(osl + p0 * DM) + C.lane; const GAS u32x2* o1 = (const GAS u32x2*)(osl + p1 * DM) + C.lane;
#pragma unroll
                for (int j = 0; j < 4; ++j) { onx0[j] = o0[64 * j]; onx1[j] = o1[64 * j]; } } }
        for (int i = 0; i < 8; ++i) {
            const int rl = C.wave * 8 + i, row = row0 + rl;
            f32x4 v[4]; u32x2 oc0[4], oc1[4]; const float w0 = nw0, w1 = nw1;
#pragma unroll
            for (int j = 0; j < 4; ++j) { v[j] = vnx[j]; oc0[j] = onx0[j]; oc1[j] = onx1[j]; }
            if (i < 7) {
#pragma unroll
                for (int j = 0; j < 4; ++j) vnx[j] = ldrow4(xsrc, xbf, (size_t)(row + 1), C.lane + 64 * j);
                if (layer > 0) { nw0 = nnw0; nw1 = nnw1;
                    const GAS u32x2* o0 = (const GAS u32x2*)(osl + (size_t)nnp0 * DM) + C.lane; const GAS u32x2* o1 = (const GAS u32x2*)(osl + (size_t)nnp1 * DM) + C.lane;
#pragma unroll
                    for (int j = 0; j < 4; ++j) { onx0[j] = o0[64 * j]; onx1[j] = o1[64 * j]; }
                    if (i < 6) { nnw0 = tokw[row * 2 + 4]; nnw1 = tokw[row * 2 + 5]; nnp0 = tokp[row * 2 + 4]; nnp1 = tokp[row * 2 + 5]; } } }
            if (layer > 0) {
#pragma unroll
                for (int j = 0; j < 4; ++j) { const u32x2 a = oc0[j], b = oc1[j];
                    v[j].x += w0 * bflo(a.x) + w1 * bflo(b.x); v[j].y += w0 * bfhi(a.x) + w1 * bfhi(b.x); v[j].z += w0 * bflo(a.y) + w1 * bflo(b.y); v[j].w += w0 * bfhi(a.y) + w1 * bfhi(b.y); }
                if (layer == 2) { GAS f32x4* xo = (GAS f32x4*)(A.out + (size_t)row * DM) + C.lane;
#pragma unroll
                    for (int j = 0; j < 4; ++j) xo[64 * j] = v[j]; }
                else { GAS u32x2* xo = (GAS u32x2*)((bf16*)A.out + (size_t)row * DM) + C.lane;
#pragma unroll
                    for (int j = 0; j < 4; ++j) { u32x2 o; o.x = pk2(v[j].x, v[j].y); o.y = pk2(v[j].z, v[j].w); xo[64 * j] = o; } }
            }
            if (layer < 2) {
                float ss = 0.f;
#pragma unroll
                for (int j = 0; j < 4; ++j) ss += (v[j].x * v[j].x + v[j].y * v[j].y) + (v[j].z * v[j].z + v[j].w * v[j].w);
                const float rstd = rsqrtf(wave_sum(ss) * (1.f / DM) + EPS);
                float gd[8];
#pragma unroll
                for (int q = 0; q < 8; ++q) gd[q] = 0.f;
                GAS u32x2* ho = (GAS u32x2*)(hb + (size_t)row * DM) + C.lane;
#pragma unroll
                for (int j = 0; j < 4; ++j) { const f32x4 g = ((const GAS f32x4*)g1)[64 * j + C.lane];
                    const f32x4 h = {v[j].x * rstd * g.x, v[j].y * rstd * g.y, v[j].z * rstd * g.z, v[j].w * rstd * g.w};
                    u32x2 o; o.x = pk2(h.x, h.y); o.y = pk2(h.z, h.w); ho[64 * j] = o;
                    const int k = 256 * j + 4 * C.lane;
#pragma unroll
                    for (int c = 0; c < 4; ++c) { const f32x4 wa = *(const LAS f32x4*)(WG + (k + c) * 8), wb = *(const LAS f32x4*)(WG + (k + c) * 8 + 4);
                        gd[0] += h[c] * wa.x; gd[1] += h[c] * wa.y; gd[2] += h[c] * wa.z; gd[3] += h[c] * wa.w; gd[4] += h[c] * wb.x; gd[5] += h[c] * wb.y; gd[6] += h[c] * wb.z; gd[7] += h[c] * wb.w; } }
                float gv;
                { const bool b1 = C.lane & 1, b2 = C.lane & 2, b3 = C.lane & 4; float a4[4], a2[2];
#pragma unroll
                    for (int q = 0; q < 4; ++q) { const float mine = b1 ? gd[q + 4] : gd[q], send = b1 ? gd[q] : gd[q + 4]; a4[q] = mine + xor_shfl<1>(send); }
#pragma unroll
                    for (int q = 0; q < 2; ++q) { const float mine = b2 ? a4[q + 2] : a4[q], send = b2 ? a4[q] : a4[q + 2]; a2[q] = mine + xor_shfl<2>(send); }
                    { const float mine = b3 ? a2[1] : a2[0], send = b3 ? a2[0] : a2[1]; gv = mine + xor_shfl<4>(send); }
                    gv += xor_shfl<8>(gv); gv += xor_shfl<16>(gv); gv = pair_sum(gv); }
                if (C.lane < 8) { const int q = 4 * (C.lane & 1) + 2 * ((C.lane >> 1) & 1) + ((C.lane >> 2) & 1);
                    const float val = gv + gb[q];
                    float r;
                    if (q < 4) r = 15.f * tanhf(val * (1.f / 15.f));
                    else r = (val < 0.f) ? (val - log1pf(expf(val))) : -log1pf(expf(-val));
                    GL[rl * 8 + q] = r; }
            }
        }
        if (layer < 2) {
            __syncthreads();
            if (C.wave < 4) { const int hh = C.wave, t = C.lane; const float lf = GL[t * 8 + 4 + hh], ig = GL[t * 8 + hh];
                float b = lf;
#pragma unroll
                for (int o = 1; o < 64; o <<= 1) { const float u = lane_up(b, t, o); if (t >= o) b += u; }
                const float bl = lane_get(b, 63); const float gm = wave_max(bl - b + ig);
                wsp<float>(C, WS_BC)[(size_t)(row0 + t) * 4 + hh] = b; wsp<float>(C, WS_IG)[(size_t)(row0 + t) * 4 + hh] = ig;
                if (t == 0) { const int bb = row0 / SEQ, c = (row0 % SEQ) / 64; wsp<float>(C, WS_BLAST)[(bb * 4 + hh) * 128 + c] = bl; wsp<float>(C, WS_GMAX)[(bb * 4 + hh) * 128 + c] = gm; } }
            __syncthreads();
        }
    }
}
__device__ __forceinline__ void mscan(const Ctx& C, int bh, LAS float* MV) {
    const float* bl = wsp<float>(C, WS_BLAST) + bh * 128; const float* gm = wsp<float>(C, WS_GMAX) + bh * 128; const int i = C.lane;
    const float a0 = bl[2 * i], g0 = gm[2 * i], a1 = bl[2 * i + 1], g1 = gm[2 * i + 1];
    float Aa = a0 + a1, Gg = fmaxf(g0 + a1, g1);
#pragma unroll
    for (int o = 1; o < 64; o <<= 1) { const float Ap = lane_up(Aa, i, o), Gp = lane_up(Gg, i, o); if (i >= o) { Gg = fmaxf(Gp + Aa, Gg); Aa = Ap + Aa; } }
    float Ax = lane_up(Aa, i, 1), Gx = lane_up(Gg, i, 1); if (i == 0) { Ax = 0.f; Gx = -INFINITY; }
    if (i == 0) MV[0] = 0.f;
    MV[2 * i + 1] = fmaxf(Ax + a0, fmaxf(Gx + a0, g0));
    MV[2 * i + 2] = fmaxf(Aa, Gg);
}
template <int ST> __device__ __forceinline__ void stage_conv(const Ctx& C, const bf16* src  , int row0, int seq0, const float* cw  , const float* cb, const LAS float* rs, float sc, LAS unsigned char* dst) {
#pragma unroll
    for (int i = 0; i < 2; ++i) { const int task = C.tid + NTHR * i, t = task >> 4, ch = task & 15;
        float y[8];
        { const f32x4 b0 = *(const GAS f32x4*)(cb + ch * 8), b1 = *(const GAS f32x4*)(cb + ch * 8 + 4); y[0] = b0.x; y[1] = b0.y; y[2] = b0.z; y[3] = b0.w; y[4] = b1.x; y[5] = b1.y; y[6] = b1.z; y[7] = b1.w; }
#pragma unroll
        for (int j = 0; j < 4; ++j) { const int row = row0 + t - j;
            if (row >= seq0) { const u32x4 u = *(const GAS u32x4*)(src + (size_t)row * 512 + ch * 8);
                const f32x4 w0 = *(const GAS f32x4*)(cw + j * 1024 + ch * 8), w1 = *(const GAS f32x4*)(cw + j * 1024 + ch * 8 + 4);
                y[0] += w0.x * bflo(u.x); y[1] += w0.y * bfhi(u.x); y[2] += w0.z * bflo(u.y); y[3] += w0.w * bfhi(u.y); y[4] += w1.x * bflo(u.z); y[5] += w1.y * bfhi(u.z); y[6] += w1.z * bflo(u.w); y[7] += w1.w * bfhi(u.w); } }
        const float s = (rs ? rs[t] : 1.f) * sc;
#pragma unroll
        for (int q = 0; q < 8; ++q) y[q] = y[q] * sigm(y[q]) * s;
        u32x4 o; o.x = pk2(y[0], y[1]); o.y = pk2(y[2], y[3]); o.z = pk2(y[4], y[5]); o.w = pk2(y[6], y[7]);
        *(LAS u32x4*)(dst + t * (ST * 2) + ch * 16) = o; }
}
template <int ST> __device__ __forceinline__ void stage_raw128(const Ctx& C, const bf16* src  , int row0, LAS unsigned char* dst) {
#pragma unroll
    for (int i = 0; i < 2; ++i) { const int task = C.tid + NTHR * i, t = task >> 4, ch = task & 15;
        *(LAS u32x4*)(dst + t * (ST * 2) + ch * 16) = *(const GAS u32x4*)(src + (size_t)(row0 + t) * 512 + ch * 8); }
}
__device__ __forceinline__ const LAS unsigned char* tr_addr(const LAS unsigned char* base, int stride_b, int r0, int c0, int lane) {
    return base + (r0 + ((lane & 15) >> 2)) * stride_b + (c0 + 16 * ((lane >> 4) & 1) + 4 * (lane & 3)) * 2;
}
constexpr int ML_MV = 0, ML_BC = 1024, ML_GS = 1280, ML_RS = 1536, ML_NV = 2048, ML_SC = 2560, ML_KT = 4608, ML_VT = ML_KT + 20480, ML_QT = ML_VT + 20480, ML_CT = ML_QT + 17408, ML_END = ML_CT + 34816, ML_OUT = ML_KT;
static_assert(ML_END <= RING_BYTES, "mLSTM LDS map");
__device__ __forceinline__ void mlstm_u_item(const Args& A, const Ctx& C0, int layer, int bh, int c, bool scan, bool pref  ) {
    Ctx C = C0; asm volatile("" : "+v"(C.tid), "+v"(C.lane));
    LAS float* MV = (LAS float*)(C.lds + ML_MV); LAS float* RS = (LAS float*)(C.lds + ML_RS);
    LAS unsigned char* KT = C.lds + ML_KT; LAS unsigned char* VT = C.lds + ML_VT;
    const int b = bh >> 2, hh = bh & 3, row0 = b * SEQ + c * 64, seq0 = b * SEQ, lane = C.lane, hi = lane >> 5, r32 = lane & 31;
    if (scan) { if (C.wave == 0) mscan(C, bh, MV); __syncthreads(); }
    if (C.tid < 64) { const float bl = wsp<float>(C, WS_BLAST)[bh * 128 + c];
        RS[C.tid] = __expf(bl - wsp<float>(C, WS_BC)[(size_t)(row0 + C.tid) * 4 + hh] + wsp<float>(C, WS_IG)[(size_t)(row0 + C.tid) * 4 + hh] - MV[c + 1]); }
    __syncthreads();
    stage_conv<160>(C, proj(C, PJ_AK) + hh * 128, row0, seq0, A.in[3] + layer * 4096 + 512 + hh * 128, A.in[4] + layer * 1024 + 512 + hh * 128, RS, 0.08838834764831845f, KT);
    stage_raw128<160>(C, proj(C, PJ_AV) + hh * 128, row0, VT);
    __syncthreads();
    unsigned pf0 = 0u;
    if (pref) { const int t = C.tid, rown = row0 + 64; const char* p0 = nullptr;
        if (t < 134) p0 = (const char*)(proj(C, PJ_AK) + (size_t)(rown - 3 + (t >> 1)) * 512 + hh * 128) + (t & 1) * 128;
        else if (t < 262) { const int q = t - 134; p0 = (const char*)(proj(C, PJ_AV) + (size_t)(rown + (q >> 1)) * 512 + hh * 128) + (q & 1) * 128; }
        else if (t < 270) p0 = (const char*)(wsp<float>(C, WS_BC) + (size_t)(rown + (t - 262) * 8) * 4);
        else if (t < 278) p0 = (const char*)(wsp<float>(C, WS_IG) + (size_t)(rown + (t - 270) * 8) * 4);
        if (p0) pf0 = *(const GAS unsigned*)p0; }
    const int eb = C.wave >> 1, db0 = (C.wave & 1) * 2;
    f32x16 acc0 = {}, acc1 = {};
#pragma unroll
    for (int st = 0; st < 4; ++st) { const int t0 = 16 * st + 8 * hi;
        const bf16x8 af = cat8(tr16(tr_addr(VT, 320, t0, 32 * eb, lane)), tr16(tr_addr(VT, 320, t0 + 4, 32 * eb, lane)));
        const bf16x8 b0 = cat8(tr16(tr_addr(KT, 320, t0, 32 * db0, lane)), tr16(tr_addr(KT, 320, t0 + 4, 32 * db0, lane)));
        const bf16x8 b1 = cat8(tr16(tr_addr(KT, 320, t0, 32 * db0 + 32, lane)), tr16(tr_addr(KT, 320, t0 + 4, 32 * db0 + 32, lane)));
        acc0 = MFMA32(af, b0, acc0); acc1 = MFMA32(af, b1, acc1); }
    bf16* U = wsp<bf16>(C, WS_HB) + (size_t)(bh * 128 + c) * 16384;
    if (C.tid < 128) { float s = 0.f;
        for (int t = 0; t < 64; ++t) s += bflo((unsigned)*(const LAS bf16*)(KT + t * 320 + C.tid * 2));
        wsp<float>(C, WS_NUC)[(size_t)(bh * 128 + c) * 128 + C.tid] = s; }
    __syncthreads();
    { LAS bf16* US = (LAS bf16*)(C.lds + ML_KT);
#pragma unroll
        for (int r = 0; r < 16; ++r) { const int e = 32 * eb + crow(r, hi);
            US[e * 136 + 32 * db0 + r32] = (bf16)(pk2(acc0[r], 0.f) & 0xffffu); US[e * 136 + 32 * db0 + 32 + r32] = (bf16)(pk2(acc1[r], 0.f) & 0xffffu); }
        __syncthreads();
#pragma unroll
        for (int i = 0; i < 4; ++i) { const int task = C.tid + NTHR * i, e = task >> 4, ch = task & 15; *(GAS u32x4*)(U + e * 128 + ch * 8) = *(const LAS u32x4*)(US + e * 136 + ch * 8); } }
    asm volatile("" :: "v"(pf0));
    __syncthreads();
}
__device__ __forceinline__ void qknorm_rows(const Args& A, const Ctx& C, int layer) {
    const int gw = C.vcu * NWAVES + C.wave, NGW = C.G * NWAVES, lane = C.lane;
    for (int it = gw; it < NTOK * 4; it += NGW) { const int which = it & 3, row = it >> 2;
        bf16* p = proj(C, which == 0 ? PJ_BQ : which == 1 ? PJ_BK : which == 2 ? PJ_CQ : PJ_CK) + (size_t)row * 512 + lane * 8;
        const float* g = (which < 2 ? A.in[7] : A.in[9]) + layer * 128 + (which & 1) * 64 + (lane & 7) * 8;
        const u32x4 u = *(const GAS u32x4*)p; const f32x4 g0 = *(const GAS f32x4*)g, g1 = *(const GAS f32x4*)(g + 4);
        float v[8] = {bflo(u.x), bfhi(u.x), bflo(u.y), bfhi(u.y), bflo(u.z), bfhi(u.z), bflo(u.w), bfhi(u.w)}; float ss = 0.f;
#pragma unroll
        for (int i = 0; i < 8; ++i) ss += v[i] * v[i];
        ss += xor_shfl<1>(ss); ss += xor_shfl<2>(ss); ss += xor_shfl<4>(ss);
        const float rinv = rsqrtf(ss * (1.f / 64.f) + EPS) * ((which & 1) ? 1.f : 0.125f * LOG2E);
        const u32x4 o = {pk2(v[0] * rinv * g0.x, v[1] * rinv * g0.y), pk2(v[2] * rinv * g0.z, v[3] * rinv * g0.w), pk2(v[4] * rinv * g1.x, v[5] * rinv * g1.y), pk2(v[6] * rinv * g1.z, v[7] * rinv * g1.w)};
        *(GAS u32x4*)p = o; }
}
__device__ __forceinline__ void mlstm_scan(const Ctx& C) {
    LAS float* MV = (LAS float*)(C.lds + ML_MV); LAS float* DEC = (LAS float*)(C.lds + ML_RS);
    for (int w = C.vcu; w < 256; w += C.G) { const int bh = w >> 4, sl = w & 15;
        if (C.wave == 0) mscan(C, bh, MV);
        __syncthreads();
        if (C.tid < 128) DEC[C.tid] = __expf(wsp<float>(C, WS_BLAST)[bh * 128 + C.tid] + MV[C.tid] - MV[C.tid + 1]);
        __syncthreads();
        GAS unsigned* p = (GAS unsigned*)(wsp<unsigned>(C, WS_HB) + (size_t)bh * 128 * 8192 + sl * 512 + C.tid);
        float s0 = 0.f, s1 = 0.f;
        for (int c0 = 0; c0 < 128; c0 += 32) { unsigned u[32];
#pragma unroll
            for (int q = 0; q < 32; ++q) u[q] = p[(size_t)(c0 + q) * 8192];
#pragma unroll
            for (int q = 0; q < 32; ++q) { p[(size_t)(c0 + q) * 8192] = pk2(s0, s1); const float d = DEC[c0 + q]; s0 = d * s0 + bflo(u[q]); s1 = d * s1 + bfhi(u[q]); } }
        if (sl == 0 && C.tid < 128) { GAS float* np = (GAS float*)(wsp<float>(C, WS_NUC) + (size_t)bh * 128 * 128 + C.tid); float s = 0.f;
            for (int c0 = 0; c0 < 128; c0 += 16) { float u[16];
#pragma unroll
                for (int q = 0; q < 16; ++q) u[q] = np[(c0 + q) * 128];
#pragma unroll
                for (int q = 0; q < 16; ++q) { np[(c0 + q) * 128] = s; s = DEC[c0 + q] * s + u[q]; } } }
        __syncthreads();
    }
}
__device__ __forceinline__ void mlstm_out_item(const Args& A, const Ctx& C0, int layer, int bh, int c, bool scan, bool pref  , bf16* habase = nullptr  ) {
    Ctx C = C0; asm volatile("" : "+v"(C.tid), "+v"(C.lane));
    LAS float* MV = (LAS float*)(C.lds + ML_MV); LAS float* BC = (LAS float*)(C.lds + ML_BC); LAS float* GS = (LAS float*)(C.lds + ML_GS); LAS float* NV = (LAS float*)(C.lds + ML_NV);
    LAS float* SC = (LAS float*)(C.lds + ML_SC) + C.wave * 64;
    LAS unsigned char* KT = C.lds + ML_KT; LAS unsigned char* VT = C.lds + ML_VT; LAS unsigned char* QT = C.lds + ML_QT; LAS unsigned char* CT = C.lds + ML_CT; LAS float* OUT = (LAS float*)(C.lds + ML_OUT);
    const int b = bh >> 2, hh = bh & 3, row0 = b * SEQ + c * 64, seq0 = b * SEQ, lane = C.lane, hi = lane >> 5, r32 = lane & 31;
    if (scan && C.wave == 0) mscan(C, bh, MV);
    if (C.tid >= 64 && C.tid < 128) { const int t = C.tid - 64; const float bc = wsp<float>(C, WS_BC)[(size_t)(row0 + t) * 4 + hh]; BC[t] = bc; GS[t] = wsp<float>(C, WS_IG)[(size_t)(row0 + t) * 4 + hh] - bc; }
    if (C.tid >= 128 && C.tid < 256) NV[C.tid - 128] = wsp<float>(C, WS_NUC)[(size_t)(bh * 128 + c) * 128 + C.tid - 128];
    stage_conv<136>(C, proj(C, PJ_AQ) + hh * 128, row0, seq0, A.in[3] + layer * 4096 + hh * 128, A.in[4] + layer * 1024 + hh * 128, nullptr, 1.f, QT);
    stage_conv<136>(C, proj(C, PJ_AK) + hh * 128, row0, seq0, A.in[3] + layer * 4096 + 512 + hh * 128, A.in[4] + layer * 1024 + 512 + hh * 128, nullptr, 0.08838834764831845f, KT);
    stage_raw128<160>(C, proj(C, PJ_AV) + hh * 128, row0, VT);
    { const bf16* cs = wsp<bf16>(C, WS_HB) + (size_t)(bh * 128 + c) * 16384;
#pragma unroll
        for (int i = 0; i < 4; ++i) { const int task = C.tid + NTHR * i, e = task >> 4, ch = task & 15; *(LAS u32x4*)(CT + e * 272 + ch * 16) = *(const GAS u32x4*)(cs + e * 128 + ch * 8); } }
    __syncthreads();
    unsigned pf0 = 0u, pf1 = 0u;
    { const int t = C.tid; const char* p0 = nullptr; const char* p1 = nullptr;
        if (t < 128) p0 = (const char*)(proj(C, PJ_AO) + (size_t)(row0 + (t >> 1)) * 512 + hh * 128) + (t & 1) * 128;
        if (pref) { const int rown = row0 + 64;
            if (t >= 128 && t < 262) { const int q = t - 128; p0 = (const char*)(proj(C, PJ_AQ) + (size_t)(rown - 3 + (q >> 1)) * 512 + hh * 128) + (q & 1) * 128; }
            else if (t >= 262 && t < 396) { const int q = t - 262; p0 = (const char*)(proj(C, PJ_AK) + (size_t)(rown - 3 + (q >> 1)) * 512 + hh * 128) + (q & 1) * 128; }
            else if (t >= 396) { const int q = t - 396; p0 = (const char*)(proj(C, PJ_AV) + (size_t)(rown + (q >> 1)) * 512 + hh * 128) + (q & 1) * 128; }
            if (t < 12) { const int q = t + 116; p1 = (const char*)(proj(C, PJ_AV) + (size_t)(rown + (q >> 1)) * 512 + hh * 128) + (q & 1) * 128; }
            else if (t < 268) p1 = (const char*)(wsp<bf16>(C, WS_HB) + (size_t)(bh * 128 + c + 1) * 16384) + (t - 12) * 128; }
        if (p0) pf0 = *(const GAS unsigned*)p0;
        if (p1) pf1 = *(const GAS unsigned*)p1; }
    const float mc = MV[c]; const int lb = C.wave >> 2, cb = C.wave & 3, lq = 32 * lb + r32; const float bl = BC[lq];
    bf16x8 qf[8];
#pragma unroll
    for (int st = 0; st < 8; ++st) qf[st] = *(const LAS bf16x8*)(QT + lq * 272 + (16 * st + 8 * hi) * 2);
    f32x16 p0 = {}, p1 = {};
#pragma unroll
    for (int st = 0; st < 8; ++st) p0 = MFMA32(*(const LAS bf16x8*)(KT + r32 * 272 + (16 * st + 8 * hi) * 2), qf[st], p0);
    if (lb == 1) {
#pragma unroll
        for (int st = 0; st < 8; ++st) p1 = MFMA32(*(const LAS bf16x8*)(KT + (32 + r32) * 272 + (16 * st + 8 * hi) * 2), qf[st], p1); }
    f32x16 d0, d1; float mt = bl + mc;
#pragma unroll
    for (int r = 0; r < 16; ++r) { const int s = crow(r, hi); d0[r] = (s <= lq) ? bl + GS[s] : -INFINITY; mt = fmaxf(mt, d0[r]); }
#pragma unroll
    for (int r = 0; r < 16; ++r) { const int s = 32 + crow(r, hi); d1[r] = (lb == 1 && s <= lq) ? bl + GS[s] : -INFINITY; mt = fmaxf(mt, d1[r]); }
    mt = pair_max(mt);
    float rs = 0.f;
#pragma unroll
    for (int r = 0; r < 16; ++r) { p0[r] *= __expf(d0[r] - mt); p1[r] *= __expf(d1[r] - mt); rs += p0[r] + p1[r]; }
    rs = pair_sum(rs);
    float qn = 0.f;
#pragma unroll
    for (int st = 0; st < 8; ++st) { const f32x4 n0 = *(const LAS f32x4*)(NV + 16 * st + 8 * hi), n1 = *(const LAS f32x4*)(NV + 16 * st + 8 * hi + 4); const u32x4 q = __builtin_bit_cast(u32x4, qf[st]);
        qn += bflo(q.x) * n0.x + bfhi(q.x) * n0.y + bflo(q.y) * n0.z + bfhi(q.y) * n0.w + bflo(q.z) * n1.x + bfhi(q.z) * n1.y + bflo(q.w) * n1.z + bfhi(q.w) * n1.w; }
    qn = pair_sum(qn);
    const float wi = __expf(bl + mc - mt), den = wi * qn + rs, dn = fmaxf(fabsf(den), __expf(-mt));
    SC[r32] = wi / dn; SC[32 + r32] = 1.f / dn;
    f32x16 acc1 = {}, acc2 = {};
#define PKF(P, B) (bf16x8)__builtin_bit_cast(bf16x8, ((u32x4){pk2(P[B], P[B + 1]), pk2(P[B + 2], P[B + 3]), pk2(P[B + 4], P[B + 5]), pk2(P[B + 6], P[B + 7])}))
#pragma unroll
    for (int s2 = 0; s2 < 2; ++s2) { const int k0 = 16 * s2;
        const bf16x8 vf = cat8(tr16(tr_addr(VT, 320, k0 + 4 * hi, 32 * cb, lane)), tr16(tr_addr(VT, 320, k0 + 8 + 4 * hi, 32 * cb, lane)));
        acc2 = MFMA32(s2 == 0 ? PKF(p0, 0) : PKF(p0, 8), vf, acc2); }
    if (lb == 1) {
#pragma unroll
        for (int s2 = 0; s2 < 2; ++s2) { const int k0 = 32 + 16 * s2;
            const bf16x8 vf = cat8(tr16(tr_addr(VT, 320, k0 + 4 * hi, 32 * cb, lane)), tr16(tr_addr(VT, 320, k0 + 8 + 4 * hi, 32 * cb, lane)));
            acc2 = MFMA32(s2 == 0 ? PKF(p1, 0) : PKF(p1, 8), vf, acc2); } }
#undef PKF
#pragma unroll
    for (int st = 0; st < 8; ++st) acc1 = MFMA32(qf[st], *(const LAS bf16x8*)(CT + (32 * cb + r32) * 272 + (16 * st + 8 * hi) * 2), acc1);
    __syncthreads();
#pragma unroll
    for (int r = 0; r < 16; ++r) { const int l_ = crow(r, hi); OUT[(32 * lb + l_) * 132 + 32 * cb + r32] = SC[l_] * acc1[r] + SC[32 + l_] * acc2[r]; }
    __syncthreads();
    { const int row = C.tid >> 3, seg = C.tid & 7; float v[16]; float ss = 0.f;
#pragma unroll
        for (int q = 0; q < 4; ++q) { const f32x4 x = *(const LAS f32x4*)(OUT + row * 132 + seg * 16 + 4 * q); v[4 * q] = x.x; v[4 * q + 1] = x.y; v[4 * q + 2] = x.z; v[4 * q + 3] = x.w; ss += (x.x * x.x + x.y * x.y) + (x.z * x.z + x.w * x.w); }
        ss += xor_shfl<1>(ss); ss += xor_shfl<2>(ss); ss += xor_shfl<4>(ss);
        const float rinv = rsqrtf(ss * (1.f / 128.f) + EPS);
        const float* gn = A.in[6] + layer * 512 + hh * 128 + seg * 16;
        const bf16* ao = proj(C, PJ_AO) + (size_t)(row0 + row) * 512 + hh * 128 + seg * 16;
        bf16* ha = (habase ? habase : proj(C, PJ_AV)) + (size_t)(row0 + row) * 512 + hh * 128 + seg * 16;
#pragma unroll
        for (int q = 0; q < 2; ++q) { const u32x4 a = *(const GAS u32x4*)(ao + 8 * q); const f32x4 g0 = *(const GAS f32x4*)(gn + 8 * q), g1 = *(const GAS f32x4*)(gn + 8 * q + 4); const float* vv = v + 8 * q;
            u32x4 o; o.x = pk2(vv[0] * rinv * g0.x * sigm(bflo(a.x)), vv[1] * rinv * g0.y * sigm(bfhi(a.x))); o.y = pk2(vv[2] * rinv * g0.z * sigm(bflo(a.y)), vv[3] * rinv * g0.w * sigm(bfhi(a.y)));
            o.z = pk2(vv[4] * rinv * g1.x * sigm(bflo(a.z)), vv[5] * rinv * g1.y * sigm(bfhi(a.z))); o.w = pk2(vv[6] * rinv * g1.z * sigm(bflo(a.w)), vv[7] * rinv * g1.w * sigm(bfhi(a.w)));
            *(GAS u32x4*)(ha + 8 * q) = o; } }
    asm volatile("" :: "v"(pf0), "v"(pf1));
    __syncthreads();
}
constexpr int AT_TAB = 0, AT_SCR = 3072, AT_K = 5120;
template <int DV, bool ISC> __device__ __forceinline__ void attn_unit(const Args& A, const Ctx& C0, int layer, int b, int hs, int qblk, bf16* obase = nullptr  ) {
    Ctx C = C0; asm volatile("" : "+v"(C.tid), "+v"(C.lane));
    constexpr int KSTB = 144, VSTB = 2 * DV + 64, KB = 64 * KSTB, VB = 64 * VSTB, AT_V = AT_K + 4 * KB, NBLK = DV / 32;
    static_assert(AT_V + 4 * VB <= RING_BYTES, "attention LDS map");
    LAS float* TAB = (LAS float*)(C.lds + AT_TAB); LAS float* SCR = (LAS float*)(C.lds + AT_SCR) + C.wave * 64;
    const int lane = C.lane, hi = lane >> 5, r32 = lane & 31, tid = C.tid;
    const bf16 *Qp, *Kp, *Vp; bf16* Op; int pitchO; const float *gq, *gk; int hbias;
    if (ISC) { const int h = hs >> 1, wh = hs & 1; Qp = proj(C, PJ_CQ) + h * 128 + wh * 64; Kp = proj(C, PJ_CK) + h * 128 + wh * 64; Vp = proj(C, PJ_CV) + h * 128;
        Op = wsp<bf16>(C, WS_O12) + h * 256 + wh * 128; pitchO = 1024; gq = A.in[9] + layer * 128; gk = gq + 64; hbias = h; }
    else { Qp = proj(C, PJ_BQ) + hs * 64; Kp = proj(C, PJ_BK) + hs * 64; Vp = proj(C, PJ_BV) + hs * 64; Op = (obase ? obase : proj(C, PJ_BQ)) + hs * 64; pitchO = 512; gq = A.in[7] + layer * 128; gk = gq + 64; hbias = hs; }
    const size_t rowb = (size_t)b * SEQ;
    const int qs0 = qblk * 256 + C.wave * 32;
    for (int i = tid; i < 768; i += NTHR) { const int d = 703 - i; float v;
        if (ISC) { const int n = d < 0 ? -d : d; int bk = n < 8 ? n : n < 15 ? 8 : n < 27 ? 9 : n < 50 ? 10 : n < 91 ? 11 : n < 166 ? 12 : n < 305 ? 13 : n < 559 ? 14 : 15; if (d < 0) bk += 16; v = A.in[12][bk * 4 + hbias]; }
        else { const int dc = d < -256 ? -256 : d > 256 ? 256 : d; v = A.in[8][(size_t)layer * 513 * 8 + (dc + 256) * 8 + hbias]; }
        TAB[i] = v * LOG2E; }
    float MB;
    { const float gqm = wave_max(fabsf(gq[lane])), gkm = wave_max(fabsf(gk[lane]));
        float bm = 0.f;
        if (ISC) { bm = (lane < 32) ? fabsf(A.in[12][lane * 4 + hbias]) : 0.f; }
        else { for (int i = lane; i < 513; i += 64) bm = fmaxf(bm, fabsf(A.in[8][(size_t)layer * 513 * 8 + i * 8 + hbias])); }
        bm = wave_max(bm);
        MB = 64.f * (0.125f * LOG2E) * gqm * gkm * 1.02f + bm * LOG2E; }
    const float t15 = (ISC ? A.in[12][15 * 4 + hbias] * LOG2E : 0.f) - MB;
    bf16x8 qf[4];
    { float qv[32]; float ss = 0.f; const bf16* qrow = Qp + (rowb + qs0 + r32) * 512 + 8 * hi;
#pragma unroll
        for (int st = 0; st < 4; ++st) { const u32x4 u = *(const GAS u32x4*)(qrow + 16 * st);
            qv[8 * st] = bflo(u.x); qv[8 * st + 1] = bfhi(u.x); qv[8 * st + 2] = bflo(u.y); qv[8 * st + 3] = bfhi(u.y); qv[8 * st + 4] = bflo(u.z); qv[8 * st + 5] = bfhi(u.z); qv[8 * st + 6] = bflo(u.w); qv[8 * st + 7] = bfhi(u.w); }
#pragma unroll
        for (int i = 0; i < 32; ++i) ss += qv[i] * qv[i];
        ss = pair_sum(ss);
        const float rinv = rsqrtf(ss * (1.f / 64.f) + EPS) * (0.125f * LOG2E);
#pragma unroll
        for (int st = 0; st < 4; ++st) { const f32x4 g0 = *(const GAS f32x4*)(gq + 16 * st + 8 * hi) * *(const GAS f32x4*)(gk + 16 * st + 8 * hi), g1 = *(const GAS f32x4*)(gq + 16 * st + 8 * hi + 4) * *(const GAS f32x4*)(gk + 16 * st + 8 * hi + 4); const float* q = qv + 8 * st;
            const u32x4 o = {pk2(q[0] * rinv * g0.x, q[1] * rinv * g0.y), pk2(q[2] * rinv * g0.z, q[3] * rinv * g0.w), pk2(q[4] * rinv * g1.x, q[5] * rinv * g1.y), pk2(q[6] * rinv * g1.z, q[7] * rinv * g1.w)};
            qf[st] = __builtin_bit_cast(bf16x8, o); } }
    const int krow = tid >> 3, kch = tid & 7;
    const int jhi = qblk * 4 + 3, jlo = ISC ? 0 : (qblk * 4 - 8 < 0 ? 0 : qblk * 4 - 8), cqw = qblk * 4 + (C.wave >> 1);
    const bf16* ksrc = Kp + (rowb + krow) * 512 + kch * 8;
    u32x4 kregA, kregB, vregA[NBLK / 2], vregB[NBLK / 2];
#define AT_LOADT(j, KR, VR) do { KR = *(const GAS u32x4*)(ksrc + (size_t)(j) * 64 * 512); \
        if (DV == 128) { _Pragma("unroll") for (int i_ = 0; i_ < 2; ++i_) { const int idx = tid + NTHR * i_; VR[i_] = *(const GAS u32x4*)(Vp + (rowb + (size_t)(j) * 64 + (idx >> 4)) * 512 + (idx & 15) * 8); } } \
        else VR[0] = *(const GAS u32x4*)(Vp + (rowb + (size_t)(j) * 64 + krow) * 512 + kch * 8); } while (0)
    AT_LOADT(jlo, kregA, vregA); AT_LOADT(jlo + 1, kregB, vregB);
    float l = 0.f; f32x16 o[NBLK];
#pragma unroll
    for (int nb = 0; nb < NBLK; ++nb) o[nb] = f32x16{};
#define AT_VLOAD(F, nb_) do { _Pragma("unroll") for (int ks_ = 0; ks_ < 4; ++ks_) { F[2 * ks_] = tr16(vb_ + (16 * ks_) * VSTB + (nb_) * 64); F[2 * ks_ + 1] = tr16(vb_ + (16 * ks_ + 8) * VSTB + (nb_) * 64); } } while (0)
#define AT_STAGE(buf, KR, VR) do { \
        LAS unsigned char* KT = C.lds + AT_K + (buf) * KB; LAS unsigned char* VT = C.lds + AT_V + (buf) * VB; \
        { float kv[8] = {bflo(KR.x), bfhi(KR.x), bflo(KR.y), bfhi(KR.y), bflo(KR.z), bfhi(KR.z), bflo(KR.w), bfhi(KR.w)}; float ss = 0.f; \
            _Pragma("unroll") for (int i = 0; i < 8; ++i) ss += kv[i] * kv[i]; \
            ss += xor_shfl<1>(ss); ss += xor_shfl<2>(ss); ss += xor_shfl<4>(ss); \
            const float rinv = rsqrtf(ss * (1.f / 64.f) + EPS); \
            const u32x4 w = {pk2(kv[0] * rinv, kv[1] * rinv), pk2(kv[2] * rinv, kv[3] * rinv), pk2(kv[4] * rinv, kv[5] * rinv), pk2(kv[6] * rinv, kv[7] * rinv)}; \
            *(LAS u32x4*)(KT + krow * KSTB + kch * 16) = w; } \
        if (DV == 128) { _Pragma("unroll") for (int i_ = 0; i_ < 2; ++i_) { const int idx = tid + NTHR * i_; *(LAS u32x4*)(VT + (idx >> 4) * VSTB + (idx & 15) * 16) = VR[i_]; } } \
        else *(LAS u32x4*)(VT + krow * VSTB + kch * 16) = VR[0]; \
    } while (0)
#define AT_COMP(j, buf) do { \
        LAS unsigned char* KT = C.lds + AT_K + (buf) * KB; LAS unsigned char* VT = C.lds + AT_V + (buf) * VB; \
        const bool act = ((j) <= cqw) && (ISC || (j) >= cqw - 8); \
        if (act) { \
            f32x16 p0, p1; \
            const bool far = ISC && (qs0 - (64 * (j) + 63) >= 559); \
            if (far) { _Pragma("unroll") for (int r = 0; r < 16; ++r) { p0[r] = t15; p1[r] = t15; } } \
            else { const LAS float* tp = TAB + (703 - (qs0 + r32) + 64 * (j) + 4 * hi); \
                _Pragma("unroll") for (int r = 0; r < 16; ++r) { p0[r] = tp[(r & 3) + 8 * (r >> 2)] - MB; p1[r] = tp[32 + (r & 3) + 8 * (r >> 2)] - MB; } } \
            { bf16x8 kf[8]; \
                _Pragma("unroll") for (int st = 0; st < 4; ++st) { kf[2 * st] = *(const LAS bf16x8*)(KT + r32 * KSTB + (16 * st + 8 * hi) * 2); kf[2 * st + 1] = *(const LAS bf16x8*)(KT + (32 + r32) * KSTB + (16 * st + 8 * hi) * 2); } \
                __builtin_amdgcn_sched_barrier(0);        \
                _Pragma("unroll") for (int st = 0; st < 4; ++st) { p0 = MFMA32(kf[2 * st], qf[st], p0); p1 = MFMA32(kf[2 * st + 1], qf[st], p1); } } \
            float rs0 = 0.f, rs1 = 0.f, rs2 = 0.f, rs3 = 0.f;        \
            _Pragma("unroll") for (int r = 0; r < 16; r += 2) { p0[r] = __builtin_amdgcn_exp2f(p0[r]); p1[r] = __builtin_amdgcn_exp2f(p1[r]); p0[r + 1] = __builtin_amdgcn_exp2f(p0[r + 1]); p1[r + 1] = __builtin_amdgcn_exp2f(p1[r + 1]); \
                rs0 += p0[r]; rs1 += p1[r]; rs2 += p0[r + 1]; rs3 += p1[r + 1]; } \
            l += (rs0 + rs1) + (rs2 + rs3); \
            bf16x8 pw[4]; \
            pw[0] = PKF(p0, 0); pw[1] = PKF(p0, 8); pw[2] = PKF(p1, 0); pw[3] = PKF(p1, 8); \
            { s16x4 fa[8], fb[8]; const LAS unsigned char* vb_ = tr_addr(VT, VSTB, 4 * hi, 0, lane); \
                AT_VLOAD(fa, 0); \
                _Pragma("unroll") for (int nb = 0; nb < NBLK; nb += 2) { \
                    AT_VLOAD(fb, nb + 1); __builtin_amdgcn_sched_barrier(0); \
                    _Pragma("unroll") for (int ks = 0; ks < 4; ++ks) o[nb] = MFMA32(pw[ks], cat8(fa[2 * ks], fa[2 * ks + 1]), o[nb]); \
                    __builtin_amdgcn_sched_barrier(0); \
                    if (nb + 2 < NBLK) AT_VLOAD(fa, nb + 2); __builtin_amdgcn_sched_barrier(0); \
                    _Pragma("unroll") for (int ks = 0; ks < 4; ++ks) o[nb + 1] = MFMA32(pw[ks], cat8(fb[2 * ks], fb[2 * ks + 1]), o[nb + 1]); \
                    __builtin_amdgcn_sched_barrier(0); } } \
        } } while (0)
#define PKF(P, B) __builtin_bit_cast(bf16x8, ((u32x4){pk2(P[B], P[B + 1]), pk2(P[B + 2], P[B + 3]), pk2(P[B + 4], P[B + 5]), pk2(P[B + 6], P[B + 7])}))
    for (int j = jlo; j <= jhi; j += 2) { const int sb = (((j - jlo) >> 1) & 1) * 2;
        AT_STAGE(sb, kregA, vregA); AT_STAGE(sb + 1, kregB, vregB);
        __syncthreads();
        if (j + 2 <= jhi) { AT_LOADT(j + 2, kregA, vregA); AT_LOADT(j + 3, kregB, vregB); }
        AT_COMP(j, sb); AT_COMP(j + 1, sb + 1); }
#undef PKF
#undef AT_STAGE
#undef AT_COMP
#undef AT_VLOAD
#undef AT_LOADT
    l = pair_sum(l);
    SCR[32 + r32] = 1.f / l;
    bf16* orow = Op + (rowb + qs0) * pitchO;
#pragma unroll
    for (int r = 0; r < 16; ++r) { const int q = crow(r, hi); const float rl = SCR[32 + q];
#pragma unroll
        for (int nb = 0; nb < NBLK; ++nb) ((GAS bf16*)orow)[(size_t)q * pitchO + 32 * nb + r32] = (bf16)(pk2(o[nb][r] * rl, 0.f) & 0xffffu); }
    __syncthreads();
}
__device__ __forceinline__ void phase5(const Args& A, const Ctx& C, int layer) {
    const int gw = C.vcu * NWAVES + C.wave, NGW = C.G * NWAVES, lane = C.lane;
    const float lam_init = 0.8f - 0.6f * __expf(-0.3f * (float)layer);
    const float* cl = A.in[10] + layer * 256;
    const float lam = __expf(wave_sum(cl[lane] * cl[64 + lane])) - __expf(wave_sum(cl[128 + lane] * cl[192 + lane])) + lam_init;
    const float* gs = A.in[11] + layer * 128 + (lane & 15) * 8;
    const f32x4 gs0 = *(const GAS f32x4*)gs, gs1 = *(const GAS f32x4*)(gs + 4);
    const float post = 1.f - lam_init;
    const bf16* o12 = wsp<bf16>(C, WS_O12); bf16* hc = proj(C, PJ_CQ);
    for (int row = gw; row < NTOK; row += NGW) {
        { const int h = lane >> 4, e0 = (lane & 15) * 8;
            const u32x4 a = *(const GAS u32x4*)(o12 + (size_t)row * 1024 + h * 256 + e0), bq = *(const GAS u32x4*)(o12 + (size_t)row * 1024 + h * 256 + 128 + e0);
            float v[8] = {bflo(a.x) - lam * bflo(bq.x), bfhi(a.x) - lam * bfhi(bq.x), bflo(a.y) - lam * bflo(bq.y), bfhi(a.y) - lam * bfhi(bq.y), bflo(a.z) - lam * bflo(bq.z), bfhi(a.z) - lam * bfhi(bq.z), bflo(a.w) - lam * bflo(bq.w), bfhi(a.w) - lam * bfhi(bq.w)};
            float ss = 0.f;
#pragma unroll
            for (int i = 0; i < 8; ++i) ss += v[i] * v[i];
            ss += xor_shfl<1>(ss); ss += xor_shfl<2>(ss); ss += xor_shfl<4>(ss); ss += xor_shfl<8>(ss);
            const float rinv = rsqrtf(ss * (1.f / 128.f) + EPS) * post;
            const u32x4 o = {pk2(v[0] * rinv * gs0.x, v[1] * rinv * gs0.y), pk2(v[2] * rinv * gs0.z, v[3] * rinv * gs0.w), pk2(v[4] * rinv * gs1.x, v[5] * rinv * gs1.y), pk2(v[6] * rinv * gs1.z, v[7] * rinv * gs1.w)};
            *(GAS u32x4*)(hc + (size_t)row * 512 + h * 128 + e0) = o; }
    }
}
constexpr int RT_RSTD = 0, RT_HT = 1024, RT_WT = RT_HT + 128 * 68 * 4, RT_LOG = RT_WT + 128 * 40 * 4, RT_HIST = RT_LOG + 64 * 37 * 4, RT_BASE = RT_HIST + 128, RT_SEL = RT_BASE + 128, RT_END = RT_SEL + 64 * 4 * 4, RT_RED = RT_HT;
static_assert(RT_END <= RING_BYTES && 4 * 64 * 40 * 4 <= RT_LOG - RT_HT, "routing LDS map");
__device__ __forceinline__ void phase9(const Args& A, const Ctx& C, int layer, bool dummy = false  ) {
    const size_t doff = dummy ? (476 * MiB) : 0;
    moe_weight_items(A, C, layer);
    __syncthreads();
    LAS float* RSTD = (LAS float*)(C.lds + RT_RSTD); LAS float* HT = (LAS float*)(C.lds + RT_HT); LAS float* WT = (LAS float*)(C.lds + RT_WT); LAS float* LOG = (LAS float*)(C.lds + RT_LOG); LAS float* RED = (LAS float*)(C.lds + RT_RED);
    LAS int* HIST = (LAS int*)(C.lds + RT_HIST); LAS int* BASE = (LAS int*)(C.lds + RT_BASE); LAS int* SEL = (LAS int*)(C.lds + RT_SEL);
    const float* g2 = A.in[15] + layer * 1024; const float* wg = A.in[16] + layer * 4096; const float* bg = A.in[17] + layer * 4; const float* wr = A.in[18] + layer * 32768; const float* br = A.in[19] + layer * 32;
    bf16* h2 = wsp<bf16>(C, dummy ? 128 * MiB : WS_H2); const bf16* xb1 = wsp<bf16>(C, WS_XB1); const int lane = C.lane, tid = C.tid, wv = C.wave;
    const int tg = tid & 15, cg = (tid >> 4) & 7, ks = tid >> 7;
    for (int item = C.vcu; item < NTOK / 64; item += C.G) {
        const int row0 = item * 64;
        if (tid < 32) HIST[tid] = 0;
        f32x4 vnx[4];
        {
#pragma unroll
            for (int j = 0; j < 4; ++j) vnx[j] = ldrow4(xb1, true, (size_t)(row0 + wv * 8), lane + 64 * j); }
        for (int i = 0; i < 8; ++i) { const int rl = wv * 8 + i, row = row0 + rl;
            f32x4 v[4]; float ss = 0.f;
#pragma unroll
            for (int j = 0; j < 4; ++j) { v[j] = vnx[j]; ss += (v[j].x * v[j].x + v[j].y * v[j].y) + (v[j].z * v[j].z + v[j].w * v[j].w); }
            if (i < 7) {
#pragma unroll
                for (int j = 0; j < 4; ++j) vnx[j] = ldrow4(xb1, true, (size_t)(row + 1), lane + 64 * j); }
            const float rstd = rsqrtf(wave_sum(ss) * (1.f / DM) + EPS);
            GAS u32x2* ho = (GAS u32x2*)(h2 + (size_t)row * DM) + lane;
#pragma unroll
            for (int j = 0; j < 4; ++j) { const f32x4 g = ((const GAS f32x4*)g2)[64 * j + lane]; u32x2 o; o.x = pk2(v[j].x * rstd * g.x, v[j].y * rstd * g.y); o.y = pk2(v[j].z * rstd * g.z, v[j].w * rstd * g.w); ho[64 * j] = o; }
            if (lane == 0) RSTD[rl] = rstd; }
        __syncthreads();
        float acc[4][4]; float accg[4];
#pragma unroll
        for (int a = 0; a < 4; ++a) { accg[a] = 0.f;
#pragma unroll
            for (int c = 0; c < 4; ++c) acc[a][c] = 0.f; }
        const int t_lo = lane & 15, k4 = 4 * wv + (lane >> 4), wk = tid >> 2, wpart = tid & 3;
        f32x4 xq[4], gq, wq0, wq1, wq2 = {0.f, 0.f, 0.f, 0.f};
#define RT_LOADCH(kc_) do { gq = *(const GAS f32x4*)(g2 + (kc_) * 128 + k4 * 4); \
            _Pragma("unroll") for (int i = 0; i < 4; ++i) xq[i] = ldrow4(xb1, true, (size_t)(row0 + 16 * i + t_lo), (kc_) * 32 + k4); \
            { const float* src = wr + (size_t)((kc_) * 128 + wk) * 32 + wpart * 8; wq0 = *(const GAS f32x4*)src; wq1 = *(const GAS f32x4*)(src + 4); } \
            if (wpart == 0) wq2 = *(const GAS f32x4*)(wg + (size_t)((kc_) * 128 + wk) * 4); } while (0)
        RT_LOADCH(0);
        for (int kc = 0; kc < 8; ++kc) {
#pragma unroll
            for (int i = 0; i < 4; ++i) { const int t = 16 * i + t_lo; const float rs = RSTD[t];
                HT[(k4 * 4 + 0) * 68 + t] = xq[i].x * rs * gq.x; HT[(k4 * 4 + 1) * 68 + t] = xq[i].y * rs * gq.y; HT[(k4 * 4 + 2) * 68 + t] = xq[i].z * rs * gq.z; HT[(k4 * 4 + 3) * 68 + t] = xq[i].w * rs * gq.w; }
            *(LAS f32x4*)(WT + wk * 40 + wpart * 8) = wq0; *(LAS f32x4*)(WT + wk * 40 + wpart * 8 + 4) = wq1;
            if (wpart == 0) *(LAS f32x4*)(WT + wk * 40 + 32) = wq2;
            __syncthreads();
            if (kc < 7) RT_LOADCH(kc + 1);
#pragma unroll 4
            for (int kk = 0; kk < 32; ++kk) { const int k = ks * 32 + kk;
                const f32x4 a = *(const LAS f32x4*)(HT + k * 68 + 4 * tg), w = *(const LAS f32x4*)(WT + k * 40 + 4 * cg); const float wgc = WT[k * 40 + 32 + (cg & 3)];
#pragma unroll
                for (int q = 0; q < 4; ++q) { acc[q][0] += a[q] * w.x; acc[q][1] += a[q] * w.y; acc[q][2] += a[q] * w.z; acc[q][3] += a[q] * w.w; accg[q] += a[q] * wgc; } }
            __syncthreads();
        }
#undef RT_LOADCH
#pragma unroll
        for (int q = 0; q < 4; ++q) { LAS float* rp = RED + (ks * 64 + 4 * tg + q) * 40; *(LAS f32x4*)(rp + 4 * cg) = (f32x4){acc[q][0], acc[q][1], acc[q][2], acc[q][3]}; if (cg < 4) rp[32 + cg] = accg[q]; }
        __syncthreads();
        { const int tok = tid & 63, cgr = tid >> 6;
#pragma unroll
            for (int c = 0; c < 4; ++c) { const int col = 4 * cgr + c; LOG[tok * 37 + col] = (RED[(0 * 64 + tok) * 40 + col] + RED[(1 * 64 + tok) * 40 + col]) + (RED[(2 * 64 + tok) * 40 + col] + RED[(3 * 64 + tok) * 40 + col]) + br[col]; }
            if (cgr < 4) { const int col = 32 + cgr; LOG[tok * 37 + col] = (RED[(0 * 64 + tok) * 40 + col] + RED[(1 * 64 + tok) * 40 + col]) + (RED[(2 * 64 + tok) * 40 + col] + RED[(3 * 64 + tok) * 40 + col]) + bg[cgr]; } }
        __syncthreads();
        if (tid < 64) { const LAS float* lg = LOG + tid * 37;
            int gi = 0; float gmx = lg[32];
#pragma unroll
            for (int q = 1; q < 4; ++q) if (lg[32 + q] > gmx) { gmx = lg[32 + q]; gi = q; }
            float gsum = 0.f;
#pragma unroll
            for (int q = 0; q < 4; ++q) gsum += __expf(lg[32 + q] - gmx);
            const float pg = 1.f / gsum;
            const LAS float* el = lg + gi * 8; int i0 = 0; float e0 = el[0];
#pragma unroll
            for (int q = 1; q < 8; ++q) if (el[q] > e0) { e0 = el[q]; i0 = q; }
            int i1 = -1; float e1 = -INFINITY;
#pragma unroll
            for (int q = 0; q < 8; ++q) if (q != i0 && el[q] > e1) { e1 = el[q]; i1 = q; }
            const float x1 = __expf(e1 - e0), w0 = pg / (1.f + x1), w1 = pg * x1 / (1.f + x1);
            const int ea = gi * 8 + i0, eb = gi * 8 + i1;
            const int ra = atomicAdd((int*)(HIST + ea), 1), rb = atomicAdd((int*)(HIST + eb), 1);
            SEL[tid * 4 + 0] = ea; SEL[tid * 4 + 1] = eb; SEL[tid * 4 + 2] = ra; SEL[tid * 4 + 3] = rb;
            wsp<float>(C, WS_TOKW + doff)[(size_t)(row0 + tid) * 2] = w0; wsp<float>(C, WS_TOKW + doff)[(size_t)(row0 + tid) * 2 + 1] = w1; }
        __syncthreads();
        if (tid < 32) wsp<int>(C, WS_HISTG + doff)[item * 32 + tid] = HIST[tid];
        if (tid < 64) { wsp<int>(C, WS_TOKE + doff)[(size_t)(row0 + tid) * 2] = SEL[tid * 4]; wsp<int>(C, WS_TOKE + doff)[(size_t)(row0 + tid) * 2 + 1] = SEL[tid * 4 + 1];
            wsp<int>(C, WS_TOKR + doff)[(size_t)(row0 + tid) * 2] = SEL[tid * 4 + 2]; wsp<int>(C, WS_TOKR + doff)[(size_t)(row0 + tid) * 2 + 1] = SEL[tid * 4 + 3]; }
        __syncthreads();
    }
}
constexpr int P10_H = 0, P10_SEG = 65536, P10_BASE = P10_SEG + 16 * 32 * 4, P10_TOT = P10_BASE + 16 * 32 * 4;
__device__ __forceinline__ void phase10(const Ctx& C, int layer) {
    LAS int* H = (LAS int*)(C.lds + P10_H); LAS int* SEG = (LAS int*)(C.lds + P10_SEG); LAS int* SBASE = (LAS int*)(C.lds + P10_BASE); LAS int* TOT = (LAS int*)(C.lds + P10_TOT);
    LAS int* OFFS = (LAS int*)(C.lds + OFFS_OFF);
    { const int* hg = wsp<int>(C, WS_HISTG);
        for (int i = C.tid; i < 16384 / 4; i += NTHR) *(LAS u32x4*)(H + 4 * i) = *(const GAS u32x4*)(hg + 4 * i);
        __syncthreads();
        const int e = C.tid & 31, sg = C.tid >> 5; int s = 0;
        for (int i = 0; i < 32; ++i) s += H[(sg * 32 + i) * 32 + e];
        SEG[sg * 32 + e] = s;
        __syncthreads();
        if (C.tid < 32) { int run = 0; for (int q = 0; q < 16; ++q) { SBASE[q * 32 + C.tid] = run; run += SEG[q * 32 + C.tid]; } TOT[C.tid] = run; }
        __syncthreads();
        int run = SBASE[sg * 32 + e];
        for (int i = 0; i < 32; ++i) { const int v = H[(sg * 32 + i) * 32 + e]; H[(sg * 32 + i) * 32 + e] = run; run += v; }
        if (C.tid == 0) { int o = 0; for (int q = 0; q < 32; ++q) { OFFS[q] = o; o += (TOT[q] + 255) & ~255; } OFFS[32] = o; }
        __syncthreads(); }
    if (blockIdx.x == 0) { int* texp = wsp<int>(C, WS_TEXP); const int RT = OFFS[32] >> 8;
        for (int rt = C.tid; rt < RT; rt += NTHR) { int e = 0;
            for (int q = 1; q < 32; ++q) if (rt * 256 >= OFFS[q]) e = q;
            texp[rt] = e; }
        if (C.tid == 0) texp[511] = RT; }
    const int gw = C.vcu * NWAVES + C.wave, NGW = C.G * NWAVES, lane = C.lane;
    const bf16* h2 = wsp<bf16>(C, WS_H2); bf16* xs = wsp<bf16>(C, WS_XS); const int* toke = wsp<int>(C, WS_TOKE); const int* tokr = wsp<int>(C, WS_TOKR); int* tokp = wsp<int>(C, WS_TOKP);
    for (int s0 = gw; s0 < NTOK * 2; s0 += 4 * NGW) { int ev[4], rv[4]; u32x4 ra[4], rb[4];
#pragma unroll
        for (int q = 0; q < 4; ++q) { const int s = s0 + q * NGW; if (s < NTOK * 2) { ev[q] = toke[s]; rv[q] = tokr[s]; const GAS u32x4* src = (const GAS u32x4*)(h2 + (size_t)(s >> 1) * DM) + lane; ra[q] = src[0]; rb[q] = src[64]; } }
#pragma unroll
        for (int q = 0; q < 4; ++q) { const int s = s0 + q * NGW; if (s < NTOK * 2) { const int e = ev[q]; const int ipos = OFFS[e] + H[(s >> 7) * 32 + e] + rv[q];
                if (lane == 0) tokp[s] = ipos;
                GAS u32x4* dst = (GAS u32x4*)(xs + (size_t)ipos * DM) + lane; dst[0] = ra[q]; dst[64] = rb[q]; } } }
}
constexpr int PH_PER_LAYER = 13, N_PHASES = 2 * PH_PER_LAYER + 1;
#ifndef MK_ONE_LAUNCH
#define MK_ONE_LAUNCH 1
#endif
#ifndef E2_ALIGN
#define E2_ALIGN false
#define E2_SP2 true
#endif
__global__ void __launch_bounds__(NTHR, 2) fwd(Args A) {
    extern __shared__ __attribute__((aligned(16))) unsigned char lds_raw[];
    Ctx C_;
    C_.lds = (LAS unsigned char*)lds_raw; C_.MISC = (volatile LAS unsigned*)(C_.lds + MISC_OFF);
    C_.tid = threadIdx.x; C_.lane = C_.tid & 63; C_.wave = __builtin_amdgcn_readfirstlane(C_.tid >> 6);
    C_.G = gridDim.x; { const int bx = blockIdx.x; C_.vcu = (C_.G % 8 == 0) ? (bx % 8) * (C_.G / 8) + bx / 8 : bx; }
    C_.ws = A.ws; C_.ctl = (gu32*)(A.ws + WS_CTL);
    for (int u = C_.tid; u < 128; u += NTHR) ((LAS unsigned*)(C_.lds + MISC_OFF))[u] = 0u;
    __syncthreads();
    const int lo = A.ph_lo, hi = A.ph_hi;
    const bool multi = (hi - lo) > 1;
    XcdBarrier bar; bar.wv = C_.wave; bar.bar = (unsigned*)(C_.ctl + CW_BAR); bar.x = 0; bar.st = nullptr;
    if (multi) bar = xcd_barrier_post((unsigned*)(C_.ctl + CW_BAR), C_.MISC + 8, C_.wave);
#ifndef PHASE_MASK
#define PHASE_MASK 0x1fff
#endif
#define HAS(k) (((PHASE_MASK) >> (k)) & 1)
#ifndef REPMASK
#define REPMASK 0
#endif
#ifndef REPCNT
#define REPCNT 2
#endif
#define NREP(k) ((((REPMASK) >> (k)) & 1) && layer == 0 ? REPCNT : 1)
#define IN(k) (lo <= (k) && (k) < hi)
#define SEAM(k) do { if (IN(k) && IN((k) + 1)) xcd_barrier(bar); } while (0)
#define FRESH() Ctx C = C_; C.lane = xb_lane(); C.tid = C_.wave * 64 + C.lane; asm volatile("" : "+s"(C.ws), "+s"(C.ctl), "+s"(C.vcu), "+s"(C.G))
    for (int layer = 0; layer < 3; ++layer) {
        const int pb = layer * PH_PER_LAYER;
        if (HAS(0) && IN(pb + 0)) for (int rep_ = 0; rep_ < NREP(0); ++rep_) { FRESH(); phase0(A, C, layer); }
        if (layer == 2) break;
        SEAM(pb + 0);
#ifdef XBAR_PROBE
        if (layer == 0 && IN(pb + 0) && IN(pb + 1)) { for (int q = 0; q < XBAR_PROBE; ++q) xcd_barrier(bar); }
#endif
        if (HAS(1) && IN(pb + 1)) for (int rep_ = 0; rep_ < NREP(1); ++rep_) { FRESH();
            pg8::Gemm g{(bf16*)A.out + (size_t)NTOK * DM, wsp<bf16>(C, WS_WT1), NTOK, 5120, 1024}; pg8::StaticOrder S; S.init(NTOK, 5120, C.G, (int)blockIdx.x);
            pg8::EpiOut<0> E{proj(C, 0), nullptr, nullptr, PROJ_STRIDE / 2};
            pg8::gemm_phase<pg8::EpiOut<0>, pg8::StaticOrder, true, true>(C.lds, g, S, E, C.tid);
        }
        SEAM(pb + 1);
        if (HAS(2) && IN(pb + 2)) for (int rep_ = 0; rep_ < NREP(2); ++rep_) { FRESH();  for (int g8 = C.vcu; g8 < 256; g8 += C.G) for (int i8 = 0; i8 < 8; ++i8) mlstm_u_item(A, C, layer, g8 >> 4, (g8 & 15) * 8 + i8, i8 == 0, i8 < 7); }
        SEAM(pb + 2);
        if (HAS(3) && IN(pb + 3)) for (int rep_ = 0; rep_ < NREP(3); ++rep_) { FRESH(); mlstm_scan(C); }
        SEAM(pb + 3);
        if (HAS(4) && IN(pb + 4)) for (int rep_ = 0; rep_ < NREP(4); ++rep_) { FRESH();
            gu32* q0 = C.ctl + CW_Q + 64 * (layer * 4 + 0); gu32* q1 = C.ctl + CW_Q + 64 * (layer * 4 + 1); gu32* q2 = C.ctl + CW_Q + 64 * (layer * 4 + 2);
            for (int rc_ = 0; rc_ < NREP(13); ++rc_) {
                if (C.G == 256) { const int xg = C.vcu >> 5, r = C.vcu & 31;
                    for (int rd = 0; rd < 2; ++rd) { const int p = r + 32 * rd, bvh = xg * 4 + (p >> 4), pr = p & 15;
                        attn_unit<128, true>(A, C, layer, bvh >> 3, bvh & 7, 31 - pr); attn_unit<128, true>(A, C, layer, bvh >> 3, bvh & 7, pr); } }
                else { for (int it = C.vcu; it < 1024; it += C.G) attn_unit<128, true>(A, C, layer, (it & 31) >> 3, it & 7, 31 - (it >> 5)); } }
            for (int rc_ = NREP(15) - 1; rc_ >= 0; --rc_) { gu32* qq = rc_ ? C.ctl + CW_Q + 64 * (17 + 2 * rc_) : q2;
            for (;;) { if (C.tid == 0) C.MISC[0] = __hip_atomic_fetch_add(qq, 1u, RLX_AGENT); __syncthreads(); const int it = (int)C.MISC[0]; __syncthreads(); if (it >= 512) break;
                for (int i4 = 0; i4 < 4; ++i4) mlstm_out_item(A, C, layer, it >> 5, (it & 31) * 4 + i4, i4 == 0, i4 < 3, rc_ ? wsp<bf16>(C, 480 * MiB) : nullptr); } }
            for (int rc_ = NREP(14) - 1; rc_ >= 0; --rc_) { gu32* qq = rc_ ? C.ctl + CW_Q + 64 * (16 + 2 * rc_) : q1;
            for (;;) { if (C.tid == 0) C.MISC[0] = __hip_atomic_fetch_add(qq, 1u, RLX_AGENT); __syncthreads(); const int it = (int)C.MISC[0]; __syncthreads(); if (it >= 1024) break;
                attn_unit<64, false>(A, C, layer, (it & 31) >> 3, it & 7, 31 - (it >> 5), rc_ ? wsp<bf16>(C, 480 * MiB) : nullptr); } }
        }
        SEAM(pb + 4);
        if (HAS(6) && IN(pb + 6)) for (int rep_ = 0; rep_ < NREP(6); ++rep_) { FRESH();
            if (rep_ == 0) phase5(A, C, layer);
            pg8::Gemm g{(bf16*)A.out + (size_t)NTOK * DM, wsp<bf16>(C, WS_WT2), NTOK, 3072, 1024}; pg8::StaticOrder S; S.init(NTOK, 3072, C.G, (int)blockIdx.x);
            pg8::EpiOut<1> E{wsp<bf16>(C, WS_G0), wsp<bf16>(C, WS_G1), wsp<bf16>(C, WS_G2), 0};
            pg8::gemm_phase<pg8::EpiOut<1>, pg8::StaticOrder, true, true>(C.lds, g, S, E, C.tid);
        }
        SEAM(pb + 6);
        if (HAS(7) && IN(pb + 7)) for (int rep_ = 0; rep_ < NREP(7); ++rep_) { FRESH();
            pg8::StaticOrder S; S.init(NTOK, 1024, C.G, (int)blockIdx.x); bf16* Y = wsp<bf16>(C, WS_O12);
            { pg8::Gemm g{proj(C, PJ_AV), wsp<bf16>(C, WS_PT), NTOK, 1024, 512}; pg8::EpiMerge<true> E{Y, wsp<bf16>(C, WS_G0)}; pg8::gemm_phase<pg8::EpiMerge<true>, pg8::StaticOrder, true, true>(C.lds, g, S, E, C.tid); }
            __syncthreads();
            { pg8::Gemm g{proj(C, PJ_BQ), wsp<bf16>(C, WS_PT) + 1024 * 512, NTOK, 1024, 512}; pg8::EpiMerge<false> E{Y, wsp<bf16>(C, WS_G1)}; pg8::gemm_phase<pg8::EpiMerge<false>, pg8::StaticOrder, true, true>(C.lds, g, S, E, C.tid); }
            __syncthreads();
            { pg8::Gemm g{proj(C, PJ_CQ), wsp<bf16>(C, WS_PT) + 2 * 1024 * 512, NTOK, 1024, 512}; pg8::EpiMerge<false> E{Y, wsp<bf16>(C, WS_G2)}; pg8::gemm_phase<pg8::EpiMerge<false>, pg8::StaticOrder, true, true>(C.lds, g, S, E, C.tid); }
        }
        SEAM(pb + 7);
        if (HAS(8) && IN(pb + 8)) for (int rep_ = 0; rep_ < NREP(8); ++rep_) { FRESH();
            pg8::Gemm g{wsp<bf16>(C, WS_O12), wsp<bf16>(C, WS_WOT), NTOK, 1024, 1024}; pg8::StaticOrder S; S.init(NTOK, 1024, C.G, (int)blockIdx.x);
            pg8::EpiResid E{layer == 0 ? (const void*)A.in[0] : (const void*)A.out, layer > 0, wsp<bf16>(C, WS_XB1)};
            pg8::gemm_phase<pg8::EpiResid, pg8::StaticOrder, true, true>(C.lds, g, S, E, C.tid);
        }
        SEAM(pb + 8);
        if (HAS(9) && IN(pb + 9)) for (int rep_ = 0; rep_ < NREP(9); ++rep_) { FRESH(); for (int r9 = 1; r9 < NREP(16); ++r9) { phase9(A, C, layer, true); __syncthreads(); } if (NREP(17) >= 2) { moe_weight_items(A, C, layer); __syncthreads(); } phase9(A, C, layer); }
        SEAM(pb + 9);
        if (HAS(10) && IN(pb + 10)) for (int rep_ = 0; rep_ < NREP(10); ++rep_) { FRESH(); phase10(C, layer); }
        SEAM(pb + 10);
        if (HAS(11) && IN(pb + 11)) for (int rep_ = 0; rep_ < NREP(11); ++rep_) { FRESH();
            const int* texp = wsp<int>(C, WS_TEXP); const int RT = __builtin_amdgcn_readfirstlane(texp[511]);
            pg8::Gemm g{wsp<bf16>(C, WS_XS), wsp<bf16>(C, WS_W1T), 73728, 32 * 512, 1024}; pg8::MoeOrder<1> S{C.G, C.vcu, RT, texp};
            pg8::EpiSiluMul E{wsp<bf16>(C, WS_HE)};
            pg8::gemm_phase<pg8::EpiSiluMul, pg8::MoeOrder<1>, true, true>(C.lds, g, S, E, C.tid);
        }
        SEAM(pb + 11);
        if (HAS(12) && IN(pb + 12)) for (int rep_ = 0; rep_ < NREP(12); ++rep_) { FRESH();
            const int* texp = wsp<int>(C, WS_TEXP); const int RT = __builtin_amdgcn_readfirstlane(texp[511]);
            pg8::Gemm g{wsp<bf16>(C, WS_HE), wsp<bf16>(C, WS_W2T), 73728, 32 * 1024, 256}; pg8::MoeOrder<2> S{C.G, C.vcu, RT, texp};
            pg8::EpiOut<2> E{wsp<bf16>(C, WS_OSL), nullptr, nullptr, 0};
            pg8::gemm_phase<pg8::EpiOut<2>, pg8::MoeOrder<2>, E2_ALIGN, E2_SP2>(C.lds, g, S, E, C.tid);
        }
        SEAM(pb + 12);
    }
#undef IN
#undef SEAM
}

extern "C" void kernel_launch(void* const* d_in, const int* in_sizes, int n_in, void* d_out, int out_size, void* d_ws, size_t ws_size, hipStream_t stream) {
    static int grid = 0;
    if (grid == 0) {
        if (n_in != 23 || out_size != NTOK * DM || ws_size < WS_NEED) { fprintf(stderr, "kernel_launch: unexpected shapes (n_in %d out %d ws %zu)\n", n_in, out_size, ws_size); grid = -1; return; }
        int dev = 0, cus = 0, per_cu = 0;
        if (hipGetDevice(&dev) != hipSuccess || hipDeviceGetAttribute(&cus, hipDeviceAttributeMultiprocessorCount, dev) != hipSuccess) { grid = -1; return; }
        if (hipFuncSetAttribute((const void*)fwd, hipFuncAttributeMaxDynamicSharedMemorySize, LDS_BYTES) != hipSuccess) { fprintf(stderr, "kernel_launch: hipFuncSetAttribute failed\n"); grid = -1; return; }
        if (hipOccupancyMaxActiveBlocksPerMultiprocessor(&per_cu, (const void*)fwd, NTHR, LDS_BYTES) != hipSuccess || per_cu < 1) fprintf(stderr, "kernel_launch: occupancy query says %d\n", per_cu);
        (void)hipGetLastError();
        grid = cus;
    }
    if (grid < 0) return;
    (void)hipMemsetAsync((char*)d_ws + WS_CTL, 0, CTL_ZERO_BYTES, stream);
    Args a{};
    for (int i = 0; i < 23; ++i) a.in[i] = (const float*)d_in[i];
    a.out = (float*)d_out; a.ws = (unsigned char*)d_ws;
#if MK_ONE_LAUNCH
    a.ph_lo = 0; a.ph_hi = N_PHASES;
    hipLaunchKernelGGL(fwd, dim3(grid), dim3(NTHR), LDS_BYTES, stream, a);
#else
    for (int p = 0; p < N_PHASES; ++p) { a.ph_lo = p; a.ph_hi = p + 1; hipLaunchKernelGGL(fwd, dim3(grid), dim3(NTHR), LDS_BYTES, stream, a); }
#endif
}
```

```cpp
#include <hip/hip_runtime.h>
#include <cstdio>
#include <cstdint>
#include <cmath>
namespace pg8 {
#define PG8_LAS __attribute__((address_space(3)))
typedef unsigned short bf16_t;
typedef short bf16x8 __attribute__((ext_vector_type(8)));
typedef float f32x4 __attribute__((ext_vector_type(4)));
typedef unsigned u32x4 __attribute__((ext_vector_type(4)));
constexpr int BM = 256, BK = 64, HALF = 128, HTB = HALF * BK * 2  , STAGE_BYTES = 8 * HTB, NXCD = 8, WGM = 8;

__host__ __device__ __forceinline__ int lds_byte(int r, int c) { const int st = (r >> 4) * 2 + (c >> 5), rr = r & 15, cc = c & 31, ob = rr * 64 + cc * 2; return st * 1024 + (ob ^ (((ob >> 9) & 1) << 5)); }
__host__ __device__ __forceinline__ void stage_rc(int b, int& R, int& C) { const int st = b / 1024, sb = b % 1024, swz = sb ^ (((sb >> 9) & 1) << 5); R = (st >> 1) * 16 + swz / 64; C = (st & 1) * 32 + (swz % 64) / 2; }
__host__ __device__ __forceinline__ int perm32(int rho) { const int n = rho >> 4, i = rho & 15; return 8 * (i >> 2) + 4 * n + (i & 3); }

struct Unit { int pm, pn; };
struct Gemm { const bf16_t* A; const bf16_t* Bt; int M, N, K; };

struct StaticOrder {
    int nM, nN, nwg, G, c;
    __host__ __device__ void init(int M, int N, int G_, int c_) { nM = M / BM; nN = N / BM; nwg = nM * nN; G = G_; c = c_; }
    __host__ __device__ bool next(int i, Unit& u) const {
        const long L = (long)i * G + c; if (L >= nwg) return false;
        int wgid = (int)L; { const int q = nwg / NXCD, r = nwg % NXCD, xcd = wgid % NXCD, off = wgid / NXCD; wgid = (xcd < r ? xcd * (q + 1) : r * (q + 1) + (xcd - r) * q) + off; }
        const int nig = WGM * nN, gid = wgid / nig, fm = gid * WGM, gsz = (nM - fm) < WGM ? (nM - fm) : WGM;
        u.pm = fm + ((wgid % nig) % gsz); u.pn = (wgid % nig) / gsz; return true;
    }
    __device__ __forceinline__ void a_ready(const Unit&) const {}
    __device__ __forceinline__ void done(const Unit&) const {}
};

__device__ __forceinline__ unsigned cvt_pk_bf16(float lo, float hi) { unsigned r; asm volatile("v_cvt_pk_bf16_f32 %0, %1, %2" : "=v"(r) : "v"(lo), "v"(hi)); return r; }
#ifndef GAS
#define GAS __attribute__((address_space(1)))
#endif
typedef float f32x2 __attribute__((ext_vector_type(2)));
__device__ __forceinline__ float bflo(unsigned u) { return __builtin_bit_cast(float, u << 16); }
__device__ __forceinline__ float bfhi(unsigned u) { return __builtin_bit_cast(float, u & 0xffff0000u); }
__device__ __forceinline__ float sigmoidf_(float x) { return 1.f / (1.f + __expf(-x)); }
template <int MODE> struct EpiOut {
    static constexpr bool PERM = true, AFTER_DRAIN = false, CHAIN = false;
    bf16_t* b0; bf16_t* b1; bf16_t* b2; size_t stride;
    __device__ __forceinline__ void operator()(const f32x4 (&acc)[2][2][4][2], const Unit& u, int wr, int wc, int fr, int fq) const {
        int row0 = u.pm * BM + wr * 64 + fr; asm volatile("" : "+v"(row0));
        bf16_t* base; int colt, ldc;
        if (MODE == 0) { base = b0 + (size_t)(u.pn >> 1) * stride; colt = (u.pn & 1) * 256; ldc = 512; }
        else if (MODE == 1) { const int t = u.pn >> 2; base = b0 + (size_t)(160 * t - 32 * t * (t - 1)) * (1u << 19); colt = (u.pn & 3) * 256; ldc = 1024; }
        else { base = b0; colt = (u.pn & 3) * 256; ldc = 1024; }
        const int col0 = colt + wc * 32 + 8 * fq;
#pragma unroll
        for (int ai = 0; ai < 2; ++ai)
#pragma unroll
            for (int m = 0; m < 4; ++m) { bf16_t* rowp = base + (size_t)(row0 + ai * HALF + m * 16) * ldc + col0;
#pragma unroll
                for (int bj = 0; bj < 2; ++bj) { f32x4 v0 = acc[ai][bj][m][0], v1 = acc[ai][bj][m][1];
                    if (MODE == 1) {
#pragma unroll
                        for (int j = 0; j < 4; ++j) { v0[j] = sigmoidf_(v0[j]); v1[j] = sigmoidf_(v1[j]); } }
                    u32x4 w; w.x = cvt_pk_bf16(v0[0], v0[1]); w.y = cvt_pk_bf16(v0[2], v0[3]); w.z = cvt_pk_bf16(v1[0], v1[1]); w.w = cvt_pk_bf16(v1[2], v1[3]);
                    *(GAS u32x4*)(rowp + bj * HALF) = w; } }
    }
};
template <bool FIRST> struct EpiMerge {
    static constexpr bool PERM = true, AFTER_DRAIN = false, CHAIN = false;
    bf16_t* Y; const bf16_t* G;
    __device__ __forceinline__ void operator()(const f32x4 (&acc)[2][2][4][2], const Unit& u, int wr, int wc, int fr, int fq) const {
        int row0 = u.pm * BM + wr * 64 + fr; asm volatile("" : "+v"(row0)); const int col0 = u.pn * BM + wc * 32 + 8 * fq;
#pragma unroll
        for (int ai = 0; ai < 2; ++ai)
#pragma unroll
            for (int m = 0; m < 4; ++m) { const size_t ro = (size_t)(row0 + ai * HALF + m * 16) * 1024 + col0;
#pragma unroll
                for (int bj = 0; bj < 2; ++bj) { const f32x4 v0 = acc[ai][bj][m][0], v1 = acc[ai][bj][m][1];
                    const u32x4 g = *(const GAS u32x4*)(G + ro + bj * HALF);
                    float r[8] = { bflo(g.x) * v0[0], bfhi(g.x) * v0[1], bflo(g.y) * v0[2], bfhi(g.y) * v0[3], bflo(g.z) * v1[0], bfhi(g.z) * v1[1], bflo(g.w) * v1[2], bfhi(g.w) * v1[3] };
                    if (!FIRST) { const u32x4 y = *(const GAS u32x4*)(Y + ro + bj * HALF);
                        r[0] += bflo(y.x); r[1] += bfhi(y.x); r[2] += bflo(y.y); r[3] += bfhi(y.y); r[4] += bflo(y.z); r[5] += bfhi(y.z); r[6] += bflo(y.w); r[7] += bfhi(y.w); }
                    u32x4 w; w.x = cvt_pk_bf16(r[0], r[1]); w.y = cvt_pk_bf16(r[2], r[3]); w.z = cvt_pk_bf16(r[4], r[5]); w.w = cvt_pk_bf16(r[6], r[7]);
                    *(GAS u32x4*)(Y + ro + bj * HALF) = w; } }
    }
};
struct EpiResid {
    static constexpr bool PERM = true, AFTER_DRAIN = false, CHAIN = false;
    const void* XS; bool xbf; bf16_t* OUT;
    __device__ __forceinline__ void operator()(const f32x4 (&acc)[2][2][4][2], const Unit& u, int wr, int wc, int fr, int fq) const {
        int row0 = u.pm * BM + wr * 64 + fr; asm volatile("" : "+v"(row0)); const int col0 = u.pn * BM + wc * 32 + 8 * fq;
#pragma unroll
        for (int ai = 0; ai < 2; ++ai)
#pragma unroll
            for (int m = 0; m < 4; ++m) { const size_t ro = (size_t)(row0 + ai * HALF + m * 16) * 1024 + col0;
#pragma unroll
                for (int bj = 0; bj < 2; ++bj) { f32x4 x0, x1;
                    if (xbf) { const u32x4 xv = *(const GAS u32x4*)((const bf16_t*)XS + ro + bj * HALF); x0 = (f32x4){bflo(xv.x), bfhi(xv.x), bflo(xv.y), bfhi(xv.y)}; x1 = (f32x4){bflo(xv.z), bfhi(xv.z), bflo(xv.w), bfhi(xv.w)}; }
                    else { x0 = *(const GAS f32x4*)((const float*)XS + ro + bj * HALF); x1 = *(const GAS f32x4*)((const float*)XS + ro + bj * HALF + 4); }
                    x0 = x0 + acc[ai][bj][m][0]; x1 = x1 + acc[ai][bj][m][1];
                    u32x4 w; w.x = cvt_pk_bf16(x0[0], x0[1]); w.y = cvt_pk_bf16(x0[2], x0[3]); w.z = cvt_pk_bf16(x1[0], x1[1]); w.w = cvt_pk_bf16(x1[2], x1[3]);
                    *(GAS u32x4*)(OUT + ro + bj * HALF) = w; } }
    }
};
struct EpiSiluMul {
    static constexpr bool PERM = true, AFTER_DRAIN = false, CHAIN = false;
    bf16_t* O;
    __device__ __forceinline__ void operator()(const f32x4 (&acc)[2][2][4][2], const Unit& u, int wr, int wc, int fr, int fq) const {
        int row0 = u.pm * BM + wr * 64 + fr; asm volatile("" : "+v"(row0)); const int col0 = (u.pn & 1) * 128 + wc * 32 + 8 * fq;
#pragma unroll
        for (int ai = 0; ai < 2; ++ai)
#pragma unroll
            for (int m = 0; m < 4; ++m) { float r[8];
#pragma unroll
                for (int n = 0; n < 2; ++n)
#pragma unroll
                    for (int j = 0; j < 4; ++j) { const float g = acc[ai][0][m][n][j], up = acc[ai][1][m][n][j]; r[4 * n + j] = g * sigmoidf_(g) * up; }
                u32x4 w; w.x = cvt_pk_bf16(r[0], r[1]); w.y = cvt_pk_bf16(r[2], r[3]); w.z = cvt_pk_bf16(r[4], r[5]); w.w = cvt_pk_bf16(r[6], r[7]);
                *(GAS u32x4*)(O + (size_t)(row0 + ai * HALF + m * 16) * 256 + col0) = w; }
    }
};
template <int LOG_NCT> struct MoeOrder {
    int G, c, RT; const int* texp;
    __device__ __forceinline__ bool next(int i, Unit& u) const {
        const int L = i * G + c; const int rt = L >> LOG_NCT; if (rt >= RT) return false;
        const int e = __builtin_amdgcn_readfirstlane(texp[rt]); u.pm = rt; u.pn = (e << LOG_NCT) + (L & ((1 << LOG_NCT) - 1)); return true;
    }
    __device__ __forceinline__ void a_ready(const Unit&) const {}
    __device__ __forceinline__ void done(const Unit&) const {}
};
template <class Epi, class Sched, bool ALIGN_EPI = false, bool SP2 = false>
__device__ __forceinline__ void gemm_phase(PG8_LAS unsigned char* lds, const Gemm g, const Sched& S, const Epi& E, int tid_in) {
    int tid = tid_in; asm volatile("" : "+v"(tid));
    const int wid = __builtin_amdgcn_readfirstlane(tid >> 6), lane = tid & 63, wr = wid >> 2, wc = wid & 3, fr = lane & 15, fq = lane >> 4;
    const int K = g.K, nt = K / BK;
    unsigned voffA[2], voffB[2];
#pragma unroll
    for (int i = 0; i < 2; ++i) { int R, C; stage_rc(tid * 16 + i * 8192, R, C); const int Rb = Epi::PERM ? ((R & ~31) + perm32(R & 31)) : R;
        voffA[i] = (unsigned)(R * K + C) * 2u; voffB[i] = (unsigned)(Rb * K + C) * 2u; }
    const size_t kstep = (size_t)(BK * 2);
    const size_t hstep = (size_t)HALF * K * 2;
    const size_t tstep = 2 * hstep;
    const unsigned ldsw = (unsigned)wid * 1024u;
    const int aoff = lds_byte(wr * 64 + fr, fq * 8), boff = lds_byte(wc * 32 + fr, fq * 8);
#define PG8_SA(b, h) (((b) * 2 + (h)) * HTB)
#define PG8_SB(b, h) ((4 + (b) * 2 + (h)) * HTB)
#define PG8_STAGE(bufoff, gbase, voff) do { _Pragma("unroll") for (int _i = 0; _i < 2; ++_i) \
        __builtin_amdgcn_global_load_lds((const unsigned*)((const char*)(gbase) + (voff)[_i]), (PG8_LAS unsigned*)(lds + (bufoff) + ldsw + _i * 8192), 16, 0, 0); } while (0)
#define PG8_LDA(dst, b, h) do { _Pragma("unroll") for (int m = 0; m < 4; ++m) _Pragma("unroll") for (int k = 0; k < 2; ++k) dst[m][k] = *(const PG8_LAS bf16x8*)(lds + PG8_SA(b, h) + aoff + m * 2048 + k * 1024); } while (0)
#define PG8_LDB(dst, b, h) do { _Pragma("unroll") for (int n = 0; n < 2; ++n) _Pragma("unroll") for (int k = 0; k < 2; ++k) dst[n][k] = *(const PG8_LAS bf16x8*)(lds + PG8_SB(b, h) + boff + n * 2048 + k * 1024); } while (0)
#define PG8_MMA(ai, bj, At, Bt) do { __builtin_amdgcn_s_setprio(1); _Pragma("unroll") for (int m = 0; m < 4; ++m) _Pragma("unroll") for (int n = 0; n < 2; ++n) _Pragma("unroll") for (int k = 0; k < 2; ++k) \
        acc[ai][bj][m][n] = __builtin_amdgcn_mfma_f32_16x16x32_bf16(Bt[n][k], At[m][k], acc[ai][bj][m][n], 0, 0, 0); __builtin_amdgcn_s_setprio(0); } while (0)
#define PG8_WAIT_V(n) asm volatile("s_waitcnt vmcnt(" #n ")" ::: "memory")
#define PG8_WAIT_L(n) asm volatile("s_waitcnt lgkmcnt(" #n ")" ::: "memory")
#define PG8_BAR __builtin_amdgcn_s_barrier()
#define PG8_SCHED __builtin_amdgcn_sched_barrier(0)
    Unit cur, nxt; int ui = 0;
    if (!S.next(0, cur)) return;
    f32x4 acc[2][2][4][2];
#pragma unroll
    for (int a = 0; a < 2; ++a)
#pragma unroll
        for (int b = 0; b < 2; ++b)
#pragma unroll
            for (int m = 0; m < 4; ++m)
#pragma unroll
                for (int n = 0; n < 2; ++n) acc[a][b][m][n] = (f32x4){0.f, 0.f, 0.f, 0.f};
    bf16x8 At[4][2], B0[2][2], B1[2][2];
    const char* cA = (const char*)g.A + (size_t)cur.pm * tstep; const char* cB = (const char*)g.Bt + (size_t)cur.pn * tstep;
    S.a_ready(cur);
    if constexpr (SP2) {
        PG8_STAGE(PG8_SB(0, 0), cB, voffB); PG8_STAGE(PG8_SB(0, 1), cB + hstep, voffB); PG8_STAGE(PG8_SA(0, 0), cA, voffA); PG8_STAGE(PG8_SA(0, 1), cA + hstep, voffA);
        if (wr == 1) PG8_BAR;
        PG8_WAIT_V(2); PG8_BAR;
        PG8_STAGE(PG8_SB(1, 0), cB + kstep, voffB); PG8_STAGE(PG8_SA(1, 0), cA + kstep, voffA); PG8_STAGE(PG8_SB(1, 1), cB + hstep + kstep, voffB);
        PG8_WAIT_V(6); PG8_BAR;
    } else {
        PG8_STAGE(PG8_SB(0, 0), cB, voffB); PG8_STAGE(PG8_SA(0, 0), cA, voffA); PG8_STAGE(PG8_SB(0, 1), cB + hstep, voffB); PG8_STAGE(PG8_SA(0, 1), cA + hstep, voffA);
        if (wr == 1) PG8_BAR;
        PG8_WAIT_V(4); PG8_BAR;
        PG8_STAGE(PG8_SB(1, 0), cB + kstep, voffB); PG8_STAGE(PG8_SA(1, 0), cA + kstep, voffA); PG8_STAGE(PG8_SB(1, 1), cB + hstep + kstep, voffB);
        PG8_WAIT_V(6); PG8_BAR;
    }
    for (;;) {
        const bool has_next = S.next(ui + 1, nxt);
        const char* nA = has_next ? (const char*)g.A + (size_t)nxt.pm * tstep : cA; const char* nB = has_next ? (const char*)g.Bt + (size_t)nxt.pn * tstep : cB;
        for (int t = 0; t < nt; t += 2) {
            const bool last = (t == nt - 2);
            const char* a1 = cA + (size_t)(t + 1) * kstep;
            const char* a2 = last ? nA : cA + (size_t)(t + 2) * kstep; const char* b2 = last ? nB : cB + (size_t)(t + 2) * kstep;
            const char* a3 = a2 + kstep; const char* b3 = b2 + kstep;
            if (last && has_next) S.a_ready(nxt);
            if constexpr (SP2) {
            PG8_LDB(B0, 0, 0); PG8_LDB(B1, 0, 1); PG8_SCHED; PG8_LDA(At, 0, 0); PG8_STAGE(PG8_SA(1, 1), a1 + hstep, voffA);
            PG8_WAIT_V(8); PG8_WAIT_L(0); PG8_BAR; PG8_MMA(0, 0, At, B0); PG8_MMA(0, 1, At, B1); PG8_BAR; PG8_SCHED;
            PG8_LDA(At, 0, 1); PG8_STAGE(PG8_SB(0, 0), b2, voffB); PG8_STAGE(PG8_SB(0, 1), b2 + hstep, voffB); PG8_STAGE(PG8_SA(0, 0), a2, voffA);
            PG8_WAIT_V(8); PG8_WAIT_L(0); PG8_BAR; PG8_MMA(1, 0, At, B0); PG8_MMA(1, 1, At, B1); PG8_BAR; PG8_SCHED;
            PG8_LDB(B0, 1, 0); PG8_LDB(B1, 1, 1); PG8_SCHED; PG8_LDA(At, 1, 0); PG8_STAGE(PG8_SA(0, 1), a2 + hstep, voffA);
            PG8_WAIT_V(8); PG8_WAIT_L(0); PG8_BAR; PG8_MMA(0, 0, At, B0); PG8_MMA(0, 1, At, B1); PG8_BAR; PG8_SCHED;
            PG8_LDA(At, 1, 1); PG8_STAGE(PG8_SB(1, 0), b3, voffB); PG8_STAGE(PG8_SB(1, 1), b3 + hstep, voffB); PG8_STAGE(PG8_SA(1, 0), a3, voffA);
            PG8_WAIT_V(8); PG8_WAIT_L(0); PG8_BAR; PG8_MMA(1, 0, At, B0); PG8_MMA(1, 1, At, B1); PG8_BAR; PG8_SCHED;
            } else {
            PG8_LDB(B0, 0, 0); PG8_SCHED; PG8_LDA(At, 0, 0); PG8_STAGE(PG8_SA(1, 1), a1 + hstep, voffA);
            PG8_WAIT_L(8); PG8_BAR; PG8_WAIT_L(0); PG8_MMA(0, 0, At, B0); PG8_BAR; PG8_SCHED;
            PG8_LDB(B1, 0, 1); PG8_STAGE(PG8_SB(0, 0), b2, voffB);
            PG8_BAR; PG8_WAIT_L(0); PG8_MMA(0, 1, At, B1); PG8_BAR;
            PG8_LDA(At, 0, 1); PG8_STAGE(PG8_SA(0, 0), a2, voffA);
            PG8_BAR; PG8_WAIT_L(0); PG8_MMA(1, 0, At, B0); PG8_BAR; PG8_SCHED;
            PG8_STAGE(PG8_SB(0, 1), b2 + hstep, voffB);
            PG8_WAIT_V(6); PG8_BAR; PG8_MMA(1, 1, At, B1); PG8_BAR;
            PG8_LDB(B0, 1, 0); PG8_SCHED; PG8_LDA(At, 1, 0); PG8_STAGE(PG8_SA(0, 1), a2 + hstep, voffA);
            PG8_WAIT_L(8); PG8_BAR; PG8_WAIT_L(0); PG8_MMA(0, 0, At, B0); PG8_BAR; PG8_SCHED;
            PG8_LDB(B1, 1, 1); PG8_STAGE(PG8_SB(1, 0), b3, voffB);
            PG8_BAR; PG8_WAIT_L(0); PG8_MMA(0, 1, At, B1); PG8_BAR;
            PG8_LDA(At, 1, 1); PG8_STAGE(PG8_SA(1, 0), a3, voffA);
            PG8_BAR; PG8_WAIT_L(0); PG8_MMA(1, 0, At, B0); PG8_BAR; PG8_SCHED;
            PG8_STAGE(PG8_SB(1, 1), b3 + hstep, voffB);
            PG8_WAIT_V(6); PG8_BAR; PG8_MMA(1, 1, At, B1); PG8_BAR;
            }
        }
        if constexpr (ALIGN_EPI) { if (wr == 0) PG8_BAR; }
        if constexpr (!Epi::AFTER_DRAIN) { E(acc, cur, wr, wc, fr, fq); S.done(cur); }
        if (!has_next) break;
#pragma unroll
        for (int a = 0; a < 2; ++a)
#pragma unroll
            for (int b = 0; b < 2; ++b)
#pragma unroll
                for (int m = 0; m < 4; ++m)
#pragma unroll
                    for (int n = 0; n < 2; ++n) acc[a][b][m][n] = (f32x4){0.f, 0.f, 0.f, 0.f};
        cur = nxt; cA = nA; cB = nB; ++ui;
        if constexpr (ALIGN_EPI) { if (wr == 1) PG8_BAR; }
    }
    PG8_WAIT_V(0);
    if constexpr (!ALIGN_EPI) { if (wr == 0) PG8_BAR; }
    PG8_BAR;
    if constexpr (Epi::AFTER_DRAIN) { E.fused(acc, cur, wr, wc, fr, fq, lds, wid, lane); S.done(cur); }
#undef PG8_SA
#undef PG8_SB
#undef PG8_STAGE
#undef PG8_LDA
#undef PG8_LDB
#undef PG8_MMA
#undef PG8_WAIT_V
#undef PG8_WAIT_L
#undef PG8_BAR
#undef PG8_SCHED
}
}
constexpr int NTOK = 32768, SEQ = 8192, NB = 4, DM = 1024, INC = 8200;
constexpr float EPS = 1e-6f, LOG2E = 1.4426950408889634f;
constexpr size_t MiB = 1u << 20;
constexpr size_t WS_CTL = 0, CTL_ZERO_BYTES = 128 * 1024;
constexpr size_t WS_IG = 1 * MiB;
constexpr size_t WS_BC = 1 * MiB + 512 * 1024;
constexpr size_t WS_BLAST = 2 * MiB;
constexpr size_t WS_GMAX = 2 * MiB + 64 * 1024;
constexpr size_t WS_NUC = 3 * MiB;
constexpr size_t WS_TOKE = 4 * MiB;
constexpr size_t WS_TOKR = 4 * MiB + 256 * 1024;
constexpr size_t WS_TOKW = 4 * MiB + 512 * 1024;
constexpr size_t WS_TEXP = 5 * MiB;
constexpr size_t WS_HISTG = 5 * MiB + 64 * 1024;
constexpr size_t WS_WRT = 7 * MiB;
constexpr size_t WS_TOKP = 6 * MiB;
constexpr size_t WS_WT1 = 8 * MiB;
constexpr size_t WS_WT2 = 18 * MiB;
constexpr size_t WS_PT = 24 * MiB;
constexpr size_t WS_WOT = 27 * MiB;
constexpr size_t WS_PROJ = 32 * MiB;
constexpr size_t PROJ_STRIDE = 32 * MiB;
constexpr size_t WS_HB = 352 * MiB;
constexpr size_t WS_O12 = 416 * MiB;
constexpr size_t WS_G0 = 32 * MiB, WS_G1 = 192 * MiB, WS_G2 = 288 * MiB;
constexpr size_t WS_H2 = 32 * MiB;
constexpr size_t WS_XS = 96 * MiB;
constexpr size_t WS_HE = 32 * MiB;
constexpr size_t WS_OSL = 96 * MiB;
constexpr size_t WS_W1T = 416 * MiB;
constexpr size_t WS_W2T = 448 * MiB;
constexpr size_t WS_XB1 = 256 * MiB;
constexpr size_t WS_NEED = 512 * MiB;
constexpr int PJ_AQ = 0, PJ_AK = 1, PJ_AV = 2, PJ_AO = 3, PJ_BQ = 4, PJ_BK = 5, PJ_BV = 6, PJ_CQ = 7, PJ_CK = 8, PJ_CV = 9;
constexpr int CW_TMO = 0, CW_CODE = 1;
constexpr int CW_BAR = 4096;
constexpr int CW_Q = 8192;
constexpr int CW_CNT = 12288;
constexpr int RING_BYTES = 131072;
constexpr int MISC_OFF = RING_BYTES;
constexpr int OFFS_OFF = RING_BYTES + 256;
constexpr int LDS_BYTES = 147456;
constexpr int NWAVES = 8, NTHR = 512;

#ifndef GAS
#define GAS __attribute__((address_space(1)))
#endif
#define LAS __attribute__((address_space(3)))
typedef unsigned short bf16;
typedef float f32x4 __attribute__((ext_vector_type(4)));
typedef float f32x16 __attribute__((ext_vector_type(16)));
typedef short bf16x8 __attribute__((ext_vector_type(8)));
typedef unsigned u32x4 __attribute__((ext_vector_type(4)));
typedef unsigned u32x2 __attribute__((ext_vector_type(2)));
typedef short s16x4 __attribute__((ext_vector_type(4)));
typedef GAS unsigned gu32;
#define RLX_AGENT __ATOMIC_RELAXED, __HIP_MEMORY_SCOPE_AGENT
#define LDS_WAIT() asm volatile("s_waitcnt lgkmcnt(0)" ::: "memory")
typedef float f32x2_t __attribute__((ext_vector_type(2))); typedef __bf16 bf16x2_t __attribute__((ext_vector_type(2)));
__device__ __forceinline__ unsigned pk2(float lo, float hi) { f32x2_t v = {lo, hi}; bf16x2_t b = __builtin_convertvector(v, bf16x2_t); return __builtin_bit_cast(unsigned, b); }
__device__ __forceinline__ float bflo(unsigned u) { return __builtin_bit_cast(float, u << 16); }
__device__ __forceinline__ float bfhi(unsigned u) { return __builtin_bit_cast(float, u & 0xffff0000u); }
__device__ __forceinline__ float sigm(float x) { return 1.f / (1.f + __expf(-x)); }
template <int O> __device__ __forceinline__ float xor_shfl(float v) {
    return __builtin_bit_cast(float, __builtin_amdgcn_ds_swizzle(__builtin_bit_cast(int, v), (O << 10) | 0x1f));
}
__device__ __forceinline__ float wave_sum(float v) {
    v += xor_shfl<1>(v); v += xor_shfl<2>(v); v += xor_shfl<4>(v); v += xor_shfl<8>(v); v += xor_shfl<16>(v);
    auto rr = __builtin_amdgcn_permlane32_swap(__float_as_uint(v), __float_as_uint(v), false, false);
    return __uint_as_float(rr[0]) + __uint_as_float(rr[1]);
}
__device__ __forceinline__ float wave_max(float v) {
    v = fmaxf(v, xor_shfl<1>(v)); v = fmaxf(v, xor_shfl<2>(v)); v = fmaxf(v, xor_shfl<4>(v)); v = fmaxf(v, xor_shfl<8>(v)); v = fmaxf(v, xor_shfl<16>(v));
    auto rr = __builtin_amdgcn_permlane32_swap(__float_as_uint(v), __float_as_uint(v), false, false);
    return fmaxf(__uint_as_float(rr[0]), __uint_as_float(rr[1]));
}
__device__ __forceinline__ float lane_up(float v, int lane, int o) {
    return __builtin_bit_cast(float, __builtin_amdgcn_ds_bpermute(((lane - o) & 63) << 2, __builtin_bit_cast(int, v)));
}
__device__ __forceinline__ float lane_get(float v, int src) {
    return __builtin_bit_cast(float, __builtin_amdgcn_readlane(__builtin_bit_cast(int, v), src));
}
__device__ __forceinline__ float pair_sum(float v) {
    auto rr = __builtin_amdgcn_permlane32_swap(__float_as_uint(v), __float_as_uint(v), false, false);
    return __uint_as_float(rr[0]) + __uint_as_float(rr[1]);
}
__device__ __forceinline__ float pair_max(float v) {
    auto rr = __builtin_amdgcn_permlane32_swap(__float_as_uint(v), __float_as_uint(v), false, false);
    return fmaxf(__uint_as_float(rr[0]), __uint_as_float(rr[1]));
}
__device__ __forceinline__ float max3f(float a, float b, float c) { float r; asm("v_max3_f32 %0, %1, %2, %3" : "=v"(r) : "v"(a), "v"(b), "v"(c)); return r; }
__device__ __forceinline__ int crow(int r, int hi) { return (r & 3) + 8 * (r >> 2) + 4 * hi; }
typedef short v4i16_t __attribute__((ext_vector_type(4)));
__device__ __forceinline__ s16x4 tr16(const LAS unsigned char* p) { return __builtin_bit_cast(s16x4, __builtin_amdgcn_ds_read_tr16_b64_v4i16((LAS v4i16_t*)p)); }
__device__ __forceinline__ bf16x8 cat8(s16x4 lo, s16x4 hi) { return (bf16x8){lo[0], lo[1], lo[2], lo[3], hi[0], hi[1], hi[2], hi[3]}; }
__device__ __forceinline__ f32x4 ldrow4(const void* base, bool isbf, size_t row, int idx) {
    if (isbf) { const u32x2 u = ((const GAS u32x2*)((const bf16*)base + row * 1024))[idx]; return (f32x4){bflo(u.x), bfhi(u.x), bflo(u.y), bfhi(u.y)}; }
    return ((const GAS f32x4*)((const float*)base + row * 1024))[idx];
}
#define MFMA32(a, b, c) __builtin_amdgcn_mfma_f32_32x32x16_bf16((a), (b), (c), 0, 0, 0)
#define XB_TMO      128
#define XB_XCNT(j)  (256  + 64 * (j))
#define XB_XSUB(j)  (1280 + 64 * (j))
#define XB_XGEN(j)  (2304 + 64 * (j))
#define XB_TOP      3328
#define XB_TOPGEN   3392
#define XCD_BAR_WORDS 3456
#define XB_SPIN_CAP (1u << 18)

__device__ __forceinline__ unsigned xb_ld(unsigned* p)              { return __hip_atomic_load(p, __ATOMIC_RELAXED, __HIP_MEMORY_SCOPE_AGENT); }
__device__ __forceinline__ unsigned xb_add(unsigned* p, unsigned v) { return __hip_atomic_fetch_add(p, v, __ATOMIC_RELAXED, __HIP_MEMORY_SCOPE_AGENT); }
__device__ __forceinline__ unsigned xb_xcc_id() { return (unsigned)__builtin_amdgcn_s_getreg((3 << 11) | 20) & 0xFu; }
#define XB_SPIN(cond, bar) do { unsigned _sp = 0; while (cond) { __builtin_amdgcn_s_sleep(1); \
    if ((++_sp & 255u) == 0u) { if (xb_ld(&(bar)[XB_TMO])) break; if (_sp > XB_SPIN_CAP) { atomicAdd(&(bar)[XB_TMO], 1u); break; } } } } while (0)

__device__ __forceinline__ int xb_lane() { int l; asm volatile("v_mbcnt_lo_u32_b32 %0, -1, 0\n\tv_mbcnt_hi_u32_b32 %0, -1, %0" : "=v"(l)); return l; }
struct XcdBarrier {
    int wv;
    unsigned* bar; unsigned x;
    volatile LAS unsigned* st;
};

__device__ __forceinline__ XcdBarrier xcd_barrier_post(unsigned* bar, volatile LAS unsigned* st, int wv) {
    XcdBarrier b; b.wv = wv; b.bar = bar; b.x = xb_xcc_id(); b.st = st;
    if (wv == 0 && xb_lane() == 0) (void)xb_add(&bar[XB_XCNT(b.x)], 1u);
    return b;
}
__device__ __forceinline__ void xcd_barrier_complete(unsigned* bar, unsigned x, unsigned& nloc, unsigned& nx) {
    const unsigned G = gridDim.x * gridDim.y * gridDim.z;
    unsigned sum, cnt, mine, sp = 0u;
    for (;;) {
        sum = 0u; cnt = 0u; mine = 0u;
#pragma unroll
        for (unsigned j = 0; j < 16; ++j) { const unsigned c = xb_ld(&bar[XB_XCNT(j)]); sum += c; cnt += (c > 0u) ? 1u : 0u; mine = (j == x) ? c : mine; }
        if (sum == G) break;
        __builtin_amdgcn_s_sleep(1);
        if ((++sp & 255u) == 0u) { if (xb_ld(&bar[XB_TMO])) break; if (sp > XB_SPIN_CAP) { atomicAdd(&bar[XB_TMO], 1u); break; } }
    }
    nloc = mine > 0u ? mine : 1u; nx = cnt > 0u ? cnt : 1u;
}

__device__ __forceinline__ void xcd_barrier(const XcdBarrier& b) {
    asm volatile("s_waitcnt vmcnt(0)" ::: "memory");
    __syncthreads();
    if (b.wv == 0 && xb_lane() == 0) {
        unsigned* bar = b.bar;
        __builtin_amdgcn_s_waitcnt(0);
        unsigned nloc = b.st[0], nx = b.st[1];
        if (nloc == 0u) { xcd_barrier_complete(bar, b.x, nloc, nx); b.st[0] = nloc; b.st[1] = nx; }
        const unsigned old = xb_add(&bar[XB_XSUB(b.x)], 1u);
        const unsigned gen = old / nloc;
        if (old + 1u == (gen + 1u) * nloc) {
            __builtin_amdgcn_fence(__ATOMIC_RELEASE, "agent");
            asm volatile("s_waitcnt vmcnt(0)" ::: "memory");
            const unsigned og = xb_add(&bar[XB_TOP], 1u);
            const unsigned tg = og / nx;
            if (og + 1u == (tg + 1u) * nx) xb_add(&bar[XB_TOPGEN], 1u);
            else XB_SPIN(xb_ld(&bar[XB_TOPGEN]) == tg, bar);
            __builtin_amdgcn_fence(__ATOMIC_ACQUIRE, "agent");
            xb_add(&bar[XB_XGEN(b.x)], 1u);
            asm volatile("s_waitcnt vmcnt(0)" ::: "memory");
        } else {
            XB_SPIN(xb_ld(&bar[XB_XGEN(b.x)]) == gen, bar);
            __builtin_amdgcn_fence(__ATOMIC_ACQUIRE, "agent");
            asm volatile("s_waitcnt vmcnt(0)" ::: "memory");
        }
    }
    __syncthreads();
}
struct Args {
    const float* in[23]; float* out; unsigned char* ws; int ph_lo, ph_hi;
};
struct Ctx {
    LAS unsigned char* lds; volatile LAS unsigned* MISC; gu32* ctl; unsigned char* ws;
    int tid, lane, wave, vcu, G;
};
template <class T> __device__ __forceinline__ T* wsp(const Ctx& C, size_t off) { return (T*)(C.ws + off); }
__device__ __forceinline__ bf16* proj(const Ctx& C, int j) { return (bf16*)(C.ws + WS_PROJ + (size_t)j * PROJ_STRIDE); }

struct TrItem { const float* W; int ldn, k0, n0; bf16* WT; int Kdst, drow0; };
__device__ __forceinline__ void transpose_load(const TrItem& t, f32x4 (&v)[8], int lane) {
    const float* src = t.W + (size_t)(t.k0 + (lane >> 3)) * t.ldn + t.n0 + 4 * (lane & 7);
#pragma unroll
    for (int i = 0; i < 8; ++i) v[i] = *(const GAS f32x4*)(src + (size_t)(8 * i) * t.ldn);
}
__device__ __forceinline__ void transpose_commit(const TrItem& t, const f32x4 (&v)[8], LAS float* scr, int lane) {
    { const int c4 = lane & 7;
#pragma unroll
        for (int i = 0; i < 8; ++i) { LAS float* d = scr + ((lane >> 3) + 8 * i) * 33 + 4 * c4; d[0] = v[i].x; d[1] = v[i].y; d[2] = v[i].z; d[3] = v[i].w; } }
    LDS_WAIT(); asm volatile("" ::: "memory");
    const int c = lane & 7;
#pragma unroll
    for (int j = 0; j < 4; ++j) { const int n = (lane >> 3) + 8 * j; const LAS float* s = scr + (8 * c) * 33 + n;
        u32x4 o; o.x = pk2(s[0 * 33], s[1 * 33]); o.y = pk2(s[2 * 33], s[3 * 33]); o.z = pk2(s[4 * 33], s[5 * 33]); o.w = pk2(s[6 * 33], s[7 * 33]);
        *(GAS u32x4*)(t.WT + (size_t)(t.drow0 + n) * t.Kdst + t.k0 + 8 * c) = o; }
    LDS_WAIT(); asm volatile("" ::: "memory");
}
__device__ __forceinline__ TrItem layer_weight_decode(const Args& A, const Ctx& C, int layer, int it) {
    const float* win = A.in[2] + (size_t)layer * DM * INC;
    constexpr int I1 = 16 * 160, I2 = 16 * 96, I3 = 3 * 8 * 32;
    int r = it;
    if (r < I1) { const int nb = r % 160, kb = r / 160, nd = nb * 32, j = nd >> 9; const int sc = (j < 4 ? j * 512 : 2056 + (j - 4) * 512) + (nd & 511);
        return TrItem{win, INC, kb * 64, sc, wsp<bf16>(C, WS_WT1), 1024, nd}; } r -= I1;
    if (r < I2) { const int nb = r % 96, kb = r / 96; return TrItem{win, INC, kb * 64, 5128 + nb * 32, wsp<bf16>(C, WS_WT2), 1024, nb * 32}; } r -= I2;
    if (r < I3) { const int br = r / 256, q = r % 256, nb = q % 32, kb = q / 32;
        return TrItem{A.in[13] + (size_t)(layer * 3 + br) * 512 * 1024, 1024, kb * 64, nb * 32, wsp<bf16>(C, WS_PT) + (size_t)br * 1024 * 512, 512, nb * 32}; } r -= I3;
    { const int nb = r % 32, kb = r / 32; return TrItem{A.in[14] + (size_t)layer * 1024 * 1024, 1024, kb * 64, nb * 32, wsp<bf16>(C, WS_WOT), 1024, nb * 32}; }
}
__device__ __forceinline__ void layer_weight_items(const Args& A, const Ctx& C, int layer) {
    LAS float* scr = (LAS float*)(C.lds + C.wave * 16384);
    const int gw = C.vcu * NWAVES + C.wave, NGW = C.G * NWAVES;
    constexpr int NI = 16 * 160 + 16 * 96 + 3 * 8 * 32 + 16 * 32;
    if (gw >= NI) return;
    TrItem cur = layer_weight_decode(A, C, layer, gw); f32x4 v[8]; transpose_load(cur, v, C.lane);
    for (int it = gw; it < NI; it += NGW) { f32x4 vn[8]; TrItem nxt = cur; const bool hn = it + NGW < NI;
        if (hn) { nxt = layer_weight_decode(A, C, layer, it + NGW); transpose_load(nxt, vn, C.lane); }
        transpose_commit(cur, v, scr, C.lane);
        if (hn) {
#pragma unroll
            for (int i = 0; i < 8; ++i) v[i] = vn[i]; }
        cur = nxt; }
}
__device__ __forceinline__ TrItem moe_weight_decode(const Args& A, const Ctx& C, int layer, int it) {
    constexpr int I1 = 32 * 256;
    int r = it;
    if (r < I1) { const int e = r >> 8, q = r & 255, mat = q >> 7, q2 = q & 127, nb = q2 & 7, kb = q2 >> 3, n0 = nb * 32;
        const float* src = (mat ? A.in[21] : A.in[20]) + (size_t)(layer * 32 + e) * 1024 * 256;
        return TrItem{src, 256, kb * 64, n0, wsp<bf16>(C, WS_W1T), 1024, e * 512 + (n0 >> 7) * 256 + mat * 128 + (n0 & 127)}; } r -= I1;
    { const int e = r >> 7, q = r & 127, nb = q & 31, kb = q >> 5;
        return TrItem{A.in[22] + (size_t)(layer * 32 + e) * 256 * 1024, 1024, kb * 64, nb * 32, wsp<bf16>(C, WS_W2T), 256, e * 1024 + nb * 32}; }
}
__device__ __forceinline__ void moe_weight_items(const Args& A, const Ctx& C, int layer) {
    LAS float* scr = (LAS float*)(C.lds + C.wave * 16384);
    const int gw = C.vcu * NWAVES + C.wave, NGW = C.G * NWAVES;
    constexpr int NI = 32 * 256 + 32 * 128;
    if (gw >= NI) return;
    TrItem cur = moe_weight_decode(A, C, layer, gw); f32x4 v[8]; transpose_load(cur, v, C.lane);
    for (int it = gw; it < NI; it += NGW) { f32x4 vn[8]; TrItem nxt = cur; const bool hn = it + NGW < NI;
        if (hn) { nxt = moe_weight_decode(A, C, layer, it + NGW); transpose_load(nxt, vn, C.lane); }
        transpose_commit(cur, v, scr, C.lane);
        if (hn) {
#pragma unroll
            for (int i = 0; i < 8; ++i) v[i] = vn[i]; }
        cur = nxt; }
}
__device__ __forceinline__ void phase0(const Args& A, const Ctx& C, int layer) {
    if (layer < 2) { layer_weight_items(A, C, layer);
        const float* wr = A.in[18] + layer * 32768; const float* wgp = A.in[16] + layer * 4096; bf16* wt = wsp<bf16>(C, WS_WRT);
        for (int idx = C.vcu * NTHR + C.tid; idx < 65536; idx += C.G * NTHR) { const int n = idx >> 10, k = idx & 1023;
            const float w = n < 32 ? wr[k * 32 + n] : n < 36 ? wgp[k * 4 + (n - 32)] : 0.f; const unsigned hi = pk2(w, 0.f) & 0xffffu; const unsigned lo = pk2(w - bflo(hi), 0.f) & 0xffffu;
            ((GAS bf16*)wt)[idx] = (bf16)hi; ((GAS bf16*)wt)[65536 + idx] = (bf16)lo; } }
    __syncthreads();
    LAS float* WG = (LAS float*)(C.lds);
    LAS float* GL = (LAS float*)(C.lds + 32768);
    const int ll = layer < 2 ? layer : 0;
    const float* win = A.in[2] + (size_t)ll * DM * INC;
    if (layer < 2) { float wv[16];
#pragma unroll
        for (int q = 0; q < 16; ++q) { const int i = C.tid + NTHR * q; wv[q] = *(const GAS float*)(win + (size_t)(i >> 3) * INC + 2048 + (i & 7)); }
#pragma unroll
        for (int q = 0; q < 16; ++q) WG[C.tid + NTHR * q] = wv[q]; }
    __syncthreads();
    const float* g1 = A.in[1] + ll * 1024; const float* gb = A.in[5] + ll * 8;
    const void* xsrc = (layer == 0) ? (const void*)A.in[0] : (const void*)wsp<bf16>(C, WS_XB1); const bool xbf = layer > 0;
    const int* tokp = wsp<int>(C, WS_TOKP); const float* tokw = wsp<float>(C, WS_TOKW);
    const bf16* osl = wsp<bf16>(C, WS_OSL); bf16* hb = (bf16*)A.out + (size_t)NTOK * DM;
    for (int item = C.vcu; item < NTOK / 64; item += C.G) {
        const int row0 = item * 64;
        f32x4 vnx[4]; u32x2 onx0[4] = {}, onx1[4] = {}; float nw0 = 0.f, nw1 = 0.f, nnw0 = 0.f, nnw1 = 0.f; int nnp0 = 0, nnp1 = 0;
        { const int r0 = row0 + C.wave * 8;
#pragma unroll
            for (int j = 0; j < 4; ++j) vnx[j] = ldrow4(xsrc, xbf, (size_t)r0, C.lane + 64 * j);
            if (layer > 0) { nw0 = tokw[r0 * 2]; nw1 = tokw[r0 * 2 + 1]; const size_t p0 = (size_t)tokp[r0 * 2], p1 = (size_t)tokp[r0 * 2 + 1];
                nnw0 = tokw[r0 * 2 + 2]; nnw1 = tokw[r0 * 2 + 3]; nnp0 = tokp[r0 * 2 + 2]; nnp1 = tokp[r0 * 2 + 3];
                const GAS u32x2* o0 = (const GAS u32x2*)(osl + p0 * DM) + C.lane; const GAS u32x2* o1 = (const GAS u32x2*)(osl + p1 * DM) + C.lane;
#pragma unroll
                for (int j = 0; j < 4; ++j) { onx0[j] = o0[64 * j]; onx1[j] = o1[64 * j]; } } }
        for (int i = 0; i < 8; ++i) {
            const int rl = C.wave * 8 + i, row = row0 + rl;
            f32x4 v[4]; u32x2 oc0[4], oc1[4]; const float w0 = nw0, w1 = nw1;
#pragma unroll
            for (int j = 0; j < 4; ++j) { v[j] = vnx[j]; oc0[j] = onx0[j]; oc1[j] = onx1[j]; }
            if (i < 7) {
#pragma unroll
                for (int j = 0; j < 4; ++j) vnx[j] = ldrow4(xsrc, xbf, (size_t)(row + 1), C.lane + 64 * j);
                if (layer > 0) { nw0 = nnw0; nw1 = nnw1;
                    const GAS u32x2* o0 = (const GAS u32x2*)(osl + (size_t)nnp0 * DM) + C.lane; const GAS u32x2* o1 = (const GAS u32x2*)(osl + (size_t)nnp1 * DM) + C.lane;
#pragma unroll
                    for (int j = 0; j < 4; ++j) { onx0[j] = o0[64 * j]; onx1[j] = o1[64 * j]; }
                    if (i < 6) { nnw0 = tokw[row * 2 + 4]; nnw1 = tokw[row * 2 + 5]; nnp0 = tokp[row * 2 + 4]; nnp1 = tokp[row * 2 + 5]; } } }
            if (layer > 0) {
#pragma unroll
                for (int j = 0; j < 4; ++j) { const u32x2 a = oc0[j], b = oc1[j];
                    v[j].x += w0 * bflo(a.x) + w1 * bflo(b.x); v[j].y += w0 * bfhi(a.x) + w1 * bfhi(b.x); v[j].z += w0 * bflo(a.y) + w1 * bflo(b.y); v[j].w += w0 * bfhi(a.y) + w1 * bfhi(b.y); }
                if (layer == 2) { GAS f32x4* xo = (GAS f32x4*)(A.out + (size_t)row * DM) + C.lane;
#pragma unroll
                    for (int j = 0; j < 4; ++j) xo[64 * j] = v[j]; }
                else { GAS u32x2* xo = (GAS u32x2*)((bf16*)A.out + (size_t)row * DM) + C.lane;
#pragma unroll
                    for (int j = 0; j < 4; ++j) { u32x2 o; o.x = pk2(v[j].x, v[j].y); o.y = pk2(v[j].z, v[j].w); xo[64 * j] = o; } }
            }
            if (layer < 2) {
                float ss = 0.f;
#pragma unroll
                for (int j = 0; j < 4; ++j) ss += (v[j].x * v[j].x + v[j].y * v[j].y) + (v[j].z * v[j].z + v[j].w * v[j].w);
                const float rstd = rsqrtf(wave_sum(ss) * (1.f / DM) + EPS);
                float gd[8];
#pragma unroll
                for (int q = 0; q < 8; ++q) gd[q] = 0.f;
                GAS u32x2* ho = (GAS u32x2*)(hb + (size_t)row * DM) + C.lane;
#pragma unroll
                for (int j = 0; j < 4; ++j) { const f32x4 g = ((const GAS f32x4*)g1)[64 * j + C.lane];
                    const f32x4 h = {v[j].x * rstd * g.x, v[j].y * rstd * g.y, v[j].z * rstd * g.z, v[j].w * rstd * g.w};
                    u32x2 o; o.x = pk2(h.x, h.y); o.y = pk2(h.z, h.w); ho[64 * j] = o;
                    const int k = 256 * j + 4 * C.lane;
#pragma unroll
                    for (int c = 0; c < 4; ++c) { const f32x4 wa = *(const LAS f32x4*)(WG + (k + c) * 8), wb = *(const LAS f32x4*)(WG + (k + c) * 8 + 4);
                        gd[0] += h[c] * wa.x; gd[1] += h[c] * wa.y; gd[2] += h[c] * wa.z; gd[3] += h[c] * wa.w; gd[4] += h[c] * wb.x; gd[5] += h[c] * wb.y; gd[6] += h[c] * wb.z; gd[7] += h[c] * wb.w; } }
                float gv;
                { const bool b1 = C.lane & 1, b2 = C.lane & 2, b3 = C.lane & 4; float a4[4], a2[2];
#pragma unroll
                    for (int q = 0; q < 4; ++q) { const float mine = b1 ? gd[q + 4] : gd[q], send = b1 ? gd[q] : gd[q + 4]; a4[q] = mine + xor_shfl<1>(send); }
#pragma unroll
                    for (int q = 0; q < 2; ++q) { const float mine = b2 ? a4[q + 2] : a4[q], send = b2 ? a4[q] : a4[q + 2]; a2[q] = mine + xor_shfl<2>(send); }
                    { const float mine = b3 ? a2[1] : a2[0], send = b3 ? a2[0] : a2[1]; gv = mine + xor_shfl<4>(send); }
                    gv += xor_shfl<8>(gv); gv += xor_shfl<16>(gv); gv = pair_sum(gv); }
                if (C.lane < 8) { const int q = 4 * (C.lane & 1) + 2 * ((C.lane >> 1) & 1) + ((C.lane >> 2) & 1);
                    const float val = gv + gb[q];
                    float r;
                    if (q < 4) r = 15.f * tanhf(val * (1.f / 15.f));
                    else r = (val < 0.f) ? (val - log1pf(expf(val))) : -log1pf(expf(-val));
                    GL[rl * 8 + q] = r; }
            }
        }
        if (layer < 2) {
            __syncthreads();
            if (C.wave < 4) { const int hh = C.wave, t = C.lane; const float lf = GL[t * 8 + 4 + hh], ig = GL[t * 8 + hh];
                float b = lf;
#pragma unroll
                for (int o = 1; o < 64; o <<= 1) { const float u = lane_up(b, t, o); if (t >= o) b += u; }
                const float bl = lane_get(b, 63); const float gm = wave_max(bl - b + ig);
                wsp<float>(C, WS_BC)[(size_t)(row0 + t) * 4 + hh] = b; wsp<float>(C, WS_IG)[(size_t)(row0 + t) * 4 + hh] = ig;
                if (t == 0) { const int bb = row0 / SEQ, c = (row0 % SEQ) / 64; wsp<float>(C, WS_BLAST)[(bb * 4 + hh) * 128 + c] = bl; wsp<float>(C, WS_GMAX)[(bb * 4 + hh) * 128 + c] = gm; } }
            __syncthreads();
        }
    }
}
__device__ __forceinline__ void mscan(const Ctx& C, int bh, LAS float* MV) {
    const float* bl = wsp<float>(C, WS_BLAST) + bh * 128; const float* gm = wsp<float>(C, WS_GMAX) + bh * 128; const int i = C.lane;
    const float a0 = bl[2 * i], g0 = gm[2 * i], a1 = bl[2 * i + 1], g1 = gm[2 * i + 1];
    float Aa = a0 + a1, Gg = fmaxf(g0 + a1, g1);
#pragma unroll
    for (int o = 1; o < 64; o <<= 1) { const float Ap = lane_up(Aa, i, o), Gp = lane_up(Gg, i, o); if (i >= o) { Gg = fmaxf(Gp + Aa, Gg); Aa = Ap + Aa; } }
    float Ax = lane_up(Aa, i, 1), Gx = lane_up(Gg, i, 1); if (i == 0) { Ax = 0.f; Gx = -INFINITY; }
    if (i == 0) MV[0] = 0.f;
    MV[2 * i + 1] = fmaxf(Ax + a0, fmaxf(Gx + a0, g0));
    MV[2 * i + 2] = fmaxf(Aa, Gg);
}
template <int ST> __device__ __forceinline__ void stage_conv(const Ctx& C, const bf16* src  , int row0, int seq0, const float* cw  , const float* cb, const LAS float* rs, float sc, LAS unsigned char* dst) {
#pragma unroll
    for (int i = 0; i < 2; ++i) { const int task = C.tid + NTHR * i, t = task >> 4, ch = task & 15;
        float y[8];
        { const f32x4 b0 = *(const GAS f32x4*)(cb + ch * 8), b1 = *(const GAS f32x4*)(cb + ch * 8 + 4); y[0] = b0.x; y[1] = b0.y; y[2] = b0.z; y[3] = b0.w; y[4] = b1.x; y[5] = b1.y; y[6] = b1.z; y[7] = b1.w; }
#pragma unroll
        for (int j = 0; j < 4; ++j) { const int row = row0 + t - j;
            if (row >= seq0) { const u32x4 u = *(const GAS u32x4*)(src + (size_t)row * 512 + ch * 8);
                const f32x4 w0 = *(const GAS f32x4*)(cw + j * 1024 + ch * 8), w1 = *(const GAS f32x4*)(cw + j * 1024 + ch * 8 + 4);
                y[0] += w0.x * bflo(u.x); y[1] += w0.y * bfhi(u.x); y[2] += w0.z * bflo(u.y); y[3] += w0.w * bfhi(u.y); y[4] += w1.x * bflo(u.z); y[5] += w1.y * bfhi(u.z); y[6] += w1.z * bflo(u.w); y[7] += w1.w * bfhi(u.w); } }
        const float s = (rs ? rs[t] : 1.f) * sc;
#pragma unroll
        for (int q = 0; q < 8; ++q) y[q] = y[q] * sigm(y[q]) * s;
        u32x4 o; o.x = pk2(y[0], y[1]); o.y = pk2(y[2], y[3]); o.z = pk2(y[4], y[5]); o.w = pk2(y[6], y[7]);
        *(LAS u32x4*)(dst + t * (ST * 2) + ch * 16) = o; }
}
template <int ST> __device__ __forceinline__ void stage_raw128(const Ctx& C, const bf16* src  , int row0, LAS unsigned char* dst) {
#pragma unroll
    for (int i = 0; i < 2; ++i) { const int task = C.tid + NTHR * i, t = task >> 4, ch = task & 15;
        *(LAS u32x4*)(dst + t * (ST * 2) + ch * 16) = *(const GAS u32x4*)(src + (size_t)(row0 + t) * 512 + ch * 8); }
}
__device__ __forceinline__ const LAS unsigned char* tr_addr(const LAS unsigned char* base, int stride_b, int r0, int c0, int lane) {
    return base + (r0 + ((lane & 15) >> 2)) * stride_b + (c0 + 16 * ((lane >> 4) & 1) + 4 * (lane & 3)) * 2;
}
constexpr int ML_MV = 0, ML_BC = 1024, ML_GS = 1280, ML_RS = 1536, ML_NV = 2048, ML_SC = 2560, ML_KT = 4608, ML_VT = ML_KT + 20480, ML_QT = ML_VT + 20480, ML_CT = ML_QT + 17408, ML_END = ML_CT + 34816, ML_OUT = ML_KT;
static_assert(ML_END <= RING_BYTES, "mLSTM LDS map");
__device__ __forceinline__ void mlstm_u_item(const Args& A, const Ctx& C0, int layer, int bh, int c, bool scan, bool pref  ) {
    Ctx C = C0; asm volatile("" : "+v"(C.tid), "+v"(C.lane));
    LAS float* MV = (LAS float*)(C.lds + ML_MV); LAS float* RS = (LAS float*)(C.lds + ML_RS);
    LAS unsigned char* KT = C.lds + ML_KT; LAS unsigned char* VT = C.lds + ML_VT;
    const int b = bh >> 2, hh = bh & 3, row0 = b * SEQ + c * 64, seq0 = b * SEQ, lane = C.lane, hi = lane >> 5, r32 = lane & 31;
    if (scan) { if (C.wave == 0) mscan(C, bh, MV); __syncthreads(); }
    if (C.tid < 64) { const float bl = wsp<float>(C, WS_BLAST)[bh * 128 + c];
        RS[C.tid] = __expf(bl - wsp<float>(C, WS_BC)[(size_t)(row0 + C.tid) * 4 + hh] + wsp<float>(C, WS_IG)[(size_t)(row0 + C.tid) * 4 + hh] - MV[c + 1]); }
    __syncthreads();
    stage_conv<160>(C, proj(C, PJ_AK) + hh * 128, row0, seq0, A.in[3] + layer * 4096 + 512 + hh * 128, A.in[4] + layer * 1024 + 512 + hh * 128, RS, 0.08838834764831845f, KT);
    stage_raw128<160>(C, proj(C, PJ_AV) + hh * 128, row0, VT);
    __syncthreads();
    unsigned pf0 = 0u;
    if (pref) { const int t = C.tid, rown = row0 + 64; const char* p0 = nullptr;
        if (t < 134) p0 = (const char*)(proj(C, PJ_AK) + (size_t)(rown - 3 + (t >> 1)) * 512 + hh * 128) + (t & 1) * 128;
        else if (t < 262) { const int q = t - 134; p0 = (const char*)(proj(C, PJ_AV) + (size_t)(rown + (q >> 1)) * 512 + hh * 128) + (q & 1) * 128; }
        else if (t < 270) p0 = (const char*)(wsp<float>(C, WS_BC) + (size_t)(rown + (t - 262) * 8) * 4);
        else if (t < 278) p0 = (const char*)(wsp<float>(C, WS_IG) + (size_t)(rown + (t - 270) * 8) * 4);
        if (p0) pf0 = *(const GAS unsigned*)p0; }
    const int eb = C.wave >> 1, db0 = (C.wave & 1) * 2;
    f32x16 acc0 = {}, acc1 = {};
#pragma unroll
    for (int st = 0; st < 4; ++st) { const int t0 = 16 * st + 8 * hi;
        const bf16x8 af = cat8(tr16(tr_addr(VT, 320, t0, 32 * eb, lane)), tr16(tr_addr(VT, 320, t0 + 4, 32 * eb, lane)));
        const bf16x8 b0 = cat8(tr16(tr_addr(KT, 320, t0, 32 * db0, lane)), tr16(tr_addr(KT, 320, t0 + 4, 32 * db0, lane)));
        const bf16x8 b1 = cat8(tr16(tr_addr(KT, 320, t0, 32 * db0 + 32, lane)), tr16(tr_addr(KT, 320, t0 + 4, 32 * db0 + 32, lane)));
        acc0 = MFMA32(af, b0, acc0); acc1 = MFMA32(af, b1, acc1); }
    bf16* U = wsp<bf16>(C, WS_HB) + (size_t)(bh * 128 + c) * 16384;
    if (C.tid < 128) { float s = 0.f;
        for (int t = 0; t < 64; ++t) s += bflo((unsigned)*(const LAS bf16*)(KT + t * 320 + C.tid * 2));
        wsp<float>(C, WS_NUC)[(size_t)(bh * 128 + c) * 128 + C.tid] = s; }
    __syncthreads();
    { LAS bf16* US = (LAS bf16*)(C.lds + ML_KT);
#pragma unroll
        for (int r = 0; r < 16; ++r) { const int e = 32 * eb + crow(r, hi);
            US[e * 136 + 32 * db0 + r32] = (bf16)(pk2(acc0[r], 0.f) & 0xffffu); US[e * 136 + 32 * db0 + 32 + r32] = (bf16)(pk2(acc1[r], 0.f) & 0xffffu); }
        __syncthreads();
#pragma unroll
        for (int i = 0; i < 4; ++i) { const int task = C.tid + NTHR * i, e = task >> 4, ch = task & 15; *(GAS u32x4*)(U + e * 128 + ch * 8) = *(const LAS u32x4*)(US + e * 136 + ch * 8); } }
    asm volatile("" :: "v"(pf0));
    __syncthreads();
}
__device__ __forceinline__ void qknorm_rows(const Args& A, const Ctx& C, int layer) {
    const int gw = C.vcu * NWAVES + C.wave, NGW = C.G * NWAVES, lane = C.lane;
    for (int it = gw; it < NTOK * 4; it += NGW) { const int which = it & 3, row = it >> 2;
        bf16* p = proj(C, which == 0 ? PJ_BQ : which == 1 ? PJ_BK : which == 2 ? PJ_CQ : PJ_CK) + (size_t)row * 512 + lane * 8;
        const float* g = (which < 2 ? A.in[7] : A.in[9]) + layer * 128 + (which & 1) * 64 + (lane & 7) * 8;
        const u32x4 u = *(const GAS u32x4*)p; const f32x4 g0 = *(const GAS f32x4*)g, g1 = *(const GAS f32x4*)(g + 4);
        float v[8] = {bflo(u.x), bfhi(u.x), bflo(u.y), bfhi(u.y), bflo(u.z), bfhi(u.z), bflo(u.w), bfhi(u.w)}; float ss = 0.f;
#pragma unroll
        for (int i = 0; i < 8; ++i) ss += v[i] * v[i];
        ss += xor_shfl<1>(ss); ss += xor_shfl<2>(ss); ss += xor_shfl<4>(ss);
        const float rinv = rsqrtf(ss * (1.f / 64.f) + EPS) * ((which & 1) ? 1.f : 0.125f * LOG2E);
        const u32x4 o = {pk2(v[0] * rinv * g0.x, v[1] * rinv * g0.y), pk2(v[2] * rinv * g0.z, v[3] * rinv * g0.w), pk2(v[4] * rinv * g1.x, v[5] * rinv * g1.y), pk2(v[6] * rinv * g1.z, v[7] * rinv * g1.w)};
        *(GAS u32x4*)p = o; }
}
__device__ __forceinline__ void mlstm_scan(const Ctx& C) {
    LAS float* MV = (LAS float*)(C.lds + ML_MV); LAS float* DEC = (LAS float*)(C.lds + ML_RS);
    for (int w = C.vcu; w < 256; w += C.G) { const int bh = w >> 4, sl = w & 15;
        if (C.wave == 0) mscan(C, bh, MV);
        __syncthreads();
        if (C.tid < 128) DEC[C.tid] = __expf(wsp<float>(C, WS_BLAST)[bh * 128 + C.tid] + MV[C.tid] - MV[C.tid + 1]);
        __syncthreads();
        GAS unsigned* p = (GAS unsigned*)(wsp<unsigned>(C, WS_HB) + (size_t)bh * 128 * 8192 + sl * 512 + C.tid);
        float s0 = 0.f, s1 = 0.f;
        for (int c0 = 0; c0 < 128; c0 += 32) { unsigned u[32];
#pragma unroll
            for (int q = 0; q < 32; ++q) u[q] = p[(size_t)(c0 + q) * 8192];
#pragma unroll
            for (int q = 0; q < 32; ++q) { p[(size_t)(c0 + q) * 8192] = pk2(s0, s1); const float d = DEC[c0 + q]; s0 = d * s0 + bflo(u[q]); s1 = d * s1 + bfhi(u[q]); } }
        if (sl == 0 && C.tid < 128) { GAS float* np = (GAS float*)(wsp<float>(C, WS_NUC) + (size_t)bh * 128 * 128 + C.tid); float s = 0.f;
            for (int c0 = 0; c0 < 128; c0 += 16) { float u[16];
#pragma unroll
                for (int q = 0; q < 16; ++q) u[q] = np[(c0 + q) * 128];
#pragma unroll
                for (int q = 0; q < 16; ++q) { np[(c0 + q) * 128] = s; s = DEC[c0 + q] * s + u[q]; } } }
        __syncthreads();
    }
}
__device__ __forceinline__ void mlstm_out_item(const Args& A, const Ctx& C0, int layer, int bh, int c, bool scan, bool pref  , bf16* habase = nullptr  ) {
    Ctx C = C0; asm volatile("" : "+v"(C.tid), "+v"(C.lane));
    LAS float* MV = (LAS float*)(C.lds + ML_MV); LAS float* BC = (LAS float*)(C.lds + ML_BC); LAS float* GS = (LAS float*)(C.lds + ML_GS); LAS float* NV = (LAS float*)(C.lds + ML_NV);
    LAS float* SC = (LAS float*)(C.lds + ML_SC) + C.wave * 64;
    LAS unsigned char* KT = C.lds + ML_KT; LAS unsigned char* VT = C.lds + ML_VT; LAS unsigned char* QT = C.lds + ML_QT; LAS unsigned char* CT = C.lds + ML_CT; LAS float* OUT = (LAS float*)(C.lds + ML_OUT);
    const int b = bh >> 2, hh = bh & 3, row0 = b * SEQ + c * 64, seq0 = b * SEQ, lane = C.lane, hi = lane >> 5, r32 = lane & 31;
    if (scan && C.wave == 0) mscan(C, bh, MV);
    if (C.tid >= 64 && C.tid < 128) { const int t = C.tid - 64; const float bc = wsp<float>(C, WS_BC)[(size_t)(row0 + t) * 4 + hh]; BC[t] = bc; GS[t] = wsp<float>(C, WS_IG)[(size_t)(row0 + t) * 4 + hh] - bc; }
    if (C.tid >= 128 && C.tid < 256) NV[C.tid - 128] = wsp<float>(C, WS_NUC)[(size_t)(bh * 128 + c) * 128 + C.tid - 128];
    stage_conv<136>(C, proj(C, PJ_AQ) + hh * 128, row0, seq0, A.in[3] + layer * 4096 + hh * 128, A.in[4] + layer * 1024 + hh * 128, nullptr, 1.f, QT);
    stage_conv<136>(C, proj(C, PJ_AK) + hh * 128, row0, seq0, A.in[3] + layer * 4096 + 512 + hh * 128, A.in[4] + layer * 1024 + 512 + hh * 128, nullptr, 0.08838834764831845f, KT);
    stage_raw128<160>(C, proj(C, PJ_AV) + hh * 128, row0, VT);
    { const bf16* cs = wsp<bf16>(C, WS_HB) + (size_t)(bh * 128 + c) * 16384;
#pragma unroll
        for (int i = 0; i < 4; ++i) { const int task = C.tid + NTHR * i, e = task >> 4, ch = task & 15; *(LAS u32x4*)(CT + e * 272 + ch * 16) = *(const GAS u32x4*)(cs + e * 128 + ch * 8); } }
    __syncthreads();
    unsigned pf0 = 0u, pf1 = 0u;
    { const int t = C.tid; const char* p0 = nullptr; const char* p1 = nullptr;
        if (t < 128) p0 = (const char*)(proj(C, PJ_AO) + (size_t)(row0 + (t >> 1)) * 512 + hh * 128) + (t & 1) * 128;
        if (pref) { const int rown = row0 + 64;
            if (t >= 128 && t < 262) { const int q = t - 128; p0 = (const char*)(proj(C, PJ_AQ) + (size_t)(rown - 3 + (q >> 1)) * 512 + hh * 128) + (q & 1) * 128; }
            else if (t >= 262 && t < 396) { const int q = t - 262; p0 = (const char*)(proj(C, PJ_AK) + (size_t)(rown - 3 + (q >> 1)) * 512 + hh * 128) + (q & 1) * 128; }
            else if (t >= 396) { const int q = t - 396; p0 = (const char*)(proj(C, PJ_AV) + (size_t)(rown + (q >> 1)) * 512 + hh * 128) + (q & 1) * 128; }
            if (t < 12) { const int q = t + 116; p1 = (const char*)(proj(C, PJ_AV) + (size_t)(rown + (q >> 1)) * 512 + hh * 128) + (q & 1) * 128; }
            else if (t < 268) p1 = (const char*)(wsp<bf16>(C, WS_HB) + (size_t)(bh * 128 + c + 1) * 16384) + (t - 12) * 128; }
        if (p0) pf0 = *(const GAS unsigned*)p0;
        if (p1) pf1 = *(const GAS unsigned*)p1; }
    const float mc = MV[c]; const int lb = C.wave >> 2, cb = C.wave & 3, lq = 32 * lb + r32; const float bl = BC[lq];
    bf16x8 qf[8];
#pragma unroll
    for (int st = 0; st < 8; ++st) qf[st] = *(const LAS bf16x8*)(QT + lq * 272 + (16 * st + 8 * hi) * 2);
    f32x16 p0 = {}, p1 = {};
#pragma unroll
    for (int st = 0; st < 8; ++st) p0 = MFMA32(*(const LAS bf16x8*)(KT + r32 * 272 + (16 * st + 8 * hi) * 2), qf[st], p0);
    if (lb == 1) {
#pragma unroll
        for (int st = 0; st < 8; ++st) p1 = MFMA32(*(const LAS bf16x8*)(KT + (32 + r32) * 272 + (16 * st + 8 * hi) * 2), qf[st], p1); }
    f32x16 d0, d1; float mt = bl + mc;
#pragma unroll
    for (int r = 0; r < 16; ++r) { const int s = crow(r, hi); d0[r] = (s <= lq) ? bl + GS[s] : -INFINITY; mt = fmaxf(mt, d0[r]); }
#pragma unroll
    for (int r = 0; r < 16; ++r) { const int s = 32 + crow(r, hi); d1[r] = (lb == 1 && s <= lq) ? bl + GS[s] : -INFINITY; mt = fmaxf(mt, d1[r]); }
    mt = pair_max(mt);
    float rs = 0.f;
#pragma unroll
    for (int r = 0; r < 16; ++r) { p0[r] *= __expf(d0[r] - mt); p1[r] *= __expf(d1[r] - mt); rs += p0[r] + p1[r]; }
    rs = pair_sum(rs);
    float qn = 0.f;
#pragma unroll
    for (int st = 0; st < 8; ++st) { const f32x4 n0 = *(const LAS f32x4*)(NV + 16 * st + 8 * hi), n1 = *(const LAS f32x4*)(NV + 16 * st + 8 * hi + 4); const u32x4 q = __builtin_bit_cast(u32x4, qf[st]);
        qn += bflo(q.x) * n0.x + bfhi(q.x) * n0.y + bflo(q.y) * n0.z + bfhi(q.y) * n0.w + bflo(q.z) * n1.x + bfhi(q.z) * n1.y + bflo(q.w) * n1.z + bfhi(q.w) * n1.w; }
    qn = pair_sum(qn);
    const float wi = __expf(bl + mc - mt), den = wi * qn + rs, dn = fmaxf(fabsf(den), __expf(-mt));
    SC[r32] = wi / dn; SC[32 + r32] = 1.f / dn;
    f32x16 acc1 = {}, acc2 = {};
#define PKF(P, B) (bf16x8)__builtin_bit_cast(bf16x8, ((u32x4){pk2(P[B], P[B + 1]), pk2(P[B + 2], P[B + 3]), pk2(P[B + 4], P[B + 5]), pk2(P[B + 6], P[B + 7])}))
#pragma unroll
    for (int s2 = 0; s2 < 2; ++s2) { const int k0 = 16 * s2;
        const bf16x8 vf = cat8(tr16(tr_addr(VT, 320, k0 + 4 * hi, 32 * cb, lane)), tr16(tr_addr(VT, 320, k0 + 8 + 4 * hi, 32 * cb, lane)));
        acc2 = MFMA32(s2 == 0 ? PKF(p0, 0) : PKF(p0, 8), vf, acc2); }
    if (lb == 1) {
#pragma unroll
        for (int s2 = 0; s2 < 2; ++s2) { const int k0 = 32 + 16 * s2;
            const bf16x8 vf = cat8(tr16(tr_addr(VT, 320, k0 + 4 * hi, 32 * cb, lane)), tr16(tr_addr(VT, 320, k0 + 8 + 4 * hi, 32 * cb, lane)));
            acc2 = MFMA32(s2 == 0 ? PKF(p1, 0) : PKF(p1, 8), vf, acc2); } }
#undef PKF
#pragma unroll
    for (int st = 0; st < 8; ++st) acc1 = MFMA32(qf[st], *(const LAS bf16x8*)(CT + (32 * cb + r32) * 272 + (16 * st + 8 * hi) * 2), acc1);
    __syncthreads();
#pragma unroll
    for (int r = 0; r < 16; ++r) { const int l_ = crow(r, hi); OUT[(32 * lb + l_) * 132 + 32 * cb + r32] = SC[l_] * acc1[r] + SC[32 + l_] * acc2[r]; }
    __syncthreads();
    { const int row = C.tid >> 3, seg = C.tid & 7; float v[16]; float ss = 0.f;
#pragma unroll
        for (int q = 0; q < 4; ++q) { const f32x4 x = *(const LAS f32x4*)(OUT + row * 132 + seg * 16 + 4 * q); v[4 * q] = x.x; v[4 * q + 1] = x.y; v[4 * q + 2] = x.z; v[4 * q + 3] = x.w; ss += (x.x * x.x + x.y * x.y) + (x.z * x.z + x.w * x.w); }
        ss += xor_shfl<1>(ss); ss += xor_shfl<2>(ss); ss += xor_shfl<4>(ss);
        const float rinv = rsqrtf(ss * (1.f / 128.f) + EPS);
        const float* gn = A.in[6] + layer * 512 + hh * 128 + seg * 16;
        const bf16* ao = proj(C, PJ_AO) + (size_t)(row0 + row) * 512 + hh * 128 + seg * 16;
        bf16* ha = (habase ? habase : proj(C, PJ_AV)) + (size_t)(row0 + row) * 512 + hh * 128 + seg * 16;
#pragma unroll
        for (int q = 0; q < 2; ++q) { const u32x4 a = *(const GAS u32x4*)(ao + 8 * q); const f32x4 g0 = *(const GAS f32x4*)(gn + 8 * q), g1 = *(const GAS f32x4*)(gn + 8 * q + 4); const float* vv = v + 8 * q;
            u32x4 o; o.x = pk2(vv[0] * rinv * g0.x * sigm(bflo(a.x)), vv[1] * rinv * g0.y * sigm(bfhi(a.x))); o.y = pk2(vv[2] * rinv * g0.z * sigm(bflo(a.y)), vv[3] * rinv * g0.w * sigm(bfhi(a.y)));
            o.z = pk2(vv[4] * rinv * g1.x * sigm(bflo(a.z)), vv[5] * rinv * g1.y * sigm(bfhi(a.z))); o.w = pk2(vv[6] * rinv * g1.z * sigm(bflo(a.w)), vv[7] * rinv * g1.w * sigm(bfhi(a.w)));
            *(GAS u32x4*)(ha + 8 * q) = o; } }
    asm volatile("" :: "v"(pf0), "v"(pf1));
    __syncthreads();
}
constexpr int AT_TAB = 0, AT_SCR = 3072, AT_K = 5120;
template <int DV, bool ISC> __device__ __forceinline__ void attn_unit(const Args& A, const Ctx& C0, int layer, int b, int hs, int qblk, bf16* obase = nullptr  ) {
    Ctx C = C0; asm volatile("" : "+v"(C.tid), "+v"(C.lane));
    constexpr int KSTB = 144, VSTB = 2 * DV + 64, KB = 64 * KSTB, VB = 64 * VSTB, AT_V = AT_K + 4 * KB, NBLK = DV / 32;
    static_assert(AT_V + 4 * VB <= RING_BYTES, "attention LDS map");
    LAS float* TAB = (LAS float*)(C.lds + AT_TAB); LAS float* SCR = (LAS float*)(C.lds + AT_SCR) + C.wave * 64;
    const int lane = C.lane, hi = lane >> 5, r32 = lane & 31, tid = C.tid;
    const bf16 *Qp, *Kp, *Vp; bf16* Op; int pitchO; const float *gq, *gk; int hbias;
    if (ISC) { const int h = hs >> 1, wh = hs & 1; Qp = proj(C, PJ_CQ) + h * 128 + wh * 64; Kp = proj(C, PJ_CK) + h * 128 + wh * 64; Vp = proj(C, PJ_CV) + h * 128;
        Op = wsp<bf16>(C, WS_O12) + h * 256 + wh * 128; pitchO = 1024; gq = A.in[9] + layer * 128; gk = gq + 64; hbias = h; }
    else { Qp = proj(C, PJ_BQ) + hs * 64; Kp = proj(C, PJ_BK) + hs * 64; Vp = proj(C, PJ_BV) + hs * 64; Op = (obase ? obase : proj(C, PJ_BQ)) + hs * 64; pitchO = 512; gq = A.in[7] + layer * 128; gk = gq + 64; hbias = hs; }
    const size_t rowb = (size_t)b * SEQ;
    const int qs0 = qblk * 256 + C.wave * 32;
    for (int i = tid; i < 768; i += NTHR) { const int d = 703 - i; float v;
        if (ISC) { const int n = d < 0 ? -d : d; int bk = n < 8 ? n : n < 15 ? 8 : n < 27 ? 9 : n < 50 ? 10 : n < 91 ? 11 : n < 166 ? 12 : n < 305 ? 13 : n < 559 ? 14 : 15; if (d < 0) bk += 16; v = A.in[12][bk * 4 + hbias]; }
        else { const int dc = d < -256 ? -256 : d > 256 ? 256 : d; v = A.in[8][(size_t)layer * 513 * 8 + (dc + 256) * 8 + hbias]; }
        TAB[i] = v * LOG2E; }
    float MB;
    { const float gqm = wave_max(fabsf(gq[lane])), gkm = wave_max(fabsf(gk[lane]));
        float bm = 0.f;
        if (ISC) { bm = (lane < 32) ? fabsf(A.in[12][lane * 4 + hbias]) : 0.f; }
        else { for (int i = lane; i < 513; i += 64) bm = fmaxf(bm, fabsf(A.in[8][(size_t)layer * 513 * 8 + i * 8 + hbias])); }
        bm = wave_max(bm);
        MB = 64.f * (0.125f * LOG2E) * gqm * gkm * 1.02f + bm * LOG2E; }
    const float t15 = (ISC ? A.in[12][15 * 4 + hbias] * LOG2E : 0.f) - MB;
    bf16x8 qf[4];
    { float qv[32]; float ss = 0.f; const bf16* qrow = Qp + (rowb + qs0 + r32) * 512 + 8 * hi;
#pragma unroll
        for (int st = 0; st < 4; ++st) { const u32x4 u = *(const GAS u32x4*)(qrow + 16 * st);
            qv[8 * st] = bflo(u.x); qv[8 * st + 1] = bfhi(u.x); qv[8 * st + 2] = bflo(u.y); qv[8 * st + 3] = bfhi(u.y); qv[8 * st + 4] = bflo(u.z); qv[8 * st + 5] = bfhi(u.z); qv[8 * st + 6] = bflo(u.w); qv[8 * st + 7] = bfhi(u.w); }
#pragma unroll
        for (int i = 0; i < 32; ++i) ss += qv[i] * qv[i];
        ss = pair_sum(ss);
        const float rinv = rsqrtf(ss * (1.f / 64.f) + EPS) * (0.125f * LOG2E);
#pragma unroll
        for (int st = 0; st < 4; ++st) { const f32x4 g0 = *(const GAS f32x4*)(gq + 16 * st + 8 * hi) * *(const GAS f32x4*)(gk + 16 * st + 8 * hi), g1 = *(const GAS f32x4*)(gq + 16 * st + 8 * hi + 4) * *(const GAS f32x4*)(gk + 16 * st + 8 * hi + 4); const float* q = qv + 8 * st;
            const u32x4 o = {pk2(q[0] * rinv * g0.x, q[1] * rinv * g0.y), pk2(q[2] * rinv * g0.z, q[3] * rinv * g0.w), pk2(q[4] * rinv * g1.x, q[5] * rinv * g1.y), pk2(q[6] * rinv * g1.z, q[7] * rinv * g1.w)};
            qf[st] = __builtin_bit_cast(bf16x8, o); } }
    const int krow = tid >> 3, kch = tid & 7;
    const int jhi = qblk * 4 + 3, jlo = ISC ? 0 : (qblk * 4 - 8 < 0 ? 0 : qblk * 4 - 8), cqw = qblk * 4 + (C.wave >> 1);
    const bf16* ksrc = Kp + (rowb + krow) * 512 + kch * 8;
    u32x4 kregA, kregB, vregA[NBLK / 2], vregB[NBLK / 2];
#define AT_LOADT(j, KR, VR) do { KR = *(const GAS u32x4*)(ksrc + (size_t)(j) * 64 * 512); \
        if (DV == 128) { _Pragma("unroll") for (int i_ = 0; i_ < 2; ++i_) { const int idx = tid + NTHR * i_; VR[i_] = *(const GAS u32x4*)(Vp + (rowb + (size_t)(j) * 64 + (idx >> 4)) * 512 + (idx & 15) * 8); } } \
        else VR[0] = *(const GAS u32x4*)(Vp + (rowb + (size_t)(j) * 64 + krow) * 512 + kch * 8); } while (0)
    AT_LOADT(jlo, kregA, vregA); AT_LOADT(jlo + 1, kregB, vregB);
    float l = 0.f; f32x16 o[NBLK];
#pragma unroll
    for (int nb = 0; nb < NBLK; ++nb) o[nb] = f32x16{};
#define AT_VLOAD(F, nb_) do { _Pragma("unroll") for (int ks_ = 0; ks_ < 4; ++ks_) { F[2 * ks_] = tr16(vb_ + (16 * ks_) * VSTB + (nb_) * 64); F[2 * ks_ + 1] = tr16(vb_ + (16 * ks_ + 8) * VSTB + (nb_) * 64); } } while (0)
#define AT_STAGE(buf, KR, VR) do { \
        LAS unsigned char* KT = C.lds + AT_K + (buf) * KB; LAS unsigned char* VT = C.lds + AT_V + (buf) * VB; \
        { float kv[8] = {bflo(KR.x), bfhi(KR.x), bflo(KR.y), bfhi(KR.y), bflo(KR.z), bfhi(KR.z), bflo(KR.w), bfhi(KR.w)}; float ss = 0.f; \
            _Pragma("unroll") for (int i = 0; i < 8; ++i) ss += kv[i] * kv[i]; \
            ss += xor_shfl<1>(ss); ss += xor_shfl<2>(ss); ss += xor_shfl<4>(ss); \
            const float rinv = rsqrtf(ss * (1.f / 64.f) + EPS); \
            const u32x4 w = {pk2(kv[0] * rinv, kv[1] * rinv), pk2(kv[2] * rinv, kv[3] * rinv), pk2(kv[4] * rinv, kv[5] * rinv), pk2(kv[6] * rinv, kv[7] * rinv)}; \
            *(LAS u32x4*)(KT + krow * KSTB + kch * 16) = w; } \
        if (DV == 128) { _Pragma("unroll") for (int i_ = 0; i_ < 2; ++i_) { const int idx = tid + NTHR * i_; *(LAS u32x4*)(VT + (idx >> 4) * VSTB + (idx & 15) * 16) = VR[i_]; } } \
        else *(LAS u32x4*)(VT + krow * VSTB + kch * 16) = VR[0]; \
    } while (0)
#define AT_COMP(j, buf) do { \
        LAS unsigned char* KT = C.lds + AT_K + (buf) * KB; LAS unsigned char* VT = C.lds + AT_V + (buf) * VB; \
        const bool act = ((j) <= cqw) && (ISC || (j) >= cqw - 8); \
        if (act) { \
            f32x16 p0, p1; \
            const bool far = ISC && (qs0 - (64 * (j) + 63) >= 559); \
            if (far) { _Pragma("unroll") for (int r = 0; r < 16; ++r) { p0[r] = t15; p1[r] = t15; } } \
            else { const LAS float* tp = TAB + (703 - (qs0 + r32) + 64 * (j) + 4 * hi); \
                _Pragma("unroll") for (int r = 0; r < 16; ++r) { p0[r] = tp[(r & 3) + 8 * (r >> 2)] - MB; p1[r] = tp[32 + (r & 3) + 8 * (r >> 2)] - MB; } } \
            { bf16x8 kf[8]; \
                _Pragma("unroll") for (int st = 0; st < 4; ++st) { kf[2 * st] = *(const LAS bf16x8*)(KT + r32 * KSTB + (16 * st + 8 * hi) * 2); kf[2 * st + 1] = *(const LAS bf16x8*)(KT + (32 + r32) * KSTB + (16 * st + 8 * hi) * 2); } \
                __builtin_amdgcn_sched_barrier(0);        \
                _Pragma("unroll") for (int st = 0; st < 4; ++st) { p0 = MFMA32(kf[2 * st], qf[st], p0); p1 = MFMA32(kf[2 * st + 1], qf[st], p1); } } \
            float rs0 = 0.f, rs1 = 0.f, rs2 = 0.f, rs3 = 0.f;        \
            _Pragma("unroll") for (int r = 0; r < 16; r += 2) { p0[r] = __builtin_amdgcn_exp2f(p0[r]); p1[r] = __builtin_amdgcn_exp2f(p1[r]); p0[r + 1] = __builtin_amdgcn_exp2f(p0[r + 1]); p1[r + 1] = __builtin_amdgcn_exp2f(p1[r + 1]); \
                rs0 += p0[r]; rs1 += p1[r]; rs2 += p0[r + 1]; rs3 += p1[r + 1]; } \
            l += (rs0 + rs1) + (rs2 + rs3); \
            bf16x8 pw[4]; \
            pw[0] = PKF(p0, 0); pw[1] = PKF(p0, 8); pw[2] = PKF(p1, 0); pw[3] = PKF(p1, 8); \
            { s16x4 fa[8], fb[8]; const LAS unsigned char* vb_ = tr_addr(VT, VSTB, 4 * hi, 0, lane); \
                AT_VLOAD(fa, 0); \
                _Pragma("unroll") for (int nb = 0; nb < NBLK; nb += 2) { \
                    AT_VLOAD(fb, nb + 1); __builtin_amdgcn_sched_barrier(0); \
                    _Pragma("unroll") for (int ks = 0; ks < 4; ++ks) o[nb] = MFMA32(pw[ks], cat8(fa[2 * ks], fa[2 * ks + 1]), o[nb]); \
                    __builtin_amdgcn_sched_barrier(0); \
                    if (nb + 2 < NBLK) AT_VLOAD(fa, nb + 2); __builtin_amdgcn_sched_barrier(0); \
                    _Pragma("unroll") for (int ks = 0; ks < 4; ++ks) o[nb + 1] = MFMA32(pw[ks], cat8(fb[2 * ks], fb[2 * ks + 1]), o[nb + 1]); \
                    __builtin_amdgcn_sched_barrier(0); } } \
        } } while (0)
#define PKF(P, B) __builtin_bit_cast(bf16x8, ((u32x4){pk2(P[B], P[B + 1]), pk2(P[B + 2], P[B + 3]), pk2(P[B + 4], P[B + 5]), pk2(P[B + 6], P[B + 7])}))
    for (int j = jlo; j <= jhi; j += 2) { const int sb = (((j - jlo) >> 1) & 1) * 2;
        AT_STAGE(sb, kregA, vregA); AT_STAGE(sb + 1, kregB, vregB);
        __syncthreads();
        if (j + 2 <= jhi) { AT_LOADT(j + 2, kregA, vregA); AT_LOADT(j + 3, kregB, vregB); }
        AT_COMP(j, sb); AT_COMP(j + 1, sb + 1); }
#undef PKF
#undef AT_STAGE
#undef AT_COMP
#undef AT_VLOAD
#undef AT_LOADT
    l = pair_sum(l);
    SCR[32 + r32] = 1.f / l;
    bf16* orow = Op + (rowb + qs0) * pitchO;
#pragma unroll
    for (int r = 0; r < 16; ++r) { const int q = crow(r, hi); const float rl = SCR[32 + q];
#pragma unroll
        for (int nb = 0; nb < NBLK; ++nb) ((GAS bf16*)orow)[(size_t)q * pitchO + 32 * nb + r32] = (bf16)(pk2(o[nb][r] * rl, 0.f) & 0xffffu); }
    __syncthreads();
}
__device__ __forceinline__ void phase5(const Args& A, const Ctx& C, int layer) {
    const int gw = C.vcu * NWAVES + C.wave, NGW = C.G * NWAVES, lane = C.lane;
    const float lam_init = 0.8f - 0.6f * __expf(-0.3f * (float)layer);
    const float* cl = A.in[10] + layer * 256;
    const float lam = __expf(wave_sum(cl[lane] * cl[64 + lane])) - __expf(wave_sum(cl[128 + lane] * cl[192 + lane])) + lam_init;
    const float* gs = A.in[11] + layer * 128 + (lane & 15) * 8;
    const f32x4 gs0 = *(const GAS f32x4*)gs, gs1 = *(const GAS f32x4*)(gs + 4);
    const float post = 1.f - lam_init;
    const bf16* o12 = wsp<bf16>(C, WS_O12); bf16* hc = proj(C, PJ_CQ);
    const int h = lane >> 4, e0 = (lane & 15) * 8;
    for (int row0 = gw; row0 < NTOK; row0 += 4 * NGW) {
        u32x4 av[4], bv[4];
#pragma unroll
        for (int q = 0; q < 4; ++q) { const int row = row0 + q * NGW; if (row < NTOK) { av[q] = *(const GAS u32x4*)(o12 + (size_t)row * 1024 + h * 256 + e0); bv[q] = *(const GAS u32x4*)(o12 + (size_t)row * 1024 + h * 256 + 128 + e0); } }
#pragma unroll
        for (int q = 0; q < 4; ++q) { const int row = row0 + q * NGW; if (row < NTOK) { const u32x4 a = av[q], bq = bv[q];
            float v[8] = {bflo(a.x) - lam * bflo(bq.x), bfhi(a.x) - lam * bfhi(bq.x), bflo(a.y) - lam * bflo(bq.y), bfhi(a.y) - lam * bfhi(bq.y), bflo(a.z) - lam * bflo(bq.z), bfhi(a.z) - lam * bfhi(bq.z), bflo(a.w) - lam * bflo(bq.w), bfhi(a.w) - lam * bfhi(bq.w)};
            float ss = 0.f;
#pragma unroll
            for (int i = 0; i < 8; ++i) ss += v[i] * v[i];
            ss += xor_shfl<1>(ss); ss += xor_shfl<2>(ss); ss += xor_shfl<4>(ss); ss += xor_shfl<8>(ss);
            const float rinv = rsqrtf(ss * (1.f / 128.f) + EPS) * post;
            const u32x4 o = {pk2(v[0] * rinv * gs0.x, v[1] * rinv * gs0.y), pk2(v[2] * rinv * gs0.z, v[3] * rinv * gs0.w), pk2(v[4] * rinv * gs1.x, v[5] * rinv * gs1.y), pk2(v[6] * rinv * gs1.z, v[7] * rinv * gs1.w)};
            *(GAS u32x4*)(hc + (size_t)row * 512 + h * 128 + e0) = o; } }
    }
}
constexpr int RT_RSTD = 0, RT_HT = 1024, RT_WT = RT_HT + 128 * 68 * 4, RT_LOG = RT_WT + 128 * 40 * 4, RT_HIST = RT_LOG + 64 * 37 * 4, RT_BASE = RT_HIST + 128, RT_SEL = RT_BASE + 128, RT_G2S = RT_SEL + 64 * 4 * 4, RT_END = RT_G2S + 4096, RT_RED = RT_HT;
static_assert(RT_END <= RING_BYTES && 2 * 64 * 64 * 4 <= RT_LOG - RT_HT && 3 * 64 * 272 <= RT_LOG - RT_HT, "routing LDS map");
#ifndef P9PARTS
#define P9PARTS 15
#endif
__device__ __forceinline__ void phase9(const Args& A, const Ctx& C, int layer, bool dummy = false  ) {
    const int parts = dummy ? (P9PARTS) : 15;
    const size_t doff = dummy ? (476 * MiB) : 0;
    if (parts & 1) moe_weight_items(A, C, layer);
    __syncthreads();
    for (int i = C.tid; i < 1024; i += NTHR) ((LAS float*)(C.lds + RT_G2S))[i] = (A.in[15] + layer * 1024)[i];
    LAS float* RSTD = (LAS float*)(C.lds + RT_RSTD); LAS float* HT = (LAS float*)(C.lds + RT_HT); LAS float* WT = (LAS float*)(C.lds + RT_WT); LAS float* LOG = (LAS float*)(C.lds + RT_LOG); LAS float* RED = (LAS float*)(C.lds + RT_RED);
    LAS int* HIST = (LAS int*)(C.lds + RT_HIST); LAS int* BASE = (LAS int*)(C.lds + RT_BASE); LAS int* SEL = (LAS int*)(C.lds + RT_SEL);
    const float* g2 = A.in[15] + layer * 1024; const float* wg = A.in[16] + layer * 4096; const float* bg = A.in[17] + layer * 4; const float* wr = A.in[18] + layer * 32768; const float* br = A.in[19] + layer * 32;
    bf16* h2 = wsp<bf16>(C, dummy ? 128 * MiB : WS_H2); const bf16* xb1 = wsp<bf16>(C, WS_XB1); const int lane = C.lane, tid = C.tid, wv = C.wave;
    for (int item = C.vcu; item < NTOK / 64; item += C.G) {
        const int row0 = item * 64;
        if (tid < 32) HIST[tid] = 0;
        f32x4 vnx[4];
        {
#pragma unroll
            for (int j = 0; j < 4; ++j) vnx[j] = ldrow4(xb1, true, (size_t)(row0 + wv * 8), lane + 64 * j); }
        for (int i = 0; i < ((parts & 2) ? 8 : 0); ++i) { const int rl = wv * 8 + i, row = row0 + rl;
            f32x4 v[4]; float ss = 0.f;
#pragma unroll
            for (int j = 0; j < 4; ++j) { v[j] = vnx[j]; ss += (v[j].x * v[j].x + v[j].y * v[j].y) + (v[j].z * v[j].z + v[j].w * v[j].w); }
            if (i < 7) {
#pragma unroll
                for (int j = 0; j < 4; ++j) vnx[j] = ldrow4(xb1, true, (size_t)(row + 1), lane + 64 * j); }
            const float rstd = rsqrtf(wave_sum(ss) * (1.f / DM) + EPS);
            GAS u32x2* ho = (GAS u32x2*)(h2 + (size_t)row * DM) + lane;
#pragma unroll
            for (int j = 0; j < 4; ++j) { const f32x4 g = ((const GAS f32x4*)g2)[64 * j + lane]; u32x2 o; o.x = pk2(v[j].x * rstd * g.x, v[j].y * rstd * g.y); o.y = pk2(v[j].z * rstd * g.z, v[j].w * rstd * g.w); ho[64 * j] = o; }
            if (lane == 0) RSTD[rl] = rstd; }
        __syncthreads();
        if (parts & 4) {
            const int rb = wv & 1, cb = (wv >> 1) & 1, kh = wv >> 2, r32 = lane & 31, hh = lane >> 5;
            const float rs = RSTD[32 * rb + r32];
            LAS unsigned char* XS_ = C.lds + RT_HT; LAS unsigned char* WH = XS_ + 64 * 272; LAS unsigned char* WL = WH + 64 * 272; const LAS float* G2S = (const LAS float*)(C.lds + RT_G2S);
            const bf16* wrt = wsp<bf16>(C, WS_WRT);
            u32x4 xr[2], whr[2], wlr[2];
#define RT_LD(kc_) do { _Pragma("unroll") for (int i_ = 0; i_ < 2; ++i_) { const int idx = tid + NTHR * i_, t = idx >> 4, ch = idx & 15; \
                xr[i_] = *(const GAS u32x4*)(xb1 + (size_t)(row0 + t) * DM + (kc_) * 128 + ch * 8); whr[i_] = *(const GAS u32x4*)(wrt + (size_t)t * DM + (kc_) * 128 + ch * 8); wlr[i_] = *(const GAS u32x4*)(wrt + 65536 + (size_t)t * DM + (kc_) * 128 + ch * 8); } } while (0)
            RT_LD(0);
            f32x16 acc = {};
            for (int kc = 0; kc < 8; ++kc) {
#pragma unroll
                for (int i_ = 0; i_ < 2; ++i_) { const int idx = tid + NTHR * i_, t = idx >> 4, ch = idx & 15;
                    *(LAS u32x4*)(XS_ + t * 272 + ch * 16) = xr[i_]; *(LAS u32x4*)(WH + t * 272 + ch * 16) = whr[i_]; *(LAS u32x4*)(WL + t * 272 + ch * 16) = wlr[i_]; }
                __syncthreads();
                if (kc < 7) RT_LD(kc + 1);
#pragma unroll
                for (int s = 0; s < 4; ++s) { const int ko = 16 * (kh * 4 + s) + 8 * hh;
                    const u32x4 xa = *(const LAS u32x4*)(XS_ + (32 * rb + r32) * 272 + ko * 2); const f32x4 ga = *(const LAS f32x4*)(G2S + kc * 128 + ko), gb = *(const LAS f32x4*)(G2S + kc * 128 + ko + 4);
                    const bf16x8 bhi = *(const LAS bf16x8*)(WH + (32 * cb + r32) * 272 + ko * 2), blo = *(const LAS bf16x8*)(WL + (32 * cb + r32) * 272 + ko * 2);
                    const float h0 = bflo(xa.x) * rs * ga.x, h1 = bfhi(xa.x) * rs * ga.y, h2_ = bflo(xa.y) * rs * ga.z, h3 = bfhi(xa.y) * rs * ga.w;
                    const float h4 = bflo(xa.z) * rs * gb.x, h5 = bfhi(xa.z) * rs * gb.y, h6 = bflo(xa.w) * rs * gb.z, h7 = bfhi(xa.w) * rs * gb.w;
                    const u32x4 hi4 = {pk2(h0, h1), pk2(h2_, h3), pk2(h4, h5), pk2(h6, h7)};
                    const u32x4 lo4 = {pk2(h0 - bflo(hi4.x), h1 - bfhi(hi4.x)), pk2(h2_ - bflo(hi4.y), h3 - bfhi(hi4.y)), pk2(h4 - bflo(hi4.z), h5 - bfhi(hi4.z)), pk2(h6 - bflo(hi4.w), h7 - bfhi(hi4.w))};
                    const bf16x8 ahi = __builtin_bit_cast(bf16x8, hi4), alo = __builtin_bit_cast(bf16x8, lo4);
                    acc = MFMA32(ahi, bhi, acc); acc = MFMA32(ahi, blo, acc); acc = MFMA32(alo, bhi, acc); }
                __syncthreads();
            }
#undef RT_LD
#pragma unroll
            for (int r_ = 0; r_ < 16; ++r_) RED[(kh * 64 + 32 * rb + crow(r_, hh)) * 64 + 32 * cb + r32] = acc[r_];
        }
        __syncthreads();
        { const int tok = tid & 63, cgr = tid >> 6;
#pragma unroll
            for (int c = 0; c < 4; ++c) { const int col = 4 * cgr + c; LOG[tok * 37 + col] = RED[tok * 64 + col] + RED[(64 + tok) * 64 + col] + br[col]; }
            if (cgr < 4) { const int col = 32 + cgr; LOG[tok * 37 + col] = RED[tok * 64 + col] + RED[(64 + tok) * 64 + col] + bg[cgr]; } }
        __syncthreads();
        if (tid < 64 && (parts & 8)) { const LAS float* lg = LOG + tid * 37;
            int gi = 0; float gmx = lg[32];
#pragma unroll
            for (int q = 1; q < 4; ++q) if (lg[32 + q] > gmx) { gmx = lg[32 + q]; gi = q; }
            float gsum = 0.f;
#pragma unroll
            for (int q = 0; q < 4; ++q) gsum += __expf(lg[32 + q] - gmx);
            const float pg = 1.f / gsum;
            const LAS float* el = lg + gi * 8; int i0 = 0; float e0 = el[0];
#pragma unroll
            for (int q = 1; q < 8; ++q) if (el[q] > e0) { e0 = el[q]; i0 = q; }
            int i1 = -1; float e1 = -INFINITY;
#pragma unroll
            for (int q = 0; q < 8; ++q) if (q != i0 && el[q] > e1) { e1 = el[q]; i1 = q; }
            const float x1 = __expf(e1 - e0), w0 = pg / (1.f + x1), w1 = pg * x1 / (1.f + x1);
            const int ea = gi * 8 + i0, eb = gi * 8 + i1;
            const int ra = atomicAdd((int*)(HIST + ea), 1), rb = atomicAdd((int*)(HIST + eb), 1);
            SEL[tid * 4 + 0] = ea; SEL[tid * 4 + 1] = eb; SEL[tid * 4 + 2] = ra; SEL[tid * 4 + 3] = rb;
            wsp<float>(C, WS_TOKW + doff)[(size_t)(row0 + tid) * 2] = w0; wsp<float>(C, WS_TOKW + doff)[(size_t)(row0 + tid) * 2 + 1] = w1; }
        __syncthreads();
        if (tid < 32) wsp<int>(C, WS_HISTG + doff)[item * 32 + tid] = HIST[tid];
        if (tid < 64) { wsp<int>(C, WS_TOKE + doff)[(size_t)(row0 + tid) * 2] = SEL[tid * 4]; wsp<int>(C, WS_TOKE + doff)[(size_t)(row0 + tid) * 2 + 1] = SEL[tid * 4 + 1];
            wsp<int>(C, WS_TOKR + doff)[(size_t)(row0 + tid) * 2] = SEL[tid * 4 + 2]; wsp<int>(C, WS_TOKR + doff)[(size_t)(row0 + tid) * 2 + 1] = SEL[tid * 4 + 3]; }
        __syncthreads();
    }
}
constexpr int P10_H = 0, P10_SEG = 65536, P10_BASE = P10_SEG + 16 * 32 * 4, P10_TOT = P10_BASE + 16 * 32 * 4;
__device__ __forceinline__ void phase10(const Ctx& C, int layer) {
    LAS int* H = (LAS int*)(C.lds + P10_H); LAS int* SEG = (LAS int*)(C.lds + P10_SEG); LAS int* SBASE = (LAS int*)(C.lds + P10_BASE); LAS int* TOT = (LAS int*)(C.lds + P10_TOT);
    LAS int* OFFS = (LAS int*)(C.lds + OFFS_OFF);
    { const int* hg = wsp<int>(C, WS_HISTG);
        for (int i = C.tid; i < 16384 / 4; i += NTHR) *(LAS u32x4*)(H + 4 * i) = *(const GAS u32x4*)(hg + 4 * i);
        __syncthreads();
        const int e = C.tid & 31, sg = C.tid >> 5; int s = 0;
        for (int i = 0; i < 32; ++i) s += H[(sg * 32 + i) * 32 + e];
        SEG[sg * 32 + e] = s;
        __syncthreads();
        if (C.tid < 32) { int run = 0; for (int q = 0; q < 16; ++q) { SBASE[q * 32 + C.tid] = run; run += SEG[q * 32 + C.tid]; } TOT[C.tid] = run; }
        __syncthreads();
        int run = SBASE[sg * 32 + e];
        for (int i = 0; i < 32; ++i) { const int v = H[(sg * 32 + i) * 32 + e]; H[(sg * 32 + i) * 32 + e] = run; run += v; }
        if (C.tid == 0) { int o = 0; for (int q = 0; q < 32; ++q) { OFFS[q] = o; o += (TOT[q] + 255) & ~255; } OFFS[32] = o; }
        __syncthreads(); }
    if (blockIdx.x == 0) { int* texp = wsp<int>(C, WS_TEXP); const int RT = OFFS[32] >> 8;
        for (int rt = C.tid; rt < RT; rt += NTHR) { int e = 0;
            for (int q = 1; q < 32; ++q) if (rt * 256 >= OFFS[q]) e = q;
            texp[rt] = e; }
        if (C.tid == 0) texp[511] = RT; }
    const int gw = C.vcu * NWAVES + C.wave, NGW = C.G * NWAVES, lane = C.lane;
    const bf16* h2 = wsp<bf16>(C, WS_H2); bf16* xs = wsp<bf16>(C, WS_XS); const int* toke = wsp<int>(C, WS_TOKE); const int* tokr = wsp<int>(C, WS_TOKR); int* tokp = wsp<int>(C, WS_TOKP);
    for (int s0 = gw; s0 < NTOK * 2; s0 += 4 * NGW) { int ev[4], rv[4]; u32x4 ra[4], rb[4];
#pragma unroll
        for (int q = 0; q < 4; ++q) { const int s = s0 + q * NGW; if (s < NTOK * 2) { ev[q] = toke[s]; rv[q] = tokr[s]; const GAS u32x4* src = (const GAS u32x4*)(h2 + (size_t)(s >> 1) * DM) + lane; ra[q] = src[0]; rb[q] = src[64]; } }
#pragma unroll
        for (int q = 0; q < 4; ++q) { const int s = s0 + q * NGW; if (s < NTOK * 2) { const int e = ev[q]; const int ipos = OFFS[e] + H[(s >> 7) * 32 + e] + rv[q];
                if (lane == 0) tokp[s] = ipos;
                GAS u32x4* dst = (GAS u32x4*)(xs + (size_t)ipos * DM) + lane; dst[0] = ra[q]; dst[64] = rb[q]; } } }
}
constexpr int PH_PER_LAYER = 13, N_PHASES = 2 * PH_PER_LAYER + 1;
#ifndef MK_ONE_LAUNCH
#define MK_ONE_LAUNCH 1
#endif
#ifndef E2_ALIGN
#define E2_ALIGN false
#define E2_SP2 true
#endif
__global__ void __launch_bounds__(NTHR, 2) fwd(Args A) {
    extern __shared__ __attribute__((aligned(16))) unsigned char lds_raw[];
    Ctx C_;
    C_.lds = (LAS unsigned char*)lds_raw; C_.MISC = (volatile LAS unsigned*)(C_.lds + MISC_OFF);
    C_.tid = threadIdx.x; C_.lane = C_.tid & 63; C_.wave = __builtin_amdgcn_readfirstlane(C_.tid >> 6);
    C_.G = gridDim.x; { const int bx = blockIdx.x; C_.vcu = (C_.G % 8 == 0) ? (bx % 8) * (C_.G / 8) + bx / 8 : bx; }
    C_.ws = A.ws; C_.ctl = (gu32*)(A.ws + WS_CTL);
    for (int u = C_.tid; u < 128; u += NTHR) ((LAS unsigned*)(C_.lds + MISC_OFF))[u] = 0u;
    __syncthreads();
    const int lo = A.ph_lo, hi = A.ph_hi;
    const bool multi = (hi - lo) > 1;
    XcdBarrier bar; bar.wv = C_.wave; bar.bar = (unsigned*)(C_.ctl + CW_BAR); bar.x = 0; bar.st = nullptr;
    if (multi) bar = xcd_barrier_post((unsigned*)(C_.ctl + CW_BAR), C_.MISC + 8, C_.wave);
#ifndef PHASE_MASK
#define PHASE_MASK 0x1fff
#endif
#define HAS(k) (((PHASE_MASK) >> (k)) & 1)
#ifndef REPMASK
#define REPMASK 0
#endif
#ifndef REPCNT
#define REPCNT 2
#endif
#define NREP(k) ((((REPMASK) >> (k)) & 1) && layer == 0 ? REPCNT : 1)
#define IN(k) (lo <= (k) && (k) < hi)
#define SEAM(k) do { if (IN(k) && IN((k) + 1)) xcd_barrier(bar); } while (0)
#define FRESH() Ctx C = C_; C.lane = xb_lane(); C.tid = C_.wave * 64 + C.lane; asm volatile("" : "+s"(C.ws), "+s"(C.ctl), "+s"(C.vcu), "+s"(C.G))
    for (int layer = 0; layer < 3; ++layer) {
        const int pb = layer * PH_PER_LAYER;
        if (HAS(0) && IN(pb + 0)) for (int rep_ = 0; rep_ < NREP(0); ++rep_) { FRESH(); phase0(A, C, layer); }
        if (layer == 2) break;
        SEAM(pb + 0);
#ifdef XBAR_PROBE
        if (layer == 0 && IN(pb + 0) && IN(pb + 1)) { for (int q = 0; q < XBAR_PROBE; ++q) xcd_barrier(bar); }
#endif
        if (HAS(1) && IN(pb + 1)) for (int rep_ = 0; rep_ < NREP(1); ++rep_) { FRESH();
            pg8::Gemm g{(bf16*)A.out + (size_t)NTOK * DM, wsp<bf16>(C, WS_WT1), NTOK, 5120, 1024}; pg8::StaticOrder S; S.init(NTOK, 5120, C.G, (int)blockIdx.x);
            pg8::EpiOut<0> E{proj(C, 0), nullptr, nullptr, PROJ_STRIDE / 2};
            pg8::gemm_phase<pg8::EpiOut<0>, pg8::StaticOrder, true, true>(C.lds, g, S, E, C.tid);
        }
        SEAM(pb + 1);
        if (HAS(2) && IN(pb + 2)) for (int rep_ = 0; rep_ < NREP(2); ++rep_) { FRESH();  for (int g8 = C.vcu; g8 < 256; g8 += C.G) for (int i8 = 0; i8 < 8; ++i8) mlstm_u_item(A, C, layer, g8 >> 4, (g8 & 15) * 8 + i8, i8 == 0, i8 < 7); }
        SEAM(pb + 2);
        if (HAS(3) && IN(pb + 3)) for (int rep_ = 0; rep_ < NREP(3); ++rep_) { FRESH(); mlstm_scan(C); }
        SEAM(pb + 3);
        if (HAS(4) && IN(pb + 4)) for (int rep_ = 0; rep_ < NREP(4); ++rep_) { FRESH();
            gu32* q0 = C.ctl + CW_Q + 64 * (layer * 4 + 0); gu32* q1 = C.ctl + CW_Q + 64 * (layer * 4 + 1); gu32* q2 = C.ctl + CW_Q + 64 * (layer * 4 + 2);
            for (int rc_ = 0; rc_ < NREP(13); ++rc_) {
                if (C.G == 256) { const int xg = C.vcu >> 5, r = C.vcu & 31;
                    for (int rd = 0; rd < 2; ++rd) { const int p = r + 32 * rd, bvh = xg * 4 + (p >> 4), pr = p & 15;
                        attn_unit<128, true>(A, C, layer, bvh >> 3, bvh & 7, 31 - pr); attn_unit<128, true>(A, C, layer, bvh >> 3, bvh & 7, pr); } }
                else { for (int it = C.vcu; it < 1024; it += C.G) attn_unit<128, true>(A, C, layer, (it & 31) >> 3, it & 7, 31 - (it >> 5)); } }
            for (int rc_ = NREP(15) - 1; rc_ >= 0; --rc_) { gu32* qq = rc_ ? C.ctl + CW_Q + 64 * (17 + 2 * rc_) : q2;
            for (;;) { if (C.tid == 0) C.MISC[0] = __hip_atomic_fetch_add(qq, 1u, RLX_AGENT); __syncthreads(); const int it = (int)C.MISC[0]; __syncthreads(); if (it >= 512) break;
                for (int i4 = 0; i4 < 4; ++i4) mlstm_out_item(A, C, layer, it >> 5, (it & 31) * 4 + i4, i4 == 0, i4 < 3, rc_ ? wsp<bf16>(C, 480 * MiB) : nullptr); } }
            for (int rc_ = NREP(14) - 1; rc_ >= 0; --rc_) { gu32* qq = rc_ ? C.ctl + CW_Q + 64 * (16 + 2 * rc_) : q1;
            for (;;) { if (C.tid == 0) C.MISC[0] = __hip_atomic_fetch_add(qq, 1u, RLX_AGENT); __syncthreads(); const int it = (int)C.MISC[0]; __syncthreads(); if (it >= 1024) break;
                attn_unit<64, false>(A, C, layer, (it & 31) >> 3, it & 7, 31 - (it >> 5), rc_ ? wsp<bf16>(C, 480 * MiB) : nullptr); } }
        }
        SEAM(pb + 4);
        if (HAS(6) && IN(pb + 6)) for (int rep_ = 0; rep_ < NREP(6); ++rep_) { FRESH();
            if (rep_ == 0) phase5(A, C, layer);
            pg8::Gemm g{(bf16*)A.out + (size_t)NTOK * DM, wsp<bf16>(C, WS_WT2), NTOK, 3072, 1024}; pg8::StaticOrder S; S.init(NTOK, 3072, C.G, (int)blockIdx.x);
            pg8::EpiOut<1> E{wsp<bf16>(C, WS_G0), wsp<bf16>(C, WS_G1), wsp<bf16>(C, WS_G2), 0};
            pg8::gemm_phase<pg8::EpiOut<1>, pg8::StaticOrder, true, true>(C.lds, g, S, E, C.tid);
        }
        SEAM(pb + 6);
        if (HAS(7) && IN(pb + 7)) for (int rep_ = 0; rep_ < NREP(7); ++rep_) { FRESH();
            pg8::StaticOrder S; S.init(NTOK, 1024, C.G, (int)blockIdx.x); bf16* Y = wsp<bf16>(C, WS_O12);
            { pg8::Gemm g{proj(C, PJ_AV), wsp<bf16>(C, WS_PT), NTOK, 1024, 512}; pg8::EpiMerge<true> E{Y, wsp<bf16>(C, WS_G0)}; pg8::gemm_phase<pg8::EpiMerge<true>, pg8::StaticOrder, true, true>(C.lds, g, S, E, C.tid); }
            __syncthreads();
            { pg8::Gemm g{proj(C, PJ_BQ), wsp<bf16>(C, WS_PT) + 1024 * 512, NTOK, 1024, 512}; pg8::EpiMerge<false> E{Y, wsp<bf16>(C, WS_G1)}; pg8::gemm_phase<pg8::EpiMerge<false>, pg8::StaticOrder, true, true>(C.lds, g, S, E, C.tid); }
            __syncthreads();
            { pg8::Gemm g{proj(C, PJ_CQ), wsp<bf16>(C, WS_PT) + 2 * 1024 * 512, NTOK, 1024, 512}; pg8::EpiMerge<false> E{Y, wsp<bf16>(C, WS_G2)}; pg8::gemm_phase<pg8::EpiMerge<false>, pg8::StaticOrder, true, true>(C.lds, g, S, E, C.tid); }
        }
        SEAM(pb + 7);
        if (HAS(8) && IN(pb + 8)) for (int rep_ = 0; rep_ < NREP(8); ++rep_) { FRESH();
            pg8::Gemm g{wsp<bf16>(C, WS_O12), wsp<bf16>(C, WS_WOT), NTOK, 1024, 1024}; pg8::StaticOrder S; S.init(NTOK, 1024, C.G, (int)blockIdx.x);
            pg8::EpiResid E{layer == 0 ? (const void*)A.in[0] : (const void*)A.out, layer > 0, wsp<bf16>(C, WS_XB1)};
            pg8::gemm_phase<pg8::EpiResid, pg8::StaticOrder, true, true>(C.lds, g, S, E, C.tid);
        }
        SEAM(pb + 8);
        if (HAS(9) && IN(pb + 9)) for (int rep_ = 0; rep_ < NREP(9); ++rep_) { FRESH(); for (int r9 = 1; r9 < NREP(16); ++r9) { phase9(A, C, layer, true); __syncthreads(); } if (NREP(17) >= 2) { moe_weight_items(A, C, layer); __syncthreads(); } phase9(A, C, layer); }
        SEAM(pb + 9);
        if (HAS(10) && IN(pb + 10)) for (int rep_ = 0; rep_ < NREP(10); ++rep_) { FRESH(); phase10(C, layer); }
        SEAM(pb + 10);
        if (HAS(11) && IN(pb + 11)) for (int rep_ = 0; rep_ < NREP(11); ++rep_) { FRESH();
            const int* texp = wsp<int>(C, WS_TEXP); const int RT = __builtin_amdgcn_readfirstlane(texp[511]);
            pg8::Gemm g{wsp<bf16>(C, WS_XS), wsp<bf16>(C, WS_W1T), 73728, 32 * 512, 1024}; pg8::MoeOrder<1> S{C.G, C.vcu, RT, texp};
            pg8::EpiSiluMul E{wsp<bf16>(C, WS_HE)};
            pg8::gemm_phase<pg8::EpiSiluMul, pg8::MoeOrder<1>, true, true>(C.lds, g, S, E, C.tid);
        }
        SEAM(pb + 11);
        if (HAS(12) && IN(pb + 12)) for (int rep_ = 0; rep_ < NREP(12); ++rep_) { FRESH();
            const int* texp = wsp<int>(C, WS_TEXP); const int RT = __builtin_amdgcn_readfirstlane(texp[511]);
            pg8::Gemm g{wsp<bf16>(C, WS_HE), wsp<bf16>(C, WS_W2T), 73728, 32 * 1024, 256}; pg8::MoeOrder<2> S{C.G, C.vcu, RT, texp};
            pg8::EpiOut<2> E{wsp<bf16>(C, WS_OSL), nullptr, nullptr, 0};
            pg8::gemm_phase<pg8::EpiOut<2>, pg8::MoeOrder<2>, E2_ALIGN, E2_SP2>(C.lds, g, S, E, C.tid);
        }
        SEAM(pb + 12);
    }
#undef IN
#undef SEAM
}

extern "C" void kernel_launch(void* const* d_in, const int* in_sizes, int n_in, void* d_out, int out_size, void* d_ws, size_t ws_size, hipStream_t stream) {
    static int grid = 0;
    if (grid == 0) {
        if (n_in != 23 || out_size != NTOK * DM || ws_size < WS_NEED) { fprintf(stderr, "kernel_launch: unexpected shapes (n_in %d out %d ws %zu)\n", n_in, out_size, ws_size); grid = -1; return; }
        int dev = 0, cus = 0, per_cu = 0;
        if (hipGetDevice(&dev) != hipSuccess || hipDeviceGetAttribute(&cus, hipDeviceAttributeMultiprocessorCount, dev) != hipSuccess) { grid = -1; return; }
        if (hipFuncSetAttribute((const void*)fwd, hipFuncAttributeMaxDynamicSharedMemorySize, LDS_BYTES) != hipSuccess) { fprintf(stderr, "kernel_launch: hipFuncSetAttribute failed\n"); grid = -1; return; }
        if (hipOccupancyMaxActiveBlocksPerMultiprocessor(&per_cu, (const void*)fwd, NTHR, LDS_BYTES) != hipSuccess || per_cu < 1) fprintf(stderr, "kernel_launch: occupancy query says %d\n", per_cu);
        (void)hipGetLastError();
        grid = cus;
    }
    if (grid < 0) return;
    (void)hipMemsetAsync((char*)d_ws + WS_CTL, 0, CTL_ZERO_BYTES, stream);
    Args a{};
    for (int i = 0; i < 23; ++i) a.in[i] = (const float*)d_in[i];
    a.out = (float*)d_out; a.ws = (unsigned char*)d_ws;
#if MK_ONE_LAUNCH
    a.ph_lo = 0; a.ph_hi = N_PHASES;
    hipLaunchKernelGGL(fwd, dim3(grid), dim3(NTHR), LDS_BYTES, stream, a);
#else
    for (int p = 0; p < N_PHASES; ++p) { a.ph_lo = p; a.ph_hi = p + 1; hipLaunchKernelGGL(fwd, dim3(grid), dim3(NTHR), LDS_BYTES, stream, a); }
#endif
}
```

```cpp
#include <hip/hip_runtime.h>
#include <cstdio>
#include <cstdint>
#include <cmath>
namespace pg8 {
#define PG8_LAS __attribute__((address_space(3)))
typedef unsigned short bf16_t;
typedef short bf16x8 __attribute__((ext_vector_type(8)));
typedef float f32x4 __attribute__((ext_vector_type(4)));
typedef unsigned u32x4 __attribute__((ext_vector_type(4)));
constexpr int BM = 256, BK = 64, HALF = 128, HTB = HALF * BK * 2  , STAGE_BYTES = 8 * HTB, NXCD = 8, WGM = 8;

__host__ __device__ __forceinline__ int lds_byte(int r, int c) { const int st = (r >> 4) * 2 + (c >> 5), rr = r & 15, cc = c & 31, ob = rr * 64 + cc * 2; return st * 1024 + (ob ^ (((ob >> 9) & 1) << 5)); }
__host__ __device__ __forceinline__ void stage_rc(int b, int& R, int& C) { const int st = b / 1024, sb = b % 1024, swz = sb ^ (((sb >> 9) & 1) << 5); R = (st >> 1) * 16 + swz / 64; C = (st & 1) * 32 + (swz % 64) / 2; }
__host__ __device__ __forceinline__ int perm32(int rho) { const int n = rho >> 4, i = rho & 15; return 8 * (i >> 2) + 4 * n + (i & 3); }

struct Unit { int pm, pn; };
struct Gemm { const bf16_t* A; const bf16_t* Bt; int M, N, K; };

struct StaticOrder {
    int nM, nN, nwg, G, c;
    __host__ __device__ void init(int M, int N, int G_, int c_) { nM = M / BM; nN = N / BM; nwg = nM * nN; G = G_; c = c_; }
    __host__ __device__ bool next(int i, Unit& u) const {
        const long L = (long)i * G + c; if (L >= nwg) return false;
        int wgid = (int)L; { const int q = nwg / NXCD, r = nwg % NXCD, xcd = wgid % NXCD, off = wgid / NXCD; wgid = (xcd < r ? xcd * (q + 1) : r * (q + 1) + (xcd - r) * q) + off; }
        const int nig = WGM * nN, gid = wgid / nig, fm = gid * WGM, gsz = (nM - fm) < WGM ? (nM - fm) : WGM;
        u.pm = fm + ((wgid % nig) % gsz); u.pn = (wgid % nig) / gsz; return true;
    }
    __device__ __forceinline__ void a_ready(const Unit&) const {}
    __device__ __forceinline__ void done(const Unit&) const {}
};

__device__ __forceinline__ unsigned cvt_pk_bf16(float lo, float hi) { unsigned r; asm volatile("v_cvt_pk_bf16_f32 %0, %1, %2" : "=v"(r) : "v"(lo), "v"(hi)); return r; }
#ifndef GAS
#define GAS __attribute__((address_space(1)))
#endif
typedef float f32x2 __attribute__((ext_vector_type(2)));
__device__ __forceinline__ float bflo(unsigned u) { return __builtin_bit_cast(float, u << 16); }
__device__ __forceinline__ float bfhi(unsigned u) { return __builtin_bit_cast(float, u & 0xffff0000u); }
__device__ __forceinline__ float sigmoidf_(float x) { return 1.f / (1.f + __expf(-x)); }
template <int MODE> struct EpiOut {
    static constexpr bool PERM = true, AFTER_DRAIN = false, CHAIN = false;
    bf16_t* b0; bf16_t* b1; bf16_t* b2; size_t stride;
    __device__ __forceinline__ void operator()(const f32x4 (&acc)[2][2][4][2], const Unit& u, int wr, int wc, int fr, int fq) const {
        int row0 = u.pm * BM + wr * 64 + fr; asm volatile("" : "+v"(row0));
        bf16_t* base; int colt, ldc;
        if (MODE == 0) { base = b0 + (size_t)(u.pn >> 1) * stride; colt = (u.pn & 1) * 256; ldc = 512; }
        else if (MODE == 1) { const int t = u.pn >> 2; base = b0 + (size_t)(160 * t - 32 * t * (t - 1)) * (1u << 19); colt = (u.pn & 3) * 256; ldc = 1024; }
        else { base = b0; colt = (u.pn & 3) * 256; ldc = 1024; }
        const int col0 = colt + wc * 32 + 8 * fq;
#pragma unroll
        for (int ai = 0; ai < 2; ++ai)
#pragma unroll
            for (int m = 0; m < 4; ++m) { bf16_t* rowp = base + (size_t)(row0 + ai * HALF + m * 16) * ldc + col0;
#pragma unroll
                for (int bj = 0; bj < 2; ++bj) { f32x4 v0 = acc[ai][bj][m][0], v1 = acc[ai][bj][m][1];
                    if (MODE == 1) {
#pragma unroll
                        for (int j = 0; j < 4; ++j) { v0[j] = sigmoidf_(v0[j]); v1[j] = sigmoidf_(v1[j]); } }
                    u32x4 w; w.x = cvt_pk_bf16(v0[0], v0[1]); w.y = cvt_pk_bf16(v0[2], v0[3]); w.z = cvt_pk_bf16(v1[0], v1[1]); w.w = cvt_pk_bf16(v1[2], v1[3]);
                    *(GAS u32x4*)(rowp + bj * HALF) = w; } }
    }
};
template <bool FIRST> struct EpiMerge {
    static constexpr bool PERM = true, AFTER_DRAIN = false, CHAIN = false;
    bf16_t* Y; const bf16_t* G;
    __device__ __forceinline__ void operator()(const f32x4 (&acc)[2][2][4][2], const Unit& u, int wr, int wc, int fr, int fq) const {
        int row0 = u.pm * BM + wr * 64 + fr; asm volatile("" : "+v"(row0)); const int col0 = u.pn * BM + wc * 32 + 8 * fq;
#pragma unroll
        for (int ai = 0; ai < 2; ++ai)
#pragma unroll
            for (int m = 0; m < 4; ++m) { const size_t ro = (size_t)(row0 + ai * HALF + m * 16) * 1024 + col0;
#pragma unroll
                for (int bj = 0; bj < 2; ++bj) { const f32x4 v0 = acc[ai][bj][m][0], v1 = acc[ai][bj][m][1];
                    const u32x4 g = *(const GAS u32x4*)(G + ro + bj * HALF);
                    float r[8] = { bflo(g.x) * v0[0], bfhi(g.x) * v0[1], bflo(g.y) * v0[2], bfhi(g.y) * v0[3], bflo(g.z) * v1[0], bfhi(g.z) * v1[1], bflo(g.w) * v1[2], bfhi(g.w) * v1[3] };
                    if (!FIRST) { const u32x4 y = *(const GAS u32x4*)(Y + ro + bj * HALF);
                        r[0] += bflo(y.x); r[1] += bfhi(y.x); r[2] += bflo(y.y); r[3] += bfhi(y.y); r[4] += bflo(y.z); r[5] += bfhi(y.z); r[6] += bflo(y.w); r[7] += bfhi(y.w); }
                    u32x4 w; w.x = cvt_pk_bf16(r[0], r[1]); w.y = cvt_pk_bf16(r[2], r[3]); w.z = cvt_pk_bf16(r[4], r[5]); w.w = cvt_pk_bf16(r[6], r[7]);
                    *(GAS u32x4*)(Y + ro + bj * HALF) = w; } }
    }
};
struct EpiResid {
    static constexpr bool PERM = true, AFTER_DRAIN = false, CHAIN = false;
    const void* XS; bool xbf; bf16_t* OUT;
    __device__ __forceinline__ void operator()(const f32x4 (&acc)[2][2][4][2], const Unit& u, int wr, int wc, int fr, int fq) const {
        int row0 = u.pm * BM + wr * 64 + fr; asm volatile("" : "+v"(row0)); const int col0 = u.pn * BM + wc * 32 + 8 * fq;
#pragma unroll
        for (int ai = 0; ai < 2; ++ai)
#pragma unroll
            for (int m = 0; m < 4; ++m) { const size_t ro = (size_t)(row0 + ai * HALF + m * 16) * 1024 + col0;
#pragma unroll
                for (int bj = 0; bj < 2; ++bj) { f32x4 x0, x1;
                    if (xbf) { const u32x4 xv = *(const GAS u32x4*)((const bf16_t*)XS + ro + bj * HALF); x0 = (f32x4){bflo(xv.x), bfhi(xv.x), bflo(xv.y), bfhi(xv.y)}; x1 = (f32x4){bflo(xv.z), bfhi(xv.z), bflo(xv.w), bfhi(xv.w)}; }
                    else { x0 = *(const GAS f32x4*)((const float*)XS + ro + bj * HALF); x1 = *(const GAS f32x4*)((const float*)XS + ro + bj * HALF + 4); }
                    x0 = x0 + acc[ai][bj][m][0]; x1 = x1 + acc[ai][bj][m][1];
                    u32x4 w; w.x = cvt_pk_bf16(x0[0], x0[1]); w.y = cvt_pk_bf16(x0[2], x0[3]); w.z = cvt_pk_bf16(x1[0], x1[1]); w.w = cvt_pk_bf16(x1[2], x1[3]);
                    *(GAS u32x4*)(OUT + ro + bj * HALF) = w; } }
    }
};
struct EpiSiluMul {
    static constexpr bool PERM = true, AFTER_DRAIN = false, CHAIN = false;
    bf16_t* O;
    __device__ __forceinline__ void operator()(const f32x4 (&acc)[2][2][4][2], const Unit& u, int wr, int wc, int fr, int fq) const {
        int row0 = u.pm * BM + wr * 64 + fr; asm volatile("" : "+v"(row0)); const int col0 = (u.pn & 1) * 128 + wc * 32 + 8 * fq;
#pragma unroll
        for (int ai = 0; ai < 2; ++ai)
#pragma unroll
            for (int m = 0; m < 4; ++m) { float r[8];
#pragma unroll
                for (int n = 0; n < 2; ++n)
#pragma unroll
                    for (int j = 0; j < 4; ++j) { const float g = acc[ai][0][m][n][j], up = acc[ai][1][m][n][j]; r[4 * n + j] = g * sigmoidf_(g) * up; }
                u32x4 w; w.x = cvt_pk_bf16(r[0], r[1]); w.y = cvt_pk_bf16(r[2], r[3]); w.z = cvt_pk_bf16(r[4], r[5]); w.w = cvt_pk_bf16(r[6], r[7]);
                *(GAS u32x4*)(O + (size_t)(row0 + ai * HALF + m * 16) * 256 + col0) = w; }
    }
};
template <int LOG_NCT> struct MoeOrder {
    int G, c, RT; const int* texp;
    __device__ __forceinline__ bool next(int i, Unit& u) const {
        const int L = i * G + c; const int rt = L >> LOG_NCT; if (rt >= RT) return false;
        const int e = __builtin_amdgcn_readfirstlane(texp[rt]); u.pm = rt; u.pn = (e << LOG_NCT) + (L & ((1 << LOG_NCT) - 1)); return true;
    }
    __device__ __forceinline__ void a_ready(const Unit&) const {}
    __device__ __forceinline__ void done(const Unit&) const {}
};
template <class Epi, class Sched, bool ALIGN_EPI = false, bool SP2 = false>
__device__ __forceinline__ void gemm_phase(PG8_LAS unsigned char* lds, const Gemm g, const Sched& S, const Epi& E, int tid_in) {
    int tid = tid_in; asm volatile("" : "+v"(tid));
    const int wid = __builtin_amdgcn_readfirstlane(tid >> 6), lane = tid & 63, wr = wid >> 2, wc = wid & 3, fr = lane & 15, fq = lane >> 4;
    const int K = g.K, nt = K / BK;
    unsigned voffA[2], voffB[2];
#pragma unroll
    for (int i = 0; i < 2; ++i) { int R, C; stage_rc(tid * 16 + i * 8192, R, C); const int Rb = Epi::PERM ? ((R & ~31) + perm32(R & 31)) : R;
        voffA[i] = (unsigned)(R * K + C) * 2u; voffB[i] = (unsigned)(Rb * K + C) * 2u; }
    const size_t kstep = (size_t)(BK * 2);
    const size_t hstep = (size_t)HALF * K * 2;
    const size_t tstep = 2 * hstep;
    const unsigned ldsw = (unsigned)wid * 1024u;
    const int aoff = lds_byte(wr * 64 + fr, fq * 8), boff = lds_byte(wc * 32 + fr, fq * 8);
#define PG8_SA(b, h) (((b) * 2 + (h)) * HTB)
#define PG8_SB(b, h) ((4 + (b) * 2 + (h)) * HTB)
#define PG8_STAGE(bufoff, gbase, voff) do { _Pragma("unroll") for (int _i = 0; _i < 2; ++_i) \
        __builtin_amdgcn_global_load_lds((const unsigned*)((const char*)(gbase) + (voff)[_i]), (PG8_LAS unsigned*)(lds + (bufoff) + ldsw + _i * 8192), 16, 0, 0); } while (0)
#define PG8_LDA(dst, b, h) do { _Pragma("unroll") for (int m = 0; m < 4; ++m) _Pragma("unroll") for (int k = 0; k < 2; ++k) dst[m][k] = *(const PG8_LAS bf16x8*)(lds + PG8_SA(b, h) + aoff + m * 2048 + k * 1024); } while (0)
#define PG8_LDB(dst, b, h) do { _Pragma("unroll") for (int n = 0; n < 2; ++n) _Pragma("unroll") for (int k = 0; k < 2; ++k) dst[n][k] = *(const PG8_LAS bf16x8*)(lds + PG8_SB(b, h) + boff + n * 2048 + k * 1024); } while (0)
#define PG8_MMA(ai, bj, At, Bt) do { __builtin_amdgcn_s_setprio(1); _Pragma("unroll") for (int m = 0; m < 4; ++m) _Pragma("unroll") for (int n = 0; n < 2; ++n) _Pragma("unroll") for (int k = 0; k < 2; ++k) \
        acc[ai][bj][m][n] = __builtin_amdgcn_mfma_f32_16x16x32_bf16(Bt[n][k], At[m][k], acc[ai][bj][m][n], 0, 0, 0); __builtin_amdgcn_s_setprio(0); } while (0)
#define PG8_WAIT_V(n) asm volatile("s_waitcnt vmcnt(" #n ")" ::: "memory")
#define PG8_WAIT_L(n) asm volatile("s_waitcnt lgkmcnt(" #n ")" ::: "memory")
#define PG8_BAR __builtin_amdgcn_s_barrier()
#define PG8_SCHED __builtin_amdgcn_sched_barrier(0)
    Unit cur, nxt; int ui = 0;
    if (!S.next(0, cur)) return;
    f32x4 acc[2][2][4][2];
#pragma unroll
    for (int a = 0; a < 2; ++a)
#pragma unroll
        for (int b = 0; b < 2; ++b)
#pragma unroll
            for (int m = 0; m < 4; ++m)
#pragma unroll
                for (int n = 0; n < 2; ++n) acc[a][b][m][n] = (f32x4){0.f, 0.f, 0.f, 0.f};
    bf16x8 At[4][2], B0[2][2], B1[2][2];
    const char* cA = (const char*)g.A + (size_t)cur.pm * tstep; const char* cB = (const char*)g.Bt + (size_t)cur.pn * tstep;
    S.a_ready(cur);
    if constexpr (SP2) {
        PG8_STAGE(PG8_SB(0, 0), cB, voffB); PG8_STAGE(PG8_SB(0, 1), cB + hstep, voffB); PG8_STAGE(PG8_SA(0, 0), cA, voffA); PG8_STAGE(PG8_SA(0, 1), cA + hstep, voffA);
        if (wr == 1) PG8_BAR;
        PG8_WAIT_V(2); PG8_BAR;
        PG8_STAGE(PG8_SB(1, 0), cB + kstep, voffB); PG8_STAGE(PG8_SA(1, 0), cA + kstep, voffA); PG8_STAGE(PG8_SB(1, 1), cB + hstep + kstep, voffB);
        PG8_WAIT_V(6); PG8_BAR;
    } else {
        PG8_STAGE(PG8_SB(0, 0), cB, voffB); PG8_STAGE(PG8_SA(0, 0), cA, voffA); PG8_STAGE(PG8_SB(0, 1), cB + hstep, voffB); PG8_STAGE(PG8_SA(0, 1), cA + hstep, voffA);
        if (wr == 1) PG8_BAR;
        PG8_WAIT_V(4); PG8_BAR;
        PG8_STAGE(PG8_SB(1, 0), cB + kstep, voffB); PG8_STAGE(PG8_SA(1, 0), cA + kstep, voffA); PG8_STAGE(PG8_SB(1, 1), cB + hstep + kstep, voffB);
        PG8_WAIT_V(6); PG8_BAR;
    }
    for (;;) {
        const bool has_next = S.next(ui + 1, nxt);
        const char* nA = has_next ? (const char*)g.A + (size_t)nxt.pm * tstep : cA; const char* nB = has_next ? (const char*)g.Bt + (size_t)nxt.pn * tstep : cB;
        for (int t = 0; t < nt; t += 2) {
            const bool last = (t == nt - 2);
            const char* a1 = cA + (size_t)(t + 1) * kstep;
            const char* a2 = last ? nA : cA + (size_t)(t + 2) * kstep; const char* b2 = last ? nB : cB + (size_t)(t + 2) * kstep;
            const char* a3 = a2 + kstep; const char* b3 = b2 + kstep;
            if (last && has_next) S.a_ready(nxt);
            if constexpr (SP2) {
            PG8_LDB(B0, 0, 0); PG8_LDB(B1, 0, 1); PG8_SCHED; PG8_LDA(At, 0, 0); PG8_STAGE(PG8_SA(1, 1), a1 + hstep, voffA);
            PG8_WAIT_V(8); PG8_WAIT_L(0); PG8_BAR; PG8_MMA(0, 0, At, B0); PG8_MMA(0, 1, At, B1); PG8_BAR; PG8_SCHED;
            PG8_LDA(At, 0, 1); PG8_STAGE(PG8_SB(0, 0), b2, voffB); PG8_STAGE(PG8_SB(0, 1), b2 + hstep, voffB); PG8_STAGE(PG8_SA(0, 0), a2, voffA);
            PG8_WAIT_V(8); PG8_WAIT_L(0); PG8_BAR; PG8_MMA(1, 0, At, B0); PG8_MMA(1, 1, At, B1); PG8_BAR; PG8_SCHED;
            PG8_LDB(B0, 1, 0); PG8_LDB(B1, 1, 1); PG8_SCHED; PG8_LDA(At, 1, 0); PG8_STAGE(PG8_SA(0, 1), a2 + hstep, voffA);
            PG8_WAIT_V(8); PG8_WAIT_L(0); PG8_BAR; PG8_MMA(0, 0, At, B0); PG8_MMA(0, 1, At, B1); PG8_BAR; PG8_SCHED;
            PG8_LDA(At, 1, 1); PG8_STAGE(PG8_SB(1, 0), b3, voffB); PG8_STAGE(PG8_SB(1, 1), b3 + hstep, voffB); PG8_STAGE(PG8_SA(1, 0), a3, voffA);
            PG8_WAIT_V(8); PG8_WAIT_L(0); PG8_BAR; PG8_MMA(1, 0, At, B0); PG8_MMA(1, 1, At, B1); PG8_BAR; PG8_SCHED;
            } else {
            PG8_LDB(B0, 0, 0); PG8_SCHED; PG8_LDA(At, 0, 0); PG8_STAGE(PG8_SA(1, 1), a1 + hstep, voffA);
            PG8_WAIT_L(8); PG8_BAR; PG8_WAIT_L(0); PG8_MMA(0, 0, At, B0); PG8_BAR; PG8_SCHED;
            PG8_LDB(B1, 0, 1); PG8_STAGE(PG8_SB(0, 0), b2, voffB);
            PG8_BAR; PG8_WAIT_L(0); PG8_MMA(0, 1, At, B1); PG8_BAR;
            PG8_LDA(At, 0, 1); PG8_STAGE(PG8_SA(0, 0), a2, voffA);
            PG8_BAR; PG8_WAIT_L(0); PG8_MMA(1, 0, At, B0); PG8_BAR; PG8_SCHED;
            PG8_STAGE(PG8_SB(0, 1), b2 + hstep, voffB);
            PG8_WAIT_V(6); PG8_BAR; PG8_MMA(1, 1, At, B1); PG8_BAR;
            PG8_LDB(B0, 1, 0); PG8_SCHED; PG8_LDA(At, 1, 0); PG8_STAGE(PG8_SA(0, 1), a2 + hstep, voffA);
            PG8_WAIT_L(8); PG8_BAR; PG8_WAIT_L(0); PG8_MMA(0, 0, At, B0); PG8_BAR; PG8_SCHED;
            PG8_LDB(B1, 1, 1); PG8_STAGE(PG8_SB(1, 0), b3, voffB);
            PG8_BAR; PG8_WAIT_L(0); PG8_MMA(0, 1, At, B1); PG8_BAR;
            PG8_LDA(At, 1, 1); PG8_STAGE(PG8_SA(1, 0), a3, voffA);
            PG8_BAR; PG8_WAIT_L(0); PG8_MMA(1, 0, At, B0); PG8_BAR; PG8_SCHED;
            PG8_STAGE(PG8_SB(1, 1), b3 + hstep, voffB);
            PG8_WAIT_V(6); PG8_BAR; PG8_MMA(1, 1, At, B1); PG8_BAR;
            }
        }
        if constexpr (ALIGN_EPI) { if (wr == 0) PG8_BAR; }
        if constexpr (!Epi::AFTER_DRAIN) { E(acc, cur, wr, wc, fr, fq); S.done(cur); }
        if (!has_next) break;
#pragma unroll
        for (int a = 0; a < 2; ++a)
#pragma unroll
            for (int b = 0; b < 2; ++b)
#pragma unroll
                for (int m = 0; m < 4; ++m)
#pragma unroll
                    for (int n = 0; n < 2; ++n) acc[a][b][m][n] = (f32x4){0.f, 0.f, 0.f, 0.f};
        cur = nxt; cA = nA; cB = nB; ++ui;
        if constexpr (ALIGN_EPI) { if (wr == 1) PG8_BAR; }
    }
    PG8_WAIT_V(0);
    if constexpr (!ALIGN_EPI) { if (wr == 0) PG8_BAR; }
    PG8_BAR;
    if constexpr (Epi::AFTER_DRAIN) { E.fused(acc, cur, wr, wc, fr, fq, lds, wid, lane); S.done(cur); }
#undef PG8_SA
#undef PG8_SB
#undef PG8_STAGE
#undef PG8_LDA
#undef PG8_LDB
#undef PG8_MMA
#undef PG8_WAIT_V
#undef PG8_WAIT_L
#undef PG8_BAR
#undef PG8_SCHED
}
}
constexpr int NTOK = 32768, SEQ = 8192, NB = 4, DM = 1024, INC = 8200;
constexpr float EPS = 1e-6f, LOG2E = 1.4426950408889634f;
constexpr size_t MiB = 1u << 20;
constexpr size_t WS_CTL = 0, CTL_ZERO_BYTES = 128 * 1024;
constexpr size_t WS_IG = 1 * MiB;
constexpr size_t WS_BC = 1 * MiB + 512 * 1024;
constexpr size_t WS_BLAST = 2 * MiB;
constexpr size_t WS_GMAX = 2 * MiB + 64 * 1024;
constexpr size_t WS_NUC = 3 * MiB;
constexpr size_t WS_TOKE = 4 * MiB;
constexpr size_t WS_TOKR = 4 * MiB + 256 * 1024;
constexpr size_t WS_TOKW = 4 * MiB + 512 * 1024;
constexpr size_t WS_TEXP = 5 * MiB;
constexpr size_t WS_HISTG = 5 * MiB + 64 * 1024;
constexpr size_t WS_WRT = 7 * MiB;
constexpr size_t WS_TOKP = 6 * MiB;
constexpr size_t WS_WT1 = 8 * MiB;
constexpr size_t WS_WT2 = 18 * MiB;
constexpr size_t WS_PT = 24 * MiB;
constexpr size_t WS_WOT = 27 * MiB;
constexpr size_t WS_PROJ = 32 * MiB;
constexpr size_t PROJ_STRIDE = 32 * MiB;
constexpr size_t WS_HB = 352 * MiB;
constexpr size_t WS_O12 = 416 * MiB;
constexpr size_t WS_G0 = 32 * MiB, WS_G1 = 192 * MiB, WS_G2 = 288 * MiB;
constexpr size_t WS_H2 = 32 * MiB;
constexpr size_t WS_XS = 96 * MiB;
constexpr size_t WS_HE = 32 * MiB;
constexpr size_t WS_OSL = 96 * MiB;
constexpr size_t WS_W1T = 416 * MiB;
constexpr size_t WS_W2T = 448 * MiB;
constexpr size_t WS_XB1 = 256 * MiB;
constexpr size_t WS_NEED = 512 * MiB;
constexpr int PJ_AQ = 0, PJ_AK = 1, PJ_AV = 2, PJ_AO = 3, PJ_BQ = 4, PJ_BK = 5, PJ_BV = 6, PJ_CQ = 7, PJ_CK = 8, PJ_CV = 9;
constexpr int CW_TMO = 0, CW_CODE = 1;
constexpr int CW_BAR = 4096;
constexpr int CW_Q = 8192;
constexpr int CW_CNT = 12288;
constexpr int RING_BYTES = 131072;
constexpr int MISC_OFF = RING_BYTES;
constexpr int OFFS_OFF = RING_BYTES + 256;
constexpr int LDS_BYTES = 147456;
constexpr int NWAVES = 8, NTHR = 512;

#ifndef GAS
#define GAS __attribute__((address_space(1)))
#endif
#define LAS __attribute__((address_space(3)))
typedef unsigned short bf16;
typedef float f32x4 __attribute__((ext_vector_type(4)));
typedef float f32x16 __attribute__((ext_vector_type(16)));
typedef short bf16x8 __attribute__((ext_vector_type(8)));
typedef unsigned u32x4 __attribute__((ext_vector_type(4)));
typedef unsigned u32x2 __attribute__((ext_vector_type(2)));
typedef short s16x4 __attribute__((ext_vector_type(4)));
typedef GAS unsigned gu32;
#define RLX_AGENT __ATOMIC_RELAXED, __HIP_MEMORY_SCOPE_AGENT
#define LDS_WAIT() asm volatile("s_waitcnt lgkmcnt(0)" ::: "memory")
typedef float f32x2_t __attribute__((ext_vector_type(2))); typedef __bf16 bf16x2_t __attribute__((ext_vector_type(2)));
__device__ __forceinline__ unsigned pk2(float lo, float hi) { f32x2_t v = {lo, hi}; bf16x2_t b = __builtin_convertvector(v, bf16x2_t); return __builtin_bit_cast(unsigned, b); }
__device__ __forceinline__ float bflo(unsigned u) { return __builtin_bit_cast(float, u << 16); }
__device__ __forceinline__ float bfhi(unsigned u) { return __builtin_bit_cast(float, u & 0xffff0000u); }
__device__ __forceinline__ float sigm(float x) { return 1.f / (1.f + __expf(-x)); }
template <int O> __device__ __forceinline__ float xor_shfl(float v) {
    return __builtin_bit_cast(float, __builtin_amdgcn_ds_swizzle(__builtin_bit_cast(int, v), (O << 10) | 0x1f));
}
__device__ __forceinline__ float wave_sum(float v) {
    v += xor_shfl<1>(v); v += xor_shfl<2>(v); v += xor_shfl<4>(v); v += xor_shfl<8>(v); v += xor_shfl<16>(v);
    auto rr = __builtin_amdgcn_permlane32_swap(__float_as_uint(v), __float_as_uint(v), false, false);
    return __uint_as_float(rr[0]) + __uint_as_float(rr[1]);
}
__device__ __forceinline__ float wave_max(float v) {
    v = fmaxf(v, xor_shfl<1>(v)); v = fmaxf(v, xor_shfl<2>(v)); v = fmaxf(v, xor_shfl<4>(v)); v = fmaxf(v, xor_shfl<8>(v)); v = fmaxf(v, xor_shfl<16>(v));
    auto rr = __builtin_amdgcn_permlane32_swap(__float_as_uint(v), __float_as_uint(v), false, false);
    return fmaxf(__uint_as_float(rr[0]), __uint_as_float(rr[1]));
}
__device__ __forceinline__ float lane_up(float v, int lane, int o) {
    return __builtin_bit_cast(float, __builtin_amdgcn_ds_bpermute(((lane - o) & 63) << 2, __builtin_bit_cast(int, v)));
}
__device__ __forceinline__ float lane_get(float v, int src) {
    return __builtin_bit_cast(float, __builtin_amdgcn_readlane(__builtin_bit_cast(int, v), src));
}
__device__ __forceinline__ float pair_sum(float v) {
    auto rr = __builtin_amdgcn_permlane32_swap(__float_as_uint(v), __float_as_uint(v), false, false);
    return __uint_as_float(rr[0]) + __uint_as_float(rr[1]);
}
__device__ __forceinline__ float pair_max(float v) {
    auto rr = __builtin_amdgcn_permlane32_swap(__float_as_uint(v), __float_as_uint(v), false, false);
    return fmaxf(__uint_as_float(rr[0]), __uint_as_float(rr[1]));
}
__device__ __forceinline__ float max3f(float a, float b, float c) { float r; asm("v_max3_f32 %0, %1, %2, %3" : "=v"(r) : "v"(a), "v"(b), "v"(c)); return r; }
__device__ __forceinline__ int crow(int r, int hi) { return (r & 3) + 8 * (r >> 2) + 4 * hi; }
typedef short v4i16_t __attribute__((ext_vector_type(4)));
__device__ __forceinline__ s16x4 tr16(const LAS unsigned char* p) { return __builtin_bit_cast(s16x4, __builtin_amdgcn_ds_read_tr16_b64_v4i16((LAS v4i16_t*)p)); }
__device__ __forceinline__ bf16x8 cat8(s16x4 lo, s16x4 hi) { return (bf16x8){lo[0], lo[1], lo[2], lo[3], hi[0], hi[1], hi[2], hi[3]}; }
__device__ __forceinline__ f32x4 ldrow4(const void* base, bool isbf, size_t row, int idx) {
    if (isbf) { const u32x2 u = ((const GAS u32x2*)((const bf16*)base + row * 1024))[idx]; return (f32x4){bflo(u.x), bfhi(u.x), bflo(u.y), bfhi(u.y)}; }
    return ((const GAS f32x4*)((const float*)base + row * 1024))[idx];
}
#define MFMA32(a, b, c) __builtin_amdgcn_mfma_f32_32x32x16_bf16((a), (b), (c), 0, 0, 0)
#define XB_TMO      128
#define XB_XCNT(j)  (256  + 64 * (j))
#define XB_XSUB(j)  (1280 + 64 * (j))
#define XB_XGEN(j)  (2304 + 64 * (j))
#define XB_TOP      3328
#define XB_TOPGEN   3392
#define XCD_BAR_WORDS 3456
#define XB_SPIN_CAP (1u << 18)

__device__ __forceinline__ unsigned xb_ld(unsigned* p)              { return __hip_atomic_load(p, __ATOMIC_RELAXED, __HIP_MEMORY_SCOPE_AGENT); }
__device__ __forceinline__ unsigned xb_add(unsigned* p, unsigned v) { return __hip_atomic_fetch_add(p, v, __ATOMIC_RELAXED, __HIP_MEMORY_SCOPE_AGENT); }
__device__ __forceinline__ unsigned xb_xcc_id() { return (unsigned)__builtin_amdgcn_s_getreg((3 << 11) | 20) & 0xFu; }
#define XB_SPIN(cond, bar) do { unsigned _sp = 0; while (cond) { __builtin_amdgcn_s_sleep(1); \
    if ((++_sp & 255u) == 0u) { if (xb_ld(&(bar)[XB_TMO])) break; if (_sp > XB_SPIN_CAP) { atomicAdd(&(bar)[XB_TMO], 1u); break; } } } } while (0)

__device__ __forceinline__ int xb_lane() { int l; asm volatile("v_mbcnt_lo_u32_b32 %0, -1, 0\n\tv_mbcnt_hi_u32_b32 %0, -1, %0" : "=v"(l)); return l; }
struct XcdBarrier {
    int wv;
    unsigned* bar; unsigned x;
    volatile LAS unsigned* st;
};

__device__ __forceinline__ XcdBarrier xcd_barrier_post(unsigned* bar, volatile LAS unsigned* st, int wv) {
    XcdBarrier b; b.wv = wv; b.bar = bar; b.x = xb_xcc_id(); b.st = st;
    if (wv == 0 && xb_lane() == 0) (void)xb_add(&bar[XB_XCNT(b.x)], 1u);
    return b;
}
__device__ __forceinline__ void xcd_barrier_complete(unsigned* bar, unsigned x, unsigned& nloc, unsigned& nx) {
    const unsigned G = gridDim.x * gridDim.y * gridDim.z;
    unsigned sum, cnt, mine, sp = 0u;
    for (;;) {
        sum = 0u; cnt = 0u; mine = 0u;
#pragma unroll
        for (unsigned j = 0; j < 16; ++j) { const unsigned c = xb_ld(&bar[XB_XCNT(j)]); sum += c; cnt += (c > 0u) ? 1u : 0u; mine = (j == x) ? c : mine; }
        if (sum == G) break;
        __builtin_amdgcn_s_sleep(1);
        if ((++sp & 255u) == 0u) { if (xb_ld(&bar[XB_TMO])) break; if (sp > XB_SPIN_CAP) { atomicAdd(&bar[XB_TMO], 1u); break; } }
    }
    nloc = mine > 0u ? mine : 1u; nx = cnt > 0u ? cnt : 1u;
}

__device__ __forceinline__ void xcd_barrier(const XcdBarrier& b) {
    asm volatile("s_waitcnt vmcnt(0)" ::: "memory");
    __syncthreads();
    if (b.wv == 0 && xb_lane() == 0) {
        unsigned* bar = b.bar;
        __builtin_amdgcn_s_waitcnt(0);
        unsigned nloc = b.st[0], nx = b.st[1];
        if (nloc == 0u) { xcd_barrier_complete(bar, b.x, nloc, nx); b.st[0] = nloc; b.st[1] = nx; }
        const unsigned old = xb_add(&bar[XB_XSUB(b.x)], 1u);
        const unsigned gen = old / nloc;
        if (old + 1u == (gen + 1u) * nloc) {
            __builtin_amdgcn_fence(__ATOMIC_RELEASE, "agent");
            asm volatile("s_waitcnt vmcnt(0)" ::: "memory");
            const unsigned og = xb_add(&bar[XB_TOP], 1u);
            const unsigned tg = og / nx;
            if (og + 1u == (tg + 1u) * nx) xb_add(&bar[XB_TOPGEN], 1u);
            else XB_SPIN(xb_ld(&bar[XB_TOPGEN]) == tg, bar);
            __builtin_amdgcn_fence(__ATOMIC_ACQUIRE, "agent");
            xb_add(&bar[XB_XGEN(b.x)], 1u);
            asm volatile("s_waitcnt vmcnt(0)" ::: "memory");
        } else {
            XB_SPIN(xb_ld(&bar[XB_XGEN(b.x)]) == gen, bar);
            __builtin_amdgcn_fence(__ATOMIC_ACQUIRE, "agent");
            asm volatile("s_waitcnt vmcnt(0)" ::: "memory");
        }
    }
    __syncthreads();
}
struct Args {
    const float* in[23]; float* out; unsigned char* ws; int ph_lo, ph_hi;
};
struct Ctx {
    LAS unsigned char* lds; volatile LAS unsigned* MISC; gu32* ctl; unsigned char* ws;
    int tid, lane, wave, vcu, G;
};
template <class T> __device__ __forceinline__ T* wsp(const Ctx& C, size_t off) { return (T*)(C.ws + off); }
__device__ __forceinline__ bf16* proj(const Ctx& C, int j) { return (bf16*)(C.ws + WS_PROJ + (size_t)j * PROJ_STRIDE); }

struct TrItem { const float* W; int ldn, k0, n0; bf16* WT; int Kdst, drow0; };
__device__ __forceinline__ void transpose_load(const TrItem& t, f32x4 (&v)[8], int lane) {
    const float* src = t.W + (size_t)(t.k0 + (lane >> 3)) * t.ldn + t.n0 + 4 * (lane & 7);
#pragma unroll
    for (int i = 0; i < 8; ++i) v[i] = *(const GAS f32x4*)(src + (size_t)(8 * i) * t.ldn);
}
__device__ __forceinline__ void transpose_commit(const TrItem& t, const f32x4 (&v)[8], LAS float* scr, int lane) {
    { const int c4 = lane & 7;
#pragma unroll
        for (int i = 0; i < 8; ++i) { LAS float* d = scr + ((lane >> 3) + 8 * i) * 33 + 4 * c4; d[0] = v[i].x; d[1] = v[i].y; d[2] = v[i].z; d[3] = v[i].w; } }
    LDS_WAIT(); asm volatile("" ::: "memory");
    const int c = lane & 7;
#pragma unroll
    for (int j = 0; j < 4; ++j) { const int n = (lane >> 3) + 8 * j; const LAS float* s = scr + (8 * c) * 33 + n;
        u32x4 o; o.x = pk2(s[0 * 33], s[1 * 33]); o.y = pk2(s[2 * 33], s[3 * 33]); o.z = pk2(s[4 * 33], s[5 * 33]); o.w = pk2(s[6 * 33], s[7 * 33]);
        *(GAS u32x4*)(t.WT + (size_t)(t.drow0 + n) * t.Kdst + t.k0 + 8 * c) = o; }
    LDS_WAIT(); asm volatile("" ::: "memory");
}
__device__ __forceinline__ TrItem layer_weight_decode(const Args& A, const Ctx& C, int layer, int it) {
    const float* win = A.in[2] + (size_t)layer * DM * INC;
    constexpr int I1 = 16 * 160, I2 = 16 * 96, I3 = 3 * 8 * 32;
    int r = it;
    if (r < I1) { const int nb = r % 160, kb = r / 160, nd = nb * 32, j = nd >> 9; const int sc = (j < 4 ? j * 512 : 2056 + (j - 4) * 512) + (nd & 511);
        return TrItem{win, INC, kb * 64, sc, wsp<bf16>(C, WS_WT1), 1024, nd}; } r -= I1;
    if (r < I2) { const int nb = r % 96, kb = r / 96; return TrItem{win, INC, kb * 64, 5128 + nb * 32, wsp<bf16>(C, WS_WT2), 1024, nb * 32}; } r -= I2;
    if (r < I3) { const int br = r / 256, q = r % 256, nb = q % 32, kb = q / 32;
        return TrItem{A.in[13] + (size_t)(layer * 3 + br) * 512 * 1024, 1024, kb * 64, nb * 32, wsp<bf16>(C, WS_PT) + (size_t)br * 1024 * 512, 512, nb * 32}; } r -= I3;
    { const int nb = r % 32, kb = r / 32; return TrItem{A.in[14] + (size_t)layer * 1024 * 1024, 1024, kb * 64, nb * 32, wsp<bf16>(C, WS_WOT), 1024, nb * 32}; }
}
__device__ __forceinline__ void layer_weight_items(const Args& A, const Ctx& C, int layer) {
    LAS float* scr = (LAS float*)(C.lds + C.wave * 16384);
    const int gw = C.vcu * NWAVES + C.wave, NGW = C.G * NWAVES;
    constexpr int NI = 16 * 160 + 16 * 96 + 3 * 8 * 32 + 16 * 32;
    if (gw >= NI) return;
    TrItem cur = layer_weight_decode(A, C, layer, gw); f32x4 v[8]; transpose_load(cur, v, C.lane);
    for (int it = gw; it < NI; it += NGW) { f32x4 vn[8]; TrItem nxt = cur; const bool hn = it + NGW < NI;
        if (hn) { nxt = layer_weight_decode(A, C, layer, it + NGW); transpose_load(nxt, vn, C.lane); }
        transpose_commit(cur, v, scr, C.lane);
        if (hn) {
#pragma unroll
            for (int i = 0; i < 8; ++i) v[i] = vn[i]; }
        cur = nxt; }
}
__device__ __forceinline__ TrItem moe_weight_decode(const Args& A, const Ctx& C, int layer, int it) {
    constexpr int I1 = 32 * 256;
    int r = it;
    if (r < I1) { const int e = r >> 8, q = r & 255, mat = q >> 7, q2 = q & 127, nb = q2 & 7, kb = q2 >> 3, n0 = nb * 32;
        const float* src = (mat ? A.in[21] : A.in[20]) + (size_t)(layer * 32 + e) * 1024 * 256;
        return TrItem{src, 256, kb * 64, n0, wsp<bf16>(C, WS_W1T), 1024, e * 512 + (n0 >> 7) * 256 + mat * 128 + (n0 & 127)}; } r -= I1;
    { const int e = r >> 7, q = r & 127, nb = q & 31, kb = q >> 5;
        return TrItem{A.in[22] + (size_t)(layer * 32 + e) * 256 * 1024, 1024, kb * 64, nb * 32, wsp<bf16>(C, WS_W2T), 256, e * 1024 + nb * 32}; }
}
__device__ __forceinline__ void moe_weight_items(const Args& A, const Ctx& C, int layer) {
    LAS float* scr = (LAS float*)(C.lds + C.wave * 16384);
    const int gw = C.vcu * NWAVES + C.wave, NGW = C.G * NWAVES;
    constexpr int NI = 32 * 256 + 32 * 128;
    if (gw >= NI) return;
    TrItem cur = moe_weight_decode(A, C, layer, gw); f32x4 v[8]; transpose_load(cur, v, C.lane);
    for (int it = gw; it < NI; it += NGW) { f32x4 vn[8]; TrItem nxt = cur; const bool hn = it + NGW < NI;
        if (hn) { nxt = moe_weight_decode(A, C, layer, it + NGW); transpose_load(nxt, vn, C.lane); }
        transpose_commit(cur, v, scr, C.lane);
        if (hn) {
#pragma unroll
            for (int i = 0; i < 8; ++i) v[i] = vn[i]; }
        cur = nxt; }
}
__device__ __forceinline__ void phase0(const Args& A, const Ctx& C, int layer, int parts = 7  ) {
    if (layer < 2) { if (parts & 1) layer_weight_items(A, C, layer);
        const float* wr = A.in[18] + layer * 32768; const float* wgp = A.in[16] + layer * 4096; bf16* wt = wsp<bf16>(C, WS_WRT);
        for (int idx = C.vcu * NTHR + C.tid; idx < ((parts & 2) ? 65536 : 0); idx += C.G * NTHR) { const int n = idx >> 10, k = idx & 1023;
            const float w = n < 32 ? wr[k * 32 + n] : n < 36 ? wgp[k * 4 + (n - 32)] : 0.f; const unsigned hi = pk2(w, 0.f) & 0xffffu; const unsigned lo = pk2(w - bflo(hi), 0.f) & 0xffffu;
            ((GAS bf16*)wt)[idx] = (bf16)hi; ((GAS bf16*)wt)[65536 + idx] = (bf16)lo; } }
    __syncthreads();
    LAS float* WG = (LAS float*)(C.lds);
    LAS float* GL = (LAS float*)(C.lds + 32768);
    const int ll = layer < 2 ? layer : 0;
    const float* win = A.in[2] + (size_t)ll * DM * INC;
    if (layer < 2) { float wv[16];
#pragma unroll
        for (int q = 0; q < 16; ++q) { const int i = C.tid + NTHR * q; wv[q] = *(const GAS float*)(win + (size_t)(i >> 3) * INC + 2048 + (i & 7)); }
#pragma unroll
        for (int q = 0; q < 16; ++q) { const int i = C.tid + NTHR * q, k = i >> 3, gt = i & 7;
            WG[(gt >> 2) * 4096 + ((((k >> 8) * 4 + (k & 3)) * 64 + ((k & 255) >> 2)) << 2) + (gt & 3)] = wv[q]; } }
    __syncthreads();
    const float* g1 = A.in[1] + ll * 1024; const float* gb = A.in[5] + ll * 8;
    const void* xsrc = (layer == 0) ? (const void*)A.in[0] : (const void*)wsp<bf16>(C, WS_XB1); const bool xbf = layer > 0;
    const int* tokp = wsp<int>(C, WS_TOKP); const float* tokw = wsp<float>(C, WS_TOKW);
    const bf16* osl = wsp<bf16>(C, WS_OSL); bf16* hb = (bf16*)A.out + (size_t)NTOK * DM;
    for (int item = C.vcu; item < ((parts & 4) ? NTOK / 64 : 0); item += C.G) {
        const int row0 = item * 64;
        f32x4 vnx[4]; u32x2 onx0[4] = {}, onx1[4] = {}; float nw0 = 0.f, nw1 = 0.f, nnw0 = 0.f, nnw1 = 0.f; int nnp0 = 0, nnp1 = 0;
        { const int r0 = row0 + C.wave * 8;
#pragma unroll
            for (int j = 0; j < 4; ++j) vnx[j] = ldrow4(xsrc, xbf, (size_t)r0, C.lane + 64 * j);
            if (layer > 0) { nw0 = tokw[r0 * 2]; nw1 = tokw[r0 * 2 + 1]; const size_t p0 = (size_t)tokp[r0 * 2], p1 = (size_t)tokp[r0 * 2 + 1];
                nnw0 = tokw[r0 * 2 + 2]; nnw1 = tokw[r0 * 2 + 3]; nnp0 = tokp[r0 * 2 + 2]; nnp1 = tokp[r0 * 2 + 3];
                const GAS u32x2* o0 = (const GAS u32x2*)(osl + p0 * DM) + C.lane; const GAS u32x2* o1 = (const GAS u32x2*)(osl + p1 * DM) + C.lane;
#pragma unroll
                for (int j = 0; j < 4; ++j) { onx0[j] = o0[64 * j]; onx1[j] = o1[64 * j]; } } }
        for (int i = 0; i < 8; ++i) {
            const int rl = C.wave * 8 + i, row = row0 + rl;
            f32x4 v[4]; u32x2 oc0[4], oc1[4]; const float w0 = nw0, w1 = nw1;
#pragma unroll
            for (int j = 0; j < 4; ++j) { v[j] = vnx[j]; oc0[j] = onx0[j]; oc1[j] = onx1[j]; }
            if (i < 7) {
#pragma unroll
                for (int j = 0; j < 4; ++j) vnx[j] = ldrow4(xsrc, xbf, (size_t)(row + 1), C.lane + 64 * j);
                if (layer > 0) { nw0 = nnw0; nw1 = nnw1;
                    const GAS u32x2* o0 = (const GAS u32x2*)(osl + (size_t)nnp0 * DM) + C.lane; const GAS u32x2* o1 = (const GAS u32x2*)(osl + (size_t)nnp1 * DM) + C.lane;
#pragma unroll
                    for (int j = 0; j < 4; ++j) { onx0[j] = o0[64 * j]; onx1[j] = o1[64 * j]; }
                    if (i < 6) { nnw0 = tokw[row * 2 + 4]; nnw1 = tokw[row * 2 + 5]; nnp0 = tokp[row * 2 + 4]; nnp1 = tokp[row * 2 + 5]; } } }
            if (layer > 0) {
#pragma unroll
                for (int j = 0; j < 4; ++j) { const u32x2 a = oc0[j], b = oc1[j];
                    v[j].x += w0 * bflo(a.x) + w1 * bflo(b.x); v[j].y += w0 * bfhi(a.x) + w1 * bfhi(b.x); v[j].z += w0 * bflo(a.y) + w1 * bflo(b.y); v[j].w += w0 * bfhi(a.y) + w1 * bfhi(b.y); }
                if (layer == 2) { GAS f32x4* xo = (GAS f32x4*)(A.out + (size_t)row * DM) + C.lane;
#pragma unroll
                    for (int j = 0; j < 4; ++j) xo[64 * j] = v[j]; }
                else { GAS u32x2* xo = (GAS u32x2*)((bf16*)A.out + (size_t)row * DM) + C.lane;
#pragma unroll
                    for (int j = 0; j < 4; ++j) { u32x2 o; o.x = pk2(v[j].x, v[j].y); o.y = pk2(v[j].z, v[j].w); xo[64 * j] = o; } }
            }
            if (layer < 2) {
                float ss = 0.f;
#pragma unroll
                for (int j = 0; j < 4; ++j) ss += (v[j].x * v[j].x + v[j].y * v[j].y) + (v[j].z * v[j].z + v[j].w * v[j].w);
                const float rstd = rsqrtf(wave_sum(ss) * (1.f / DM) + EPS);
                float gd[8];
#pragma unroll
                for (int q = 0; q < 8; ++q) gd[q] = 0.f;
                GAS u32x2* ho = (GAS u32x2*)(hb + (size_t)row * DM) + C.lane;
#pragma unroll
                for (int j = 0; j < 4; ++j) { const f32x4 g = ((const GAS f32x4*)g1)[64 * j + C.lane];
                    const f32x4 h = {v[j].x * rstd * g.x, v[j].y * rstd * g.y, v[j].z * rstd * g.z, v[j].w * rstd * g.w};
                    u32x2 o; o.x = pk2(h.x, h.y); o.y = pk2(h.z, h.w); ho[64 * j] = o;
                    const int k = 256 * j + 4 * C.lane;
#pragma unroll
                    for (int c = 0; c < 4; ++c) { const f32x4 wa = *(const LAS f32x4*)(WG + (((j * 4 + c) * 64 + C.lane) << 2)), wb = *(const LAS f32x4*)(WG + 4096 + (((j * 4 + c) * 64 + C.lane) << 2));
                        gd[0] += h[c] * wa.x; gd[1] += h[c] * wa.y; gd[2] += h[c] * wa.z; gd[3] += h[c] * wa.w; gd[4] += h[c] * wb.x; gd[5] += h[c] * wb.y; gd[6] += h[c] * wb.z; gd[7] += h[c] * wb.w; } }
                float gv;
                { const bool b1 = C.lane & 1, b2 = C.lane & 2, b3 = C.lane & 4; float a4[4], a2[2];
#pragma unroll
                    for (int q = 0; q < 4; ++q) { const float mine = b1 ? gd[q + 4] : gd[q], send = b1 ? gd[q] : gd[q + 4]; a4[q] = mine + xor_shfl<1>(send); }
#pragma unroll
                    for (int q = 0; q < 2; ++q) { const float mine = b2 ? a4[q + 2] : a4[q], send = b2 ? a4[q] : a4[q + 2]; a2[q] = mine + xor_shfl<2>(send); }
                    { const float mine = b3 ? a2[1] : a2[0], send = b3 ? a2[0] : a2[1]; gv = mine + xor_shfl<4>(send); }
                    gv += xor_shfl<8>(gv); gv += xor_shfl<16>(gv); gv = pair_sum(gv); }
                if (C.lane < 8) { const int q = 4 * (C.lane & 1) + 2 * ((C.lane >> 1) & 1) + ((C.lane >> 2) & 1);
                    const float val = gv + gb[q];
                    float r;
                    if (q < 4) r = 15.f * tanhf(val * (1.f / 15.f));
                    else r = (val < 0.f) ? (val - log1pf(expf(val))) : -log1pf(expf(-val));
                    GL[rl * 8 + q] = r; }
            }
        }
        if (layer < 2) {
            __syncthreads();
            if (C.wave < 4) { const int hh = C.wave, t = C.lane; const float lf = GL[t * 8 + 4 + hh], ig = GL[t * 8 + hh];
                float b = lf;
#pragma unroll
                for (int o = 1; o < 64; o <<= 1) { const float u = lane_up(b, t, o); if (t >= o) b += u; }
                const float bl = lane_get(b, 63); const float gm = wave_max(bl - b + ig);
                wsp<float>(C, WS_BC)[(size_t)(row0 + t) * 4 + hh] = b; wsp<float>(C, WS_IG)[(size_t)(row0 + t) * 4 + hh] = ig;
                if (t == 0) { const int bb = row0 / SEQ, c = (row0 % SEQ) / 64; wsp<float>(C, WS_BLAST)[(bb * 4 + hh) * 128 + c] = bl; wsp<float>(C, WS_GMAX)[(bb * 4 + hh) * 128 + c] = gm; } }
            __syncthreads();
        }
    }
}
__device__ __forceinline__ void mscan(const Ctx& C, int bh, LAS float* MV) {
    const float* bl = wsp<float>(C, WS_BLAST) + bh * 128; const float* gm = wsp<float>(C, WS_GMAX) + bh * 128; const int i = C.lane;
    const float a0 = bl[2 * i], g0 = gm[2 * i], a1 = bl[2 * i + 1], g1 = gm[2 * i + 1];
    float Aa = a0 + a1, Gg = fmaxf(g0 + a1, g1);
#pragma unroll
    for (int o = 1; o < 64; o <<= 1) { const float Ap = lane_up(Aa, i, o), Gp = lane_up(Gg, i, o); if (i >= o) { Gg = fmaxf(Gp + Aa, Gg); Aa = Ap + Aa; } }
    float Ax = lane_up(Aa, i, 1), Gx = lane_up(Gg, i, 1); if (i == 0) { Ax = 0.f; Gx = -INFINITY; }
    if (i == 0) MV[0] = 0.f;
    MV[2 * i + 1] = fmaxf(Ax + a0, fmaxf(Gx + a0, g0));
    MV[2 * i + 2] = fmaxf(Aa, Gg);
}
template <int ST> __device__ __forceinline__ void stage_conv(const Ctx& C, const bf16* src  , int row0, int seq0, const float* cw  , const float* cb, const LAS float* rs, float sc, LAS unsigned char* dst) {
#pragma unroll
    for (int i = 0; i < 2; ++i) { const int task = C.tid + NTHR * i, t = task >> 4, ch = task & 15;
        float y[8];
        { const f32x4 b0 = *(const GAS f32x4*)(cb + ch * 8), b1 = *(const GAS f32x4*)(cb + ch * 8 + 4); y[0] = b0.x; y[1] = b0.y; y[2] = b0.z; y[3] = b0.w; y[4] = b1.x; y[5] = b1.y; y[6] = b1.z; y[7] = b1.w; }
#pragma unroll
        for (int j = 0; j < 4; ++j) { const int row = row0 + t - j;
            if (row >= seq0) { const u32x4 u = *(const GAS u32x4*)(src + (size_t)row * 512 + ch * 8);
                const f32x4 w0 = *(const GAS f32x4*)(cw + j * 1024 + ch * 8), w1 = *(const GAS f32x4*)(cw + j * 1024 + ch * 8 + 4);
                y[0] += w0.x * bflo(u.x); y[1] += w0.y * bfhi(u.x); y[2] += w0.z * bflo(u.y); y[3] += w0.w * bfhi(u.y); y[4] += w1.x * bflo(u.z); y[5] += w1.y * bfhi(u.z); y[6] += w1.z * bflo(u.w); y[7] += w1.w * bfhi(u.w); } }
        const float s = (rs ? rs[t] : 1.f) * sc;
#pragma unroll
        for (int q = 0; q < 8; ++q) y[q] = y[q] * sigm(y[q]) * s;
        u32x4 o; o.x = pk2(y[0], y[1]); o.y = pk2(y[2], y[3]); o.z = pk2(y[4], y[5]); o.w = pk2(y[6], y[7]);
        *(LAS u32x4*)(dst + t * (ST * 2) + ch * 16) = o; }
}
template <int ST> __device__ __forceinline__ void stage_raw128(const Ctx& C, const bf16* src  , int row0, LAS unsigned char* dst) {
#pragma unroll
    for (int i = 0; i < 2; ++i) { const int task = C.tid + NTHR * i, t = task >> 4, ch = task & 15;
        *(LAS u32x4*)(dst + t * (ST * 2) + ch * 16) = *(const GAS u32x4*)(src + (size_t)(row0 + t) * 512 + ch * 8); }
}
__device__ __forceinline__ const LAS unsigned char* tr_addr(const LAS unsigned char* base, int stride_b, int r0, int c0, int lane) {
    return base + (r0 + ((lane & 15) >> 2)) * stride_b + (c0 + 16 * ((lane >> 4) & 1) + 4 * (lane & 3)) * 2;
}
constexpr int ML_MV = 0, ML_BC = 1024, ML_GS = 1280, ML_RS = 1536, ML_NV = 2048, ML_SC = 2560, ML_KT = 4608, ML_VT = ML_KT + 20480, ML_QT = ML_VT + 20480, ML_CT = ML_QT + 17408, ML_END = ML_CT + 34816, ML_OUT = ML_KT;
static_assert(ML_END <= RING_BYTES, "mLSTM LDS map");
__device__ __forceinline__ void mlstm_u_item(const Args& A, const Ctx& C0, int layer, int bh, int c, bool scan, bool pref  ) {
    Ctx C = C0; asm volatile("" : "+v"(C.tid), "+v"(C.lane));
    LAS float* MV = (LAS float*)(C.lds + ML_MV); LAS float* RS = (LAS float*)(C.lds + ML_RS);
    LAS unsigned char* KT = C.lds + ML_KT; LAS unsigned char* VT = C.lds + ML_VT;
    const int b = bh >> 2, hh = bh & 3, row0 = b * SEQ + c * 64, seq0 = b * SEQ, lane = C.lane, hi = lane >> 5, r32 = lane & 31;
    if (scan) { if (C.wave == 0) mscan(C, bh, MV); __syncthreads(); }
    if (C.tid < 64) { const float bl = wsp<float>(C, WS_BLAST)[bh * 128 + c];
        RS[C.tid] = __expf(bl - wsp<float>(C, WS_BC)[(size_t)(row0 + C.tid) * 4 + hh] + wsp<float>(C, WS_IG)[(size_t)(row0 + C.tid) * 4 + hh] - MV[c + 1]); }
    __syncthreads();
    stage_conv<160>(C, proj(C, PJ_AK) + hh * 128, row0, seq0, A.in[3] + layer * 4096 + 512 + hh * 128, A.in[4] + layer * 1024 + 512 + hh * 128, RS, 0.08838834764831845f, KT);
    stage_raw128<160>(C, proj(C, PJ_AV) + hh * 128, row0, VT);
    __syncthreads();
    unsigned pf0 = 0u;
    if (pref) { const int t = C.tid, rown = row0 + 64; const char* p0 = nullptr;
        if (t < 134) p0 = (const char*)(proj(C, PJ_AK) + (size_t)(rown - 3 + (t >> 1)) * 512 + hh * 128) + (t & 1) * 128;
        else if (t < 262) { const int q = t - 134; p0 = (const char*)(proj(C, PJ_AV) + (size_t)(rown + (q >> 1)) * 512 + hh * 128) + (q & 1) * 128; }
        else if (t < 270) p0 = (const char*)(wsp<float>(C, WS_BC) + (size_t)(rown + (t - 262) * 8) * 4);
        else if (t < 278) p0 = (const char*)(wsp<float>(C, WS_IG) + (size_t)(rown + (t - 270) * 8) * 4);
        if (p0) pf0 = *(const GAS unsigned*)p0; }
    const int eb = C.wave >> 1, db0 = (C.wave & 1) * 2;
    f32x16 acc0 = {}, acc1 = {};
#pragma unroll
    for (int st = 0; st < 4; ++st) { const int t0 = 16 * st + 8 * hi;
        const bf16x8 af = cat8(tr16(tr_addr(VT, 320, t0, 32 * eb, lane)), tr16(tr_addr(VT, 320, t0 + 4, 32 * eb, lane)));
        const bf16x8 b0 = cat8(tr16(tr_addr(KT, 320, t0, 32 * db0, lane)), tr16(tr_addr(KT, 320, t0 + 4, 32 * db0, lane)));
        const bf16x8 b1 = cat8(tr16(tr_addr(KT, 320, t0, 32 * db0 + 32, lane)), tr16(tr_addr(KT, 320, t0 + 4, 32 * db0 + 32, lane)));
        acc0 = MFMA32(af, b0, acc0); acc1 = MFMA32(af, b1, acc1); }
    bf16* U = wsp<bf16>(C, WS_HB) + (size_t)(bh * 128 + c) * 16384;
    if (C.tid < 128) { float s = 0.f;
        for (int t = 0; t < 64; ++t) s += bflo((unsigned)*(const LAS bf16*)(KT + t * 320 + C.tid * 2));
        wsp<float>(C, WS_NUC)[(size_t)(bh * 128 + c) * 128 + C.tid] = s; }
    __syncthreads();
    { LAS bf16* US = (LAS bf16*)(C.lds + ML_KT);
#pragma unroll
        for (int r = 0; r < 16; ++r) { const int e = 32 * eb + crow(r, hi);
            US[e * 136 + 32 * db0 + r32] = (bf16)(pk2(acc0[r], 0.f) & 0xffffu); US[e * 136 + 32 * db0 + 32 + r32] = (bf16)(pk2(acc1[r], 0.f) & 0xffffu); }
        __syncthreads();
#pragma unroll
        for (int i = 0; i < 4; ++i) { const int task = C.tid + NTHR * i, e = task >> 4, ch = task & 15; *(GAS u32x4*)(U + e * 128 + ch * 8) = *(const LAS u32x4*)(US + e * 136 + ch * 8); } }
    asm volatile("" :: "v"(pf0));
    __syncthreads();
}
__device__ __forceinline__ void qknorm_rows(const Args& A, const Ctx& C, int layer) {
    const int gw = C.vcu * NWAVES + C.wave, NGW = C.G * NWAVES, lane = C.lane;
    for (int it = gw; it < NTOK * 4; it += NGW) { const int which = it & 3, row = it >> 2;
        bf16* p = proj(C, which == 0 ? PJ_BQ : which == 1 ? PJ_BK : which == 2 ? PJ_CQ : PJ_CK) + (size_t)row * 512 + lane * 8;
        const float* g = (which < 2 ? A.in[7] : A.in[9]) + layer * 128 + (which & 1) * 64 + (lane & 7) * 8;
        const u32x4 u = *(const GAS u32x4*)p; const f32x4 g0 = *(const GAS f32x4*)g, g1 = *(const GAS f32x4*)(g + 4);
        float v[8] = {bflo(u.x), bfhi(u.x), bflo(u.y), bfhi(u.y), bflo(u.z), bfhi(u.z), bflo(u.w), bfhi(u.w)}; float ss = 0.f;
#pragma unroll
        for (int i = 0; i < 8; ++i) ss += v[i] * v[i];
        ss += xor_shfl<1>(ss); ss += xor_shfl<2>(ss); ss += xor_shfl<4>(ss);
        const float rinv = rsqrtf(ss * (1.f / 64.f) + EPS) * ((which & 1) ? 1.f : 0.125f * LOG2E);
        const u32x4 o = {pk2(v[0] * rinv * g0.x, v[1] * rinv * g0.y), pk2(v[2] * rinv * g0.z, v[3] * rinv * g0.w), pk2(v[4] * rinv * g1.x, v[5] * rinv * g1.y), pk2(v[6] * rinv * g1.z, v[7] * rinv * g1.w)};
        *(GAS u32x4*)p = o; }
}
__device__ __forceinline__ void mlstm_scan(const Ctx& C) {
    LAS float* MV = (LAS float*)(C.lds + ML_MV); LAS float* DEC = (LAS float*)(C.lds + ML_RS);
    for (int w = C.vcu; w < 256; w += C.G) { const int bh = w >> 4, sl = w & 15;
        if (C.wave == 0) mscan(C, bh, MV);
        __syncthreads();
        if (C.tid < 128) DEC[C.tid] = __expf(wsp<float>(C, WS_BLAST)[bh * 128 + C.tid] + MV[C.tid] - MV[C.tid + 1]);
        __syncthreads();
        GAS unsigned* p = (GAS unsigned*)(wsp<unsigned>(C, WS_HB) + (size_t)bh * 128 * 8192 + sl * 512 + C.tid);
        float s0 = 0.f, s1 = 0.f;
        for (int c0 = 0; c0 < 128; c0 += 32) { unsigned u[32];
#pragma unroll
            for (int q = 0; q < 32; ++q) u[q] = p[(size_t)(c0 + q) * 8192];
#pragma unroll
            for (int q = 0; q < 32; ++q) { p[(size_t)(c0 + q) * 8192] = pk2(s0, s1); const float d = DEC[c0 + q]; s0 = d * s0 + bflo(u[q]); s1 = d * s1 + bfhi(u[q]); } }
        if (sl == 0 && C.tid < 128) { GAS float* np = (GAS float*)(wsp<float>(C, WS_NUC) + (size_t)bh * 128 * 128 + C.tid); float s = 0.f;
            for (int c0 = 0; c0 < 128; c0 += 16) { float u[16];
#pragma unroll
                for (int q = 0; q < 16; ++q) u[q] = np[(c0 + q) * 128];
#pragma unroll
                for (int q = 0; q < 16; ++q) { np[(c0 + q) * 128] = s; s = DEC[c0 + q] * s + u[q]; } } }
        __syncthreads();
    }
}
__device__ __forceinline__ void mlstm_out_item(const Args& A, const Ctx& C0, int layer, int bh, int c, bool scan, bool pref  , bf16* habase = nullptr  ) {
    Ctx C = C0; asm volatile("" : "+v"(C.tid), "+v"(C.lane));
    LAS float* MV = (LAS float*)(C.lds + ML_MV); LAS float* BC = (LAS float*)(C.lds + ML_BC); LAS float* GS = (LAS float*)(C.lds + ML_GS); LAS float* NV = (LAS float*)(C.lds + ML_NV);
    LAS float* SC = (LAS float*)(C.lds + ML_SC) + C.wave * 64;
    LAS unsigned char* KT = C.lds + ML_KT; LAS unsigned char* VT = C.lds + ML_VT; LAS unsigned char* QT = C.lds + ML_QT; LAS unsigned char* CT = C.lds + ML_CT; LAS float* OUT = (LAS float*)(C.lds + ML_OUT);
    const int b = bh >> 2, hh = bh & 3, row0 = b * SEQ + c * 64, seq0 = b * SEQ, lane = C.lane, hi = lane >> 5, r32 = lane & 31;
    if (scan && C.wave == 0) mscan(C, bh, MV);
    if (C.tid >= 64 && C.tid < 128) { const int t = C.tid - 64; const float bc = wsp<float>(C, WS_BC)[(size_t)(row0 + t) * 4 + hh]; BC[t] = bc; GS[t] = wsp<float>(C, WS_IG)[(size_t)(row0 + t) * 4 + hh] - bc; }
    if (C.tid >= 128 && C.tid < 256) NV[C.tid - 128] = wsp<float>(C, WS_NUC)[(size_t)(bh * 128 + c) * 128 + C.tid - 128];
    stage_conv<136>(C, proj(C, PJ_AQ) + hh * 128, row0, seq0, A.in[3] + layer * 4096 + hh * 128, A.in[4] + layer * 1024 + hh * 128, nullptr, 1.f, QT);
    stage_conv<136>(C, proj(C, PJ_AK) + hh * 128, row0, seq0, A.in[3] + layer * 4096 + 512 + hh * 128, A.in[4] + layer * 1024 + 512 + hh * 128, nullptr, 0.08838834764831845f, KT);
    stage_raw128<160>(C, proj(C, PJ_AV) + hh * 128, row0, VT);
    { const bf16* cs = wsp<bf16>(C, WS_HB) + (size_t)(bh * 128 + c) * 16384;
#pragma unroll
        for (int i = 0; i < 4; ++i) { const int task = C.tid + NTHR * i, e = task >> 4, ch = task & 15; *(LAS u32x4*)(CT + e * 272 + ch * 16) = *(const GAS u32x4*)(cs + e * 128 + ch * 8); } }
    __syncthreads();
    unsigned pf0 = 0u, pf1 = 0u;
    { const int t = C.tid; const char* p0 = nullptr; const char* p1 = nullptr;
        if (t < 128) p0 = (const char*)(proj(C, PJ_AO) + (size_t)(row0 + (t >> 1)) * 512 + hh * 128) + (t & 1) * 128;
        if (pref) { const int rown = row0 + 64;
            if (t >= 128 && t < 262) { const int q = t - 128; p0 = (const char*)(proj(C, PJ_AQ) + (size_t)(rown - 3 + (q >> 1)) * 512 + hh * 128) + (q & 1) * 128; }
            else if (t >= 262 && t < 396) { const int q = t - 262; p0 = (const char*)(proj(C, PJ_AK) + (size_t)(rown - 3 + (q >> 1)) * 512 + hh * 128) + (q & 1) * 128; }
            else if (t >= 396) { const int q = t - 396; p0 = (const char*)(proj(C, PJ_AV) + (size_t)(rown + (q >> 1)) * 512 + hh * 128) + (q & 1) * 128; }
            if (t < 12) { const int q = t + 116; p1 = (const char*)(proj(C, PJ_AV) + (size_t)(rown + (q >> 1)) * 512 + hh * 128) + (q & 1) * 128; }
            else if (t < 268) p1 = (const char*)(wsp<bf16>(C, WS_HB) + (size_t)(bh * 128 + c + 1) * 16384) + (t - 12) * 128; }
        if (p0) pf0 = *(const GAS unsigned*)p0;
        if (p1) pf1 = *(const GAS unsigned*)p1; }
    const float mc = MV[c]; const int lb = C.wave >> 2, cb = C.wave & 3, lq = 32 * lb + r32; const float bl = BC[lq];
    bf16x8 qf[8];
#pragma unroll
    for (int st = 0; st < 8; ++st) qf[st] = *(const LAS bf16x8*)(QT + lq * 272 + (16 * st + 8 * hi) * 2);
    f32x16 p0 = {}, p1 = {};
#pragma unroll
    for (int st = 0; st < 8; ++st) p0 = MFMA32(*(const LAS bf16x8*)(KT + r32 * 272 + (16 * st + 8 * hi) * 2), qf[st], p0);
    if (lb == 1) {
#pragma unroll
        for (int st = 0; st < 8; ++st) p1 = MFMA32(*(const LAS bf16x8*)(KT + (32 + r32) * 272 + (16 * st + 8 * hi) * 2), qf[st], p1); }
    f32x16 d0, d1; float mt = bl + mc;
#pragma unroll
    for (int r = 0; r < 16; ++r) { const int s = crow(r, hi); d0[r] = (s <= lq) ? bl + GS[s] : -INFINITY; mt = fmaxf(mt, d0[r]); }
#pragma unroll
    for (int r = 0; r < 16; ++r) { const int s = 32 + crow(r, hi); d1[r] = (lb == 1 && s <= lq) ? bl + GS[s] : -INFINITY; mt = fmaxf(mt, d1[r]); }
    mt = pair_max(mt);
    float rs = 0.f;
#pragma unroll
    for (int r = 0; r < 16; ++r) { p0[r] *= __expf(d0[r] - mt); p1[r] *= __expf(d1[r] - mt); rs += p0[r] + p1[r]; }
    rs = pair_sum(rs);
    float qn = 0.f;
#pragma unroll
    for (int st = 0; st < 8; ++st) { const f32x4 n0 = *(const LAS f32x4*)(NV + 16 * st + 8 * hi), n1 = *(const LAS f32x4*)(NV + 16 * st + 8 * hi + 4); const u32x4 q = __builtin_bit_cast(u32x4, qf[st]);
        qn += bflo(q.x) * n0.x + bfhi(q.x) * n0.y + bflo(q.y) * n0.z + bfhi(q.y) * n0.w + bflo(q.z) * n1.x + bfhi(q.z) * n1.y + bflo(q.w) * n1.z + bfhi(q.w) * n1.w; }
    qn = pair_sum(qn);
    const float wi = __expf(bl + mc - mt), den = wi * qn + rs, dn = fmaxf(fabsf(den), __expf(-mt));
    SC[r32] = wi / dn; SC[32 + r32] = 1.f / dn;
    f32x16 acc1 = {}, acc2 = {};
#define PKF(P, B) (bf16x8)__builtin_bit_cast(bf16x8, ((u32x4){pk2(P[B], P[B + 1]), pk2(P[B + 2], P[B + 3]), pk2(P[B + 4], P[B + 5]), pk2(P[B + 6], P[B + 7])}))
#pragma unroll
    for (int s2 = 0; s2 < 2; ++s2) { const int k0 = 16 * s2;
        const bf16x8 vf = cat8(tr16(tr_addr(VT, 320, k0 + 4 * hi, 32 * cb, lane)), tr16(tr_addr(VT, 320, k0 + 8 + 4 * hi, 32 * cb, lane)));
        acc2 = MFMA32(s2 == 0 ? PKF(p0, 0) : PKF(p0, 8), vf, acc2); }
    if (lb == 1) {
#pragma unroll
        for (int s2 = 0; s2 < 2; ++s2) { const int k0 = 32 + 16 * s2;
            const bf16x8 vf = cat8(tr16(tr_addr(VT, 320, k0 + 4 * hi, 32 * cb, lane)), tr16(tr_addr(VT, 320, k0 + 8 + 4 * hi, 32 * cb, lane)));
            acc2 = MFMA32(s2 == 0 ? PKF(p1, 0) : PKF(p1, 8), vf, acc2); } }
#undef PKF
#pragma unroll
    for (int st = 0; st < 8; ++st) acc1 = MFMA32(qf[st], *(const LAS bf16x8*)(CT + (32 * cb + r32) * 272 + (16 * st + 8 * hi) * 2), acc1);
    __syncthreads();
#pragma unroll
    for (int r = 0; r < 16; ++r) { const int l_ = crow(r, hi); OUT[(32 * lb + l_) * 132 + 32 * cb + r32] = SC[l_] * acc1[r] + SC[32 + l_] * acc2[r]; }
    __syncthreads();
    { const int row = C.tid >> 3, seg = C.tid & 7; float v[16]; float ss = 0.f;
#pragma unroll
        for (int q = 0; q < 4; ++q) { const f32x4 x = *(const LAS f32x4*)(OUT + row * 132 + seg * 16 + 4 * q); v[4 * q] = x.x; v[4 * q + 1] = x.y; v[4 * q + 2] = x.z; v[4 * q + 3] = x.w; ss += (x.x * x.x + x.y * x.y) + (x.z * x.z + x.w * x.w); }
        ss += xor_shfl<1>(ss); ss += xor_shfl<2>(ss); ss += xor_shfl<4>(ss);
        const float rinv = rsqrtf(ss * (1.f / 128.f) + EPS);
        const float* gn = A.in[6] + layer * 512 + hh * 128 + seg * 16;
        const bf16* ao = proj(C, PJ_AO) + (size_t)(row0 + row) * 512 + hh * 128 + seg * 16;
        bf16* ha = (habase ? habase : proj(C, PJ_AV)) + (size_t)(row0 + row) * 512 + hh * 128 + seg * 16;
#pragma unroll
        for (int q = 0; q < 2; ++q) { const u32x4 a = *(const GAS u32x4*)(ao + 8 * q); const f32x4 g0 = *(const GAS f32x4*)(gn + 8 * q), g1 = *(const GAS f32x4*)(gn + 8 * q + 4); const float* vv = v + 8 * q;
            u32x4 o; o.x = pk2(vv[0] * rinv * g0.x * sigm(bflo(a.x)), vv[1] * rinv * g0.y * sigm(bfhi(a.x))); o.y = pk2(vv[2] * rinv * g0.z * sigm(bflo(a.y)), vv[3] * rinv * g0.w * sigm(bfhi(a.y)));
            o.z = pk2(vv[4] * rinv * g1.x * sigm(bflo(a.z)), vv[5] * rinv * g1.y * sigm(bfhi(a.z))); o.w = pk2(vv[6] * rinv * g1.z * sigm(bflo(a.w)), vv[7] * rinv * g1.w * sigm(bfhi(a.w)));
            *(GAS u32x4*)(ha + 8 * q) = o; } }
    asm volatile("" :: "v"(pf0), "v"(pf1));
    __syncthreads();
}
constexpr int AT_TAB = 0, AT_SCR = 3072, AT_K = 5120;
template <int DV, bool ISC> __device__ __forceinline__ void attn_unit(const Args& A, const Ctx& C0, int layer, int b, int hs, int qblk, bf16* obase = nullptr  ) {
    Ctx C = C0; asm volatile("" : "+v"(C.tid), "+v"(C.lane));
    constexpr int KSTB = 144, VSTB = 2 * DV + 64, KB = 64 * KSTB, VB = 64 * VSTB, AT_V = AT_K + 4 * KB, NBLK = DV / 32;
    static_assert(AT_V + 4 * VB <= RING_BYTES, "attention LDS map");
    LAS float* TAB = (LAS float*)(C.lds + AT_TAB); LAS float* SCR = (LAS float*)(C.lds + AT_SCR) + C.wave * 64;
    const int lane = C.lane, hi = lane >> 5, r32 = lane & 31, tid = C.tid;
    const bf16 *Qp, *Kp, *Vp; bf16* Op; int pitchO; const float *gq, *gk; int hbias;
    if (ISC) { const int h = hs >> 1, wh = hs & 1; Qp = proj(C, PJ_CQ) + h * 128 + wh * 64; Kp = proj(C, PJ_CK) + h * 128 + wh * 64; Vp = proj(C, PJ_CV) + h * 128;
        Op = wsp<bf16>(C, WS_O12) + h * 256 + wh * 128; pitchO = 1024; gq = A.in[9] + layer * 128; gk = gq + 64; hbias = h; }
    else { Qp = proj(C, PJ_BQ) + hs * 64; Kp = proj(C, PJ_BK) + hs * 64; Vp = proj(C, PJ_BV) + hs * 64; Op = (obase ? obase : proj(C, PJ_BQ)) + hs * 64; pitchO = 512; gq = A.in[7] + layer * 128; gk = gq + 64; hbias = hs; }
    const size_t rowb = (size_t)b * SEQ;
    const int qs0 = qblk * 256 + C.wave * 32;
    for (int i = tid; i < 768; i += NTHR) { const int d = 703 - i; float v;
        if (ISC) { const int n = d < 0 ? -d : d; int bk = n < 8 ? n : n < 15 ? 8 : n < 27 ? 9 : n < 50 ? 10 : n < 91 ? 11 : n < 166 ? 12 : n < 305 ? 13 : n < 559 ? 14 : 15; if (d < 0) bk += 16; v = A.in[12][bk * 4 + hbias]; }
        else { const int dc = d < -256 ? -256 : d > 256 ? 256 : d; v = A.in[8][(size_t)layer * 513 * 8 + (dc + 256) * 8 + hbias]; }
        TAB[i] = v * LOG2E; }
    float MB;
    { const float gqm = wave_max(fabsf(gq[lane])), gkm = wave_max(fabsf(gk[lane]));
        float bm = 0.f;
        if (ISC) { bm = (lane < 32) ? fabsf(A.in[12][lane * 4 + hbias]) : 0.f; }
        else { for (int i = lane; i < 513; i += 64) bm = fmaxf(bm, fabsf(A.in[8][(size_t)layer * 513 * 8 + i * 8 + hbias])); }
        bm = wave_max(bm);
        MB = 64.f * (0.125f * LOG2E) * gqm * gkm * 1.02f + bm * LOG2E; }
    const float t15 = (ISC ? A.in[12][15 * 4 + hbias] * LOG2E : 0.f) - MB;
    bf16x8 qf[4];
    { float qv[32]; float ss = 0.f; const bf16* qrow = Qp + (rowb + qs0 + r32) * 512 + 8 * hi;
#pragma unroll
        for (int st = 0; st < 4; ++st) { const u32x4 u = *(const GAS u32x4*)(qrow + 16 * st);
            qv[8 * st] = bflo(u.x); qv[8 * st + 1] = bfhi(u.x); qv[8 * st + 2] = bflo(u.y); qv[8 * st + 3] = bfhi(u.y); qv[8 * st + 4] = bflo(u.z); qv[8 * st + 5] = bfhi(u.z); qv[8 * st + 6] = bflo(u.w); qv[8 * st + 7] = bfhi(u.w); }
#pragma unroll
        for (int i = 0; i < 32; ++i) ss += qv[i] * qv[i];
        ss = pair_sum(ss);
        const float rinv = rsqrtf(ss * (1.f / 64.f) + EPS) * (0.125f * LOG2E);
#pragma unroll
        for (int st = 0; st < 4; ++st) { const f32x4 g0 = *(const GAS f32x4*)(gq + 16 * st + 8 * hi) * *(const GAS f32x4*)(gk + 16 * st + 8 * hi), g1 = *(const GAS f32x4*)(gq + 16 * st + 8 * hi + 4) * *(const GAS f32x4*)(gk + 16 * st + 8 * hi + 4); const float* q = qv + 8 * st;
            const u32x4 o = {pk2(q[0] * rinv * g0.x, q[1] * rinv * g0.y), pk2(q[2] * rinv * g0.z, q[3] * rinv * g0.w), pk2(q[4] * rinv * g1.x, q[5] * rinv * g1.y), pk2(q[6] * rinv * g1.z, q[7] * rinv * g1.w)};
            qf[st] = __builtin_bit_cast(bf16x8, o); } }
    const int krow = tid >> 3, kch = tid & 7;
    const int jhi = qblk * 4 + 3, jlo = ISC ? 0 : (qblk * 4 - 8 < 0 ? 0 : qblk * 4 - 8), cqw = qblk * 4 + (C.wave >> 1);
    const bf16* ksrc = Kp + (rowb + krow) * 512 + kch * 8;
    u32x4 kregA, kregB, vregA[NBLK / 2], vregB[NBLK / 2];
#define AT_LOADT(j, KR, VR) do { KR = *(const GAS u32x4*)(ksrc + (size_t)(j) * 64 * 512); \
        if (DV == 128) { _Pragma("unroll") for (int i_ = 0; i_ < 2; ++i_) { const int idx = tid + NTHR * i_; VR[i_] = *(const GAS u32x4*)(Vp + (rowb + (size_t)(j) * 64 + (idx >> 4)) * 512 + (idx & 15) * 8); } } \
        else VR[0] = *(const GAS u32x4*)(Vp + (rowb + (size_t)(j) * 64 + krow) * 512 + kch * 8); } while (0)
    AT_LOADT(jlo, kregA, vregA); AT_LOADT(jlo + 1, kregB, vregB);
    float l = 0.f; f32x16 o[NBLK];
#pragma unroll
    for (int nb = 0; nb < NBLK; ++nb) o[nb] = f32x16{};
#define AT_VLOAD(F, nb_) do { _Pragma("unroll") for (int ks_ = 0; ks_ < 4; ++ks_) { F[2 * ks_] = tr16(vb_ + (16 * ks_) * VSTB + (nb_) * 64); F[2 * ks_ + 1] = tr16(vb_ + (16 * ks_ + 8) * VSTB + (nb_) * 64); } } while (0)
#define AT_STAGE(buf, KR, VR) do { \
        LAS unsigned char* KT = C.lds + AT_K + (buf) * KB; LAS unsigned char* VT = C.lds + AT_V + (buf) * VB; \
        { float kv[8] = {bflo(KR.x), bfhi(KR.x), bflo(KR.y), bfhi(KR.y), bflo(KR.z), bfhi(KR.z), bflo(KR.w), bfhi(KR.w)}; float ss = 0.f; \
            _Pragma("unroll") for (int i = 0; i < 8; ++i) ss += kv[i] * kv[i]; \
            ss += xor_shfl<1>(ss); ss += xor_shfl<2>(ss); ss += xor_shfl<4>(ss); \
            const float rinv = rsqrtf(ss * (1.f / 64.f) + EPS); \
            const u32x4 w = {pk2(kv[0] * rinv, kv[1] * rinv), pk2(kv[2] * rinv, kv[3] * rinv), pk2(kv[4] * rinv, kv[5] * rinv), pk2(kv[6] * rinv, kv[7] * rinv)}; \
            *(LAS u32x4*)(KT + krow * KSTB + kch * 16) = w; } \
        if (DV == 128) { _Pragma("unroll") for (int i_ = 0; i_ < 2; ++i_) { const int idx = tid + NTHR * i_; *(LAS u32x4*)(VT + (idx >> 4) * VSTB + (idx & 15) * 16) = VR[i_]; } } \
        else *(LAS u32x4*)(VT + krow * VSTB + kch * 16) = VR[0]; \
    } while (0)
#define AT_COMP(j, buf) do { \
        LAS unsigned char* KT = C.lds + AT_K + (buf) * KB; LAS unsigned char* VT = C.lds + AT_V + (buf) * VB; \
        const bool act = ((j) <= cqw) && (ISC || (j) >= cqw - 8); \
        if (act) { \
            f32x16 p0, p1; \
            const bool far = ISC && (qs0 - (64 * (j) + 63) >= 559); \
            if (far) { _Pragma("unroll") for (int r = 0; r < 16; ++r) { p0[r] = t15; p1[r] = t15; } } \
            else { const LAS float* tp = TAB + (703 - (qs0 + r32) + 64 * (j) + 4 * hi); \
                _Pragma("unroll") for (int r = 0; r < 16; ++r) { p0[r] = tp[(r & 3) + 8 * (r >> 2)] - MB; p1[r] = tp[32 + (r & 3) + 8 * (r >> 2)] - MB; } } \
            { bf16x8 kf[8]; \
                _Pragma("unroll") for (int st = 0; st < 4; ++st) { kf[2 * st] = *(const LAS bf16x8*)(KT + r32 * KSTB + (16 * st + 8 * hi) * 2); kf[2 * st + 1] = *(const LAS bf16x8*)(KT + (32 + r32) * KSTB + (16 * st + 8 * hi) * 2); } \
                __builtin_amdgcn_sched_barrier(0);        \
                _Pragma("unroll") for (int st = 0; st < 4; ++st) { p0 = MFMA32(kf[2 * st], qf[st], p0); p1 = MFMA32(kf[2 * st + 1], qf[st], p1); } } \
            float rs0 = 0.f, rs1 = 0.f, rs2 = 0.f, rs3 = 0.f;        \
            _Pragma("unroll") for (int r = 0; r < 16; r += 2) { p0[r] = __builtin_amdgcn_exp2f(p0[r]); p1[r] = __builtin_amdgcn_exp2f(p1[r]); p0[r + 1] = __builtin_amdgcn_exp2f(p0[r + 1]); p1[r + 1] = __builtin_amdgcn_exp2f(p1[r + 1]); \
                rs0 += p0[r]; rs1 += p1[r]; rs2 += p0[r + 1]; rs3 += p1[r + 1]; } \
            l += (rs0 + rs1) + (rs2 + rs3); \
            bf16x8 pw[4]; \
            pw[0] = PKF(p0, 0); pw[1] = PKF(p0, 8); pw[2] = PKF(p1, 0); pw[3] = PKF(p1, 8); \
            { s16x4 fa[8], fb[8]; const LAS unsigned char* vb_ = tr_addr(VT, VSTB, 4 * hi, 0, lane); \
                AT_VLOAD(fa, 0); \
                _Pragma("unroll") for (int nb = 0; nb < NBLK; nb += 2) { \
                    AT_VLOAD(fb, nb + 1); __builtin_amdgcn_sched_barrier(0); \
                    _Pragma("unroll") for (int ks = 0; ks < 4; ++ks) o[nb] = MFMA32(pw[ks], cat8(fa[2 * ks], fa[2 * ks + 1]), o[nb]); \
                    __builtin_amdgcn_sched_barrier(0); \
                    if (nb + 2 < NBLK) AT_VLOAD(fa, nb + 2); __builtin_amdgcn_sched_barrier(0); \
                    _Pragma("unroll") for (int ks = 0; ks < 4; ++ks) o[nb + 1] = MFMA32(pw[ks], cat8(fb[2 * ks], fb[2 * ks + 1]), o[nb + 1]); \
                    __builtin_amdgcn_sched_barrier(0); } } \
        } } while (0)
#define PKF(P, B) __builtin_bit_cast(bf16x8, ((u32x4){pk2(P[B], P[B + 1]), pk2(P[B + 2], P[B + 3]), pk2(P[B + 4], P[B + 5]), pk2(P[B + 6], P[B + 7])}))
    for (int j = jlo; j <= jhi; j += 2) { const int sb = (((j - jlo) >> 1) & 1) * 2;
        AT_STAGE(sb, kregA, vregA); AT_STAGE(sb + 1, kregB, vregB);
        __syncthreads();
        if (j + 2 <= jhi) { AT_LOADT(j + 2, kregA, vregA); AT_LOADT(j + 3, kregB, vregB); }
        AT_COMP(j, sb); AT_COMP(j + 1, sb + 1); }
#undef PKF
#undef AT_STAGE
#undef AT_COMP
#undef AT_VLOAD
#undef AT_LOADT
    l = pair_sum(l);
    SCR[32 + r32] = 1.f / l;
    bf16* orow = Op + (rowb + qs0) * pitchO;
#pragma unroll
    for (int r = 0; r < 16; ++r) { const int q = crow(r, hi); const float rl = SCR[32 + q];
#pragma unroll
        for (int nb = 0; nb < NBLK; ++nb) ((GAS bf16*)orow)[(size_t)q * pitchO + 32 * nb + r32] = (bf16)(pk2(o[nb][r] * rl, 0.f) & 0xffffu); }
    __syncthreads();
}
__device__ __forceinline__ void phase5(const Args& A, const Ctx& C, int layer) {
    const int gw = C.vcu * NWAVES + C.wave, NGW = C.G * NWAVES, lane = C.lane;
    const float lam_init = 0.8f - 0.6f * __expf(-0.3f * (float)layer);
    const float* cl = A.in[10] + layer * 256;
    const float lam = __expf(wave_sum(cl[lane] * cl[64 + lane])) - __expf(wave_sum(cl[128 + lane] * cl[192 + lane])) + lam_init;
    const float* gs = A.in[11] + layer * 128 + (lane & 15) * 8;
    const f32x4 gs0 = *(const GAS f32x4*)gs, gs1 = *(const GAS f32x4*)(gs + 4);
    const float post = 1.f - lam_init;
    const bf16* o12 = wsp<bf16>(C, WS_O12); bf16* hc = proj(C, PJ_CQ);
    const int h = lane >> 4, e0 = (lane & 15) * 8;
    for (int row0 = gw; row0 < NTOK; row0 += 4 * NGW) {
        u32x4 av[4], bv[4];
#pragma unroll
        for (int q = 0; q < 4; ++q) { const int row = row0 + q * NGW; if (row < NTOK) { av[q] = *(const GAS u32x4*)(o12 + (size_t)row * 1024 + h * 256 + e0); bv[q] = *(const GAS u32x4*)(o12 + (size_t)row * 1024 + h * 256 + 128 + e0); } }
#pragma unroll
        for (int q = 0; q < 4; ++q) { const int row = row0 + q * NGW; if (row < NTOK) { const u32x4 a = av[q], bq = bv[q];
            float v[8] = {bflo(a.x) - lam * bflo(bq.x), bfhi(a.x) - lam * bfhi(bq.x), bflo(a.y) - lam * bflo(bq.y), bfhi(a.y) - lam * bfhi(bq.y), bflo(a.z) - lam * bflo(bq.z), bfhi(a.z) - lam * bfhi(bq.z), bflo(a.w) - lam * bflo(bq.w), bfhi(a.w) - lam * bfhi(bq.w)};
            float ss = 0.f;
#pragma unroll
            for (int i = 0; i < 8; ++i) ss += v[i] * v[i];
            ss += xor_shfl<1>(ss); ss += xor_shfl<2>(ss); ss += xor_shfl<4>(ss); ss += xor_shfl<8>(ss);
            const float rinv = rsqrtf(ss * (1.f / 128.f) + EPS) * post;
            const u32x4 o = {pk2(v[0] * rinv * gs0.x, v[1] * rinv * gs0.y), pk2(v[2] * rinv * gs0.z, v[3] * rinv * gs0.w), pk2(v[4] * rinv * gs1.x, v[5] * rinv * gs1.y), pk2(v[6] * rinv * gs1.z, v[7] * rinv * gs1.w)};
            *(GAS u32x4*)(hc + (size_t)row * 512 + h * 128 + e0) = o; } }
    }
}
constexpr int RT_RSTD = 0, RT_HT = 1024, RT_WT = RT_HT + 128 * 68 * 4, RT_LOG = RT_WT + 128 * 40 * 4, RT_HIST = RT_LOG + 64 * 37 * 4, RT_BASE = RT_HIST + 128, RT_SEL = RT_BASE + 128, RT_G2S = RT_SEL + 64 * 4 * 4, RT_END = RT_G2S + 4096, RT_RED = RT_HT;
static_assert(RT_END <= RING_BYTES && 2 * 64 * 65 * 4 <= RT_LOG - RT_HT && 3 * 64 * 272 <= RT_LOG - RT_HT, "routing LDS map");
#ifndef P9PARTS
#define P9PARTS 15
#endif
__device__ __forceinline__ void phase9(const Args& A, const Ctx& C, int layer, bool dummy = false  ) {
    const int parts = dummy ? (P9PARTS) : 15;
    const size_t doff = dummy ? (476 * MiB) : 0;
    if (parts & 1) moe_weight_items(A, C, layer);
    __syncthreads();
    for (int i = C.tid; i < 1024; i += NTHR) ((LAS float*)(C.lds + RT_G2S))[i] = (A.in[15] + layer * 1024)[i];
    LAS float* RSTD = (LAS float*)(C.lds + RT_RSTD); LAS float* HT = (LAS float*)(C.lds + RT_HT); LAS float* WT = (LAS float*)(C.lds + RT_WT); LAS float* LOG = (LAS float*)(C.lds + RT_LOG); LAS float* RED = (LAS float*)(C.lds + RT_RED);
    LAS int* HIST = (LAS int*)(C.lds + RT_HIST); LAS int* BASE = (LAS int*)(C.lds + RT_BASE); LAS int* SEL = (LAS int*)(C.lds + RT_SEL);
    const float* g2 = A.in[15] + layer * 1024; const float* wg = A.in[16] + layer * 4096; const float* bg = A.in[17] + layer * 4; const float* wr = A.in[18] + layer * 32768; const float* br = A.in[19] + layer * 32;
    bf16* h2 = wsp<bf16>(C, dummy ? 128 * MiB : WS_H2); const bf16* xb1 = wsp<bf16>(C, WS_XB1); const int lane = C.lane, tid = C.tid, wv = C.wave;
    for (int item = C.vcu; item < NTOK / 64; item += C.G) {
        const int row0 = item * 64;
        if (tid < 32) HIST[tid] = 0;
        f32x4 vnx[4];
        {
#pragma unroll
            for (int j = 0; j < 4; ++j) vnx[j] = ldrow4(xb1, true, (size_t)(row0 + wv * 8), lane + 64 * j); }
        for (int i = 0; i < ((parts & 2) ? 8 : 0); ++i) { const int rl = wv * 8 + i, row = row0 + rl;
            f32x4 v[4]; float ss = 0.f;
#pragma unroll
            for (int j = 0; j < 4; ++j) { v[j] = vnx[j]; ss += (v[j].x * v[j].x + v[j].y * v[j].y) + (v[j].z * v[j].z + v[j].w * v[j].w); }
            if (i < 7) {
#pragma unroll
                for (int j = 0; j < 4; ++j) vnx[j] = ldrow4(xb1, true, (size_t)(row + 1), lane + 64 * j); }
            const float rstd = rsqrtf(wave_sum(ss) * (1.f / DM) + EPS);
            GAS u32x2* ho = (GAS u32x2*)(h2 + (size_t)row * DM) + lane;
#pragma unroll
            for (int j = 0; j < 4; ++j) { const f32x4 g = ((const GAS f32x4*)g2)[64 * j + lane]; u32x2 o; o.x = pk2(v[j].x * rstd * g.x, v[j].y * rstd * g.y); o.y = pk2(v[j].z * rstd * g.z, v[j].w * rstd * g.w); ho[64 * j] = o; }
            if (lane == 0) RSTD[rl] = rstd; }
        __syncthreads();
        if (parts & 4) {
            const int rb = wv & 1, cb = (wv >> 1) & 1, kh = wv >> 2, r32 = lane & 31, hh = lane >> 5;
            const float rs = RSTD[32 * rb + r32];
            LAS unsigned char* XS_ = C.lds + RT_HT; LAS unsigned char* WH = XS_ + 64 * 272; LAS unsigned char* WL = WH + 64 * 272; const LAS float* G2S = (const LAS float*)(C.lds + RT_G2S);
            const bf16* wrt = wsp<bf16>(C, WS_WRT);
            u32x4 xr[2], whr[2], wlr[2];
#define RT_LD(kc_) do { _Pragma("unroll") for (int i_ = 0; i_ < 2; ++i_) { const int idx = tid + NTHR * i_, t = idx >> 4, ch = idx & 15; \
                xr[i_] = *(const GAS u32x4*)(xb1 + (size_t)(row0 + t) * DM + (kc_) * 128 + ch * 8); whr[i_] = *(const GAS u32x4*)(wrt + (size_t)t * DM + (kc_) * 128 + ch * 8); wlr[i_] = *(const GAS u32x4*)(wrt + 65536 + (size_t)t * DM + (kc_) * 128 + ch * 8); } } while (0)
            RT_LD(0);
            f32x16 acc = {};
            for (int kc = 0; kc < 8; ++kc) {
#pragma unroll
                for (int i_ = 0; i_ < 2; ++i_) { const int idx = tid + NTHR * i_, t = idx >> 4, ch = idx & 15;
                    *(LAS u32x4*)(XS_ + t * 272 + ch * 16) = xr[i_]; *(LAS u32x4*)(WH + t * 272 + ch * 16) = whr[i_]; *(LAS u32x4*)(WL + t * 272 + ch * 16) = wlr[i_]; }
                __syncthreads();
                if (kc < 7) RT_LD(kc + 1);
#pragma unroll
                for (int s = 0; s < 4; ++s) { const int ko = 16 * (kh * 4 + s) + 8 * hh;
                    const u32x4 xa = *(const LAS u32x4*)(XS_ + (32 * rb + r32) * 272 + ko * 2); const f32x4 ga = *(const LAS f32x4*)(G2S + kc * 128 + ko), gb = *(const LAS f32x4*)(G2S + kc * 128 + ko + 4);
                    const bf16x8 bhi = *(const LAS bf16x8*)(WH + (32 * cb + r32) * 272 + ko * 2), blo = *(const LAS bf16x8*)(WL + (32 * cb + r32) * 272 + ko * 2);
                    const float h0 = bflo(xa.x) * rs * ga.x, h1 = bfhi(xa.x) * rs * ga.y, h2_ = bflo(xa.y) * rs * ga.z, h3 = bfhi(xa.y) * rs * ga.w;
                    const float h4 = bflo(xa.z) * rs * gb.x, h5 = bfhi(xa.z) * rs * gb.y, h6 = bflo(xa.w) * rs * gb.z, h7 = bfhi(xa.w) * rs * gb.w;
                    const u32x4 hi4 = {pk2(h0, h1), pk2(h2_, h3), pk2(h4, h5), pk2(h6, h7)};
                    const u32x4 lo4 = {pk2(h0 - bflo(hi4.x), h1 - bfhi(hi4.x)), pk2(h2_ - bflo(hi4.y), h3 - bfhi(hi4.y)), pk2(h4 - bflo(hi4.z), h5 - bfhi(hi4.z)), pk2(h6 - bflo(hi4.w), h7 - bfhi(hi4.w))};
                    const bf16x8 ahi = __builtin_bit_cast(bf16x8, hi4), alo = __builtin_bit_cast(bf16x8, lo4);
                    acc = MFMA32(ahi, bhi, acc); acc = MFMA32(ahi, blo, acc); acc = MFMA32(alo, bhi, acc); }
                __syncthreads();
            }
#undef RT_LD
#pragma unroll
            for (int r_ = 0; r_ < 16; ++r_) RED[(kh * 64 + 32 * rb + crow(r_, hh)) * 65 + 32 * cb + r32] = acc[r_];
        }
        __syncthreads();
        { const int tok = tid & 63, cgr = tid >> 6;
#pragma unroll
            for (int c = 0; c < 4; ++c) { const int col = 4 * cgr + c; LOG[tok * 37 + col] = RED[tok * 65 + col] + RED[(64 + tok) * 65 + col] + br[col]; }
            if (cgr < 4) { const int col = 32 + cgr; LOG[tok * 37 + col] = RED[tok * 65 + col] + RED[(64 + tok) * 65 + col] + bg[cgr]; } }
        __syncthreads();
        if (tid < 64 && (parts & 8)) { const LAS float* lg = LOG + tid * 37;
            int gi = 0; float gmx = lg[32];
#pragma unroll
            for (int q = 1; q < 4; ++q) if (lg[32 + q] > gmx) { gmx = lg[32 + q]; gi = q; }
            float gsum = 0.f;
#pragma unroll
            for (int q = 0; q < 4; ++q) gsum += __expf(lg[32 + q] - gmx);
            const float pg = 1.f / gsum;
            const LAS float* el = lg + gi * 8; int i0 = 0; float e0 = el[0];
#pragma unroll
            for (int q = 1; q < 8; ++q) if (el[q] > e0) { e0 = el[q]; i0 = q; }
            int i1 = -1; float e1 = -INFINITY;
#pragma unroll
            for (int q = 0; q < 8; ++q) if (q != i0 && el[q] > e1) { e1 = el[q]; i1 = q; }
            const float x1 = __expf(e1 - e0), w0 = pg / (1.f + x1), w1 = pg * x1 / (1.f + x1);
            const int ea = gi * 8 + i0, eb = gi * 8 + i1;
            const int ra = atomicAdd((int*)(HIST + ea), 1), rb = atomicAdd((int*)(HIST + eb), 1);
            SEL[tid * 4 + 0] = ea; SEL[tid * 4 + 1] = eb; SEL[tid * 4 + 2] = ra; SEL[tid * 4 + 3] = rb;
            wsp<float>(C, WS_TOKW + doff)[(size_t)(row0 + tid) * 2] = w0; wsp<float>(C, WS_TOKW + doff)[(size_t)(row0 + tid) * 2 + 1] = w1; }
        __syncthreads();
        if (tid < 32) wsp<int>(C, WS_HISTG + doff)[item * 32 + tid] = HIST[tid];
        if (tid < 64) { wsp<int>(C, WS_TOKE + doff)[(size_t)(row0 + tid) * 2] = SEL[tid * 4]; wsp<int>(C, WS_TOKE + doff)[(size_t)(row0 + tid) * 2 + 1] = SEL[tid * 4 + 1];
            wsp<int>(C, WS_TOKR + doff)[(size_t)(row0 + tid) * 2] = SEL[tid * 4 + 2]; wsp<int>(C, WS_TOKR + doff)[(size_t)(row0 + tid) * 2 + 1] = SEL[tid * 4 + 3]; }
        __syncthreads();
    }
}
constexpr int P10_H = 0, P10_SEG = 65536, P10_BASE = P10_SEG + 16 * 32 * 4, P10_TOT = P10_BASE + 16 * 32 * 4;
__device__ __forceinline__ void phase10(const Ctx& C, int layer) {
    LAS int* H = (LAS int*)(C.lds + P10_H); LAS int* SEG = (LAS int*)(C.lds + P10_SEG); LAS int* SBASE = (LAS int*)(C.lds + P10_BASE); LAS int* TOT = (LAS int*)(C.lds + P10_TOT);
    LAS int* OFFS = (LAS int*)(C.lds + OFFS_OFF);
    { const int* hg = wsp<int>(C, WS_HISTG);
        for (int i = C.tid; i < 16384 / 4; i += NTHR) *(LAS u32x4*)(H + 4 * i) = *(const GAS u32x4*)(hg + 4 * i);
        __syncthreads();
        const int e = C.tid & 31, sg = C.tid >> 5; int s = 0;
        for (int i = 0; i < 32; ++i) s += H[(sg * 32 + i) * 32 + e];
        SEG[sg * 32 + e] = s;
        __syncthreads();
        if (C.tid < 32) { int run = 0; for (int q = 0; q < 16; ++q) { SBASE[q * 32 + C.tid] = run; run += SEG[q * 32 + C.tid]; } TOT[C.tid] = run; }
        __syncthreads();
        int run = SBASE[sg * 32 + e];
        for (int i = 0; i < 32; ++i) { const int v = H[(sg * 32 + i) * 32 + e]; H[(sg * 32 + i) * 32 + e] = run; run += v; }
        if (C.tid == 0) { int o = 0; for (int q = 0; q < 32; ++q) { OFFS[q] = o; o += (TOT[q] + 255) & ~255; } OFFS[32] = o; }
        __syncthreads(); }
    if (blockIdx.x == 0) { int* texp = wsp<int>(C, WS_TEXP); const int RT = OFFS[32] >> 8;
        for (int rt = C.tid; rt < RT; rt += NTHR) { int e = 0;
            for (int q = 1; q < 32; ++q) if (rt * 256 >= OFFS[q]) e = q;
            texp[rt] = e; }
        if (C.tid == 0) texp[511] = RT; }
    const int gw = C.vcu * NWAVES + C.wave, NGW = C.G * NWAVES, lane = C.lane;
    const bf16* h2 = wsp<bf16>(C, WS_H2); bf16* xs = wsp<bf16>(C, WS_XS); const int* toke = wsp<int>(C, WS_TOKE); const int* tokr = wsp<int>(C, WS_TOKR); int* tokp = wsp<int>(C, WS_TOKP);
    for (int s0 = gw; s0 < NTOK * 2; s0 += 4 * NGW) { int ev[4], rv[4]; u32x4 ra[4], rb[4];
#pragma unroll
        for (int q = 0; q < 4; ++q) { const int s = s0 + q * NGW; if (s < NTOK * 2) { ev[q] = toke[s]; rv[q] = tokr[s]; const GAS u32x4* src = (const GAS u32x4*)(h2 + (size_t)(s >> 1) * DM) + lane; ra[q] = src[0]; rb[q] = src[64]; } }
#pragma unroll
        for (int q = 0; q < 4; ++q) { const int s = s0 + q * NGW; if (s < NTOK * 2) { const int e = ev[q]; const int ipos = OFFS[e] + H[(s >> 7) * 32 + e] + rv[q];
                if (lane == 0) tokp[s] = ipos;
                GAS u32x4* dst = (GAS u32x4*)(xs + (size_t)ipos * DM) + lane; dst[0] = ra[q]; dst[64] = rb[q]; } } }
}
constexpr int PH_PER_LAYER = 13, N_PHASES = 2 * PH_PER_LAYER + 1;
#ifndef MK_ONE_LAUNCH
#define MK_ONE_LAUNCH 1
#endif
#ifndef E2_ALIGN
#define E2_ALIGN false
#define E2_SP2 true
#endif
__global__ void __launch_bounds__(NTHR, 2) fwd(Args A) {
    extern __shared__ __attribute__((aligned(16))) unsigned char lds_raw[];
    Ctx C_;
    C_.lds = (LAS unsigned char*)lds_raw; C_.MISC = (volatile LAS unsigned*)(C_.lds + MISC_OFF);
    C_.tid = threadIdx.x; C_.lane = C_.tid & 63; C_.wave = __builtin_amdgcn_readfirstlane(C_.tid >> 6);
    C_.G = gridDim.x; { const int bx = blockIdx.x; C_.vcu = (C_.G % 8 == 0) ? (bx % 8) * (C_.G / 8) + bx / 8 : bx; }
    C_.ws = A.ws; C_.ctl = (gu32*)(A.ws + WS_CTL);
    for (int u = C_.tid; u < 128; u += NTHR) ((LAS unsigned*)(C_.lds + MISC_OFF))[u] = 0u;
    __syncthreads();
    const int lo = A.ph_lo, hi = A.ph_hi;
    const bool multi = (hi - lo) > 1;
    XcdBarrier bar; bar.wv = C_.wave; bar.bar = (unsigned*)(C_.ctl + CW_BAR); bar.x = 0; bar.st = nullptr;
    if (multi) bar = xcd_barrier_post((unsigned*)(C_.ctl + CW_BAR), C_.MISC + 8, C_.wave);
#ifndef PHASE_MASK
#define PHASE_MASK 0x1fff
#endif
#define HAS(k) (((PHASE_MASK) >> (k)) & 1)
#ifndef REPMASK
#define REPMASK 0
#endif
#ifndef P0PARTS
#define P0PARTS 7
#endif
#ifndef REPCNT
#define REPCNT 2
#endif
#define NREP(k) ((((REPMASK) >> (k)) & 1) && layer == 0 ? REPCNT : 1)
#define IN(k) (lo <= (k) && (k) < hi)
#define SEAM(k) do { if (IN(k) && IN((k) + 1)) xcd_barrier(bar); } while (0)
#define FRESH() Ctx C = C_; C.lane = xb_lane(); C.tid = C_.wave * 64 + C.lane; asm volatile("" : "+s"(C.ws), "+s"(C.ctl), "+s"(C.vcu), "+s"(C.G))
    for (int layer = 0; layer < 3; ++layer) {
        const int pb = layer * PH_PER_LAYER;
        if (HAS(0) && IN(pb + 0)) for (int rep_ = 0; rep_ < NREP(0); ++rep_) { FRESH(); phase0(A, C, layer, rep_ == 0 ? 7 : P0PARTS); }
        if (layer == 2) break;
        SEAM(pb + 0);
#ifdef XBAR_PROBE
        if (layer == 0 && IN(pb + 0) && IN(pb + 1)) { for (int q = 0; q < XBAR_PROBE; ++q) xcd_barrier(bar); }
#endif
        if (HAS(1) && IN(pb + 1)) for (int rep_ = 0; rep_ < NREP(1); ++rep_) { FRESH();
            pg8::Gemm g{(bf16*)A.out + (size_t)NTOK * DM, wsp<bf16>(C, WS_WT1), NTOK, 5120, 1024}; pg8::StaticOrder S; S.init(NTOK, 5120, C.G, (int)blockIdx.x);
            pg8::EpiOut<0> E{proj(C, 0), nullptr, nullptr, PROJ_STRIDE / 2};
            pg8::gemm_phase<pg8::EpiOut<0>, pg8::StaticOrder, true, true>(C.lds, g, S, E, C.tid);
        }
        SEAM(pb + 1);
        if (HAS(2) && IN(pb + 2)) for (int rep_ = 0; rep_ < NREP(2); ++rep_) { FRESH();  for (int g8 = C.vcu; g8 < 256; g8 += C.G) for (int i8 = 0; i8 < 8; ++i8) mlstm_u_item(A, C, layer, g8 >> 4, (g8 & 15) * 8 + i8, i8 == 0, i8 < 7); }
        SEAM(pb + 2);
        if (HAS(3) && IN(pb + 3)) for (int rep_ = 0; rep_ < NREP(3); ++rep_) { FRESH(); mlstm_scan(C); }
        SEAM(pb + 3);
        if (HAS(4) && IN(pb + 4)) for (int rep_ = 0; rep_ < NREP(4); ++rep_) { FRESH();
            gu32* q0 = C.ctl + CW_Q + 64 * (layer * 4 + 0); gu32* q1 = C.ctl + CW_Q + 64 * (layer * 4 + 1); gu32* q2 = C.ctl + CW_Q + 64 * (layer * 4 + 2);
            for (int rc_ = 0; rc_ < NREP(13); ++rc_) {
                if (C.G == 256) { const int xg = C.vcu >> 5, r = C.vcu & 31;
                    for (int rd = 0; rd < 2; ++rd) { const int p = r + 32 * rd, bvh = xg * 4 + (p >> 4), pr = p & 15;
                        attn_unit<128, true>(A, C, layer, bvh >> 3, bvh & 7, 31 - pr); attn_unit<128, true>(A, C, layer, bvh >> 3, bvh & 7, pr); } }
                else { for (int it = C.vcu; it < 1024; it += C.G) attn_unit<128, true>(A, C, layer, (it & 31) >> 3, it & 7, 31 - (it >> 5)); } }
            for (int rc_ = NREP(15) - 1; rc_ >= 0; --rc_) { gu32* qq = rc_ ? C.ctl + CW_Q + 64 * (17 + 2 * rc_) : q2;
            for (;;) { if (C.tid == 0) C.MISC[0] = __hip_atomic_fetch_add(qq, 1u, RLX_AGENT); __syncthreads(); const int it = (int)C.MISC[0]; __syncthreads(); if (it >= 512) break;
                for (int i4 = 0; i4 < 4; ++i4) mlstm_out_item(A, C, layer, it >> 5, (it & 31) * 4 + i4, i4 == 0, i4 < 3, rc_ ? wsp<bf16>(C, 480 * MiB) : nullptr); } }
            for (int rc_ = NREP(14) - 1; rc_ >= 0; --rc_) { gu32* qq = rc_ ? C.ctl + CW_Q + 64 * (16 + 2 * rc_) : q1;
            for (;;) { if (C.tid == 0) C.MISC[0] = __hip_atomic_fetch_add(qq, 1u, RLX_AGENT); __syncthreads(); const int it = (int)C.MISC[0]; __syncthreads(); if (it >= 1024) break;
                attn_unit<64, false>(A, C, layer, (it & 31) >> 3, it & 7, 31 - (it >> 5), rc_ ? wsp<bf16>(C, 480 * MiB) : nullptr); } }
        }
        SEAM(pb + 4);
        if (HAS(6) && IN(pb + 6)) for (int rep_ = 0; rep_ < NREP(6); ++rep_) { FRESH();
            if (rep_ == 0) phase5(A, C, layer);
            pg8::Gemm g{(bf16*)A.out + (size_t)NTOK * DM, wsp<bf16>(C, WS_WT2), NTOK, 3072, 1024}; pg8::StaticOrder S; S.init(NTOK, 3072, C.G, (int)blockIdx.x);
            pg8::EpiOut<1> E{wsp<bf16>(C, WS_G0), wsp<bf16>(C, WS_G1), wsp<bf16>(C, WS_G2), 0};
            pg8::gemm_phase<pg8::EpiOut<1>, pg8::StaticOrder, true, true>(C.lds, g, S, E, C.tid);
        }
        SEAM(pb + 6);
        if (HAS(7) && IN(pb + 7)) for (int rep_ = 0; rep_ < NREP(7); ++rep_) { FRESH();
            pg8::StaticOrder S; S.init(NTOK, 1024, C.G, (int)blockIdx.x); bf16* Y = wsp<bf16>(C, WS_O12);
            { pg8::Gemm g{proj(C, PJ_AV), wsp<bf16>(C, WS_PT), NTOK, 1024, 512}; pg8::EpiMerge<true> E{Y, wsp<bf16>(C, WS_G0)}; pg8::gemm_phase<pg8::EpiMerge<true>, pg8::StaticOrder, true, true>(C.lds, g, S, E, C.tid); }
            __syncthreads();
            { pg8::Gemm g{proj(C, PJ_BQ), wsp<bf16>(C, WS_PT) + 1024 * 512, NTOK, 1024, 512}; pg8::EpiMerge<false> E{Y, wsp<bf16>(C, WS_G1)}; pg8::gemm_phase<pg8::EpiMerge<false>, pg8::StaticOrder, true, true>(C.lds, g, S, E, C.tid); }
            __syncthreads();
            { pg8::Gemm g{proj(C, PJ_CQ), wsp<bf16>(C, WS_PT) + 2 * 1024 * 512, NTOK, 1024, 512}; pg8::EpiMerge<false> E{Y, wsp<bf16>(C, WS_G2)}; pg8::gemm_phase<pg8::EpiMerge<false>, pg8::StaticOrder, true, true>(C.lds, g, S, E, C.tid); }
        }
        SEAM(pb + 7);
        if (HAS(8) && IN(pb + 8)) for (int rep_ = 0; rep_ < NREP(8); ++rep_) { FRESH();
            pg8::Gemm g{wsp<bf16>(C, WS_O12), wsp<bf16>(C, WS_WOT), NTOK, 1024, 1024}; pg8::StaticOrder S; S.init(NTOK, 1024, C.G, (int)blockIdx.x);
            pg8::EpiResid E{layer == 0 ? (const void*)A.in[0] : (const void*)A.out, layer > 0, wsp<bf16>(C, WS_XB1)};
            pg8::gemm_phase<pg8::EpiResid, pg8::StaticOrder, true, true>(C.lds, g, S, E, C.tid);
        }
        SEAM(pb + 8);
        if (HAS(9) && IN(pb + 9)) for (int rep_ = 0; rep_ < NREP(9); ++rep_) { FRESH(); for (int r9 = 1; r9 < NREP(16); ++r9) { phase9(A, C, layer, true); __syncthreads(); } if (NREP(17) >= 2) { moe_weight_items(A, C, layer); __syncthreads(); } phase9(A, C, layer); }
        SEAM(pb + 9);
        if (HAS(10) && IN(pb + 10)) for (int rep_ = 0; rep_ < NREP(10); ++rep_) { FRESH(); phase10(C, layer); }
        SEAM(pb + 10);
        if (HAS(11) && IN(pb + 11)) for (int rep_ = 0; rep_ < NREP(11); ++rep_) { FRESH();
            const int* texp = wsp<int>(C, WS_TEXP); const int RT = __builtin_amdgcn_readfirstlane(texp[511]);
            pg8::Gemm g{wsp<bf16>(C, WS_XS), wsp<bf16>(C, WS_W1T), 73728, 32 * 512, 1024}; pg8::MoeOrder<1> S{C.G, C.vcu, RT, texp};
            pg8::EpiSiluMul E{wsp<bf16>(C, WS_HE)};
            pg8::gemm_phase<pg8::EpiSiluMul, pg8::MoeOrder<1>, true, true>(C.lds, g, S, E, C.tid);
        }
        SEAM(pb + 11);
        if (HAS(12) && IN(pb + 12)) for (int rep_ = 0; rep_ < NREP(12); ++rep_) { FRESH();
            const int* texp = wsp<int>(C, WS_TEXP); const int RT = __builtin_amdgcn_readfirstlane(texp[511]);
            pg8::Gemm g{wsp<bf16>(C, WS_HE), wsp<bf16>(C, WS_W2T), 73728, 32 * 1024, 256}; pg8::MoeOrder<2> S{C.G, C.vcu, RT, texp};
            pg8::EpiOut<2> E{wsp<bf16>(C, WS_OSL), nullptr, nullptr, 0};
            pg8::gemm_phase<pg8::EpiOut<2>, pg8::MoeOrder<2>, E2_ALIGN, E2_SP2>(C.lds, g, S, E, C.tid);
        }
        SEAM(pb + 12);
    }
#undef IN
#undef SEAM
}

extern "C" void kernel_launch(void* const* d_in, const int* in_sizes, int n_in, void* d_out, int out_size, void* d_ws, size_t ws_size, hipStream_t stream) {
    static int grid = 0;
    if (grid == 0) {
        if (n_in != 23 || out_size != NTOK * DM || ws_size < WS_NEED) { fprintf(stderr, "kernel_launch: unexpected shapes (n_in %d out %d ws %zu)\n", n_in, out_size, ws_size); grid = -1; return; }
        int dev = 0, cus = 0, per_cu = 0;
        if (hipGetDevice(&dev) != hipSuccess || hipDeviceGetAttribute(&cus, hipDeviceAttributeMultiprocessorCount, dev) != hipSuccess) { grid = -1; return; }
        if (hipFuncSetAttribute((const void*)fwd, hipFuncAttributeMaxDynamicSharedMemorySize, LDS_BYTES) != hipSuccess) { fprintf(stderr, "kernel_launch: hipFuncSetAttribute failed\n"); grid = -1; return; }
        if (hipOccupancyMaxActiveBlocksPerMultiprocessor(&per_cu, (const void*)fwd, NTHR, LDS_BYTES) != hipSuccess || per_cu < 1) fprintf(stderr, "kernel_launch: occupancy query says %d\n", per_cu);
        (void)hipGetLastError();
        grid = cus;
    }
    if (grid < 0) return;
    (void)hipMemsetAsync((char*)d_ws + WS_CTL, 0, CTL_ZERO_BYTES, stream);
    Args a{};
    for (int i = 0; i < 23; ++i) a.in[i] = (const float*)d_in[i];
    a.out = (float*)d_out; a.ws = (unsigned char*)d_ws;
#if MK_ONE_LAUNCH
    a.ph_lo = 0; a.ph_hi = N_PHASES;
    hipLaunchKernelGGL(fwd, dim3(grid), dim3(NTHR), LDS_BYTES, stream, a);
#else
    for (int p = 0; p < N_PHASES; ++p) { a.ph_lo = p; a.ph_hi = p + 1; hipLaunchKernelGGL(fwd, dim3(grid), dim3(NTHR), LDS_BYTES, stream, a); }
#endif
}
```

```cpp
#include <hip/hip_runtime.h>
#include <cstdio>
#include <cstdint>
#include <cmath>
namespace pg8 {
#define PG8_LAS __attribute__((address_space(3)))
typedef unsigned short bf16_t;
typedef short bf16x8 __attribute__((ext_vector_type(8)));
typedef float f32x4 __attribute__((ext_vector_type(4)));
typedef unsigned u32x4 __attribute__((ext_vector_type(4)));
constexpr int BM = 256, BK = 64, HALF = 128, HTB = HALF * BK * 2  , STAGE_BYTES = 8 * HTB, NXCD = 8, WGM = 8;

__host__ __device__ __forceinline__ int lds_byte(int r, int c) { const int st = (r >> 4) * 2 + (c >> 5), rr = r & 15, cc = c & 31, ob = rr * 64 + cc * 2; return st * 1024 + (ob ^ (((ob >> 9) & 1) << 5)); }
__host__ __device__ __forceinline__ void stage_rc(int b, int& R, int& C) { const int st = b / 1024, sb = b % 1024, swz = sb ^ (((sb >> 9) & 1) << 5); R = (st >> 1) * 16 + swz / 64; C = (st & 1) * 32 + (swz % 64) / 2; }
__host__ __device__ __forceinline__ int perm32(int rho) { const int n = rho >> 4, i = rho & 15; return 8 * (i >> 2) + 4 * n + (i & 3); }

struct Unit { int pm, pn, t; };
struct Gemm { const bf16_t* A; const bf16_t* Bt; int M, N, K; };

struct StaticOrder {
    int nM, nN, nwg, G, c;
    __host__ __device__ void init(int M, int N, int G_, int c_) { nM = M / BM; nN = N / BM; nwg = nM * nN; G = G_; c = c_; }
    __host__ __device__ bool next(int i, Unit& u) const {
        const long L = (long)i * G + c; if (L >= nwg) return false;
        int wgid = (int)L; { const int q = nwg / NXCD, r = nwg % NXCD, xcd = wgid % NXCD, off = wgid / NXCD; wgid = (xcd < r ? xcd * (q + 1) : r * (q + 1) + (xcd - r) * q) + off; }
        const int nig = WGM * nN, gid = wgid / nig, fm = gid * WGM, gsz = (nM - fm) < WGM ? (nM - fm) : WGM;
        u.pm = fm + ((wgid % nig) % gsz); u.pn = (wgid % nig) / gsz; return true;
    }
    __device__ __forceinline__ void a_ready(const Unit&) const {}
    __device__ __forceinline__ void done(const Unit&) const {}
    __device__ __forceinline__ const bf16_t* a_base(const Gemm& g, const Unit&) const { return g.A; }
    __device__ __forceinline__ const bf16_t* b_base(const Gemm& g, const Unit&) const { return g.Bt; }
};

__device__ __forceinline__ unsigned cvt_pk_bf16(float lo, float hi) { unsigned r; asm volatile("v_cvt_pk_bf16_f32 %0, %1, %2" : "=v"(r) : "v"(lo), "v"(hi)); return r; }
#ifndef GAS
#define GAS __attribute__((address_space(1)))
#endif
typedef float f32x2 __attribute__((ext_vector_type(2)));
typedef unsigned u32x2 __attribute__((ext_vector_type(2)));
__device__ __forceinline__ float bflo(unsigned u) { return __builtin_bit_cast(float, u << 16); }
__device__ __forceinline__ float bfhi(unsigned u) { return __builtin_bit_cast(float, u & 0xffff0000u); }
__device__ __forceinline__ float sigmoidf_(float x) { return 1.f / (1.f + __expf(-x)); }
template <int MODE> struct EpiOut {
    static constexpr bool PERM = true, AFTER_DRAIN = false, CHAIN = false;
    bf16_t* b0; bf16_t* b1; bf16_t* b2; size_t stride;
    __device__ __forceinline__ void operator()(const f32x4 (&acc)[2][2][4][2], const Unit& u, int wr, int wc, int fr, int fq) const {
        int row0 = u.pm * BM + wr * 64 + fr; asm volatile("" : "+v"(row0));
        bf16_t* base; int colt, ldc;
        if (MODE == 0) { base = b0 + (size_t)(u.pn >> 1) * stride; colt = (u.pn & 1) * 256; ldc = 512; }
        else if (MODE == 1) { const int t = u.pn >> 2; base = b0 + (size_t)(160 * t - 32 * t * (t - 1)) * (1u << 19); colt = (u.pn & 3) * 256; ldc = 1024; }
        else { base = b0; colt = (u.pn & 3) * 256; ldc = 1024; }
        const int col0 = colt + wc * 32 + 8 * fq;
#pragma unroll
        for (int ai = 0; ai < 2; ++ai)
#pragma unroll
            for (int m = 0; m < 4; ++m) { bf16_t* rowp = base + (size_t)(row0 + ai * HALF + m * 16) * ldc + col0;
#pragma unroll
                for (int bj = 0; bj < 2; ++bj) { f32x4 v0 = acc[ai][bj][m][0], v1 = acc[ai][bj][m][1];
                    if (MODE == 1) {
#pragma unroll
                        for (int j = 0; j < 4; ++j) { v0[j] = sigmoidf_(v0[j]); v1[j] = sigmoidf_(v1[j]); } }
                    if (MODE == 1) {
                        unsigned q[8];
#pragma unroll
                        for (int j = 0; j < 4; ++j) { q[j] = (unsigned)fminf(v0[j] * 256.f, 255.f); q[4 + j] = (unsigned)fminf(v1[j] * 256.f, 255.f); }
                        u32x2 w8; w8.x = q[0] | (q[1] << 8) | (q[2] << 16) | (q[3] << 24); w8.y = q[4] | (q[5] << 8) | (q[6] << 16) | (q[7] << 24);
                        *(GAS u32x2*)((unsigned char*)base + ((size_t)(u.pm * 4 + (u.pn & 3)) << 16) + (((ai * 4 + m) * 2 + bj) << 12) + ((wr * 4 + wc) << 9) + ((fr + 16 * fq) << 3)) = w8; }
                    else { u32x4 w; w.x = cvt_pk_bf16(v0[0], v0[1]); w.y = cvt_pk_bf16(v0[2], v0[3]); w.z = cvt_pk_bf16(v1[0], v1[1]); w.w = cvt_pk_bf16(v1[2], v1[3]);
                        *(GAS u32x4*)(rowp + bj * HALF) = w; } } }
    }
};
template <bool FIRST> struct EpiMerge {
    static constexpr bool PERM = true, AFTER_DRAIN = false, CHAIN = false;
    bf16_t* Y; const bf16_t* G;
    __device__ __forceinline__ void operator()(const f32x4 (&acc)[2][2][4][2], const Unit& u, int wr, int wc, int fr, int fq) const {
        int row0 = u.pm * BM + wr * 64 + fr; asm volatile("" : "+v"(row0)); const int col0 = u.pn * BM + wc * 32 + 8 * fq;
        const bf16_t* gt = G + ((size_t)(u.pm * 4 + u.pn) << 16) + ((wr * 4 + wc) << 9) + ((fr + 16 * fq) << 3);
#pragma unroll
        for (int ai = 0; ai < 2; ++ai) { u32x4 g[4][2], y[4][2];
#pragma unroll
            for (int m = 0; m < 4; ++m)
#pragma unroll
                for (int bj = 0; bj < 2; ++bj) { g[m][bj] = *(const GAS u32x4*)(gt + (((ai * 4 + m) * 2 + bj) << 12));
                    if (!FIRST) y[m][bj] = *(const GAS u32x4*)(Y + (size_t)(row0 + ai * HALF + m * 16) * 1024 + col0 + bj * HALF); }
            __builtin_amdgcn_sched_barrier(0);
#pragma unroll
            for (int m = 0; m < 4; ++m)
#pragma unroll
                for (int bj = 0; bj < 2; ++bj) { const f32x4 v0 = acc[ai][bj][m][0], v1 = acc[ai][bj][m][1]; const u32x4 gg = g[m][bj];
                    float r[8] = { bflo(gg.x) * v0[0], bfhi(gg.x) * v0[1], bflo(gg.y) * v0[2], bfhi(gg.y) * v0[3], bflo(gg.z) * v1[0], bfhi(gg.z) * v1[1], bflo(gg.w) * v1[2], bfhi(gg.w) * v1[3] };
                    if (!FIRST) { const u32x4 yy = y[m][bj];
                        r[0] += bflo(yy.x); r[1] += bfhi(yy.x); r[2] += bflo(yy.y); r[3] += bfhi(yy.y); r[4] += bflo(yy.z); r[5] += bfhi(yy.z); r[6] += bflo(yy.w); r[7] += bfhi(yy.w); }
                    u32x4 w; w.x = cvt_pk_bf16(r[0], r[1]); w.y = cvt_pk_bf16(r[2], r[3]); w.z = cvt_pk_bf16(r[4], r[5]); w.w = cvt_pk_bf16(r[6], r[7]);
                    *(GAS u32x4*)(Y + (size_t)(row0 + ai * HALF + m * 16) * 1024 + col0 + bj * HALF) = w; }
            __builtin_amdgcn_sched_barrier(0); }
    }
};
struct EpiResid {
    static constexpr bool PERM = true, AFTER_DRAIN = false, CHAIN = false;
    const void* XS; bool xbf; bf16_t* OUT;
    __device__ __forceinline__ void operator()(const f32x4 (&acc)[2][2][4][2], const Unit& u, int wr, int wc, int fr, int fq) const {
        int row0 = u.pm * BM + wr * 64 + fr; asm volatile("" : "+v"(row0)); const int col0 = u.pn * BM + wc * 32 + 8 * fq;
#pragma unroll
        for (int ai = 0; ai < 2; ++ai) {
            if (xbf) { u32x4 xv[4][2];
#pragma unroll
                for (int m = 0; m < 4; ++m)
#pragma unroll
                    for (int bj = 0; bj < 2; ++bj) xv[m][bj] = *(const GAS u32x4*)((const bf16_t*)XS + (size_t)(row0 + ai * HALF + m * 16) * 1024 + col0 + bj * HALF);
                __builtin_amdgcn_sched_barrier(0);
#pragma unroll
                for (int m = 0; m < 4; ++m)
#pragma unroll
                    for (int bj = 0; bj < 2; ++bj) { const u32x4 xx = xv[m][bj]; const f32x4 x0 = (f32x4){bflo(xx.x), bfhi(xx.x), bflo(xx.y), bfhi(xx.y)} + acc[ai][bj][m][0], x1 = (f32x4){bflo(xx.z), bfhi(xx.z), bflo(xx.w), bfhi(xx.w)} + acc[ai][bj][m][1];
                        u32x4 w; w.x = cvt_pk_bf16(x0[0], x0[1]); w.y = cvt_pk_bf16(x0[2], x0[3]); w.z = cvt_pk_bf16(x1[0], x1[1]); w.w = cvt_pk_bf16(x1[2], x1[3]);
                        *(GAS u32x4*)(OUT + (size_t)(row0 + ai * HALF + m * 16) * 1024 + col0 + bj * HALF) = w; }
            } else { f32x4 xa[4][2], xb[4][2];
#pragma unroll
                for (int m = 0; m < 4; ++m)
#pragma unroll
                    for (int bj = 0; bj < 2; ++bj) { const float* xp = (const float*)XS + (size_t)(row0 + ai * HALF + m * 16) * 1024 + col0 + bj * HALF; xa[m][bj] = *(const GAS f32x4*)xp; xb[m][bj] = *(const GAS f32x4*)(xp + 4); }
                __builtin_amdgcn_sched_barrier(0);
#pragma unroll
                for (int m = 0; m < 4; ++m)
#pragma unroll
                    for (int bj = 0; bj < 2; ++bj) { const f32x4 x0 = xa[m][bj] + acc[ai][bj][m][0], x1 = xb[m][bj] + acc[ai][bj][m][1];
                        u32x4 w; w.x = cvt_pk_bf16(x0[0], x0[1]); w.y = cvt_pk_bf16(x0[2], x0[3]); w.z = cvt_pk_bf16(x1[0], x1[1]); w.w = cvt_pk_bf16(x1[2], x1[3]);
                        *(GAS u32x4*)(OUT + (size_t)(row0 + ai * HALF + m * 16) * 1024 + col0 + bj * HALF) = w; }
            }
            __builtin_amdgcn_sched_barrier(0); }
    }
};
struct EpiSiluMul {
    static constexpr bool PERM = true, AFTER_DRAIN = false, CHAIN = false;
    bf16_t* O;
    __device__ __forceinline__ void operator()(const f32x4 (&acc)[2][2][4][2], const Unit& u, int wr, int wc, int fr, int fq) const {
        int row0 = u.pm * BM + wr * 64 + fr; asm volatile("" : "+v"(row0)); const int col0 = (u.pn & 1) * 128 + wc * 32 + 8 * fq;
#pragma unroll
        for (int ai = 0; ai < 2; ++ai)
#pragma unroll
            for (int m = 0; m < 4; ++m) { float r[8];
#pragma unroll
                for (int n = 0; n < 2; ++n)
#pragma unroll
                    for (int j = 0; j < 4; ++j) { const float g = acc[ai][0][m][n][j], up = acc[ai][1][m][n][j]; r[4 * n + j] = g * sigmoidf_(g) * up; }
                u32x4 w; w.x = cvt_pk_bf16(r[0], r[1]); w.y = cvt_pk_bf16(r[2], r[3]); w.z = cvt_pk_bf16(r[4], r[5]); w.w = cvt_pk_bf16(r[6], r[7]);
                *(GAS u32x4*)(O + (size_t)(row0 + ai * HALF + m * 16) * 256 + col0) = w; }
    }
};
template <int LOG_NCT> struct MoeOrder {
    int G, c, RT; const __attribute__((address_space(3))) int* texp;
    __device__ __forceinline__ bool next(int i, Unit& u) const {
        const int L = i * G + c; const int rt = L >> LOG_NCT; if (rt >= RT) return false;
        const int e = __builtin_amdgcn_readfirstlane(texp[rt]); u.pm = rt; u.pn = (e << LOG_NCT) + (L & ((1 << LOG_NCT) - 1)); return true;
    }
    __device__ __forceinline__ void a_ready(const Unit&) const {}
    __device__ __forceinline__ void done(const Unit&) const {}
    __device__ __forceinline__ const bf16_t* a_base(const Gemm& g, const Unit&) const { return g.A; }
    __device__ __forceinline__ const bf16_t* b_base(const Gemm& g, const Unit&) const { return g.Bt; }
};
struct ChainOrder {
    StaticOrder base;
    __device__ __forceinline__ bool next(int i, Unit& u) const { const int ti = i / 3; if (!base.next(ti, u)) return false; u.t = i - 3 * ti; return true; }
    __device__ __forceinline__ void a_ready(const Unit&) const {}
    __device__ __forceinline__ void done(const Unit&) const {}
    __device__ __forceinline__ const bf16_t* a_base(const Gemm& g, const Unit& u) const { return g.A + (size_t)(2 * u.t + (u.t >> 1)) * (size_t)(16u << 20); }
    __device__ __forceinline__ const bf16_t* b_base(const Gemm& g, const Unit& u) const { return g.Bt + (size_t)u.t * 1024 * 512; }
};
struct EpiChain {
    static constexpr bool PERM = true, AFTER_DRAIN = false, CHAIN = true;
    bf16_t* Y; const bf16_t* G;
    static __device__ __forceinline__ float dq(unsigned w, int k) { return (float)((w >> (8 * k)) & 0xffu) * (1.f / 256.f) + (0.5f / 256.f); }
    __device__ __forceinline__ void operator()(f32x4 (&acc)[2][2][4][2], const Unit& u, int wr, int wc, int fr, int fq) const {
        int row0 = u.pm * BM + wr * 64 + fr; asm volatile("" : "+v"(row0)); const int col0 = u.pn * BM + wc * 32 + 8 * fq;
        const int t = u.t; const size_t toff = ((size_t)(u.pm * 4 + u.pn) << 16) + ((wr * 4 + wc) << 9) + ((fr + 16 * fq) << 3);
        const unsigned char* ga = (const unsigned char*)G + ((size_t)(160 * t - 32 * t * (t - 1)) << 20) + toff;
        if (t < 2) { const int t1 = t + 1; const unsigned char* gb = (const unsigned char*)G + ((size_t)(160 * t1 - 32 * t1 * (t1 - 1)) << 20) + toff;
            u32x2 a[2][4][2], b[2][4][2];
#pragma unroll
            for (int ai = 0; ai < 2; ++ai)
#pragma unroll
                for (int m = 0; m < 4; ++m)
#pragma unroll
                    for (int bj = 0; bj < 2; ++bj) { a[ai][m][bj] = *(const GAS u32x2*)(ga + (((ai * 4 + m) * 2 + bj) << 12)); b[ai][m][bj] = *(const GAS u32x2*)(gb + (((ai * 4 + m) * 2 + bj) << 12)); }
            __builtin_amdgcn_sched_barrier(0);
#pragma unroll
            for (int ai = 0; ai < 2; ++ai)
#pragma unroll
                for (int m = 0; m < 4; ++m)
#pragma unroll
                    for (int bj = 0; bj < 2; ++bj) { const u32x2 x = a[ai][m][bj], y = b[ai][m][bj];
                        f32x4& v0 = acc[ai][bj][m][0]; f32x4& v1 = acc[ai][bj][m][1];
#pragma unroll
                        for (int j = 0; j < 4; ++j) { v0[j] *= dq(x.x, j) * __builtin_amdgcn_rcpf(dq(y.x, j)); v1[j] *= dq(x.y, j) * __builtin_amdgcn_rcpf(dq(y.y, j)); } }
            __builtin_amdgcn_sched_barrier(0);
        } else {
            u32x2 a[2][4][2];
#pragma unroll
            for (int ai = 0; ai < 2; ++ai)
#pragma unroll
                for (int m = 0; m < 4; ++m)
#pragma unroll
                    for (int bj = 0; bj < 2; ++bj) a[ai][m][bj] = *(const GAS u32x2*)(ga + (((ai * 4 + m) * 2 + bj) << 12));
            __builtin_amdgcn_sched_barrier(0);
#pragma unroll
            for (int ai = 0; ai < 2; ++ai)
#pragma unroll
                for (int m = 0; m < 4; ++m)
#pragma unroll
                    for (int bj = 0; bj < 2; ++bj) { const u32x2 x = a[ai][m][bj]; const f32x4 v0 = acc[ai][bj][m][0], v1 = acc[ai][bj][m][1];
                        u32x4 w; w.x = cvt_pk_bf16(v0[0] * dq(x.x, 0), v0[1] * dq(x.x, 1)); w.y = cvt_pk_bf16(v0[2] * dq(x.x, 2), v0[3] * dq(x.x, 3));
                        w.z = cvt_pk_bf16(v1[0] * dq(x.y, 0), v1[1] * dq(x.y, 1)); w.w = cvt_pk_bf16(v1[2] * dq(x.y, 2), v1[3] * dq(x.y, 3));
                        *(GAS u32x4*)(Y + (size_t)(row0 + ai * HALF + m * 16) * 1024 + col0 + bj * HALF) = w; }
            __builtin_amdgcn_sched_barrier(0);
        }
    }
};
template <class Epi, class Sched, bool ALIGN_EPI = false, bool SP2 = false, bool GATHER = false>
__device__ __forceinline__ void gemm_phase(PG8_LAS unsigned char* lds, const Gemm g, const Sched& S, const Epi& E, int tid_in, const PG8_LAS int* tokl = nullptr) {
    int tid = tid_in; asm volatile("" : "+v"(tid));
    const int wid = __builtin_amdgcn_readfirstlane(tid >> 6), lane = tid & 63, wr = wid >> 2, wc = wid & 3, fr = lane & 15, fq = lane >> 4;
    const int K = g.K, nt = K / BK;
    unsigned voffA[2], voffB[2];
#pragma unroll
    for (int i = 0; i < 2; ++i) { int R, C; stage_rc(tid * 16 + i * 8192, R, C); const int Rb = Epi::PERM ? ((R & ~31) + perm32(R & 31)) : R;
        voffA[i] = (unsigned)(R * K + C) * 2u; voffB[i] = (unsigned)(Rb * K + C) * 2u; }
    const size_t kstep = (size_t)(BK * 2);
    const size_t hstep = (size_t)HALF * K * 2;
    const size_t tstep = 2 * hstep;
    const unsigned ldsw = (unsigned)wid * 1024u;
    const int aoff = lds_byte(wr * 64 + fr, fq * 8), boff = lds_byte(wc * 32 + fr, fq * 8);
#define PG8_SA(b, h) (((b) * 2 + (h)) * HTB)
#define PG8_SB(b, h) ((4 + (b) * 2 + (h)) * HTB)
#define PG8_STAGE(bufoff, gbase, voff) do { _Pragma("unroll") for (int _i = 0; _i < 2; ++_i) \
        __builtin_amdgcn_global_load_lds((const unsigned*)((const char*)(gbase) + (voff)[_i]), (PG8_LAS unsigned*)(lds + (bufoff) + ldsw + _i * 8192), 16, 0, 0); } while (0)
#define PG8_STAGE_A(bufoff, kb, h, SEL) do { if constexpr (GATHER) { if (SEL) PG8_STAGE(bufoff, kb, gsel[h]); else PG8_STAGE(bufoff, kb, gcur[h]); } else { PG8_STAGE(bufoff, (kb) + (h) * hstep, voffA); } } while (0)
#define PG8_GOFF(dst, slot) do { _Pragma("unroll") for (int h_ = 0; h_ < 2; ++h_) _Pragma("unroll") for (int i_ = 0; i_ < 2; ++i_) { int R_, C_; stage_rc(tid * 16 + i_ * 8192, R_, C_); \
        dst[h_][i_] = (unsigned)tokl[(slot) * 256 + h_ * 128 + R_] * (unsigned)(K * 2) + (unsigned)(C_ * 2); } } while (0)
#define PG8_LDA(dst, b, h) do { _Pragma("unroll") for (int m = 0; m < 4; ++m) _Pragma("unroll") for (int k = 0; k < 2; ++k) dst[m][k] = *(const PG8_LAS bf16x8*)(lds + PG8_SA(b, h) + aoff + m * 2048 + k * 1024); } while (0)
#define PG8_LDB(dst, b, h) do { _Pragma("unroll") for (int n = 0; n < 2; ++n) _Pragma("unroll") for (int k = 0; k < 2; ++k) dst[n][k] = *(const PG8_LAS bf16x8*)(lds + PG8_SB(b, h) + boff + n * 2048 + k * 1024); } while (0)
#define PG8_MMA(ai, bj, At, Bt) do { __builtin_amdgcn_s_setprio(1); _Pragma("unroll") for (int m = 0; m < 4; ++m) _Pragma("unroll") for (int n = 0; n < 2; ++n) _Pragma("unroll") for (int k = 0; k < 2; ++k) \
        acc[ai][bj][m][n] = __builtin_amdgcn_mfma_f32_16x16x32_bf16(Bt[n][k], At[m][k], acc[ai][bj][m][n], 0, 0, 0); __builtin_amdgcn_s_setprio(0); } while (0)
#define PG8_WAIT_V(n) asm volatile("s_waitcnt vmcnt(" #n ")" ::: "memory")
#define PG8_WAIT_L(n) asm volatile("s_waitcnt lgkmcnt(" #n ")" ::: "memory")
#define PG8_BAR __builtin_amdgcn_s_barrier()
#define PG8_SCHED __builtin_amdgcn_sched_barrier(0)
    Unit cur, nxt; int ui = 0;
    if (!S.next(0, cur)) return;
    f32x4 acc[2][2][4][2];
#pragma unroll
    for (int a = 0; a < 2; ++a)
#pragma unroll
        for (int b = 0; b < 2; ++b)
#pragma unroll
            for (int m = 0; m < 4; ++m)
#pragma unroll
                for (int n = 0; n < 2; ++n) acc[a][b][m][n] = (f32x4){0.f, 0.f, 0.f, 0.f};
    bf16x8 At[4][2], B0[2][2], B1[2][2];
    const char* cA = (const char*)S.a_base(g, cur) + (GATHER ? (size_t)0 : (size_t)cur.pm * tstep); const char* cB = (const char*)S.b_base(g, cur) + (size_t)cur.pn * tstep;
    unsigned gcur[2][2] = {}, gnxt[2][2] = {}, gsel[2][2] = {};
    if constexpr (GATHER) PG8_GOFF(gcur, 0);
    S.a_ready(cur);
    if constexpr (SP2) {
        PG8_STAGE(PG8_SB(0, 0), cB, voffB); PG8_STAGE(PG8_SB(0, 1), cB + hstep, voffB); PG8_STAGE_A(PG8_SA(0, 0), cA, 0, false); PG8_STAGE_A(PG8_SA(0, 1), cA, 1, false);
        if (wr == 1) PG8_BAR;
        PG8_WAIT_V(2); PG8_BAR;
        PG8_STAGE(PG8_SB(1, 0), cB + kstep, voffB); PG8_STAGE_A(PG8_SA(1, 0), cA + kstep, 0, false); PG8_STAGE(PG8_SB(1, 1), cB + hstep + kstep, voffB);
        PG8_WAIT_V(6); PG8_BAR;
    } else {
        PG8_STAGE(PG8_SB(0, 0), cB, voffB); PG8_STAGE(PG8_SA(0, 0), cA, voffA); PG8_STAGE(PG8_SB(0, 1), cB + hstep, voffB); PG8_STAGE(PG8_SA(0, 1), cA + hstep, voffA);
        if (wr == 1) PG8_BAR;
        PG8_WAIT_V(4); PG8_BAR;
        PG8_STAGE(PG8_SB(1, 0), cB + kstep, voffB); PG8_STAGE(PG8_SA(1, 0), cA + kstep, voffA); PG8_STAGE(PG8_SB(1, 1), cB + hstep + kstep, voffB);
        PG8_WAIT_V(6); PG8_BAR;
    }
    for (;;) {
        const bool has_next = S.next(ui + 1, nxt);
        if constexpr (GATHER) { if (has_next) PG8_GOFF(gnxt, ui + 1); else { _Pragma("unroll") for (int h_ = 0; h_ < 2; ++h_) _Pragma("unroll") for (int i_ = 0; i_ < 2; ++i_) gnxt[h_][i_] = gcur[h_][i_]; } }
        const char* nA = has_next ? (const char*)S.a_base(g, nxt) + (GATHER ? (size_t)0 : (size_t)nxt.pm * tstep) : cA; const char* nB = has_next ? (const char*)S.b_base(g, nxt) + (size_t)nxt.pn * tstep : cB;
        for (int t = 0; t < nt; t += 2) {
            const bool last = (t == nt - 2);
            const char* a1 = cA + (size_t)(t + 1) * kstep;
            const char* a2 = last ? nA : cA + (size_t)(t + 2) * kstep; const char* b2 = last ? nB : cB + (size_t)(t + 2) * kstep;
            const char* a3 = a2 + kstep; const char* b3 = b2 + kstep;
            if (last && has_next) S.a_ready(nxt);
            if constexpr (GATHER) { _Pragma("unroll") for (int h_ = 0; h_ < 2; ++h_) _Pragma("unroll") for (int i_ = 0; i_ < 2; ++i_) gsel[h_][i_] = last ? gnxt[h_][i_] : gcur[h_][i_]; }
            if constexpr (SP2) {
            PG8_LDB(B0, 0, 0); PG8_LDB(B1, 0, 1); PG8_SCHED; PG8_LDA(At, 0, 0); PG8_STAGE_A(PG8_SA(1, 1), a1, 1, false);
            PG8_WAIT_V(8); PG8_WAIT_L(0); PG8_BAR; PG8_MMA(0, 0, At, B0); PG8_MMA(0, 1, At, B1); PG8_BAR; PG8_SCHED;
            PG8_LDA(At, 0, 1); PG8_STAGE(PG8_SB(0, 0), b2, voffB); PG8_STAGE(PG8_SB(0, 1), b2 + hstep, voffB); PG8_STAGE_A(PG8_SA(0, 0), a2, 0, true);
            PG8_WAIT_V(8); PG8_WAIT_L(0); PG8_BAR; PG8_MMA(1, 0, At, B0); PG8_MMA(1, 1, At, B1); PG8_BAR; PG8_SCHED;
            PG8_LDB(B0, 1, 0); PG8_LDB(B1, 1, 1); PG8_SCHED; PG8_LDA(At, 1, 0); PG8_STAGE_A(PG8_SA(0, 1), a2, 1, true);
            PG8_WAIT_V(8); PG8_WAIT_L(0); PG8_BAR; PG8_MMA(0, 0, At, B0); PG8_MMA(0, 1, At, B1); PG8_BAR; PG8_SCHED;
            PG8_LDA(At, 1, 1); PG8_STAGE(PG8_SB(1, 0), b3, voffB); PG8_STAGE(PG8_SB(1, 1), b3 + hstep, voffB); PG8_STAGE_A(PG8_SA(1, 0), a3, 0, true);
            PG8_WAIT_V(8); PG8_WAIT_L(0); PG8_BAR; PG8_MMA(1, 0, At, B0); PG8_MMA(1, 1, At, B1); PG8_BAR; PG8_SCHED;
            } else {
            PG8_LDB(B0, 0, 0); PG8_SCHED; PG8_LDA(At, 0, 0); PG8_STAGE(PG8_SA(1, 1), a1 + hstep, voffA);
            PG8_WAIT_L(8); PG8_BAR; PG8_WAIT_L(0); PG8_MMA(0, 0, At, B0); PG8_BAR; PG8_SCHED;
            PG8_LDB(B1, 0, 1); PG8_STAGE(PG8_SB(0, 0), b2, voffB);
            PG8_BAR; PG8_WAIT_L(0); PG8_MMA(0, 1, At, B1); PG8_BAR;
            PG8_LDA(At, 0, 1); PG8_STAGE(PG8_SA(0, 0), a2, voffA);
            PG8_BAR; PG8_WAIT_L(0); PG8_MMA(1, 0, At, B0); PG8_BAR; PG8_SCHED;
            PG8_STAGE(PG8_SB(0, 1), b2 + hstep, voffB);
            PG8_WAIT_V(6); PG8_BAR; PG8_MMA(1, 1, At, B1); PG8_BAR;
            PG8_LDB(B0, 1, 0); PG8_SCHED; PG8_LDA(At, 1, 0); PG8_STAGE(PG8_SA(0, 1), a2 + hstep, voffA);
            PG8_WAIT_L(8); PG8_BAR; PG8_WAIT_L(0); PG8_MMA(0, 0, At, B0); PG8_BAR; PG8_SCHED;
            PG8_LDB(B1, 1, 1); PG8_STAGE(PG8_SB(1, 0), b3, voffB);
            PG8_BAR; PG8_WAIT_L(0); PG8_MMA(0, 1, At, B1); PG8_BAR;
            PG8_LDA(At, 1, 1); PG8_STAGE(PG8_SA(1, 0), a3, voffA);
            PG8_BAR; PG8_WAIT_L(0); PG8_MMA(1, 0, At, B0); PG8_BAR; PG8_SCHED;
            PG8_STAGE(PG8_SB(1, 1), b3 + hstep, voffB);
            PG8_WAIT_V(6); PG8_BAR; PG8_MMA(1, 1, At, B1); PG8_BAR;
            }
        }
        if constexpr (ALIGN_EPI) { if (wr == 0) PG8_BAR; }
        if constexpr (!Epi::AFTER_DRAIN) { E(acc, cur, wr, wc, fr, fq); S.done(cur); }
        if (!has_next) break;
        if (!Epi::CHAIN || nxt.t == 0) {
#pragma unroll
        for (int a = 0; a < 2; ++a)
#pragma unroll
            for (int b = 0; b < 2; ++b)
#pragma unroll
                for (int m = 0; m < 4; ++m)
#pragma unroll
                    for (int n = 0; n < 2; ++n) acc[a][b][m][n] = (f32x4){0.f, 0.f, 0.f, 0.f}; }
        cur = nxt; cA = nA; cB = nB; ++ui;
        if constexpr (GATHER) { _Pragma("unroll") for (int h_ = 0; h_ < 2; ++h_) _Pragma("unroll") for (int i_ = 0; i_ < 2; ++i_) gcur[h_][i_] = gnxt[h_][i_]; }
        if constexpr (ALIGN_EPI) { if (wr == 1) PG8_BAR; }
    }
    PG8_WAIT_V(0);
    if constexpr (!ALIGN_EPI) { if (wr == 0) PG8_BAR; }
    PG8_BAR;
    if constexpr (Epi::AFTER_DRAIN) { E.fused(acc, cur, wr, wc, fr, fq, lds, wid, lane); S.done(cur); }
#undef PG8_SA
#undef PG8_SB
#undef PG8_STAGE
#undef PG8_STAGE_A
#undef PG8_GOFF
#undef PG8_LDA
#undef PG8_LDB
#undef PG8_MMA
#undef PG8_WAIT_V
#undef PG8_WAIT_L
#undef PG8_BAR
#undef PG8_SCHED
}
}
constexpr int NTOK = 32768, SEQ = 8192, NB = 4, DM = 1024, INC = 8200;
constexpr float EPS = 1e-6f, LOG2E = 1.4426950408889634f;
constexpr size_t MiB = 1u << 20;
constexpr size_t WS_CTL = 0, CTL_ZERO_BYTES = 128 * 1024;
constexpr size_t WS_IG = 1 * MiB;
constexpr size_t WS_BC = 1 * MiB + 512 * 1024;
constexpr size_t WS_BLAST = 2 * MiB;
constexpr size_t WS_GMAX = 2 * MiB + 64 * 1024;
constexpr size_t WS_NUC = 3 * MiB;
constexpr size_t WS_TOKE = 4 * MiB;
constexpr size_t WS_TOKR = 4 * MiB + 256 * 1024;
constexpr size_t WS_TOKW = 4 * MiB + 512 * 1024;
constexpr size_t WS_TEXP = 5 * MiB;
constexpr size_t WS_HISTG = 5 * MiB + 64 * 1024;
constexpr size_t WS_WRT = 7 * MiB;
constexpr size_t WS_TOKP = 6 * MiB;
constexpr size_t WS_WT1 = 8 * MiB;
constexpr size_t WS_WT2 = 18 * MiB;
constexpr size_t WS_PT = 24 * MiB;
constexpr size_t WS_WOT = 27 * MiB;
constexpr size_t WS_PROJ = 32 * MiB;
constexpr size_t PROJ_STRIDE = 32 * MiB;
constexpr size_t WS_HB = 352 * MiB;
constexpr size_t WS_O12 = 416 * MiB;
constexpr size_t WS_G0 = 32 * MiB, WS_G1 = 192 * MiB, WS_G2 = 288 * MiB;
constexpr size_t WS_H2 = 32 * MiB;
constexpr size_t WS_XS = 96 * MiB;
constexpr size_t WS_HE = 352 * MiB;
constexpr size_t WS_TOKS = 6 * MiB + 512 * 1024;
constexpr size_t WS_OSL = 96 * MiB;
constexpr size_t WS_W1T = 416 * MiB;
constexpr size_t WS_W2T = 448 * MiB;
constexpr size_t WS_XB1 = 256 * MiB;
constexpr size_t WS_NEED = 512 * MiB;
constexpr int PJ_AQ = 0, PJ_AK = 1, PJ_AV = 2, PJ_AO = 3, PJ_BQ = 4, PJ_BK = 5, PJ_BV = 6, PJ_CQ = 7, PJ_CK = 8, PJ_CV = 9;
constexpr int CW_TMO = 0, CW_CODE = 1;
constexpr int CW_BAR = 4096;
constexpr int CW_Q = 8192;
constexpr int CW_CNT = 12288;
constexpr int RING_BYTES = 131072;
constexpr int MISC_OFF = RING_BYTES;
constexpr int OFFS_OFF = RING_BYTES + 256;
constexpr int TEXP_OFF = RING_BYTES + 4096;
constexpr int TOKL_OFF = RING_BYTES + 6144;
constexpr int LDS_BYTES = 147456;
constexpr int NWAVES = 8, NTHR = 512;

#ifndef GAS
#define GAS __attribute__((address_space(1)))
#endif
#define LAS __attribute__((address_space(3)))
typedef unsigned short bf16;
typedef float f32x4 __attribute__((ext_vector_type(4)));
typedef float f32x16 __attribute__((ext_vector_type(16)));
typedef short bf16x8 __attribute__((ext_vector_type(8)));
typedef unsigned u32x4 __attribute__((ext_vector_type(4)));
typedef unsigned u32x2 __attribute__((ext_vector_type(2)));
typedef short s16x4 __attribute__((ext_vector_type(4)));
typedef GAS unsigned gu32;
#define RLX_AGENT __ATOMIC_RELAXED, __HIP_MEMORY_SCOPE_AGENT
#define LDS_WAIT() asm volatile("s_waitcnt lgkmcnt(0)" ::: "memory")
typedef float f32x2_t __attribute__((ext_vector_type(2))); typedef __bf16 bf16x2_t __attribute__((ext_vector_type(2)));
__device__ __forceinline__ unsigned pk2(float lo, float hi) { f32x2_t v = {lo, hi}; bf16x2_t b = __builtin_convertvector(v, bf16x2_t); return __builtin_bit_cast(unsigned, b); }
__device__ __forceinline__ float bflo(unsigned u) { return __builtin_bit_cast(float, u << 16); }
__device__ __forceinline__ float bfhi(unsigned u) { return __builtin_bit_cast(float, u & 0xffff0000u); }
__device__ __forceinline__ float sigm(float x) { return 1.f / (1.f + __expf(-x)); }
template <int O> __device__ __forceinline__ float xor_shfl(float v) {
    const int x = __builtin_bit_cast(int, v);
    if constexpr (O == 1) return __builtin_bit_cast(float, __builtin_amdgcn_update_dpp(x, x, 0xB1, 0xf, 0xf, false));
    else if constexpr (O == 2) return __builtin_bit_cast(float, __builtin_amdgcn_update_dpp(x, x, 0x4E, 0xf, 0xf, false));
    else if constexpr (O == 4) { int t = __builtin_amdgcn_update_dpp(x, x, 0x104, 0xf, 0x5, false);
        t = __builtin_amdgcn_update_dpp(t, x, 0x114, 0xf, 0xA, false); return __builtin_bit_cast(float, t); }
    else if constexpr (O == 8) return __builtin_bit_cast(float, __builtin_amdgcn_update_dpp(x, x, 0x128, 0xf, 0xf, false));
    else return __builtin_bit_cast(float, __builtin_amdgcn_ds_swizzle(x, (O << 10) | 0x1f));
}
__device__ __forceinline__ float wave_sum(float v) {
    v += xor_shfl<1>(v); v += xor_shfl<2>(v); v += xor_shfl<4>(v); v += xor_shfl<8>(v);
    { auto rr = __builtin_amdgcn_permlane16_swap(__float_as_uint(v), __float_as_uint(v), false, false); v = __uint_as_float(rr[0]) + __uint_as_float(rr[1]); }
    auto rr = __builtin_amdgcn_permlane32_swap(__float_as_uint(v), __float_as_uint(v), false, false);
    return __uint_as_float(rr[0]) + __uint_as_float(rr[1]);
}
__device__ __forceinline__ float wave_max(float v) {
    v = fmaxf(v, xor_shfl<1>(v)); v = fmaxf(v, xor_shfl<2>(v)); v = fmaxf(v, xor_shfl<4>(v)); v = fmaxf(v, xor_shfl<8>(v));
    { auto rr = __builtin_amdgcn_permlane16_swap(__float_as_uint(v), __float_as_uint(v), false, false); v = fmaxf(__uint_as_float(rr[0]), __uint_as_float(rr[1])); }
    auto rr = __builtin_amdgcn_permlane32_swap(__float_as_uint(v), __float_as_uint(v), false, false);
    return fmaxf(__uint_as_float(rr[0]), __uint_as_float(rr[1]));
}
__device__ __forceinline__ float lane_up(float v, int lane, int o) {
    return __builtin_bit_cast(float, __builtin_amdgcn_ds_bpermute(((lane - o) & 63) << 2, __builtin_bit_cast(int, v)));
}
__device__ __forceinline__ float lane_get(float v, int src) {
    return __builtin_bit_cast(float, __builtin_amdgcn_readlane(__builtin_bit_cast(int, v), src));
}
__device__ __forceinline__ float pair_sum(float v) {
    auto rr = __builtin_amdgcn_permlane32_swap(__float_as_uint(v), __float_as_uint(v), false, false);
    return __uint_as_float(rr[0]) + __uint_as_float(rr[1]);
}
__device__ __forceinline__ float pair_max(float v) {
    auto rr = __builtin_amdgcn_permlane32_swap(__float_as_uint(v), __float_as_uint(v), false, false);
    return fmaxf(__uint_as_float(rr[0]), __uint_as_float(rr[1]));
}
__device__ __forceinline__ float max3f(float a, float b, float c) { float r; asm("v_max3_f32 %0, %1, %2, %3" : "=v"(r) : "v"(a), "v"(b), "v"(c)); return r; }
__device__ __forceinline__ int crow(int r, int hi) { return (r & 3) + 8 * (r >> 2) + 4 * hi; }
typedef short v4i16_t __attribute__((ext_vector_type(4)));
__device__ __forceinline__ s16x4 tr16(const LAS unsigned char* p) { return __builtin_bit_cast(s16x4, __builtin_amdgcn_ds_read_tr16_b64_v4i16((LAS v4i16_t*)p)); }
__device__ __forceinline__ bf16x8 cat8(s16x4 lo, s16x4 hi) { return (bf16x8){lo[0], lo[1], lo[2], lo[3], hi[0], hi[1], hi[2], hi[3]}; }
__device__ __forceinline__ f32x4 ldrow4(const void* base, bool isbf, size_t row, int idx) {
    if (isbf) { const u32x2 u = ((const GAS u32x2*)((const bf16*)base + row * 1024))[idx]; return (f32x4){bflo(u.x), bfhi(u.x), bflo(u.y), bfhi(u.y)}; }
    return ((const GAS f32x4*)((const float*)base + row * 1024))[idx];
}
__device__ __forceinline__ u32x4 ldrow4raw(const void* base, bool isbf, size_t row, int idx) {
    if (isbf) { const u32x2 u = ((const GAS u32x2*)((const bf16*)base + row * 1024))[idx]; return (u32x4){u.x, u.y, 0u, 0u}; }
    return ((const GAS u32x4*)((const float*)base + row * 1024))[idx];
}
__device__ __forceinline__ f32x4 cvtrow4(u32x4 raw, bool isbf) {
    if (isbf) return (f32x4){bflo(raw.x), bfhi(raw.x), bflo(raw.y), bfhi(raw.y)};
    return __builtin_bit_cast(f32x4, raw);
}
#define MFMA32(a, b, c) __builtin_amdgcn_mfma_f32_32x32x16_bf16((a), (b), (c), 0, 0, 0)
#define XB_TMO      128
#define XB_XCNT(j)  (256  + 64 * (j))
#define XB_XSUB(j)  (1280 + 64 * (j))
#define XB_XGEN(j)  (2304 + 64 * (j))
#define XB_TOP      3328
#define XB_TOPGEN   3392
#define XCD_BAR_WORDS 3456
#define XB_SPIN_CAP (1u << 18)

__device__ __forceinline__ unsigned xb_ld(unsigned* p)              { return __hip_atomic_load(p, __ATOMIC_RELAXED, __HIP_MEMORY_SCOPE_AGENT); }
__device__ __forceinline__ unsigned xb_add(unsigned* p, unsigned v) { return __hip_atomic_fetch_add(p, v, __ATOMIC_RELAXED, __HIP_MEMORY_SCOPE_AGENT); }
__device__ __forceinline__ unsigned xb_xcc_id() { return (unsigned)__builtin_amdgcn_s_getreg((3 << 11) | 20) & 0xFu; }
#define XB_SPIN(cond, bar) do { unsigned _sp = 0; while (cond) { __builtin_amdgcn_s_sleep(1); \
    if ((++_sp & 255u) == 0u) { if (xb_ld(&(bar)[XB_TMO])) break; if (_sp > XB_SPIN_CAP) { atomicAdd(&(bar)[XB_TMO], 1u); break; } } } } while (0)

__device__ __forceinline__ int xb_lane() { int l; asm volatile("v_mbcnt_lo_u32_b32 %0, -1, 0\n\tv_mbcnt_hi_u32_b32 %0, -1, %0" : "=v"(l)); return l; }
struct XcdBarrier {
    int wv;
    unsigned* bar; unsigned x;
    volatile LAS unsigned* st;
};

__device__ __forceinline__ XcdBarrier xcd_barrier_post(unsigned* bar, volatile LAS unsigned* st, int wv) {
    XcdBarrier b; b.wv = wv; b.bar = bar; b.x = xb_xcc_id(); b.st = st;
    if (wv == 0 && xb_lane() == 0) (void)xb_add(&bar[XB_XCNT(b.x)], 1u);
    return b;
}
__device__ __forceinline__ void xcd_barrier_complete(unsigned* bar, unsigned x, unsigned& nloc, unsigned& nx) {
    const unsigned G = gridDim.x * gridDim.y * gridDim.z;
    unsigned sum, cnt, mine, sp = 0u;
    for (;;) {
        sum = 0u; cnt = 0u; mine = 0u;
#pragma unroll
        for (unsigned j = 0; j < 16; ++j) { const unsigned c = xb_ld(&bar[XB_XCNT(j)]); sum += c; cnt += (c > 0u) ? 1u : 0u; mine = (j == x) ? c : mine; }
        if (sum == G) break;
        __builtin_amdgcn_s_sleep(1);
        if ((++sp & 255u) == 0u) { if (xb_ld(&bar[XB_TMO])) break; if (sp > XB_SPIN_CAP) { atomicAdd(&bar[XB_TMO], 1u); break; } }
    }
    nloc = mine > 0u ? mine : 1u; nx = cnt > 0u ? cnt : 1u;
}

__device__ __forceinline__ void xcd_barrier(const XcdBarrier& b) {
    asm volatile("s_waitcnt vmcnt(0)" ::: "memory");
    __syncthreads();
    if (b.wv == 0 && xb_lane() == 0) {
        unsigned* bar = b.bar;
        __builtin_amdgcn_s_waitcnt(0);
        unsigned nloc = b.st[0], nx = b.st[1];
        if (nloc == 0u) { xcd_barrier_complete(bar, b.x, nloc, nx); b.st[0] = nloc; b.st[1] = nx; }
        const unsigned old = xb_add(&bar[XB_XSUB(b.x)], 1u);
        const unsigned gen = old / nloc;
        if (old + 1u == (gen + 1u) * nloc) {
            __builtin_amdgcn_fence(__ATOMIC_RELEASE, "agent");
            asm volatile("s_waitcnt vmcnt(0)" ::: "memory");
            const unsigned og = xb_add(&bar[XB_TOP], 1u);
            const unsigned tg = og / nx;
            if (og + 1u == (tg + 1u) * nx) xb_add(&bar[XB_TOPGEN], 1u);
            else XB_SPIN(xb_ld(&bar[XB_TOPGEN]) == tg, bar);
            __builtin_amdgcn_fence(__ATOMIC_ACQUIRE, "agent");
            xb_add(&bar[XB_XGEN(b.x)], 1u);
            asm volatile("s_waitcnt vmcnt(0)" ::: "memory");
        } else {
            XB_SPIN(xb_ld(&bar[XB_XGEN(b.x)]) == gen, bar);
            __builtin_amdgcn_fence(__ATOMIC_ACQUIRE, "agent");
            asm volatile("s_waitcnt vmcnt(0)" ::: "memory");
        }
    }
    __syncthreads();
}
struct Args {
    const float* in[23]; float* out; unsigned char* ws; int ph_lo, ph_hi;
};
struct Ctx {
    LAS unsigned char* lds; volatile LAS unsigned* MISC; gu32* ctl; unsigned char* ws;
    int tid, lane, wave, vcu, G;
};
template <class T> __device__ __forceinline__ T* wsp(const Ctx& C, size_t off) { return (T*)(C.ws + off); }
__device__ __forceinline__ bf16* proj(const Ctx& C, int j) { return (bf16*)(C.ws + WS_PROJ + (size_t)j * PROJ_STRIDE); }

struct TrItem { const float* W; int ldn, k0, n0; bf16* WT; int Kdst, drow0; };
__device__ __forceinline__ void transpose_load(const TrItem& t, f32x4 (&v)[8], int lane) {
    const float* src = t.W + (size_t)(t.k0 + (lane >> 3)) * t.ldn + t.n0 + 4 * (lane & 7);
#pragma unroll
    for (int i = 0; i < 8; ++i) v[i] = *(const GAS f32x4*)(src + (size_t)(8 * i) * t.ldn);
}
__device__ __forceinline__ void transpose_commit(const TrItem& t, const f32x4 (&v)[8], LAS float* scr, int lane) {
    { const int c4 = lane & 7;
#pragma unroll
        for (int i = 0; i < 8; ++i) { LAS float* d = scr + ((lane >> 3) + 8 * i) * 33 + 4 * c4; d[0] = v[i].x; d[1] = v[i].y; d[2] = v[i].z; d[3] = v[i].w; } }
    LDS_WAIT(); asm volatile("" ::: "memory");
    const int c = lane & 7;
#pragma unroll
    for (int j = 0; j < 4; ++j) { const int n = (lane >> 3) + 8 * j; const LAS float* s = scr + (8 * c) * 33 + n;
        u32x4 o; o.x = pk2(s[0 * 33], s[1 * 33]); o.y = pk2(s[2 * 33], s[3 * 33]); o.z = pk2(s[4 * 33], s[5 * 33]); o.w = pk2(s[6 * 33], s[7 * 33]);
        *(GAS u32x4*)(t.WT + (size_t)(t.drow0 + n) * t.Kdst + t.k0 + 8 * c) = o; }
    LDS_WAIT(); asm volatile("" ::: "memory");
}
__device__ __forceinline__ TrItem layer_weight_decode(const Args& A, const Ctx& C, int layer, int it) {
    const float* win = A.in[2] + (size_t)layer * DM * INC;
    constexpr int I1 = 16 * 160, I2 = 16 * 96, I3 = 3 * 8 * 32;
    int r = it;
    if (r < I1) { const int nb = r % 160, kb = r / 160, nd = nb * 32, j = nd >> 9; const int sc = (j < 4 ? j * 512 : 2056 + (j - 4) * 512) + (nd & 511);
        return TrItem{win, INC, kb * 64, sc, wsp<bf16>(C, WS_WT1), 1024, nd}; } r -= I1;
    if (r < I2) { const int nb = r % 96, kb = r / 96; return TrItem{win, INC, kb * 64, 5128 + nb * 32, wsp<bf16>(C, WS_WT2), 1024, nb * 32}; } r -= I2;
    if (r < I3) { const int br = r / 256, q = r % 256, nb = q % 32, kb = q / 32;
        return TrItem{A.in[13] + (size_t)(layer * 3 + br) * 512 * 1024, 1024, kb * 64, nb * 32, wsp<bf16>(C, WS_PT) + (size_t)br * 1024 * 512, 512, nb * 32}; } r -= I3;
    { const int nb = r % 32, kb = r / 32; return TrItem{A.in[14] + (size_t)layer * 1024 * 1024, 1024, kb * 64, nb * 32, wsp<bf16>(C, WS_WOT), 1024, nb * 32}; }
}
__device__ __forceinline__ void layer_weight_items(const Args& A, const Ctx& C, int layer) {
    LAS float* scr = (LAS float*)(C.lds + C.wave * 16384);
    const int gw = C.vcu * NWAVES + C.wave, NGW = C.G * NWAVES;
    constexpr int NI = 16 * 160 + 16 * 96 + 3 * 8 * 32 + 16 * 32;
    if (gw >= NI) return;
    TrItem cur = layer_weight_decode(A, C, layer, gw); f32x4 v[8]; transpose_load(cur, v, C.lane);
    for (int it = gw; it < NI; it += NGW) { f32x4 vn[8]; TrItem nxt = cur; const bool hn = it + NGW < NI;
        if (hn) { nxt = layer_weight_decode(A, C, layer, it + NGW); transpose_load(nxt, vn, C.lane); }
        transpose_commit(cur, v, scr, C.lane);
        if (hn) {
#pragma unroll
            for (int i = 0; i < 8; ++i) v[i] = vn[i]; }
        cur = nxt; }
}
__device__ __forceinline__ TrItem moe_weight_decode(const Args& A, const Ctx& C, int layer, int it) {
    constexpr int I1 = 32 * 256;
    int r = it;
    if (r < I1) { const int e = r >> 8, q = r & 255, mat = q >> 7, q2 = q & 127, nb = q2 & 7, kb = q2 >> 3, n0 = nb * 32;
        const float* src = (mat ? A.in[21] : A.in[20]) + (size_t)(layer * 32 + e) * 1024 * 256;
        return TrItem{src, 256, kb * 64, n0, wsp<bf16>(C, WS_W1T), 1024, e * 512 + (n0 >> 7) * 256 + mat * 128 + (n0 & 127)}; } r -= I1;
    { const int e = r >> 7, q = r & 127, nb = q & 31, kb = q >> 5;
        return TrItem{A.in[22] + (size_t)(layer * 32 + e) * 256 * 1024, 1024, kb * 64, nb * 32, wsp<bf16>(C, WS_W2T), 256, e * 1024 + nb * 32}; }
}
__device__ __forceinline__ void moe_weight_items(const Args& A, const Ctx& C, int layer) {
    LAS float* scr = (LAS float*)(C.lds + C.wave * 16384);
    const int gw = C.vcu * NWAVES + C.wave, NGW = C.G * NWAVES;
    constexpr int NI = 32 * 256 + 32 * 128;
    if (gw >= NI) return;
    TrItem cur = moe_weight_decode(A, C, layer, gw); f32x4 v[8]; transpose_load(cur, v, C.lane);
    for (int it = gw; it < NI; it += NGW) { f32x4 vn[8]; TrItem nxt = cur; const bool hn = it + NGW < NI;
        if (hn) { nxt = moe_weight_decode(A, C, layer, it + NGW); transpose_load(nxt, vn, C.lane); }
        transpose_commit(cur, v, scr, C.lane);
        if (hn) {
#pragma unroll
            for (int i = 0; i < 8; ++i) v[i] = vn[i]; }
        cur = nxt; }
}
template <int KIND> __device__ __forceinline__ void phase0(const Args& A, const Ctx& C, int parts = 7  ) {
    constexpr int layer = KIND;
    if (layer < 2) { if (parts & 1) layer_weight_items(A, C, layer);
        const float* wr = A.in[18] + layer * 32768; const float* wgp = A.in[16] + layer * 4096; bf16* wt = wsp<bf16>(C, WS_WRT);
        for (int idx = C.vcu * NTHR + C.tid; idx < ((parts & 2) ? 65536 : 0); idx += C.G * NTHR) { const int n = idx >> 10, k = idx & 1023;
            const float w = n < 32 ? wr[k * 32 + n] : n < 36 ? wgp[k * 4 + (n - 32)] : 0.f; const unsigned hi = pk2(w, 0.f) & 0xffffu; const unsigned lo = pk2(w - bflo(hi), 0.f) & 0xffffu;
            ((GAS bf16*)wt)[idx] = (bf16)hi; ((GAS bf16*)wt)[65536 + idx] = (bf16)lo; } }
    __syncthreads();
    LAS float* WG = (LAS float*)(C.lds);
    LAS float* GL = (LAS float*)(C.lds + 32768);
    const int ll = layer < 2 ? layer : 0;
    const float* win = A.in[2] + (size_t)ll * DM * INC;
    if (layer < 2) { float wv[16];
#pragma unroll
        for (int q = 0; q < 16; ++q) { const int i = C.tid + NTHR * q; wv[q] = *(const GAS float*)(win + (size_t)(i >> 3) * INC + 2048 + (i & 7)); }
#pragma unroll
        for (int q = 0; q < 16; ++q) { const int i = C.tid + NTHR * q, k = i >> 3, gt = i & 7;
            WG[(gt >> 2) * 4096 + ((((k >> 8) * 4 + (k & 3)) * 64 + ((k & 255) >> 2)) << 2) + (gt & 3)] = wv[q]; } }
    __syncthreads();
    const float* g1 = A.in[1] + ll * 1024; const float* gb = A.in[5] + ll * 8;
    const void* xsrc = (layer == 0) ? (const void*)A.in[0] : (const void*)wsp<bf16>(C, WS_XB1); const bool xbf = layer > 0;
    const GAS int* tokp = (const GAS int*)wsp<int>(C, WS_TOKP); const GAS float* tokw = (const GAS float*)wsp<float>(C, WS_TOKW);
    const bf16* osl = wsp<bf16>(C, WS_OSL); bf16* hb = (bf16*)A.out + (size_t)NTOK * DM;
    const int gq_ = 4 * (C.lane & 1) + 2 * ((C.lane >> 1) & 1) + ((C.lane >> 2) & 1); const float gbq = *(const GAS float*)(gb + gq_);
    f32x4 g1r[4];
#pragma unroll
    for (int j = 0; j < 4; ++j) g1r[j] = ((const GAS f32x4*)g1)[64 * j + C.lane];
    for (int item = C.vcu; item < ((parts & 4) ? NTOK / 64 : 0); item += C.G) {
        const int row0 = item * 64;
        u32x4 vnx[4]; u32x2 onx0[4] = {}, onx1[4] = {}; float nw0 = 0.f, nw1 = 0.f, nnw0 = 0.f, nnw1 = 0.f; int nnp0 = 0, nnp1 = 0;
        { const int r0 = row0 + C.wave * 8;
#pragma unroll
            for (int j = 0; j < 4; ++j) vnx[j] = ldrow4raw(xsrc, xbf, (size_t)r0, C.lane + 64 * j);
            if (layer > 0) { nw0 = tokw[r0 * 2]; nw1 = tokw[r0 * 2 + 1]; const size_t p0 = (size_t)tokp[r0 * 2], p1 = (size_t)tokp[r0 * 2 + 1];
                nnw0 = tokw[r0 * 2 + 2]; nnw1 = tokw[r0 * 2 + 3]; nnp0 = tokp[r0 * 2 + 2]; nnp1 = tokp[r0 * 2 + 3];
                const GAS u32x2* o0 = (const GAS u32x2*)(osl + p0 * DM) + C.lane; const GAS u32x2* o1 = (const GAS u32x2*)(osl + p1 * DM) + C.lane;
#pragma unroll
                for (int j = 0; j < 4; ++j) { onx0[j] = o0[64 * j]; onx1[j] = o1[64 * j]; } } }
        for (int i = 0; i < 8; ++i) {
            const int rl = C.wave * 8 + i, row = row0 + rl;
            f32x4 v[4]; u32x2 oc0[4], oc1[4]; const float w0 = nw0, w1 = nw1;
#pragma unroll
            for (int j = 0; j < 4; ++j) { v[j] = cvtrow4(vnx[j], xbf); oc0[j] = onx0[j]; oc1[j] = onx1[j]; }
            if (i < 7) {
#pragma unroll
                for (int j = 0; j < 4; ++j) vnx[j] = ldrow4raw(xsrc, xbf, (size_t)(row + 1), C.lane + 64 * j);
                if (layer > 0) { nw0 = nnw0; nw1 = nnw1;
                    const GAS u32x2* o0 = (const GAS u32x2*)(osl + (size_t)nnp0 * DM) + C.lane; const GAS u32x2* o1 = (const GAS u32x2*)(osl + (size_t)nnp1 * DM) + C.lane;
#pragma unroll
                    for (int j = 0; j < 4; ++j) { onx0[j] = o0[64 * j]; onx1[j] = o1[64 * j]; }
                    if (i < 6) { nnw0 = tokw[row * 2 + 4]; nnw1 = tokw[row * 2 + 5]; nnp0 = tokp[row * 2 + 4]; nnp1 = tokp[row * 2 + 5]; } } }
            if (layer > 0) {
#pragma unroll
                for (int j = 0; j < 4; ++j) { const u32x2 a = oc0[j], b = oc1[j];
                    v[j].x += w0 * bflo(a.x) + w1 * bflo(b.x); v[j].y += w0 * bfhi(a.x) + w1 * bfhi(b.x); v[j].z += w0 * bflo(a.y) + w1 * bflo(b.y); v[j].w += w0 * bfhi(a.y) + w1 * bfhi(b.y); }
                if (layer == 2) { GAS f32x4* xo = (GAS f32x4*)(A.out + (size_t)row * DM) + C.lane;
#pragma unroll
                    for (int j = 0; j < 4; ++j) xo[64 * j] = v[j]; }
                else { GAS u32x2* xo = (GAS u32x2*)((bf16*)A.out + (size_t)row * DM) + C.lane;
#pragma unroll
                    for (int j = 0; j < 4; ++j) { u32x2 o; o.x = pk2(v[j].x, v[j].y); o.y = pk2(v[j].z, v[j].w); xo[64 * j] = o; } }
            }
            if (layer < 2) {
                float ss = 0.f;
#pragma unroll
                for (int j = 0; j < 4; ++j) ss += (v[j].x * v[j].x + v[j].y * v[j].y) + (v[j].z * v[j].z + v[j].w * v[j].w);
                const float rstd = rsqrtf(wave_sum(ss) * (1.f / DM) + EPS);
                float gd[8];
#pragma unroll
                for (int q = 0; q < 8; ++q) gd[q] = 0.f;
                GAS u32x2* ho = (GAS u32x2*)(hb + (size_t)row * DM) + C.lane;
#pragma unroll
                for (int j = 0; j < 4; ++j) { const f32x4 g = g1r[j];
                    const f32x4 h = {v[j].x * rstd * g.x, v[j].y * rstd * g.y, v[j].z * rstd * g.z, v[j].w * rstd * g.w};
                    u32x2 o; o.x = pk2(h.x, h.y); o.y = pk2(h.z, h.w); ho[64 * j] = o;
                    const int k = 256 * j + 4 * C.lane;
#pragma unroll
                    for (int c = 0; c < 4; ++c) { const f32x4 wa = *(const LAS f32x4*)(WG + (((j * 4 + c) * 64 + C.lane) << 2)), wb = *(const LAS f32x4*)(WG + 4096 + (((j * 4 + c) * 64 + C.lane) << 2));
                        gd[0] += h[c] * wa.x; gd[1] += h[c] * wa.y; gd[2] += h[c] * wa.z; gd[3] += h[c] * wa.w; gd[4] += h[c] * wb.x; gd[5] += h[c] * wb.y; gd[6] += h[c] * wb.z; gd[7] += h[c] * wb.w; } }
                float gv;
                { const bool b1 = C.lane & 1, b2 = C.lane & 2, b3 = C.lane & 4; float a4[4], a2[2];
#pragma unroll
                    for (int q = 0; q < 4; ++q) { const float mine = b1 ? gd[q + 4] : gd[q], send = b1 ? gd[q] : gd[q + 4]; a4[q] = mine + xor_shfl<1>(send); }
#pragma unroll
                    for (int q = 0; q < 2; ++q) { const float mine = b2 ? a4[q + 2] : a4[q], send = b2 ? a4[q] : a4[q + 2]; a2[q] = mine + xor_shfl<2>(send); }
                    { const float mine = b3 ? a2[1] : a2[0], send = b3 ? a2[0] : a2[1]; gv = mine + xor_shfl<4>(send); }
                    gv += xor_shfl<8>(gv); gv += xor_shfl<16>(gv); gv = pair_sum(gv); }
                if (C.lane < 8) { const int q = 4 * (C.lane & 1) + 2 * ((C.lane >> 1) & 1) + ((C.lane >> 2) & 1);
                    const float val = gv + gbq;
                    float r;
                    if (q < 4) r = 15.f * tanhf(val * (1.f / 15.f));
                    else r = (val < 0.f) ? (val - log1pf(expf(val))) : -log1pf(expf(-val));
                    GL[rl * 8 + q] = r; }
            }
        }
        if (layer < 2) {
            __syncthreads();
            if (C.wave < 4) { const int hh = C.wave, t = C.lane; const float lf = GL[t * 8 + 4 + hh], ig = GL[t * 8 + hh];
                float b = lf;
#pragma unroll
                for (int o = 1; o < 64; o <<= 1) { const float u = lane_up(b, t, o); if (t >= o) b += u; }
                const float bl = lane_get(b, 63); const float gm = wave_max(bl - b + ig);
                wsp<float>(C, WS_BC)[(size_t)(row0 + t) * 4 + hh] = b; wsp<float>(C, WS_IG)[(size_t)(row0 + t) * 4 + hh] = ig;
                if (t == 0) { const int bb = row0 / SEQ, c = (row0 % SEQ) / 64; wsp<float>(C, WS_BLAST)[(bb * 4 + hh) * 128 + c] = bl; wsp<float>(C, WS_GMAX)[(bb * 4 + hh) * 128 + c] = gm; } }
            __syncthreads();
        }
    }
}
__device__ __forceinline__ void mscan(const Ctx& C, int bh, LAS float* MV) {
    const GAS float* bl = (const GAS float*)(wsp<float>(C, WS_BLAST) + bh * 128); const GAS float* gm = (const GAS float*)(wsp<float>(C, WS_GMAX) + bh * 128); const int i = C.lane;
    const float a0 = bl[2 * i], g0 = gm[2 * i], a1 = bl[2 * i + 1], g1 = gm[2 * i + 1];
    float Aa = a0 + a1, Gg = fmaxf(g0 + a1, g1);
#pragma unroll
    for (int o = 1; o < 64; o <<= 1) { const float Ap = lane_up(Aa, i, o), Gp = lane_up(Gg, i, o); if (i >= o) { Gg = fmaxf(Gp + Aa, Gg); Aa = Ap + Aa; } }
    float Ax = lane_up(Aa, i, 1), Gx = lane_up(Gg, i, 1); if (i == 0) { Ax = 0.f; Gx = -INFINITY; }
    if (i == 0) MV[0] = 0.f;
    MV[2 * i + 1] = fmaxf(Ax + a0, fmaxf(Gx + a0, g0));
    MV[2 * i + 2] = fmaxf(Aa, Gg);
}
struct ConvU { u32x4 u[2][4]; };
struct ConvW { f32x4 w[4][2]; f32x4 b[2]; };
__device__ __forceinline__ void conv_issue_u(const Ctx& C, const bf16* src  , int row0, int seq0, ConvU& R) {
    const int ch = C.tid & 15;
#pragma unroll
    for (int i = 0; i < 2; ++i) { const int t = (C.tid + NTHR * i) >> 4;
#pragma unroll
        for (int j = 0; j < 4; ++j) { int row = row0 + t - j; row = row < seq0 ? seq0 : row; R.u[i][j] = *(const GAS u32x4*)(src + (size_t)row * 512 + ch * 8); } }
}
__device__ __forceinline__ void conv_issue_w(const Ctx& C, const float* cw  , const float* cb, ConvW& W) {
    const int ch = C.tid & 15;
#pragma unroll
    for (int j = 0; j < 4; ++j) { W.w[j][0] = *(const GAS f32x4*)(cw + j * 1024 + ch * 8); W.w[j][1] = *(const GAS f32x4*)(cw + j * 1024 + ch * 8 + 4); }
    W.b[0] = *(const GAS f32x4*)(cb + ch * 8); W.b[1] = *(const GAS f32x4*)(cb + ch * 8 + 4);
}
template <int ST> __device__ __forceinline__ void conv_finish(const Ctx& C, const ConvU& R, const ConvW& W, int row0, int seq0, const LAS float* rs, float sc, LAS unsigned char* dst) {
    const int ch = C.tid & 15;
#pragma unroll
    for (int i = 0; i < 2; ++i) { const int t = (C.tid + NTHR * i) >> 4;
        float y[8] = {W.b[0].x, W.b[0].y, W.b[0].z, W.b[0].w, W.b[1].x, W.b[1].y, W.b[1].z, W.b[1].w};
#pragma unroll
        for (int j = 0; j < 4; ++j) { const float m = (row0 + t - j >= seq0) ? 1.f : 0.f; const u32x4 u = R.u[i][j]; const f32x4 w0 = W.w[j][0] * m, w1 = W.w[j][1] * m;
            y[0] += w0.x * bflo(u.x); y[1] += w0.y * bfhi(u.x); y[2] += w0.z * bflo(u.y); y[3] += w0.w * bfhi(u.y); y[4] += w1.x * bflo(u.z); y[5] += w1.y * bfhi(u.z); y[6] += w1.z * bflo(u.w); y[7] += w1.w * bfhi(u.w); }
        const float s = (rs ? rs[t] : 1.f) * sc;
#pragma unroll
        for (int q = 0; q < 8; ++q) y[q] = y[q] * sigm(y[q]) * s;
        u32x4 o; o.x = pk2(y[0], y[1]); o.y = pk2(y[2], y[3]); o.z = pk2(y[4], y[5]); o.w = pk2(y[6], y[7]);
        *(LAS u32x4*)(dst + t * (ST * 2) + ch * 16) = o; }
}
template <int ST> __device__ __forceinline__ void stage_raw128(const Ctx& C, const bf16* src  , int row0, LAS unsigned char* dst) {
#pragma unroll
    for (int i = 0; i < 2; ++i) { const int task = C.tid + NTHR * i, t = task >> 4, ch = task & 15;
        *(LAS u32x4*)(dst + t * (ST * 2) + ch * 16) = *(const GAS u32x4*)(src + (size_t)(row0 + t) * 512 + ch * 8); }
}
__device__ __forceinline__ const LAS unsigned char* tr_addr(const LAS unsigned char* base, int stride_b, int r0, int c0, int lane) {
    return base + (r0 + ((lane & 15) >> 2)) * stride_b + (c0 + 16 * ((lane >> 4) & 1) + 4 * (lane & 3)) * 2;
}
constexpr int ML_MV = 0, ML_BC = 1024, ML_GS = 1280, ML_RS = 1536, ML_NV = 2048, ML_SC = 2560, ML_KT = 4608, ML_VT = ML_KT + 20480, ML_QT = ML_VT + 20480, ML_CT = ML_QT + 17408, ML_END = ML_CT + 34816, ML_OUT = ML_KT;
static_assert(ML_END <= RING_BYTES, "mLSTM LDS map");
__device__ __forceinline__ void mlstm_u_item(const Args& A, const Ctx& C0, int layer, int bh, int c, bool scan, bool pref  ) {
    Ctx C = C0; asm volatile("" : "+v"(C.tid), "+v"(C.lane));
    LAS float* MV = (LAS float*)(C.lds + ML_MV); LAS float* RS = (LAS float*)(C.lds + ML_RS);
    LAS unsigned char* KT = C.lds + ML_KT; LAS unsigned char* VT = C.lds + ML_VT;
    const int b = bh >> 2, hh = bh & 3, row0 = b * SEQ + c * 64, seq0 = b * SEQ, lane = C.lane, hi = lane >> 5, r32 = lane & 31;
    ConvU ku; ConvW kw; u32x4 vr[2]; float rbl = 0.f, rbc = 0.f, rig = 0.f;
    conv_issue_u(C, proj(C, PJ_AK) + hh * 128, row0, seq0, ku);
#pragma unroll
    for (int i = 0; i < 2; ++i) { const int task = C.tid + NTHR * i; vr[i] = *(const GAS u32x4*)(proj(C, PJ_AV) + hh * 128 + (size_t)(row0 + (task >> 4)) * 512 + (task & 15) * 8); }
    conv_issue_w(C, A.in[3] + layer * 4096 + 512 + hh * 128, A.in[4] + layer * 1024 + 512 + hh * 128, kw);
    if (C.tid < 64) { rbl = *(const GAS float*)(wsp<float>(C, WS_BLAST) + bh * 128 + c); rbc = *(const GAS float*)(wsp<float>(C, WS_BC) + (size_t)(row0 + C.tid) * 4 + hh); rig = *(const GAS float*)(wsp<float>(C, WS_IG) + (size_t)(row0 + C.tid) * 4 + hh); }
    if (scan) { if (C.wave == 0) mscan(C, bh, MV); __syncthreads(); }
    if (C.tid < 64) RS[C.tid] = __expf(rbl - rbc + rig - MV[c + 1]);
    __syncthreads();
    conv_finish<160>(C, ku, kw, row0, seq0, RS, 0.08838834764831845f, KT);
#pragma unroll
    for (int i = 0; i < 2; ++i) { const int task = C.tid + NTHR * i; *(LAS u32x4*)(VT + (task >> 4) * 320 + (task & 15) * 16) = vr[i]; }
    __syncthreads();
    unsigned pf0 = 0u;
    if (pref) { const int t = C.tid, rown = row0 + 64; const char* p0 = nullptr;
        if (t < 134) p0 = (const char*)(proj(C, PJ_AK) + (size_t)(rown - 3 + (t >> 1)) * 512 + hh * 128) + (t & 1) * 128;
        else if (t < 262) { const int q = t - 134; p0 = (const char*)(proj(C, PJ_AV) + (size_t)(rown + (q >> 1)) * 512 + hh * 128) + (q & 1) * 128; }
        else if (t < 270) p0 = (const char*)(wsp<float>(C, WS_BC) + (size_t)(rown + (t - 262) * 8) * 4);
        else if (t < 278) p0 = (const char*)(wsp<float>(C, WS_IG) + (size_t)(rown + (t - 270) * 8) * 4);
        if (p0) pf0 = *(const GAS unsigned*)p0; }
    const int eb = C.wave >> 1, db0 = (C.wave & 1) * 2;
    f32x16 acc0 = {}, acc1 = {};
#pragma unroll
    for (int st = 0; st < 4; ++st) { const int t0 = 16 * st + 8 * hi;
        const bf16x8 af = cat8(tr16(tr_addr(VT, 320, t0, 32 * eb, lane)), tr16(tr_addr(VT, 320, t0 + 4, 32 * eb, lane)));
        const bf16x8 b0 = cat8(tr16(tr_addr(KT, 320, t0, 32 * db0, lane)), tr16(tr_addr(KT, 320, t0 + 4, 32 * db0, lane)));
        const bf16x8 b1 = cat8(tr16(tr_addr(KT, 320, t0, 32 * db0 + 32, lane)), tr16(tr_addr(KT, 320, t0 + 4, 32 * db0 + 32, lane)));
        acc0 = MFMA32(af, b0, acc0); acc1 = MFMA32(af, b1, acc1); }
    bf16* U = wsp<bf16>(C, WS_HB) + (size_t)(bh * 128 + c) * 16384;
    if (C.tid < 128) { float s0 = 0.f, s1 = 0.f, s2 = 0.f, s3 = 0.f;
#pragma unroll
        for (int t = 0; t < 64; t += 4) { s0 += bflo((unsigned)*(const LAS bf16*)(KT + t * 320 + C.tid * 2)); s1 += bflo((unsigned)*(const LAS bf16*)(KT + (t + 1) * 320 + C.tid * 2));
            s2 += bflo((unsigned)*(const LAS bf16*)(KT + (t + 2) * 320 + C.tid * 2)); s3 += bflo((unsigned)*(const LAS bf16*)(KT + (t + 3) * 320 + C.tid * 2)); }
        wsp<float>(C, WS_NUC)[(size_t)(bh * 128 + c) * 128 + C.tid] = (s0 + s1) + (s2 + s3); }
    __syncthreads();
    { LAS bf16* US = (LAS bf16*)(C.lds + ML_KT);
#pragma unroll
        for (int r = 0; r < 16; ++r) { const int e = 32 * eb + crow(r, hi);
            US[e * 136 + 32 * db0 + r32] = (bf16)(pk2(acc0[r], 0.f) & 0xffffu); US[e * 136 + 32 * db0 + 32 + r32] = (bf16)(pk2(acc1[r], 0.f) & 0xffffu); }
        __syncthreads();
#pragma unroll
        for (int i = 0; i < 4; ++i) { const int task = C.tid + NTHR * i, e = task >> 4, ch = task & 15; *(GAS u32x4*)(U + e * 128 + ch * 8) = *(const LAS u32x4*)(US + e * 136 + ch * 8); } }
    asm volatile("" :: "v"(pf0));
    __syncthreads();
}
__device__ __forceinline__ void qknorm_rows(const Args& A, const Ctx& C, int layer) {
    const int gw = C.vcu * NWAVES + C.wave, NGW = C.G * NWAVES, lane = C.lane;
    for (int it = gw; it < NTOK * 4; it += NGW) { const int which = it & 3, row = it >> 2;
        bf16* p = proj(C, which == 0 ? PJ_BQ : which == 1 ? PJ_BK : which == 2 ? PJ_CQ : PJ_CK) + (size_t)row * 512 + lane * 8;
        const float* g = (which < 2 ? A.in[7] : A.in[9]) + layer * 128 + (which & 1) * 64 + (lane & 7) * 8;
        const u32x4 u = *(const GAS u32x4*)p; const f32x4 g0 = *(const GAS f32x4*)g, g1 = *(const GAS f32x4*)(g + 4);
        float v[8] = {bflo(u.x), bfhi(u.x), bflo(u.y), bfhi(u.y), bflo(u.z), bfhi(u.z), bflo(u.w), bfhi(u.w)}; float ss = 0.f;
#pragma unroll
        for (int i = 0; i < 8; ++i) ss += v[i] * v[i];
        ss += xor_shfl<1>(ss); ss += xor_shfl<2>(ss); ss += xor_shfl<4>(ss);
        const float rinv = rsqrtf(ss * (1.f / 64.f) + EPS) * ((which & 1) ? 1.f : 0.125f * LOG2E);
        const u32x4 o = {pk2(v[0] * rinv * g0.x, v[1] * rinv * g0.y), pk2(v[2] * rinv * g0.z, v[3] * rinv * g0.w), pk2(v[4] * rinv * g1.x, v[5] * rinv * g1.y), pk2(v[6] * rinv * g1.z, v[7] * rinv * g1.w)};
        *(GAS u32x4*)p = o; }
}
__device__ __forceinline__ void mlstm_scan(const Ctx& C) {
    LAS float* MV = (LAS float*)(C.lds + ML_MV); LAS float* DEC = (LAS float*)(C.lds + ML_RS);
    for (int w = C.vcu; w < 256; w += C.G) { const int bh = w >> 4, sl = w & 15;
        if (C.wave == 0) mscan(C, bh, MV);
        __syncthreads();
        if (C.tid < 128) DEC[C.tid] = __expf(wsp<float>(C, WS_BLAST)[bh * 128 + C.tid] + MV[C.tid] - MV[C.tid + 1]);
        __syncthreads();
        GAS unsigned* p = (GAS unsigned*)(wsp<unsigned>(C, WS_HB) + (size_t)bh * 128 * 8192 + sl * 512 + C.tid);
        float s0 = 0.f, s1 = 0.f;
        for (int c0 = 0; c0 < 128; c0 += 32) { unsigned u[32];
#pragma unroll
            for (int q = 0; q < 32; ++q) u[q] = p[(size_t)(c0 + q) * 8192];
#pragma unroll
            for (int q = 0; q < 32; ++q) { p[(size_t)(c0 + q) * 8192] = pk2(s0, s1); const float d = DEC[c0 + q]; s0 = d * s0 + bflo(u[q]); s1 = d * s1 + bfhi(u[q]); } }
        if (sl == 0 && C.tid < 128) { GAS float* np = (GAS float*)(wsp<float>(C, WS_NUC) + (size_t)bh * 128 * 128 + C.tid); float s = 0.f;
            for (int c0 = 0; c0 < 128; c0 += 16) { float u[16];
#pragma unroll
                for (int q = 0; q < 16; ++q) u[q] = np[(c0 + q) * 128];
#pragma unroll
                for (int q = 0; q < 16; ++q) { np[(c0 + q) * 128] = s; s = DEC[c0 + q] * s + u[q]; } } }
        __syncthreads();
    }
}
__device__ __forceinline__ void mlstm_out_item(const Args& A, const Ctx& C0, int layer, int bh, int c, bool scan, bool pref  , bf16* habase = nullptr  ) {
    Ctx C = C0; asm volatile("" : "+v"(C.tid), "+v"(C.lane));
    LAS float* MV = (LAS float*)(C.lds + ML_MV); LAS float* BC = (LAS float*)(C.lds + ML_BC); LAS float* GS = (LAS float*)(C.lds + ML_GS); LAS float* NV = (LAS float*)(C.lds + ML_NV);
    LAS float* SC = (LAS float*)(C.lds + ML_SC) + C.wave * 64;
    LAS unsigned char* KT = C.lds + ML_KT; LAS unsigned char* VT = C.lds + ML_VT; LAS unsigned char* QT = C.lds + ML_QT; LAS unsigned char* CT = C.lds + ML_CT; LAS float* OUT = (LAS float*)(C.lds + ML_OUT);
    const int b = bh >> 2, hh = bh & 3, row0 = b * SEQ + c * 64, seq0 = b * SEQ, lane = C.lane, hi = lane >> 5, r32 = lane & 31;
    ConvU qu, ku; ConvW qw, kw; u32x4 vr[2], cr[4]; float r0_ = 0.f, r1_ = 0.f;
    conv_issue_u(C, proj(C, PJ_AQ) + hh * 128, row0, seq0, qu);
    conv_issue_u(C, proj(C, PJ_AK) + hh * 128, row0, seq0, ku);
#pragma unroll
    for (int i = 0; i < 2; ++i) { const int task = C.tid + NTHR * i; vr[i] = *(const GAS u32x4*)(proj(C, PJ_AV) + hh * 128 + (size_t)(row0 + (task >> 4)) * 512 + (task & 15) * 8); }
    { const bf16* cs = wsp<bf16>(C, WS_HB) + (size_t)(bh * 128 + c) * 16384;
#pragma unroll
        for (int i = 0; i < 4; ++i) { const int task = C.tid + NTHR * i; cr[i] = *(const GAS u32x4*)(cs + (task >> 4) * 128 + (task & 15) * 8); } }
    if (C.tid >= 64 && C.tid < 128) { const int t = C.tid - 64; r0_ = *(const GAS float*)(wsp<float>(C, WS_BC) + (size_t)(row0 + t) * 4 + hh); r1_ = *(const GAS float*)(wsp<float>(C, WS_IG) + (size_t)(row0 + t) * 4 + hh); }
    if (C.tid >= 128 && C.tid < 256) r0_ = *(const GAS float*)(wsp<float>(C, WS_NUC) + (size_t)(bh * 128 + c) * 128 + C.tid - 128);
    conv_issue_w(C, A.in[3] + layer * 4096 + hh * 128, A.in[4] + layer * 1024 + hh * 128, qw);
    conv_issue_w(C, A.in[3] + layer * 4096 + 512 + hh * 128, A.in[4] + layer * 1024 + 512 + hh * 128, kw);
    if (scan && C.wave == 0) mscan(C, bh, MV);
    conv_finish<136>(C, qu, qw, row0, seq0, nullptr, 1.f, QT);
    conv_finish<136>(C, ku, kw, row0, seq0, nullptr, 0.08838834764831845f, KT);
#pragma unroll
    for (int i = 0; i < 2; ++i) { const int task = C.tid + NTHR * i; *(LAS u32x4*)(VT + (task >> 4) * 320 + (task & 15) * 16) = vr[i]; }
#pragma unroll
    for (int i = 0; i < 4; ++i) { const int task = C.tid + NTHR * i; *(LAS u32x4*)(CT + (task >> 4) * 272 + (task & 15) * 16) = cr[i]; }
    if (C.tid >= 64 && C.tid < 128) { BC[C.tid - 64] = r0_; GS[C.tid - 64] = r1_ - r0_; }
    if (C.tid >= 128 && C.tid < 256) NV[C.tid - 128] = r0_;
    __syncthreads();
    unsigned pf0 = 0u, pf1 = 0u;
    { const int t = C.tid; const char* p0 = nullptr; const char* p1 = nullptr;
        if (t < 128) p0 = (const char*)(proj(C, PJ_AO) + (size_t)(row0 + (t >> 1)) * 512 + hh * 128) + (t & 1) * 128;
        if (pref) { const int rown = row0 + 64;
            if (t >= 128 && t < 262) { const int q = t - 128; p0 = (const char*)(proj(C, PJ_AQ) + (size_t)(rown - 3 + (q >> 1)) * 512 + hh * 128) + (q & 1) * 128; }
            else if (t >= 262 && t < 396) { const int q = t - 262; p0 = (const char*)(proj(C, PJ_AK) + (size_t)(rown - 3 + (q >> 1)) * 512 + hh * 128) + (q & 1) * 128; }
            else if (t >= 396) { const int q = t - 396; p0 = (const char*)(proj(C, PJ_AV) + (size_t)(rown + (q >> 1)) * 512 + hh * 128) + (q & 1) * 128; }
            if (t < 12) { const int q = t + 116; p1 = (const char*)(proj(C, PJ_AV) + (size_t)(rown + (q >> 1)) * 512 + hh * 128) + (q & 1) * 128; }
            else if (t < 268) p1 = (const char*)(wsp<bf16>(C, WS_HB) + (size_t)(bh * 128 + c + 1) * 16384) + (t - 12) * 128; }
        if (p0) pf0 = *(const GAS unsigned*)p0;
        if (p1) pf1 = *(const GAS unsigned*)p1; }
    const float mc = MV[c]; const int lb = C.wave >> 2, cb = C.wave & 3, lq = 32 * lb + r32; const float bl = BC[lq];
    bf16x8 qf[8];
#pragma unroll
    for (int st = 0; st < 8; ++st) qf[st] = *(const LAS bf16x8*)(QT + lq * 272 + (16 * st + 8 * hi) * 2);
    f32x16 p0 = {}, p1 = {};
#pragma unroll
    for (int st = 0; st < 8; ++st) p0 = MFMA32(*(const LAS bf16x8*)(KT + r32 * 272 + (16 * st + 8 * hi) * 2), qf[st], p0);
    if (lb == 1) {
#pragma unroll
        for (int st = 0; st < 8; ++st) p1 = MFMA32(*(const LAS bf16x8*)(KT + (32 + r32) * 272 + (16 * st + 8 * hi) * 2), qf[st], p1); }
    f32x16 d0, d1; float mt = bl + mc;
    f32x4 gsa[4], gsb[4];
#pragma unroll
    for (int k = 0; k < 4; ++k) { gsa[k] = *(const LAS f32x4*)(GS + 8 * k + 4 * hi); gsb[k] = *(const LAS f32x4*)(GS + 32 + 8 * k + 4 * hi); }
#pragma unroll
    for (int r = 0; r < 16; ++r) { const int s = crow(r, hi); const float g = gsa[r >> 2][r & 3]; d0[r] = (s <= lq) ? bl + g : -INFINITY; mt = fmaxf(mt, d0[r]); }
#pragma unroll
    for (int r = 0; r < 16; ++r) { const int s = 32 + crow(r, hi); const float g = gsb[r >> 2][r & 3]; d1[r] = (lb == 1 && s <= lq) ? bl + g : -INFINITY; mt = fmaxf(mt, d1[r]); }
    mt = pair_max(mt);
    float rs = 0.f;
#pragma unroll
    for (int r = 0; r < 16; ++r) { p0[r] *= __expf(d0[r] - mt); p1[r] *= __expf(d1[r] - mt); rs += p0[r] + p1[r]; }
    rs = pair_sum(rs);
    float qn = 0.f;
#pragma unroll
    for (int st = 0; st < 8; ++st) { const f32x4 n0 = *(const LAS f32x4*)(NV + 16 * st + 8 * hi), n1 = *(const LAS f32x4*)(NV + 16 * st + 8 * hi + 4); const u32x4 q = __builtin_bit_cast(u32x4, qf[st]);
        qn += bflo(q.x) * n0.x + bfhi(q.x) * n0.y + bflo(q.y) * n0.z + bfhi(q.y) * n0.w + bflo(q.z) * n1.x + bfhi(q.z) * n1.y + bflo(q.w) * n1.z + bfhi(q.w) * n1.w; }
    qn = pair_sum(qn);
    const float wi = __expf(bl + mc - mt), den = wi * qn + rs, dn = fmaxf(fabsf(den), __expf(-mt));
    SC[r32] = wi / dn; SC[32 + r32] = 1.f / dn;
    f32x16 acc1 = {}, acc2 = {};
#define PKF(P, B) (bf16x8)__builtin_bit_cast(bf16x8, ((u32x4){pk2(P[B], P[B + 1]), pk2(P[B + 2], P[B + 3]), pk2(P[B + 4], P[B + 5]), pk2(P[B + 6], P[B + 7])}))
#pragma unroll
    for (int s2 = 0; s2 < 2; ++s2) { const int k0 = 16 * s2;
        const bf16x8 vf = cat8(tr16(tr_addr(VT, 320, k0 + 4 * hi, 32 * cb, lane)), tr16(tr_addr(VT, 320, k0 + 8 + 4 * hi, 32 * cb, lane)));
        acc2 = MFMA32(s2 == 0 ? PKF(p0, 0) : PKF(p0, 8), vf, acc2); }
    if (lb == 1) {
#pragma unroll
        for (int s2 = 0; s2 < 2; ++s2) { const int k0 = 32 + 16 * s2;
            const bf16x8 vf = cat8(tr16(tr_addr(VT, 320, k0 + 4 * hi, 32 * cb, lane)), tr16(tr_addr(VT, 320, k0 + 8 + 4 * hi, 32 * cb, lane)));
            acc2 = MFMA32(s2 == 0 ? PKF(p1, 0) : PKF(p1, 8), vf, acc2); } }
#undef PKF
#pragma unroll
    for (int st = 0; st < 8; ++st) acc1 = MFMA32(qf[st], *(const LAS bf16x8*)(CT + (32 * cb + r32) * 272 + (16 * st + 8 * hi) * 2), acc1);
    const int frow = C.tid >> 3, fseg = C.tid & 7; u32x4 aor[2]; f32x4 gnr[4];
    { const float* gn = A.in[6] + layer * 512 + hh * 128 + fseg * 16; const bf16* ao = proj(C, PJ_AO) + (size_t)(row0 + frow) * 512 + hh * 128 + fseg * 16;
#pragma unroll
        for (int q = 0; q < 2; ++q) { aor[q] = *(const GAS u32x4*)(ao + 8 * q); gnr[2 * q] = *(const GAS f32x4*)(gn + 8 * q); gnr[2 * q + 1] = *(const GAS f32x4*)(gn + 8 * q + 4); } }
    __syncthreads();
#pragma unroll
    for (int r = 0; r < 16; ++r) { const int l_ = crow(r, hi); OUT[(32 * lb + l_) * 132 + 32 * cb + r32] = SC[l_] * acc1[r] + SC[32 + l_] * acc2[r]; }
    __syncthreads();
    { const int row = C.tid >> 3, seg = C.tid & 7; float v[16]; float ss = 0.f;
#pragma unroll
        for (int q = 0; q < 4; ++q) { const f32x4 x = *(const LAS f32x4*)(OUT + row * 132 + seg * 16 + 4 * q); v[4 * q] = x.x; v[4 * q + 1] = x.y; v[4 * q + 2] = x.z; v[4 * q + 3] = x.w; ss += (x.x * x.x + x.y * x.y) + (x.z * x.z + x.w * x.w); }
        ss += xor_shfl<1>(ss); ss += xor_shfl<2>(ss); ss += xor_shfl<4>(ss);
        const float rinv = rsqrtf(ss * (1.f / 128.f) + EPS);
        bf16* ha = (habase ? habase : proj(C, PJ_AV)) + (size_t)(row0 + row) * 512 + hh * 128 + seg * 16;
#pragma unroll
        for (int q = 0; q < 2; ++q) { const u32x4 a = aor[q]; const f32x4 g0 = gnr[2 * q], g1 = gnr[2 * q + 1]; const float* vv = v + 8 * q;
            u32x4 o; o.x = pk2(vv[0] * rinv * g0.x * sigm(bflo(a.x)), vv[1] * rinv * g0.y * sigm(bfhi(a.x))); o.y = pk2(vv[2] * rinv * g0.z * sigm(bflo(a.y)), vv[3] * rinv * g0.w * sigm(bfhi(a.y)));
            o.z = pk2(vv[4] * rinv * g1.x * sigm(bflo(a.z)), vv[5] * rinv * g1.y * sigm(bfhi(a.z))); o.w = pk2(vv[6] * rinv * g1.z * sigm(bflo(a.w)), vv[7] * rinv * g1.w * sigm(bfhi(a.w)));
            *(GAS u32x4*)(ha + 8 * q) = o; } }
    asm volatile("" :: "v"(pf0), "v"(pf1));
    __syncthreads();
}
constexpr int AT_TAB = 0, AT_SCR = 4096, AT_K = 6144;
template <int DV, bool ISC> __device__ __forceinline__ void attn_unit(const Args& A, const Ctx& C0, int layer, int b, int hs, int qblk, bf16* obase = nullptr  ) {
    Ctx C = C0; asm volatile("" : "+v"(C.tid), "+v"(C.lane));
    constexpr int KSTB = 144, VSTB = 2 * DV + 64, KB = 64 * KSTB, VB = 64 * VSTB, AT_V = AT_K + 4 * KB, NBLK = DV / 32;
    static_assert(AT_V + 4 * VB <= RING_BYTES, "attention LDS map");
    LAS float* TAB = (LAS float*)(C.lds + AT_TAB); LAS float* SCR = (LAS float*)(C.lds + AT_SCR) + C.wave * 64;
    const int lane = C.lane, hi = lane >> 5, r32 = lane & 31, tid = C.tid;
    const bf16 *Qp, *Kp, *Vp; bf16* Op; int pitchO; const float *gq, *gk; int hbias;
    if (ISC) { const int h = hs >> 1, wh = hs & 1; Qp = proj(C, PJ_CQ) + h * 128 + wh * 64; Kp = proj(C, PJ_CK) + h * 128 + wh * 64; Vp = proj(C, PJ_CV) + h * 128;
        Op = wsp<bf16>(C, WS_O12) + h * 256 + wh * 128; pitchO = 1024; gq = A.in[9] + layer * 128; gk = gq + 64; hbias = h; }
    else { Qp = proj(C, PJ_BQ) + hs * 64; Kp = proj(C, PJ_BK) + hs * 64; Vp = proj(C, PJ_BV) + hs * 64; Op = (obase ? obase : proj(C, PJ_BQ)) + hs * 64; pitchO = 512; gq = A.in[7] + layer * 128; gk = gq + 64; hbias = hs; }
    const size_t rowb = (size_t)b * SEQ;
    const int qs0 = qblk * 256 + C.wave * 32;
    const int krow = tid >> 3, kch = tid & 7;
    const int jhi = qblk * 4 + 3, jlo = ISC ? 0 : (qblk * 4 - 8 < 0 ? 0 : qblk * 4 - 8), cqw = qblk * 4 + (C.wave >> 1);
    const bf16* ksrc = Kp + (rowb + krow) * 512 + kch * 8;
    u32x4 kregA, kregB, vregA[NBLK / 2], vregB[NBLK / 2];
#define AT_LOADT(j, KR, VR) do { KR = *(const GAS u32x4*)(ksrc + (size_t)(j) * 64 * 512); \
        if (DV == 128) { _Pragma("unroll") for (int i_ = 0; i_ < 2; ++i_) { const int idx = tid + NTHR * i_; VR[i_] = *(const GAS u32x4*)(Vp + (rowb + (size_t)(j) * 64 + (idx >> 4)) * 512 + (idx & 15) * 8); } } \
        else VR[0] = *(const GAS u32x4*)(Vp + (rowb + (size_t)(j) * 64 + krow) * 512 + kch * 8); } while (0)
    const GAS float* tsrc = (const GAS float*)(ISC ? A.in[12] : A.in[8] + (size_t)layer * 513 * 8);
#define AT_TIDX(i_, out_) do { const int d_ = 703 - (i_); \
        if (ISC) { const int n_ = d_ < 0 ? -d_ : d_; int bk_ = n_ < 8 ? n_ : n_ < 15 ? 8 : n_ < 27 ? 9 : n_ < 50 ? 10 : n_ < 91 ? 11 : n_ < 166 ? 12 : n_ < 305 ? 13 : n_ < 559 ? 14 : 15; if (d_ < 0) bk_ += 16; out_ = bk_ * 4 + hbias; } \
        else { const int dc_ = d_ < -256 ? -256 : d_ > 256 ? 256 : d_; out_ = (dc_ + 256) * 8 + hbias; } } while (0)
    int ti0, ti1; AT_TIDX(tid, ti0); AT_TIDX(tid + 512, ti1);
    const float tv0 = tsrc[ti0], tv1 = tsrc[ti1];
#undef AT_TIDX
    const float gqv = *(const GAS float*)(gq + lane), gkv = *(const GAS float*)(gk + lane);
    float bmr[9];
#pragma unroll
    for (int k = 0; k < 9; ++k) bmr[k] = 0.f;
    if (ISC) bmr[0] = tsrc[(lane & 31) * 4 + hbias];
    else {
#pragma unroll
        for (int k = 0; k < 9; ++k) { const int i = lane + 64 * k; bmr[k] = tsrc[(i < 513 ? i : 512) * 8 + hbias]; } }
    float t15r = 0.f; if (ISC) t15r = tsrc[15 * 4 + hbias];
    u32x4 qraw[4]; f32x4 gg[4][4];
    { const bf16* qrow = Qp + (rowb + qs0 + r32) * 512 + 8 * hi;
#pragma unroll
        for (int st = 0; st < 4; ++st) qraw[st] = *(const GAS u32x4*)(qrow + 16 * st);
#pragma unroll
        for (int st = 0; st < 4; ++st) { gg[st][0] = *(const GAS f32x4*)(gq + 16 * st + 8 * hi); gg[st][1] = *(const GAS f32x4*)(gq + 16 * st + 8 * hi + 4); gg[st][2] = *(const GAS f32x4*)(gk + 16 * st + 8 * hi); gg[st][3] = *(const GAS f32x4*)(gk + 16 * st + 8 * hi + 4); } }
    AT_LOADT(jlo, kregA, vregA); AT_LOADT(jlo + 1, kregB, vregB);
    TAB[tid] = tv0 * LOG2E; TAB[tid + 512] = tv1 * LOG2E;
    float MB;
    { const float gqm = wave_max(fabsf(gqv)), gkm = wave_max(fabsf(gkv));
        float bm = 0.f;
#pragma unroll
        for (int k = 0; k < 9; ++k) bm = fmaxf(bm, fabsf(bmr[k]));
        bm = wave_max(bm);
        MB = 64.f * (0.125f * LOG2E) * gqm * gkm * 1.02f + bm * LOG2E; }
    const float t15 = t15r * LOG2E - MB;
    bf16x8 qf[4];
    { float qv[32]; float ss = 0.f;
#pragma unroll
        for (int st = 0; st < 4; ++st) { const u32x4 u = qraw[st];
            qv[8 * st] = bflo(u.x); qv[8 * st + 1] = bfhi(u.x); qv[8 * st + 2] = bflo(u.y); qv[8 * st + 3] = bfhi(u.y); qv[8 * st + 4] = bflo(u.z); qv[8 * st + 5] = bfhi(u.z); qv[8 * st + 6] = bflo(u.w); qv[8 * st + 7] = bfhi(u.w); }
#pragma unroll
        for (int i = 0; i < 32; ++i) ss += qv[i] * qv[i];
        ss = pair_sum(ss);
        const float rinv = rsqrtf(ss * (1.f / 64.f) + EPS) * (0.125f * LOG2E);
#pragma unroll
        for (int st = 0; st < 4; ++st) { const f32x4 g0 = gg[st][0] * gg[st][2], g1 = gg[st][1] * gg[st][3]; const float* q = qv + 8 * st;
            const u32x4 o = {pk2(q[0] * rinv * g0.x, q[1] * rinv * g0.y), pk2(q[2] * rinv * g0.z, q[3] * rinv * g0.w), pk2(q[4] * rinv * g1.x, q[5] * rinv * g1.y), pk2(q[6] * rinv * g1.z, q[7] * rinv * g1.w)};
            qf[st] = __builtin_bit_cast(bf16x8, o); } }
    float l = 0.f; f32x16 o[NBLK];
#pragma unroll
    for (int nb = 0; nb < NBLK; ++nb) o[nb] = f32x16{};
#define AT_VLOAD(F, nb_) do { _Pragma("unroll") for (int ks_ = 0; ks_ < 4; ++ks_) { F[2 * ks_] = tr16(vb_ + (16 * ks_) * VSTB + (nb_) * 64); F[2 * ks_ + 1] = tr16(vb_ + (16 * ks_ + 8) * VSTB + (nb_) * 64); } } while (0)
#define AT_STAGE(buf, KR, VR) do { \
        LAS unsigned char* KT = C.lds + AT_K + (buf) * KB; LAS unsigned char* VT = C.lds + AT_V + (buf) * VB; \
        { float kv[8] = {bflo(KR.x), bfhi(KR.x), bflo(KR.y), bfhi(KR.y), bflo(KR.z), bfhi(KR.z), bflo(KR.w), bfhi(KR.w)}; float ss = 0.f; \
            _Pragma("unroll") for (int i = 0; i < 8; ++i) ss += kv[i] * kv[i]; \
            ss += xor_shfl<1>(ss); ss += xor_shfl<2>(ss); ss += xor_shfl<4>(ss); \
            const float rinv = rsqrtf(ss * (1.f / 64.f) + EPS); \
            const u32x4 w = {pk2(kv[0] * rinv, kv[1] * rinv), pk2(kv[2] * rinv, kv[3] * rinv), pk2(kv[4] * rinv, kv[5] * rinv), pk2(kv[6] * rinv, kv[7] * rinv)}; \
            *(LAS u32x4*)(KT + krow * KSTB + kch * 16) = w; } \
        if (DV == 128) { _Pragma("unroll") for (int i_ = 0; i_ < 2; ++i_) { const int idx = tid + NTHR * i_; *(LAS u32x4*)(VT + (idx >> 4) * VSTB + (idx & 15) * 16) = VR[i_]; } } \
        else *(LAS u32x4*)(VT + krow * VSTB + kch * 16) = VR[0]; \
    } while (0)
#define AT_COMP(j, buf) do { \
        LAS unsigned char* KT = C.lds + AT_K + (buf) * KB; LAS unsigned char* VT = C.lds + AT_V + (buf) * VB; \
        const bool act = ((j) <= cqw) && (ISC || (j) >= cqw - 8); \
        if (act) { \
            f32x16 p0, p1; \
            const bool far = ISC && (qs0 - (64 * (j) + 63) >= 559); \
            if (far) { _Pragma("unroll") for (int r = 0; r < 16; ++r) { p0[r] = t15; p1[r] = t15; } } \
            else { const LAS float* tp = TAB + (703 - (qs0 + r32) + 64 * (j) + 4 * hi); \
                _Pragma("unroll") for (int r = 0; r < 16; ++r) { p0[r] = tp[(r & 3) + 8 * (r >> 2)] - MB; p1[r] = tp[32 + (r & 3) + 8 * (r >> 2)] - MB; } } \
            { bf16x8 kf[8]; \
                _Pragma("unroll") for (int st = 0; st < 4; ++st) { kf[2 * st] = *(const LAS bf16x8*)(KT + r32 * KSTB + (16 * st + 8 * hi) * 2); kf[2 * st + 1] = *(const LAS bf16x8*)(KT + (32 + r32) * KSTB + (16 * st + 8 * hi) * 2); } \
                __builtin_amdgcn_sched_barrier(0);        \
                _Pragma("unroll") for (int st = 0; st < 4; ++st) { p0 = MFMA32(kf[2 * st], qf[st], p0); p1 = MFMA32(kf[2 * st + 1], qf[st], p1); } } \
            float rs0 = 0.f, rs1 = 0.f, rs2 = 0.f, rs3 = 0.f;        \
            _Pragma("unroll") for (int r = 0; r < 16; r += 2) { p0[r] = __builtin_amdgcn_exp2f(p0[r]); p1[r] = __builtin_amdgcn_exp2f(p1[r]); p0[r + 1] = __builtin_amdgcn_exp2f(p0[r + 1]); p1[r + 1] = __builtin_amdgcn_exp2f(p1[r + 1]); \
                rs0 += p0[r]; rs1 += p1[r]; rs2 += p0[r + 1]; rs3 += p1[r + 1]; } \
            l += (rs0 + rs1) + (rs2 + rs3); \
            bf16x8 pw[4]; \
            pw[0] = PKF(p0, 0); pw[1] = PKF(p0, 8); pw[2] = PKF(p1, 0); pw[3] = PKF(p1, 8); \
            { s16x4 fa[8], fb[8]; const LAS unsigned char* vb_ = tr_addr(VT, VSTB, 4 * hi, 0, lane); \
                AT_VLOAD(fa, 0); \
                _Pragma("unroll") for (int nb = 0; nb < NBLK; nb += 2) { \
                    AT_VLOAD(fb, nb + 1); __builtin_amdgcn_sched_barrier(0); \
                    _Pragma("unroll") for (int ks = 0; ks < 4; ++ks) o[nb] = MFMA32(pw[ks], cat8(fa[2 * ks], fa[2 * ks + 1]), o[nb]); \
                    __builtin_amdgcn_sched_barrier(0); \
                    if (nb + 2 < NBLK) AT_VLOAD(fa, nb + 2); __builtin_amdgcn_sched_barrier(0); \
                    _Pragma("unroll") for (int ks = 0; ks < 4; ++ks) o[nb + 1] = MFMA32(pw[ks], cat8(fb[2 * ks], fb[2 * ks + 1]), o[nb + 1]); \
                    __builtin_amdgcn_sched_barrier(0); } } \
        } } while (0)
#define PKF(P, B) __builtin_bit_cast(bf16x8, ((u32x4){pk2(P[B], P[B + 1]), pk2(P[B + 2], P[B + 3]), pk2(P[B + 4], P[B + 5]), pk2(P[B + 6], P[B + 7])}))
    for (int j = jlo; j <= jhi; j += 2) { const int sb = (((j - jlo) >> 1) & 1) * 2;
        AT_STAGE(sb, kregA, vregA); AT_STAGE(sb + 1, kregB, vregB);
        __syncthreads();
        if (j + 2 <= jhi) { AT_LOADT(j + 2, kregA, vregA); AT_LOADT(j + 3, kregB, vregB); }
        AT_COMP(j, sb); AT_COMP(j + 1, sb + 1); }
#undef PKF
#undef AT_STAGE
#undef AT_COMP
#undef AT_VLOAD
#undef AT_LOADT
    l = pair_sum(l);
    SCR[32 + r32] = 1.f / l;
    bf16* orow = Op + (rowb + qs0) * pitchO;
#pragma unroll
    for (int r = 0; r < 16; ++r) { const int q = crow(r, hi); const float rl = SCR[32 + q];
#pragma unroll
        for (int nb = 0; nb < NBLK; ++nb) ((GAS bf16*)orow)[(size_t)q * pitchO + 32 * nb + r32] = (bf16)(pk2(o[nb][r] * rl, 0.f) & 0xffffu); }
    __syncthreads();
}
__device__ __forceinline__ void phase5(const Args& A, const Ctx& C, int layer) {
    const int gw = C.vcu * NWAVES + C.wave, NGW = C.G * NWAVES, lane = C.lane;
    const float lam_init = 0.8f - 0.6f * __expf(-0.3f * (float)layer);
    const float* cl = A.in[10] + layer * 256;
    const float lam = __expf(wave_sum(cl[lane] * cl[64 + lane])) - __expf(wave_sum(cl[128 + lane] * cl[192 + lane])) + lam_init;
    const float* gs = A.in[11] + layer * 128 + (lane & 15) * 8;
    const f32x4 gs0 = *(const GAS f32x4*)gs, gs1 = *(const GAS f32x4*)(gs + 4);
    const float post = 1.f - lam_init;
    const bf16* o12 = wsp<bf16>(C, WS_O12); bf16* hc = proj(C, PJ_CQ);
    const int h = lane >> 4, e0 = (lane & 15) * 8;
    for (int row0 = gw; row0 < NTOK; row0 += 8 * NGW) {
        u32x4 av[8], bv[8];
#pragma unroll
        for (int q = 0; q < 8; ++q) { const int row = row0 + q * NGW; if (row < NTOK) { av[q] = *(const GAS u32x4*)(o12 + (size_t)row * 1024 + h * 256 + e0); bv[q] = *(const GAS u32x4*)(o12 + (size_t)row * 1024 + h * 256 + 128 + e0); } }
#pragma unroll
        for (int q = 0; q < 8; ++q) { const int row = row0 + q * NGW; if (row < NTOK) { const u32x4 a = av[q], bq = bv[q];
            float v[8] = {bflo(a.x) - lam * bflo(bq.x), bfhi(a.x) - lam * bfhi(bq.x), bflo(a.y) - lam * bflo(bq.y), bfhi(a.y) - lam * bfhi(bq.y), bflo(a.z) - lam * bflo(bq.z), bfhi(a.z) - lam * bfhi(bq.z), bflo(a.w) - lam * bflo(bq.w), bfhi(a.w) - lam * bfhi(bq.w)};
            float ss = 0.f;
#pragma unroll
            for (int i = 0; i < 8; ++i) ss += v[i] * v[i];
            ss += xor_shfl<1>(ss); ss += xor_shfl<2>(ss); ss += xor_shfl<4>(ss); ss += xor_shfl<8>(ss);
            const float rinv = rsqrtf(ss * (1.f / 128.f) + EPS) * post;
            const u32x4 o = {pk2(v[0] * rinv * gs0.x, v[1] * rinv * gs0.y), pk2(v[2] * rinv * gs0.z, v[3] * rinv * gs0.w), pk2(v[4] * rinv * gs1.x, v[5] * rinv * gs1.y), pk2(v[6] * rinv * gs1.z, v[7] * rinv * gs1.w)};
            *(GAS u32x4*)(hc + (size_t)row * 512 + h * 128 + e0) = o; } }
    }
}
constexpr int RT_RSTD = 0, RT_HT = 1024, RT_WT = RT_HT + 128 * 68 * 4, RT_LOG = RT_WT + 128 * 40 * 4, RT_HIST = RT_LOG + 64 * 37 * 4, RT_BASE = RT_HIST + 128, RT_SEL = RT_BASE + 128, RT_G2S = RT_SEL + 64 * 4 * 4, RT_END = RT_G2S + 4096, RT_RED = RT_HT;
static_assert(RT_END <= RING_BYTES && 2 * 64 * 65 * 4 <= RT_LOG - RT_HT && 3 * 64 * 272 <= RT_LOG - RT_HT, "routing LDS map");
#ifndef P9PARTS
#define P9PARTS 15
#endif
__device__ __forceinline__ void phase9(const Args& A, const Ctx& C, int layer, bool dummy = false  ) {
    const int parts = dummy ? (P9PARTS) : 15;
    const size_t doff = dummy ? (476 * MiB) : 0;
    if (parts & 1) moe_weight_items(A, C, layer);
    __syncthreads();
    for (int i = C.tid; i < 1024; i += NTHR) ((LAS float*)(C.lds + RT_G2S))[i] = (A.in[15] + layer * 1024)[i];
    LAS float* RSTD = (LAS float*)(C.lds + RT_RSTD); LAS float* HT = (LAS float*)(C.lds + RT_HT); LAS float* WT = (LAS float*)(C.lds + RT_WT); LAS float* LOG = (LAS float*)(C.lds + RT_LOG); LAS float* RED = (LAS float*)(C.lds + RT_RED);
    LAS int* HIST = (LAS int*)(C.lds + RT_HIST); LAS int* BASE = (LAS int*)(C.lds + RT_BASE); LAS int* SEL = (LAS int*)(C.lds + RT_SEL);
    const float* g2 = A.in[15] + layer * 1024; const float* wg = A.in[16] + layer * 4096; const float* bg = A.in[17] + layer * 4; const float* wr = A.in[18] + layer * 32768; const float* br = A.in[19] + layer * 32;
    bf16* h2 = wsp<bf16>(C, dummy ? 128 * MiB : WS_H2); const bf16* xb1 = wsp<bf16>(C, WS_XB1); const int lane = C.lane, tid = C.tid, wv = C.wave;
    f32x4 g2r[4];
#pragma unroll
    for (int j = 0; j < 4; ++j) g2r[j] = ((const GAS f32x4*)g2)[64 * j + lane];
    for (int item = C.vcu; item < NTOK / 64; item += C.G) {
        const int row0 = item * 64;
        if (tid < 32) HIST[tid] = 0;
        u32x4 vnx[4];
        {
#pragma unroll
            for (int j = 0; j < 4; ++j) vnx[j] = ldrow4raw(xb1, true, (size_t)(row0 + wv * 8), lane + 64 * j); }
        for (int i = 0; i < ((parts & 2) ? 8 : 0); ++i) { const int rl = wv * 8 + i, row = row0 + rl;
            f32x4 v[4]; float ss = 0.f;
#pragma unroll
            for (int j = 0; j < 4; ++j) { v[j] = cvtrow4(vnx[j], true); ss += (v[j].x * v[j].x + v[j].y * v[j].y) + (v[j].z * v[j].z + v[j].w * v[j].w); }
            if (i < 7) {
#pragma unroll
                for (int j = 0; j < 4; ++j) vnx[j] = ldrow4raw(xb1, true, (size_t)(row + 1), lane + 64 * j); }
            const float rstd = rsqrtf(wave_sum(ss) * (1.f / DM) + EPS);
            GAS u32x2* ho = (GAS u32x2*)(h2 + (size_t)row * DM) + lane;
#pragma unroll
            for (int j = 0; j < 4; ++j) { const f32x4 g = g2r[j]; u32x2 o; o.x = pk2(v[j].x * rstd * g.x, v[j].y * rstd * g.y); o.y = pk2(v[j].z * rstd * g.z, v[j].w * rstd * g.w); ho[64 * j] = o; }
            if (lane == 0) RSTD[rl] = rstd; }
        __syncthreads();
        if (parts & 4) {
            const int rb = wv & 1, cb = (wv >> 1) & 1, kh = wv >> 2, r32 = lane & 31, hh = lane >> 5;
            const float rs = RSTD[32 * rb + r32];
            LAS unsigned char* XS_ = C.lds + RT_HT; LAS unsigned char* WH = XS_ + 64 * 272; LAS unsigned char* WL = WH + 64 * 272; const LAS float* G2S = (const LAS float*)(C.lds + RT_G2S);
            const bf16* wrt = wsp<bf16>(C, WS_WRT);
            u32x4 xr[2], whr[2], wlr[2];
#define RT_LD(kc_) do { _Pragma("unroll") for (int i_ = 0; i_ < 2; ++i_) { const int idx = tid + NTHR * i_, t = idx >> 4, ch = idx & 15; \
                xr[i_] = *(const GAS u32x4*)(xb1 + (size_t)(row0 + t) * DM + (kc_) * 128 + ch * 8); whr[i_] = *(const GAS u32x4*)(wrt + (size_t)t * DM + (kc_) * 128 + ch * 8); wlr[i_] = *(const GAS u32x4*)(wrt + 65536 + (size_t)t * DM + (kc_) * 128 + ch * 8); } } while (0)
            RT_LD(0);
            f32x16 acc = {};
            for (int kc = 0; kc < 8; ++kc) {
#pragma unroll
                for (int i_ = 0; i_ < 2; ++i_) { const int idx = tid + NTHR * i_, t = idx >> 4, ch = idx & 15;
                    *(LAS u32x4*)(XS_ + t * 272 + ch * 16) = xr[i_]; *(LAS u32x4*)(WH + t * 272 + ch * 16) = whr[i_]; *(LAS u32x4*)(WL + t * 272 + ch * 16) = wlr[i_]; }
                __syncthreads();
                if (kc < 7) RT_LD(kc + 1);
#pragma unroll
                for (int s = 0; s < 4; ++s) { const int ko = 16 * (kh * 4 + s) + 8 * hh;
                    const u32x4 xa = *(const LAS u32x4*)(XS_ + (32 * rb + r32) * 272 + ko * 2); const f32x4 ga = *(const LAS f32x4*)(G2S + kc * 128 + ko), gb = *(const LAS f32x4*)(G2S + kc * 128 + ko + 4);
                    const bf16x8 bhi = *(const LAS bf16x8*)(WH + (32 * cb + r32) * 272 + ko * 2), blo = *(const LAS bf16x8*)(WL + (32 * cb + r32) * 272 + ko * 2);
                    const float h0 = bflo(xa.x) * rs * ga.x, h1 = bfhi(xa.x) * rs * ga.y, h2_ = bflo(xa.y) * rs * ga.z, h3 = bfhi(xa.y) * rs * ga.w;
                    const float h4 = bflo(xa.z) * rs * gb.x, h5 = bfhi(xa.z) * rs * gb.y, h6 = bflo(xa.w) * rs * gb.z, h7 = bfhi(xa.w) * rs * gb.w;
                    const u32x4 hi4 = {pk2(h0, h1), pk2(h2_, h3), pk2(h4, h5), pk2(h6, h7)};
                    const u32x4 lo4 = {pk2(h0 - bflo(hi4.x), h1 - bfhi(hi4.x)), pk2(h2_ - bflo(hi4.y), h3 - bfhi(hi4.y)), pk2(h4 - bflo(hi4.z), h5 - bfhi(hi4.z)), pk2(h6 - bflo(hi4.w), h7 - bfhi(hi4.w))};
                    const bf16x8 ahi = __builtin_bit_cast(bf16x8, hi4), alo = __builtin_bit_cast(bf16x8, lo4);
                    acc = MFMA32(ahi, bhi, acc); acc = MFMA32(ahi, blo, acc); acc = MFMA32(alo, bhi, acc); }
                __syncthreads();
            }
#undef RT_LD
#pragma unroll
            for (int r_ = 0; r_ < 16; ++r_) RED[(kh * 64 + 32 * rb + crow(r_, hh)) * 65 + 32 * cb + r32] = acc[r_];
        }
        __syncthreads();
        { const int tok = tid & 63, cgr = tid >> 6;
#pragma unroll
            for (int c = 0; c < 4; ++c) { const int col = 4 * cgr + c; LOG[tok * 37 + col] = RED[tok * 65 + col] + RED[(64 + tok) * 65 + col] + br[col]; }
            if (cgr < 4) { const int col = 32 + cgr; LOG[tok * 37 + col] = RED[tok * 65 + col] + RED[(64 + tok) * 65 + col] + bg[cgr]; } }
        __syncthreads();
        if (tid < 64 && (parts & 8)) { const LAS float* lg = LOG + tid * 37;
            int gi = 0; float gmx = lg[32];
#pragma unroll
            for (int q = 1; q < 4; ++q) if (lg[32 + q] > gmx) { gmx = lg[32 + q]; gi = q; }
            float gsum = 0.f;
#pragma unroll
            for (int q = 0; q < 4; ++q) gsum += __expf(lg[32 + q] - gmx);
            const float pg = 1.f / gsum;
            const LAS float* el = lg + gi * 8; int i0 = 0; float e0 = el[0];
#pragma unroll
            for (int q = 1; q < 8; ++q) if (el[q] > e0) { e0 = el[q]; i0 = q; }
            int i1 = -1; float e1 = -INFINITY;
#pragma unroll
            for (int q = 0; q < 8; ++q) if (q != i0 && el[q] > e1) { e1 = el[q]; i1 = q; }
            const float x1 = __expf(e1 - e0), w0 = pg / (1.f + x1), w1 = pg * x1 / (1.f + x1);
            const int ea = gi * 8 + i0, eb = gi * 8 + i1;
            const int ra = atomicAdd((int*)(HIST + ea), 1), rb = atomicAdd((int*)(HIST + eb), 1);
            SEL[tid * 4 + 0] = ea; SEL[tid * 4 + 1] = eb; SEL[tid * 4 + 2] = ra; SEL[tid * 4 + 3] = rb;
            wsp<float>(C, WS_TOKW + doff)[(size_t)(row0 + tid) * 2] = w0; wsp<float>(C, WS_TOKW + doff)[(size_t)(row0 + tid) * 2 + 1] = w1; }
        __syncthreads();
        if (tid < 32) wsp<int>(C, WS_HISTG + doff)[item * 32 + tid] = HIST[tid];
        if (tid < 64) { wsp<int>(C, WS_TOKE + doff)[(size_t)(row0 + tid) * 2] = SEL[tid * 4]; wsp<int>(C, WS_TOKE + doff)[(size_t)(row0 + tid) * 2 + 1] = SEL[tid * 4 + 1];
            wsp<int>(C, WS_TOKR + doff)[(size_t)(row0 + tid) * 2] = SEL[tid * 4 + 2]; wsp<int>(C, WS_TOKR + doff)[(size_t)(row0 + tid) * 2 + 1] = SEL[tid * 4 + 3]; }
        __syncthreads();
    }
}
constexpr int P10_H = 0, P10_SEG = 65536, P10_BASE = P10_SEG + 16 * 32 * 4, P10_TOT = P10_BASE + 16 * 32 * 4;
__device__ __forceinline__ void phase10(const Ctx& C, int layer) {
    LAS int* H = (LAS int*)(C.lds + P10_H); LAS int* SEG = (LAS int*)(C.lds + P10_SEG); LAS int* SBASE = (LAS int*)(C.lds + P10_BASE); LAS int* TOT = (LAS int*)(C.lds + P10_TOT);
    LAS int* OFFS = (LAS int*)(C.lds + OFFS_OFF);
    { const int* hg = wsp<int>(C, WS_HISTG);
        { u32x4 hv[8];
#pragma unroll
            for (int q = 0; q < 8; ++q) hv[q] = *(const GAS u32x4*)(hg + 4 * (C.tid + NTHR * q));
#pragma unroll
            for (int q = 0; q < 8; ++q) *(LAS u32x4*)(H + 4 * (C.tid + NTHR * q)) = hv[q]; }
        __syncthreads();
        const int e = C.tid & 31, sg = C.tid >> 5; int s = 0;
        for (int i = 0; i < 32; ++i) s += H[(sg * 32 + i) * 32 + e];
        SEG[sg * 32 + e] = s;
        __syncthreads();
        if (C.tid < 32) { int run = 0; for (int q = 0; q < 16; ++q) { SBASE[q * 32 + C.tid] = run; run += SEG[q * 32 + C.tid]; } TOT[C.tid] = run; }
        __syncthreads();
        int run = SBASE[sg * 32 + e];
        for (int i = 0; i < 32; ++i) { const int v = H[(sg * 32 + i) * 32 + e]; H[(sg * 32 + i) * 32 + e] = run; run += v; }
        if (C.tid == 0) { int o = 0; for (int q = 0; q < 32; ++q) { OFFS[q] = o; o += (TOT[q] + 255) & ~255; } OFFS[32] = o; }
        __syncthreads(); }
    if (blockIdx.x == 0) { int* texp = wsp<int>(C, WS_TEXP); const int RT = OFFS[32] >> 8;
        for (int rt = C.tid; rt < RT; rt += NTHR) { int e = 0;
            for (int q = 1; q < 32; ++q) if (rt * 256 >= OFFS[q]) e = q;
            texp[rt] = e; }
        if (C.tid == 0) texp[511] = RT; }
    { const GAS int* toke = (const GAS int*)wsp<int>(C, WS_TOKE); const GAS int* tokr = (const GAS int*)wsp<int>(C, WS_TOKR); GAS int* tokp = (GAS int*)wsp<int>(C, WS_TOKP); GAS int* toks = (GAS int*)wsp<int>(C, WS_TOKS);
        for (int s = C.vcu * NTHR + C.tid; s < NTOK * 2; s += C.G * NTHR) { const int e = toke[s]; const int ipos = OFFS[e] + H[(s >> 7) * 32 + e] + tokr[s]; tokp[s] = ipos; toks[ipos] = s >> 1; } }
}
constexpr int PH_PER_LAYER = 13, N_PHASES = 2 * PH_PER_LAYER + 1;
#ifndef MK_ONE_LAUNCH
#define MK_ONE_LAUNCH 1
#endif
#ifndef E2_ALIGN
#define E2_ALIGN false
#define E2_SP2 true
#endif
__global__ void __launch_bounds__(NTHR, 2) fwd(Args A) {
    extern __shared__ __attribute__((aligned(16))) unsigned char lds_raw[];
    Ctx C_;
    C_.lds = (LAS unsigned char*)lds_raw; C_.MISC = (volatile LAS unsigned*)(C_.lds + MISC_OFF);
    C_.tid = threadIdx.x; C_.lane = C_.tid & 63; C_.wave = __builtin_amdgcn_readfirstlane(C_.tid >> 6);
    C_.G = gridDim.x; { const int bx = blockIdx.x; C_.vcu = (C_.G % 8 == 0) ? (bx % 8) * (C_.G / 8) + bx / 8 : bx; }
    C_.ws = A.ws; C_.ctl = (gu32*)(A.ws + WS_CTL);
    for (int u = C_.tid; u < 128; u += NTHR) ((LAS unsigned*)(C_.lds + MISC_OFF))[u] = 0u;
    __syncthreads();
    const int lo = A.ph_lo, hi = A.ph_hi;
    const bool multi = (hi - lo) > 1;
    XcdBarrier bar; bar.wv = C_.wave; bar.bar = (unsigned*)(C_.ctl + CW_BAR); bar.x = 0; bar.st = nullptr;
    if (multi) bar = xcd_barrier_post((unsigned*)(C_.ctl + CW_BAR), C_.MISC + 8, C_.wave);
#ifndef PHASE_MASK
#define PHASE_MASK 0x1fff
#endif
#define HAS(k) (((PHASE_MASK) >> (k)) & 1)
#ifndef REPMASK
#define REPMASK 0
#endif
#define STAGGER(ticks) do { if ((ticks) > 0 && ((blockIdx.x >> 3) & 1)) { const unsigned long long t0_ = __builtin_amdgcn_s_memrealtime(); while (__builtin_amdgcn_s_memrealtime() - t0_ < (unsigned long long)(ticks)) __builtin_amdgcn_s_sleep(16); } } while (0)
#ifndef STG1
#define STG1 0
#endif
#ifndef STG6
#define STG6 0
#endif
#ifndef STG7
#define STG7 0
#endif
#ifndef STG8
#define STG8 0
#endif
#ifndef STG11
#define STG11 0
#endif
#ifndef STG12
#define STG12 0
#endif
#if defined(MERGE_PROBE)
#define MPM , (rep_ < NREP(7) - 1 ? MERGE_PROBE : 0)
#else
#define MPM
#endif
#ifndef P1_ALIGN
#define P1_ALIGN true
#endif
#ifndef P1_SP2
#define P1_SP2 true
#endif
#ifndef P0PARTS
#define P0PARTS 7
#endif
#ifndef REPCNT
#define REPCNT 2
#endif
#define NREP(k) ((((REPMASK) >> (k)) & 1) && layer == 0 ? REPCNT : 1)
#define IN(k) (lo <= (k) && (k) < hi)
#define SEAM(k) do { if (IN(k) && IN((k) + 1)) xcd_barrier(bar); } while (0)
#define FRESH() Ctx C = C_; C.lane = xb_lane(); C.tid = C_.wave * 64 + C.lane; asm volatile("" : "+s"(C.ws), "+s"(C.ctl), "+s"(C.vcu), "+s"(C.G))
    for (int layer = 0; layer < 3; ++layer) {
        const int pb = layer * PH_PER_LAYER;
        if (HAS(0) && IN(pb + 0)) for (int rep_ = 0; rep_ < NREP(0); ++rep_) { FRESH(); const int pp_ = rep_ == 0 ? 7 : P0PARTS; if (layer == 0) phase0<0>(A, C, pp_); else if (layer == 1) phase0<1>(A, C, pp_); else phase0<2>(A, C, pp_); }
        if (layer == 2) break;
        SEAM(pb + 0);
#ifdef XBAR_PROBE
        if (layer == 0 && IN(pb + 0) && IN(pb + 1)) { for (int q = 0; q < XBAR_PROBE; ++q) xcd_barrier(bar); }
#endif
        if (HAS(1) && IN(pb + 1)) for (int rep_ = 0; rep_ < NREP(1); ++rep_) { FRESH();
            pg8::Gemm g{(bf16*)A.out + (size_t)NTOK * DM, wsp<bf16>(C, WS_WT1), NTOK, 5120, 1024}; pg8::StaticOrder S; S.init(NTOK, 5120, C.G, (int)blockIdx.x);
            pg8::EpiOut<0> E{proj(C, 0), nullptr, nullptr, PROJ_STRIDE / 2};
            STAGGER(STG1); pg8::gemm_phase<pg8::EpiOut<0>, pg8::StaticOrder, P1_ALIGN, P1_SP2>(C.lds, g, S, E, C.tid);
        }
        SEAM(pb + 1);
        if (HAS(2) && IN(pb + 2)) for (int rep_ = 0; rep_ < NREP(2); ++rep_) { FRESH();  for (int g8 = C.vcu; g8 < 256; g8 += C.G) for (int i8 = 0; i8 < 8; ++i8) mlstm_u_item(A, C, layer, g8 >> 4, (g8 & 15) * 8 + i8, i8 == 0, i8 < 7); }
        SEAM(pb + 2);
        if (HAS(3) && IN(pb + 3)) for (int rep_ = 0; rep_ < NREP(3); ++rep_) { FRESH(); mlstm_scan(C); }
        SEAM(pb + 3);
        if (HAS(4) && IN(pb + 4)) for (int rep_ = 0; rep_ < NREP(4); ++rep_) { FRESH();
            gu32* q0 = C.ctl + CW_Q + 64 * (layer * 4 + 0); gu32* q1 = C.ctl + CW_Q + 64 * (layer * 4 + 1); gu32* q2 = C.ctl + CW_Q + 64 * (layer * 4 + 2);
            for (int rc_ = 0; rc_ < NREP(13); ++rc_) {
                if (C.G == 256) { const int xg = C.vcu >> 5, r = C.vcu & 31;
                    for (int rd = 0; rd < 2; ++rd) { const int p = r + 32 * rd, bvh = xg * 4 + (p >> 4), pr = p & 15;
                        attn_unit<128, true>(A, C, layer, bvh >> 3, bvh & 7, 31 - pr); attn_unit<128, true>(A, C, layer, bvh >> 3, bvh & 7, pr); } }
                else { for (int it = C.vcu; it < 1024; it += C.G) attn_unit<128, true>(A, C, layer, (it & 31) >> 3, it & 7, 31 - (it >> 5)); } }
            for (int rc_ = NREP(15) - 1; rc_ >= 0; --rc_) { gu32* qq = rc_ ? C.ctl + CW_Q + 64 * (17 + 2 * rc_) : q2;
            for (;;) { if (C.tid == 0) C.MISC[0] = __hip_atomic_fetch_add(qq, 1u, RLX_AGENT); __syncthreads(); const int it = (int)C.MISC[0]; __syncthreads(); if (it >= 512) break;
                for (int i4 = 0; i4 < 4; ++i4) mlstm_out_item(A, C, layer, it >> 5, (it & 31) * 4 + i4, i4 == 0, i4 < 3, rc_ ? wsp<bf16>(C, 480 * MiB) : nullptr); } }
            for (int rc_ = NREP(14) - 1; rc_ >= 0; --rc_) { gu32* qq = rc_ ? C.ctl + CW_Q + 64 * (16 + 2 * rc_) : q1;
            for (;;) { if (C.tid == 0) C.MISC[0] = __hip_atomic_fetch_add(qq, 1u, RLX_AGENT); __syncthreads(); const int it = (int)C.MISC[0]; __syncthreads(); if (it >= 1024) break;
                attn_unit<64, false>(A, C, layer, (it & 31) >> 3, it & 7, 31 - (it >> 5), rc_ ? wsp<bf16>(C, 480 * MiB) : nullptr); } }
        }
        SEAM(pb + 4);
        if (HAS(6) && IN(pb + 6)) for (int rep_ = 0; rep_ < NREP(6); ++rep_) { FRESH();
            if (rep_ == 0) phase5(A, C, layer);
            pg8::Gemm g{(bf16*)A.out + (size_t)NTOK * DM, wsp<bf16>(C, WS_WT2), NTOK, 3072, 1024}; pg8::StaticOrder S; S.init(NTOK, 3072, C.G, (int)blockIdx.x);
            pg8::EpiOut<1> E{wsp<bf16>(C, WS_G0), wsp<bf16>(C, WS_G1), wsp<bf16>(C, WS_G2), 0};
            STAGGER(STG6); pg8::gemm_phase<pg8::EpiOut<1>, pg8::StaticOrder, true, true>(C.lds, g, S, E, C.tid);
        }
        SEAM(pb + 6);
        if (HAS(7) && IN(pb + 7)) for (int rep_ = 0; rep_ < NREP(7); ++rep_) { FRESH();
            pg8::ChainOrder S; S.base.init(NTOK, 1024, C.G, (int)blockIdx.x);
            pg8::Gemm g{proj(C, PJ_AV), wsp<bf16>(C, WS_PT), NTOK, 1024, 512}; pg8::EpiChain E{wsp<bf16>(C, WS_O12), wsp<bf16>(C, WS_G0)};
            pg8::gemm_phase<pg8::EpiChain, pg8::ChainOrder, true, true>(C.lds, g, S, E, C.tid);
        }
        SEAM(pb + 7);
        if (HAS(8) && IN(pb + 8)) for (int rep_ = 0; rep_ < NREP(8); ++rep_) { FRESH();
            pg8::Gemm g{wsp<bf16>(C, WS_O12), wsp<bf16>(C, WS_WOT), NTOK, 1024, 1024}; pg8::StaticOrder S; S.init(NTOK, 1024, C.G, (int)blockIdx.x);
            pg8::EpiResid E{layer == 0 ? (const void*)A.in[0] : (const void*)A.out, layer > 0, wsp<bf16>(C, WS_XB1)};
            STAGGER(STG8); pg8::gemm_phase<pg8::EpiResid, pg8::StaticOrder, true, true>(C.lds, g, S, E, C.tid);
        }
        SEAM(pb + 8);
        if (HAS(9) && IN(pb + 9)) for (int rep_ = 0; rep_ < NREP(9); ++rep_) { FRESH(); for (int r9 = 1; r9 < NREP(16); ++r9) { phase9(A, C, layer, true); __syncthreads(); } if (NREP(17) >= 2) { moe_weight_items(A, C, layer); __syncthreads(); } phase9(A, C, layer); }
        SEAM(pb + 9);
        if (HAS(10) && IN(pb + 10)) for (int rep_ = 0; rep_ < NREP(10); ++rep_) { FRESH(); phase10(C, layer); }
        SEAM(pb + 10);
        if (HAS(11) && IN(pb + 11)) for (int rep_ = 0; rep_ < NREP(11); ++rep_) { FRESH();
            LAS int* texp = (LAS int*)(C.lds + TEXP_OFF); { const int tv_ = *(const GAS int*)(wsp<int>(C, WS_TEXP) + C.tid); texp[C.tid] = tv_; } __syncthreads(); const int RT = __builtin_amdgcn_readfirstlane(texp[511]);
            LAS int* tokl = (LAS int*)(C.lds + TOKL_OFF);
            { const GAS int* toks = (const GAS int*)wsp<int>(C, WS_TOKS); int tv_[2] = {0, 0};
#pragma unroll
                for (int q_ = 0; q_ < 2; ++q_) { const int idx = C.tid + NTHR * q_, sl = idx >> 8, rt_ = (sl * C.G + C.vcu) >> 1; if (sl < 3 && rt_ < RT) tv_[q_] = toks[rt_ * 256 + (idx & 255)]; }
#pragma unroll
                for (int q_ = 0; q_ < 2; ++q_) { const int idx = C.tid + NTHR * q_; if (idx < 768) tokl[idx] = ((unsigned)tv_[q_] < (unsigned)NTOK) ? tv_[q_] : 0; } }
            __syncthreads();
            pg8::Gemm g{wsp<bf16>(C, WS_H2), wsp<bf16>(C, WS_W1T), NTOK, 32 * 512, 1024}; pg8::MoeOrder<1> S{C.G, C.vcu, RT, texp};
            pg8::EpiSiluMul E{wsp<bf16>(C, WS_HE)};
            STAGGER(STG11); pg8::gemm_phase<pg8::EpiSiluMul, pg8::MoeOrder<1>, true, true, true>(C.lds, g, S, E, C.tid, tokl);
        }
        SEAM(pb + 11);
        if (HAS(12) && IN(pb + 12)) for (int rep_ = 0; rep_ < NREP(12); ++rep_) { FRESH();
            LAS int* texp = (LAS int*)(C.lds + TEXP_OFF); { const int tv_ = *(const GAS int*)(wsp<int>(C, WS_TEXP) + C.tid); texp[C.tid] = tv_; } __syncthreads(); const int RT = __builtin_amdgcn_readfirstlane(texp[511]);
            pg8::Gemm g{wsp<bf16>(C, WS_HE), wsp<bf16>(C, WS_W2T), 73728, 32 * 1024, 256}; pg8::MoeOrder<2> S{C.G, C.vcu, RT, texp};
            pg8::EpiOut<2> E{wsp<bf16>(C, WS_OSL), nullptr, nullptr, 0};
            STAGGER(STG12); pg8::gemm_phase<pg8::EpiOut<2>, pg8::MoeOrder<2>, E2_ALIGN, E2_SP2>(C.lds, g, S, E, C.tid);
        }
        SEAM(pb + 12);
    }
#undef IN
#undef SEAM
}

extern "C" void kernel_launch(void* const* d_in, const int* in_sizes, int n_in, void* d_out, int out_size, void* d_ws, size_t ws_size, hipStream_t stream) {
    static int grid = 0;
    if (grid == 0) {
        if (n_in != 23 || out_size != NTOK * DM || ws_size < WS_NEED) { fprintf(stderr, "kernel_launch: unexpected shapes (n_in %d out %d ws %zu)\n", n_in, out_size, ws_size); grid = -1; return; }
        int dev = 0, cus = 0, per_cu = 0;
        if (hipGetDevice(&dev) != hipSuccess || hipDeviceGetAttribute(&cus, hipDeviceAttributeMultiprocessorCount, dev) != hipSuccess) { grid = -1; return; }
        if (hipFuncSetAttribute((const void*)fwd, hipFuncAttributeMaxDynamicSharedMemorySize, LDS_BYTES) != hipSuccess) { fprintf(stderr, "kernel_launch: hipFuncSetAttribute failed\n"); grid = -1; return; }
        if (hipOccupancyMaxActiveBlocksPerMultiprocessor(&per_cu, (const void*)fwd, NTHR, LDS_BYTES) != hipSuccess || per_cu < 1) fprintf(stderr, "kernel_launch: occupancy query says %d\n", per_cu);
        (void)hipGetLastError();
        grid = cus;
    }
    if (grid < 0) return;
    (void)hipMemsetAsync((char*)d_ws + WS_CTL, 0, CTL_ZERO_BYTES, stream);
    Args a{};
    for (int i = 0; i < 23; ++i) a.in[i] = (const float*)d_in[i];
    a.out = (float*)d_out; a.ws = (unsigned char*)d_ws;
#if MK_ONE_LAUNCH
    a.ph_lo = 0; a.ph_hi = N_PHASES;
    hipLaunchKernelGGL(fwd, dim3(grid), dim3(NTHR), LDS_BYTES, stream, a);
#else
    for (int p = 0; p < N_PHASES; ++p) { a.ph_lo = p; a.ph_hi = p + 1; hipLaunchKernelGGL(fwd, dim3(grid), dim3(NTHR), LDS_BYTES, stream, a); }
#endif
}
```

```cpp
#define AT_QK_ALIGNED 1
#include <hip/hip_runtime.h>
#include <cstdio>
#include <cstdint>
#include <cmath>
#ifndef AT_ALIGN_ASM
#define AT_ALIGN_ASM asm volatile(".p2align 8")
#endif
#ifndef GEMM_ALIGN_ASM
#define GEMM_ALIGN_ASM asm volatile(".p2align 8")
#endif
namespace pg8 {
#define PG8_LAS __attribute__((address_space(3)))
typedef unsigned short bf16_t;
typedef short bf16x8 __attribute__((ext_vector_type(8)));
typedef float f32x4 __attribute__((ext_vector_type(4)));
typedef unsigned u32x4 __attribute__((ext_vector_type(4)));
typedef int i32x8 __attribute__((ext_vector_type(8)));
typedef int i32x4 __attribute__((ext_vector_type(4)));
constexpr int BM = 256, BK = 64, HALF = 128, HTB = HALF * BK * 2  , STAGE_BYTES = 8 * HTB, NXCD = 8, WGM = 8;

__host__ __device__ __forceinline__ int lds_byte(int r, int c) { const int st = (r >> 4) * 2 + (c >> 5), rr = r & 15, cc = c & 31, ob = rr * 64 + cc * 2; return st * 1024 + (ob ^ (((ob >> 9) & 1) << 5)); }
__host__ __device__ __forceinline__ void stage_rc(int b, int& R, int& C) { const int st = b / 1024, sb = b % 1024, swz = sb ^ (((sb >> 9) & 1) << 5); R = (st >> 1) * 16 + swz / 64; C = (st & 1) * 32 + (swz % 64) / 2; }
__host__ __device__ __forceinline__ int perm32(int rho) { const int n = rho >> 4, i = rho & 15; return 8 * (i >> 2) + 4 * n + (i & 3); }

struct Unit { int pm, pn, t; };
struct Gemm { const bf16_t* A; const bf16_t* Bt; int M, N, K; };

struct StaticOrder {
    int nM, nN, nwg, G, c;
    __host__ __device__ void init(int M, int N, int G_, int c_) { nM = M / BM; nN = N / BM; nwg = nM * nN; G = G_; c = c_; }
    __host__ __device__ bool next(int i, Unit& u) const {
        const long L = (long)i * G + c; if (L >= nwg) return false;
        int wgid = (int)L; { const int q = nwg / NXCD, r = nwg % NXCD, xcd = wgid % NXCD, off = wgid / NXCD; wgid = (xcd < r ? xcd * (q + 1) : r * (q + 1) + (xcd - r) * q) + off; }
        const int nig = WGM * nN, gid = wgid / nig, fm = gid * WGM, gsz = (nM - fm) < WGM ? (nM - fm) : WGM;
        u.pm = fm + ((wgid % nig) % gsz); u.pn = (wgid % nig) / gsz; return true;
    }
    __device__ __forceinline__ void a_ready(const Unit&) const {}
    __device__ __forceinline__ void done(const Unit&) const {}
    __device__ __forceinline__ const bf16_t* a_base(const Gemm& g, const Unit&) const { return g.A; }
    __device__ __forceinline__ const bf16_t* b_base(const Gemm& g, const Unit&) const { return g.Bt; }
};

struct SkipOrder {
    StaticOrder base; int skip0, nskip;
    __device__ __forceinline__ bool next(int i, Unit& u) const { if (!base.next(i, u)) return false; if (nskip < 0) u.pn += skip0; else if (u.pn >= skip0) u.pn += nskip; return true; }
    __device__ __forceinline__ void a_ready(const Unit&) const {}
    __device__ __forceinline__ void done(const Unit&) const {}
    __device__ __forceinline__ const bf16_t* a_base(const Gemm& g, const Unit&) const { return g.A; }
    __device__ __forceinline__ const bf16_t* b_base(const Gemm& g, const Unit&) const { return g.Bt; }
};
__device__ __forceinline__ unsigned cvt_pk_bf16(float lo, float hi) { unsigned r; asm volatile("v_cvt_pk_bf16_f32 %0, %1, %2" : "=v"(r) : "v"(lo), "v"(hi)); return r; }
#ifndef GAS
#define GAS __attribute__((address_space(1)))
#endif
typedef float f32x2 __attribute__((ext_vector_type(2)));
typedef unsigned u32x2 __attribute__((ext_vector_type(2)));
__device__ __forceinline__ unsigned pk4f8_(float a, float b, float c, float d) { int p = __builtin_amdgcn_cvt_pk_fp8_f32(a, b, 0, false); p = __builtin_amdgcn_cvt_pk_fp8_f32(c, d, p, true); return (unsigned)p; }
__device__ __forceinline__ float bflo(unsigned u) { return __builtin_bit_cast(float, u << 16); }
__device__ __forceinline__ float bfhi(unsigned u) { return __builtin_bit_cast(float, u & 0xffff0000u); }
__device__ __forceinline__ float sigmoidf_(float x) { return __builtin_amdgcn_rcpf(1.f + __expf(-x)); }
template <int MODE> struct EpiOut {
    static constexpr bool PERM = true, AFTER_DRAIN = false, CHAIN = false;
    bf16_t* b0; bf16_t* b1; bf16_t* b2; size_t stride;
    __device__ __forceinline__ void operator()(const f32x4 (&acc)[2][2][4][2], const Unit& u, int wr, int wc, int fr, int fq) const {
        int row0 = u.pm * BM + wr * 64 + fr; asm volatile("" : "+v"(row0));
        bf16_t* base; int colt, ldc;
        if (MODE == 0 || MODE == 3) { base = b0 + (size_t)(u.pn >> 1) * stride; colt = (u.pn & 1) * 256; ldc = 512; }
        else if (MODE == 1) { const int t = u.pn >> 2; base = b0 + (size_t)(160 * t - 32 * t * (t - 1)) * (1u << 19); colt = (u.pn & 3) * 256; ldc = 1024; }
        else { base = b0; colt = (u.pn & 3) * 256; ldc = 1024; }
        const int col0 = colt + wc * 32 + 8 * fq;
#pragma unroll
        for (int ai = 0; ai < 2; ++ai)
#pragma unroll
            for (int m = 0; m < 4; ++m) { bf16_t* rowp = base + (size_t)(row0 + ai * HALF + m * 16) * ldc + col0;
#pragma unroll
                for (int bj = 0; bj < 2; ++bj) { f32x4 v0 = acc[ai][bj][m][0], v1 = acc[ai][bj][m][1];
                    if (MODE == 3) { v0 *= (1.f / 64.f); v1 *= (1.f / 64.f); }
                    if (MODE == 2) { v0 *= 0.25f; v1 *= 0.25f;
                        u32x2 w8; w8.x = pk4f8_(v0[0], v0[1], v0[2], v0[3]); w8.y = pk4f8_(v1[0], v1[1], v1[2], v1[3]);
                        *(GAS u32x2*)((unsigned char*)base + (size_t)(row0 + ai * HALF + m * 16) * 1024 + col0 + bj * HALF) = w8; continue; }
                    if (MODE == 1) {
#pragma unroll
                        for (int j = 0; j < 4; ++j) { v0[j] = __builtin_amdgcn_rcpf(__builtin_amdgcn_exp2f(v0[j] * (-1.4426950408889634f / 64.f) - 8.f) + (1.f / 256.f)); v1[j] = __builtin_amdgcn_rcpf(__builtin_amdgcn_exp2f(v1[j] * (-1.4426950408889634f / 64.f) - 8.f) + (1.f / 256.f)); } }
                    if (MODE == 1) {
                        unsigned q[8];
#pragma unroll
                        for (int j = 0; j < 4; ++j) { q[j] = (unsigned)fminf(v0[j], 255.f); q[4 + j] = (unsigned)fminf(v1[j], 255.f); }
                        u32x2 w8; w8.x = q[0] | (q[1] << 8) | (q[2] << 16) | (q[3] << 24); w8.y = q[4] | (q[5] << 8) | (q[6] << 16) | (q[7] << 24);
                        *(GAS u32x2*)((unsigned char*)base + ((size_t)(u.pm * 4 + (u.pn & 3)) << 16) + (((ai * 4 + m) * 2 + bj) << 12) + ((wr * 4 + wc) << 9) + ((fr + 16 * fq) << 3)) = w8; }
                    else { u32x4 w; w.x = cvt_pk_bf16(v0[0], v0[1]); w.y = cvt_pk_bf16(v0[2], v0[3]); w.z = cvt_pk_bf16(v1[0], v1[1]); w.w = cvt_pk_bf16(v1[2], v1[3]);
                        *(GAS u32x4*)(rowp + bj * HALF) = w; } } }
    }
};
template <bool FIRST> struct EpiMerge {
    static constexpr bool PERM = true, AFTER_DRAIN = false, CHAIN = false;
    bf16_t* Y; const bf16_t* G;
    __device__ __forceinline__ void operator()(const f32x4 (&acc)[2][2][4][2], const Unit& u, int wr, int wc, int fr, int fq) const {
        int row0 = u.pm * BM + wr * 64 + fr; asm volatile("" : "+v"(row0)); const int col0 = u.pn * BM + wc * 32 + 8 * fq;
        const bf16_t* gt = G + ((size_t)(u.pm * 4 + u.pn) << 16) + ((wr * 4 + wc) << 9) + ((fr + 16 * fq) << 3);
#pragma unroll
        for (int ai = 0; ai < 2; ++ai) { u32x4 g[4][2], y[4][2];
#pragma unroll
            for (int m = 0; m < 4; ++m)
#pragma unroll
                for (int bj = 0; bj < 2; ++bj) { g[m][bj] = *(const GAS u32x4*)(gt + (((ai * 4 + m) * 2 + bj) << 12));
                    if (!FIRST) y[m][bj] = *(const GAS u32x4*)(Y + (size_t)(row0 + ai * HALF + m * 16) * 1024 + col0 + bj * HALF); }
            __builtin_amdgcn_sched_barrier(0);
#pragma unroll
            for (int m = 0; m < 4; ++m)
#pragma unroll
                for (int bj = 0; bj < 2; ++bj) { const f32x4 v0 = acc[ai][bj][m][0], v1 = acc[ai][bj][m][1]; const u32x4 gg = g[m][bj];
                    float r[8] = { bflo(gg.x) * v0[0], bfhi(gg.x) * v0[1], bflo(gg.y) * v0[2], bfhi(gg.y) * v0[3], bflo(gg.z) * v1[0], bfhi(gg.z) * v1[1], bflo(gg.w) * v1[2], bfhi(gg.w) * v1[3] };
                    if (!FIRST) { const u32x4 yy = y[m][bj];
                        r[0] += bflo(yy.x); r[1] += bfhi(yy.x); r[2] += bflo(yy.y); r[3] += bfhi(yy.y); r[4] += bflo(yy.z); r[5] += bfhi(yy.z); r[6] += bflo(yy.w); r[7] += bfhi(yy.w); }
                    u32x4 w; w.x = cvt_pk_bf16(r[0], r[1]); w.y = cvt_pk_bf16(r[2], r[3]); w.z = cvt_pk_bf16(r[4], r[5]); w.w = cvt_pk_bf16(r[6], r[7]);
                    *(GAS u32x4*)(Y + (size_t)(row0 + ai * HALF + m * 16) * 1024 + col0 + bj * HALF) = w; }
            __builtin_amdgcn_sched_barrier(0); }
    }
};
struct EpiResid {
    static constexpr bool PERM = true, AFTER_DRAIN = false, CHAIN = false;
    const void* XS; bool xbf; bf16_t* OUT;
    __device__ __forceinline__ void operator()(const f32x4 (&acc)[2][2][4][2], const Unit& u, int wr, int wc, int fr, int fq) const {
        int row0 = u.pm * BM + wr * 64 + fr; asm volatile("" : "+v"(row0)); const int col0 = u.pn * BM + wc * 32 + 8 * fq;
#pragma unroll
        for (int ai = 0; ai < 2; ++ai) {
            if (xbf) { u32x4 xv[4][2];
#pragma unroll
                for (int m = 0; m < 4; ++m)
#pragma unroll
                    for (int bj = 0; bj < 2; ++bj) xv[m][bj] = *(const GAS u32x4*)((const bf16_t*)XS + (size_t)(row0 + ai * HALF + m * 16) * 1024 + col0 + bj * HALF);
                __builtin_amdgcn_sched_barrier(0);
#pragma unroll
                for (int m = 0; m < 4; ++m)
#pragma unroll
                    for (int bj = 0; bj < 2; ++bj) { const u32x4 xx = xv[m][bj]; const f32x4 x0 = (f32x4){bflo(xx.x), bfhi(xx.x), bflo(xx.y), bfhi(xx.y)} + acc[ai][bj][m][0], x1 = (f32x4){bflo(xx.z), bfhi(xx.z), bflo(xx.w), bfhi(xx.w)} + acc[ai][bj][m][1];
                        u32x4 w; w.x = cvt_pk_bf16(x0[0], x0[1]); w.y = cvt_pk_bf16(x0[2], x0[3]); w.z = cvt_pk_bf16(x1[0], x1[1]); w.w = cvt_pk_bf16(x1[2], x1[3]);
                        *(GAS u32x4*)(OUT + (size_t)(row0 + ai * HALF + m * 16) * 1024 + col0 + bj * HALF) = w; }
            } else { f32x4 xa[4][2], xb[4][2];
#pragma unroll
                for (int m = 0; m < 4; ++m)
#pragma unroll
                    for (int bj = 0; bj < 2; ++bj) { const float* xp = (const float*)XS + (size_t)(row0 + ai * HALF + m * 16) * 1024 + col0 + bj * HALF; xa[m][bj] = *(const GAS f32x4*)xp; xb[m][bj] = *(const GAS f32x4*)(xp + 4); }
                __builtin_amdgcn_sched_barrier(0);
#pragma unroll
                for (int m = 0; m < 4; ++m)
#pragma unroll
                    for (int bj = 0; bj < 2; ++bj) { const f32x4 x0 = xa[m][bj] + acc[ai][bj][m][0], x1 = xb[m][bj] + acc[ai][bj][m][1];
                        u32x4 w; w.x = cvt_pk_bf16(x0[0], x0[1]); w.y = cvt_pk_bf16(x0[2], x0[3]); w.z = cvt_pk_bf16(x1[0], x1[1]); w.w = cvt_pk_bf16(x1[2], x1[3]);
                        *(GAS u32x4*)(OUT + (size_t)(row0 + ai * HALF + m * 16) * 1024 + col0 + bj * HALF) = w; }
            }
            __builtin_amdgcn_sched_barrier(0); }
    }
};
struct EpiSiluMul {
    static constexpr bool PERM = true, AFTER_DRAIN = false, CHAIN = false;
    bf16_t* O; const float* RS; const __attribute__((address_space(3))) int* tokl;
    __device__ __forceinline__ void operator()(const f32x4 (&acc)[2][2][4][2], const Unit& u, int wr, int wc, int fr, int fq) const {
        int row0 = u.pm * BM + wr * 64 + fr; asm volatile("" : "+v"(row0)); const int col0 = (u.pn & 1) * 128 + wc * 32 + 8 * fq;
        float rsv[2][4];
#pragma unroll
        for (int ai = 0; ai < 2; ++ai)
#pragma unroll
            for (int m = 0; m < 4; ++m) rsv[ai][m] = *(const GAS float*)(RS + tokl[u.t * 256 + ai * HALF + wr * 64 + m * 16 + fr]) * (1.f / 64.f);
#pragma unroll
        for (int ai = 0; ai < 2; ++ai)
#pragma unroll
            for (int m = 0; m < 4; ++m) { float r[8]; const float rs_ = rsv[ai][m];
#pragma unroll
                for (int n = 0; n < 2; ++n)
#pragma unroll
                    for (int j = 0; j < 4; ++j) { const float g = acc[ai][0][m][n][j] * rs_, up = acc[ai][1][m][n][j] * rs_; r[4 * n + j] = g * sigmoidf_(g) * up; }
                u32x2 w; w.x = pk4f8_(r[0], r[1], r[2], r[3]); w.y = pk4f8_(r[4], r[5], r[6], r[7]);
                *(GAS u32x2*)((unsigned char*)O + (size_t)(row0 + ai * HALF + m * 16) * 256 + col0) = w; }
    }
};
template <int LOG_NCT> struct MoeOrder {
    int G, c, RT; const __attribute__((address_space(3))) int* texp;
    __device__ __forceinline__ bool next(int i, Unit& u) const {
        const int L = i * G + c; const int rt = L >> LOG_NCT; if (rt >= RT) return false;
        const int e = __builtin_amdgcn_readfirstlane(texp[rt]); u.pm = rt; u.pn = (e << LOG_NCT) + (L & ((1 << LOG_NCT) - 1)); u.t = i; return true;
    }
    __device__ __forceinline__ void a_ready(const Unit&) const {}
    __device__ __forceinline__ void done(const Unit&) const {}
    __device__ __forceinline__ const bf16_t* a_base(const Gemm& g, const Unit&) const { return g.A; }
    __device__ __forceinline__ const bf16_t* b_base(const Gemm& g, const Unit&) const { return g.Bt; }
};
struct ChainOrder {
    StaticOrder base;
    __device__ __forceinline__ bool next(int i, Unit& u) const { const int ti = i / 3; if (!base.next(ti, u)) return false; u.t = i - 3 * ti; return true; }
    __device__ __forceinline__ void a_ready(const Unit&) const {}
    __device__ __forceinline__ void done(const Unit&) const {}
    __device__ __forceinline__ const bf16_t* a_base(const Gemm& g, const Unit& u) const { return g.A + (size_t)(2 * u.t + (u.t >> 1)) * (size_t)(16u << 20); }
    __device__ __forceinline__ const bf16_t* b_base(const Gemm& g, const Unit& u) const { return g.Bt + (size_t)u.t * 1024 * 512; }
};
struct EpiChain {
    static constexpr bool PERM = true, AFTER_DRAIN = false, CHAIN = true;
    bf16_t* Y; const bf16_t* G;
    static __device__ __forceinline__ float dq(unsigned w, int k) { return (float)((w >> (8 * k)) & 0xffu) * (1.f / 256.f) + (0.5f / 256.f); }
    __device__ __forceinline__ void operator()(f32x4 (&acc)[2][2][4][2], const Unit& u, int wr, int wc, int fr, int fq) const {
        int row0 = u.pm * BM + wr * 64 + fr; asm volatile("" : "+v"(row0)); const int col0 = u.pn * BM + wc * 32 + 8 * fq;
        const int t = u.t; const size_t toff = ((size_t)(u.pm * 4 + u.pn) << 16) + ((wr * 4 + wc) << 9) + ((fr + 16 * fq) << 3);
        const unsigned char* ga = (const unsigned char*)G + ((size_t)(160 * t - 32 * t * (t - 1)) << 20) + toff;
        if (t < 2) { const int t1 = t + 1; const unsigned char* gb = (const unsigned char*)G + ((size_t)(160 * t1 - 32 * t1 * (t1 - 1)) << 20) + toff;
            u32x2 a[2][4][2], b[2][4][2];
#pragma unroll
            for (int ai = 0; ai < 2; ++ai)
#pragma unroll
                for (int m = 0; m < 4; ++m)
#pragma unroll
                    for (int bj = 0; bj < 2; ++bj) { a[ai][m][bj] = *(const GAS u32x2*)(ga + (((ai * 4 + m) * 2 + bj) << 12)); b[ai][m][bj] = *(const GAS u32x2*)(gb + (((ai * 4 + m) * 2 + bj) << 12)); }
            __builtin_amdgcn_sched_barrier(0);
#pragma unroll
            for (int ai = 0; ai < 2; ++ai)
#pragma unroll
                for (int m = 0; m < 4; ++m)
#pragma unroll
                    for (int bj = 0; bj < 2; ++bj) { const u32x2 x = a[ai][m][bj], y = b[ai][m][bj];
                        f32x4& v0 = acc[ai][bj][m][0]; f32x4& v1 = acc[ai][bj][m][1];
#pragma unroll
                        for (int j = 0; j < 4; ++j) { v0[j] *= dq(x.x, j) * __builtin_amdgcn_rcpf(dq(y.x, j)); v1[j] *= dq(x.y, j) * __builtin_amdgcn_rcpf(dq(y.y, j)); } }
            __builtin_amdgcn_sched_barrier(0);
        } else {
            u32x2 a[2][4][2];
#pragma unroll
            for (int ai = 0; ai < 2; ++ai)
#pragma unroll
                for (int m = 0; m < 4; ++m)
#pragma unroll
                    for (int bj = 0; bj < 2; ++bj) a[ai][m][bj] = *(const GAS u32x2*)(ga + (((ai * 4 + m) * 2 + bj) << 12));
            __builtin_amdgcn_sched_barrier(0);
#pragma unroll
            for (int ai = 0; ai < 2; ++ai)
#pragma unroll
                for (int m = 0; m < 4; ++m)
#pragma unroll
                    for (int bj = 0; bj < 2; ++bj) { const u32x2 x = a[ai][m][bj]; const f32x4 v0 = acc[ai][bj][m][0], v1 = acc[ai][bj][m][1];
                        u32x4 w; w.x = cvt_pk_bf16(v0[0] * dq(x.x, 0), v0[1] * dq(x.x, 1)); w.y = cvt_pk_bf16(v0[2] * dq(x.x, 2), v0[3] * dq(x.x, 3));
                        w.z = cvt_pk_bf16(v1[0] * dq(x.y, 0), v1[1] * dq(x.y, 1)); w.w = cvt_pk_bf16(v1[2] * dq(x.y, 2), v1[3] * dq(x.y, 3));
                        *(GAS u32x4*)(Y + (size_t)(row0 + ai * HALF + m * 16) * 1024 + col0 + bj * HALF) = w; }
            __builtin_amdgcn_sched_barrier(0);
        }
    }
};
template <class Epi, class Sched, bool ALIGN_EPI = false, bool SP2 = false, bool GATHER = false, bool F8 = false>
__device__ __forceinline__ void gemm_phase(PG8_LAS unsigned char* lds, const Gemm g, const Sched& S, const Epi& E, int tid_in, const PG8_LAS int* tokl = nullptr) {
    int tid = tid_in; asm volatile("" : "+v"(tid));
    const int wid = __builtin_amdgcn_readfirstlane(tid >> 6), lane = tid & 63, wr = wid >> 2, wc = wid & 3, fr = lane & 15, fq = lane >> 4;
    const int K = g.K, nt = K / BK;
    unsigned voffA[2], voffB[2];
#pragma unroll
    for (int i = 0; i < 2; ++i) { int R, C; stage_rc(tid * 16 + i * 8192, R, C); const int Rb = Epi::PERM ? ((R & ~31) + perm32(R & 31)) : R;
        voffA[i] = (unsigned)(R * K + C) * 2u; voffB[i] = (unsigned)(Rb * K + C) * 2u; }
    const size_t kstep = (size_t)(BK * 2);
    const size_t hstep = (size_t)HALF * K * 2;
    const size_t tstep = 2 * hstep;
    const unsigned ldsw = (unsigned)wid * 1024u;
    const int aoff = lds_byte(wr * 64 + fr, fq * 8), boff = lds_byte(wc * 32 + fr, fq * 8);
#define PG8_SA(b, h) (((b) * 2 + (h)) * HTB)
#define PG8_SB(b, h) ((4 + (b) * 2 + (h)) * HTB)
#define PG8_STAGE(bufoff, gbase, voff) do { _Pragma("unroll") for (int _i = 0; _i < 2; ++_i) { unsigned vo_ = (voff)[_i]; asm volatile("" : "+v"(vo_));        \
        __builtin_amdgcn_global_load_lds((const unsigned*)((const char*)(gbase) + vo_), (PG8_LAS unsigned*)(lds + (bufoff) + ldsw + _i * 8192), 16, 0, 0); } } while (0)
#define PG8_STAGE_A(bufoff, kb, h, SEL) do { if constexpr (GATHER) { if (SEL) { unsigned gs_[2] = {gcur[h][0], gcur[h][1]}; if (last_ && hasn_) { _Pragma("unroll") for (int i_ = 0; i_ < 2; ++i_) { int R_, C_; stage_rc(tid * 16 + i_ * 8192, R_, C_); gs_[i_] = (unsigned)tokl[(ui + 1) * 256 + (h) * 128 + R_] * (unsigned)(K * 2) + (unsigned)(C_ * 2); } } PG8_STAGE(bufoff, kb, gs_); } else PG8_STAGE(bufoff, kb, gcur[h]); } else { PG8_STAGE(bufoff, (kb) + (h) * hstep, voffA); } } while (0)
#define PG8_GOFF(dst, slot) do { _Pragma("unroll") for (int h_ = 0; h_ < 2; ++h_) _Pragma("unroll") for (int i_ = 0; i_ < 2; ++i_) { int R_, C_; stage_rc(tid * 16 + i_ * 8192, R_, C_); \
        dst[h_][i_] = (unsigned)tokl[(slot) * 256 + h_ * 128 + R_] * (unsigned)(K * 2) + (unsigned)(C_ * 2); } } while (0)
#define PG8_LDA(dst, b, h) do { _Pragma("unroll") for (int m = 0; m < 4; ++m) _Pragma("unroll") for (int k = 0; k < 2; ++k) dst[m][k] = *(const PG8_LAS bf16x8*)(lds + PG8_SA(b, h) + aoff + m * 2048 + k * 1024); } while (0)
#define PG8_LDB(dst, b, h) do { _Pragma("unroll") for (int n = 0; n < 2; ++n) _Pragma("unroll") for (int k = 0; k < 2; ++k) dst[n][k] = *(const PG8_LAS bf16x8*)(lds + PG8_SB(b, h) + boff + n * 2048 + k * 1024); } while (0)
#define PG8_MMA(ai, bj, At, Bt) do { __builtin_amdgcn_s_setprio(1); asm volatile(".p2align 3"); __builtin_amdgcn_sched_barrier(0);        \
        if constexpr (F8) { _Pragma("unroll") for (int m = 0; m < 4; ++m) _Pragma("unroll") for (int n = 0; n < 2; ++n) \
            acc[ai][bj][m][n] = __builtin_amdgcn_mfma_scale_f32_16x16x128_f8f6f4(PG8_CAT(Bt[n][0], Bt[n][1]), PG8_CAT(At[m][0], At[m][1]), acc[ai][bj][m][n], 0, 0, 0, 0, 0, 0); } \
        else { _Pragma("unroll") for (int m = 0; m < 4; ++m) _Pragma("unroll") for (int n = 0; n < 2; ++n) _Pragma("unroll") for (int k = 0; k < 2; ++k) \
        acc[ai][bj][m][n] = __builtin_amdgcn_mfma_f32_16x16x32_bf16(Bt[n][k], At[m][k], acc[ai][bj][m][n], 0, 0, 0); } __builtin_amdgcn_s_setprio(0); } while (0)
#define PG8_CAT(lo_, hi_) __builtin_shufflevector(__builtin_bit_cast(i32x4, lo_), __builtin_bit_cast(i32x4, hi_), 0, 1, 2, 3, 4, 5, 6, 7)
#define PG8_WAIT_V(n) asm volatile("s_waitcnt vmcnt(" #n ")" ::: "memory")
#define PG8_WAIT_L(n) do { __builtin_amdgcn_s_waitcnt(0xC07F | ((n) << 8)); asm volatile("" ::: "memory"); } while (0)
#define PG8_BAR __builtin_amdgcn_s_barrier()
#define PG8_SCHED __builtin_amdgcn_sched_barrier(0)
    Unit cur, nxt; int ui = 0;
    if (!S.next(0, cur)) return;
    f32x4 acc[2][2][4][2];
#pragma unroll
    for (int a = 0; a < 2; ++a)
#pragma unroll
        for (int b = 0; b < 2; ++b)
#pragma unroll
            for (int m = 0; m < 4; ++m)
#pragma unroll
                for (int n = 0; n < 2; ++n) acc[a][b][m][n] = (f32x4){0.f, 0.f, 0.f, 0.f};
    bf16x8 At[4][2], B0[2][2], B1[2][2];
    const char* cA = (const char*)S.a_base(g, cur) + (GATHER ? (size_t)0 : (size_t)cur.pm * tstep); const char* cB = (const char*)S.b_base(g, cur) + (size_t)cur.pn * tstep;
    unsigned gcur[2][2] = {}; bool last_ = false, hasn_ = false;
    if constexpr (GATHER) PG8_GOFF(gcur, 0);
    S.a_ready(cur);
    if constexpr (SP2) {
        PG8_STAGE(PG8_SB(0, 0), cB, voffB); PG8_STAGE(PG8_SB(0, 1), cB + hstep, voffB); PG8_STAGE_A(PG8_SA(0, 0), cA, 0, false); PG8_STAGE_A(PG8_SA(0, 1), cA, 1, false);
        if (wr == 1) PG8_BAR;
        PG8_WAIT_V(2); PG8_BAR;
        PG8_STAGE(PG8_SB(1, 0), cB + kstep, voffB); PG8_STAGE_A(PG8_SA(1, 0), cA + kstep, 0, false); PG8_STAGE(PG8_SB(1, 1), cB + hstep + kstep, voffB);
        PG8_WAIT_V(6); PG8_BAR;
    } else {
        PG8_STAGE(PG8_SB(0, 0), cB, voffB); PG8_STAGE(PG8_SA(0, 0), cA, voffA); PG8_STAGE(PG8_SB(0, 1), cB + hstep, voffB); PG8_STAGE(PG8_SA(0, 1), cA + hstep, voffA);
        if (wr == 1) PG8_BAR;
        PG8_WAIT_V(4); PG8_BAR;
        PG8_STAGE(PG8_SB(1, 0), cB + kstep, voffB); PG8_STAGE(PG8_SA(1, 0), cA + kstep, voffA); PG8_STAGE(PG8_SB(1, 1), cB + hstep + kstep, voffB);
        PG8_WAIT_V(6); PG8_BAR;
    }
    GEMM_ALIGN_ASM;
    for (;;) {
        const bool has_next = S.next(ui + 1, nxt);
        hasn_ = has_next;
        const char* nA = has_next ? (const char*)S.a_base(g, nxt) + (GATHER ? (size_t)0 : (size_t)nxt.pm * tstep) : cA; const char* nB = has_next ? (const char*)S.b_base(g, nxt) + (size_t)nxt.pn * tstep : cB;
        for (int t = 0; t < nt; t += 2) {
            const bool last = (t == nt - 2); last_ = last;
            const char* a1 = cA + (size_t)(t + 1) * kstep;
            const char* a2 = last ? nA : cA + (size_t)(t + 2) * kstep; const char* b2 = last ? nB : cB + (size_t)(t + 2) * kstep;
            const char* a3 = a2 + kstep; const char* b3 = b2 + kstep;
            if (last && has_next) S.a_ready(nxt);
            if constexpr (SP2) {
            PG8_LDB(B0, 0, 0); PG8_LDB(B1, 0, 1); PG8_SCHED; PG8_LDA(At, 0, 0); PG8_STAGE_A(PG8_SA(1, 1), a1, 1, false);
            PG8_WAIT_V(8); PG8_WAIT_L(0); PG8_BAR; PG8_MMA(0, 0, At, B0); PG8_MMA(0, 1, At, B1); PG8_BAR; PG8_SCHED;
            PG8_LDA(At, 0, 1); PG8_STAGE(PG8_SB(0, 0), b2, voffB); PG8_STAGE(PG8_SB(0, 1), b2 + hstep, voffB); PG8_STAGE_A(PG8_SA(0, 0), a2, 0, true);
            PG8_WAIT_V(8); PG8_WAIT_L(0); PG8_BAR; PG8_MMA(1, 0, At, B0); PG8_MMA(1, 1, At, B1); PG8_BAR; PG8_SCHED;
            PG8_LDB(B0, 1, 0); PG8_LDB(B1, 1, 1); PG8_SCHED; PG8_LDA(At, 1, 0); PG8_STAGE_A(PG8_SA(0, 1), a2, 1, true);
            PG8_WAIT_V(8); PG8_WAIT_L(0); PG8_BAR; PG8_MMA(0, 0, At, B0); PG8_MMA(0, 1, At, B1); PG8_BAR; PG8_SCHED;
            PG8_LDA(At, 1, 1); PG8_STAGE(PG8_SB(1, 0), b3, voffB); PG8_STAGE(PG8_SB(1, 1), b3 + hstep, voffB); PG8_STAGE_A(PG8_SA(1, 0), a3, 0, true);
            PG8_WAIT_V(8); PG8_WAIT_L(0); PG8_BAR; PG8_MMA(1, 0, At, B0); PG8_MMA(1, 1, At, B1); PG8_BAR; PG8_SCHED;
            } else {
            PG8_LDB(B0, 0, 0); PG8_SCHED; PG8_LDA(At, 0, 0); PG8_STAGE(PG8_SA(1, 1), a1 + hstep, voffA);
            PG8_WAIT_L(8); PG8_BAR; PG8_WAIT_L(0); PG8_MMA(0, 0, At, B0); PG8_BAR; PG8_SCHED;
            PG8_LDB(B1, 0, 1); PG8_STAGE(PG8_SB(0, 0), b2, voffB);
            PG8_BAR; PG8_WAIT_L(0); PG8_MMA(0, 1, At, B1); PG8_BAR;
            PG8_LDA(At, 0, 1); PG8_STAGE(PG8_SA(0, 0), a2, voffA);
            PG8_BAR; PG8_WAIT_L(0); PG8_MMA(1, 0, At, B0); PG8_BAR; PG8_SCHED;
            PG8_STAGE(PG8_SB(0, 1), b2 + hstep, voffB);
            PG8_WAIT_V(6); PG8_BAR; PG8_MMA(1, 1, At, B1); PG8_BAR;
            PG8_LDB(B0, 1, 0); PG8_SCHED; PG8_LDA(At, 1, 0); PG8_STAGE(PG8_SA(0, 1), a2 + hstep, voffA);
            PG8_WAIT_L(8); PG8_BAR; PG8_WAIT_L(0); PG8_MMA(0, 0, At, B0); PG8_BAR; PG8_SCHED;
            PG8_LDB(B1, 1, 1); PG8_STAGE(PG8_SB(1, 0), b3, voffB);
            PG8_BAR; PG8_WAIT_L(0); PG8_MMA(0, 1, At, B1); PG8_BAR;
            PG8_LDA(At, 1, 1); PG8_STAGE(PG8_SA(1, 0), a3, voffA);
            PG8_BAR; PG8_WAIT_L(0); PG8_MMA(1, 0, At, B0); PG8_BAR; PG8_SCHED;
            PG8_STAGE(PG8_SB(1, 1), b3 + hstep, voffB);
            PG8_WAIT_V(6); PG8_BAR; PG8_MMA(1, 1, At, B1); PG8_BAR;
            }
        }
        if constexpr (ALIGN_EPI) { if (wr == 0) PG8_BAR; }
        if constexpr (!Epi::AFTER_DRAIN) { E(acc, cur, wr, wc, fr, fq); S.done(cur); }
        if (!has_next) break;
        if (!Epi::CHAIN || nxt.t == 0) {
#pragma unroll
        for (int a = 0; a < 2; ++a)
#pragma unroll
            for (int b = 0; b < 2; ++b)
#pragma unroll
                for (int m = 0; m < 4; ++m)
#pragma unroll
                    for (int n = 0; n < 2; ++n) acc[a][b][m][n] = (f32x4){0.f, 0.f, 0.f, 0.f}; }
        cur = nxt; cA = nA; cB = nB; ++ui;
        if constexpr (GATHER) PG8_GOFF(gcur, ui);
        if constexpr (ALIGN_EPI) { if (wr == 1) PG8_BAR; }
    }
    PG8_WAIT_V(0);
    if constexpr (!ALIGN_EPI) { if (wr == 0) PG8_BAR; }
    PG8_BAR;
    if constexpr (Epi::AFTER_DRAIN) { E.fused(acc, cur, wr, wc, fr, fq, lds, wid, lane); S.done(cur); }
#undef PG8_SA
#undef PG8_SB
#undef PG8_STAGE
#undef PG8_STAGE_A
#undef PG8_GOFF
#undef PG8_LDA
#undef PG8_LDB
#undef PG8_MMA
#undef PG8_CAT
#undef PG8_WAIT_V
#undef PG8_WAIT_L
#undef PG8_BAR
#undef PG8_SCHED
}
}
constexpr int NTOK = 32768, SEQ = 8192, NB = 4, DM = 1024, INC = 8200;
constexpr float EPS = 1e-6f, LOG2E = 1.4426950408889634f;
constexpr size_t MiB = 1u << 20;
constexpr size_t WS_CTL = 0, CTL_ZERO_BYTES = 128 * 1024;
constexpr size_t WS_IG = 1 * MiB;
constexpr size_t WS_BC = 1 * MiB + 512 * 1024;
constexpr size_t WS_BLAST = 2 * MiB;
constexpr size_t WS_GMAX = 2 * MiB + 64 * 1024;
constexpr size_t WS_NUC = 3 * MiB;
constexpr size_t WS_TOKE = 4 * MiB;
constexpr size_t WS_TOKR = 4 * MiB + 256 * 1024;
constexpr size_t WS_TOKW = 4 * MiB + 512 * 1024;
constexpr size_t WS_TEXP = 5 * MiB;
constexpr size_t WS_HISTG = 5 * MiB + 64 * 1024;
constexpr size_t WS_WRT = 7 * MiB;
constexpr size_t WS_RSTD = 5 * MiB + 128 * 1024;
constexpr size_t WS_TOKP = 6 * MiB;
constexpr size_t WS_WT1 = 8 * MiB;
constexpr size_t WS_WT2 = 18 * MiB;
constexpr size_t WS_WAO8 = 21 * MiB;
constexpr size_t WS_PT = 24 * MiB;
constexpr size_t WS_WOT = 27 * MiB;
constexpr size_t WS_PROJ = 32 * MiB;
constexpr size_t PROJ_STRIDE = 32 * MiB;
constexpr size_t WS_HB = 352 * MiB;
constexpr size_t WS_O12 = 416 * MiB;
constexpr size_t WS_G0 = 32 * MiB, WS_G1 = 192 * MiB, WS_G2 = 288 * MiB;
constexpr size_t WS_H2 = 32 * MiB;
constexpr size_t WS_X8 = 32 * MiB;
constexpr size_t WS_XS = 96 * MiB;
constexpr size_t WS_HE = 352 * MiB;
constexpr size_t WS_TOKS = 6 * MiB + 512 * 1024;
constexpr size_t WS_OSL = 96 * MiB;
constexpr size_t WS_W1T = 416 * MiB;
constexpr size_t WS_W2T = 448 * MiB;
constexpr size_t WS_XB1 = 256 * MiB;
constexpr size_t WS_KC = 480 * MiB;
constexpr size_t WS_NEED = 512 * MiB;
constexpr int PJ_AQ = 0, PJ_AK = 1, PJ_AV = 2, PJ_AO = 3, PJ_BQ = 4, PJ_BK = 5, PJ_BV = 6, PJ_CQ = 7, PJ_CK = 8, PJ_CV = 9;
constexpr int CW_TMO = 0, CW_CODE = 1;
constexpr int CW_BAR = 4096;
constexpr int CW_Q = 8192;
constexpr int CW_CNT = 12288;
constexpr int RING_BYTES = 131072;
constexpr int MISC_OFF = RING_BYTES;
constexpr int OFFS_OFF = RING_BYTES + 256;
constexpr int TEXP_OFF = RING_BYTES + 4096;
constexpr int TOKL_OFF = RING_BYTES + 6144;
constexpr int LDS_BYTES = 147456;
constexpr int NWAVES = 8, NTHR = 512;

#ifndef GAS
#define GAS __attribute__((address_space(1)))
#endif
#define LAS __attribute__((address_space(3)))
typedef unsigned short bf16;
typedef float f32x4 __attribute__((ext_vector_type(4)));
typedef float f32x16 __attribute__((ext_vector_type(16)));
typedef short bf16x8 __attribute__((ext_vector_type(8)));
typedef unsigned u32x4 __attribute__((ext_vector_type(4)));
typedef unsigned u32x2 __attribute__((ext_vector_type(2)));
typedef short s16x4 __attribute__((ext_vector_type(4)));
typedef GAS unsigned gu32;
#define RLX_AGENT __ATOMIC_RELAXED, __HIP_MEMORY_SCOPE_AGENT
#define LDS_WAIT() asm volatile("s_waitcnt lgkmcnt(0)" ::: "memory")
typedef float f32x2_t __attribute__((ext_vector_type(2))); typedef __bf16 bf16x2_t __attribute__((ext_vector_type(2)));
__device__ __forceinline__ unsigned pk2(float lo, float hi) { f32x2_t v = {lo, hi}; bf16x2_t b = __builtin_convertvector(v, bf16x2_t); return __builtin_bit_cast(unsigned, b); }
__device__ __forceinline__ float bflo(unsigned u) { return __builtin_bit_cast(float, u << 16); }
__device__ __forceinline__ float bfhi(unsigned u) { return __builtin_bit_cast(float, u & 0xffff0000u); }
__device__ __forceinline__ float sigm(float x) { return __builtin_amdgcn_rcpf(1.f + __expf(-x)); }
template <int O> __device__ __forceinline__ float xor_shfl(float v) {
    const int x = __builtin_bit_cast(int, v);
    if constexpr (O == 1) return __builtin_bit_cast(float, __builtin_amdgcn_update_dpp(x, x, 0xB1, 0xf, 0xf, false));
    else if constexpr (O == 2) return __builtin_bit_cast(float, __builtin_amdgcn_update_dpp(x, x, 0x4E, 0xf, 0xf, false));
    else if constexpr (O == 4) { int t = __builtin_amdgcn_update_dpp(x, x, 0x104, 0xf, 0x5, false);
        t = __builtin_amdgcn_update_dpp(t, x, 0x114, 0xf, 0xA, false); return __builtin_bit_cast(float, t); }
    else if constexpr (O == 8) return __builtin_bit_cast(float, __builtin_amdgcn_update_dpp(x, x, 0x128, 0xf, 0xf, false));
    else return __builtin_bit_cast(float, __builtin_amdgcn_ds_swizzle(x, (O << 10) | 0x1f));
}
__device__ __forceinline__ float wave_sum(float v) {
    v += xor_shfl<1>(v); v += xor_shfl<2>(v); v += xor_shfl<4>(v); v += xor_shfl<8>(v);
    { auto rr = __builtin_amdgcn_permlane16_swap(__float_as_uint(v), __float_as_uint(v), false, false); v = __uint_as_float(rr[0]) + __uint_as_float(rr[1]); }
    auto rr = __builtin_amdgcn_permlane32_swap(__float_as_uint(v), __float_as_uint(v), false, false);
    return __uint_as_float(rr[0]) + __uint_as_float(rr[1]);
}
__device__ __forceinline__ float wave_max(float v) {
    v = fmaxf(v, xor_shfl<1>(v)); v = fmaxf(v, xor_shfl<2>(v)); v = fmaxf(v, xor_shfl<4>(v)); v = fmaxf(v, xor_shfl<8>(v));
    { auto rr = __builtin_amdgcn_permlane16_swap(__float_as_uint(v), __float_as_uint(v), false, false); v = fmaxf(__uint_as_float(rr[0]), __uint_as_float(rr[1])); }
    auto rr = __builtin_amdgcn_permlane32_swap(__float_as_uint(v), __float_as_uint(v), false, false);
    return fmaxf(__uint_as_float(rr[0]), __uint_as_float(rr[1]));
}
__device__ __forceinline__ float lane_up(float v, int lane, int o) {
    return __builtin_bit_cast(float, __builtin_amdgcn_ds_bpermute(((lane - o) & 63) << 2, __builtin_bit_cast(int, v)));
}
__device__ __forceinline__ float lane_get(float v, int src) {
    return __builtin_bit_cast(float, __builtin_amdgcn_readlane(__builtin_bit_cast(int, v), src));
}
__device__ __forceinline__ float pair_sum(float v) {
    auto rr = __builtin_amdgcn_permlane32_swap(__float_as_uint(v), __float_as_uint(v), false, false);
    return __uint_as_float(rr[0]) + __uint_as_float(rr[1]);
}
__device__ __forceinline__ float pair_max(float v) {
    auto rr = __builtin_amdgcn_permlane32_swap(__float_as_uint(v), __float_as_uint(v), false, false);
    return fmaxf(__uint_as_float(rr[0]), __uint_as_float(rr[1]));
}
__device__ __forceinline__ float max3f(float a, float b, float c) { float r; asm("v_max3_f32 %0, %1, %2, %3" : "=v"(r) : "v"(a), "v"(b), "v"(c)); return r; }
__device__ __forceinline__ int crow(int r, int hi) { return (r & 3) + 8 * (r >> 2) + 4 * hi; }
typedef short v4i16_t __attribute__((ext_vector_type(4)));
__device__ __forceinline__ s16x4 tr16(const LAS unsigned char* p) { return __builtin_bit_cast(s16x4, __builtin_amdgcn_ds_read_tr16_b64_v4i16((LAS v4i16_t*)p)); }
__device__ __forceinline__ bf16x8 cat8(s16x4 lo, s16x4 hi) { return (bf16x8){lo[0], lo[1], lo[2], lo[3], hi[0], hi[1], hi[2], hi[3]}; }
__device__ __forceinline__ f32x4 ldrow4(const void* base, bool isbf, size_t row, int idx) {
    if (isbf) { const u32x2 u = ((const GAS u32x2*)((const bf16*)base + row * 1024))[idx]; return (f32x4){bflo(u.x), bfhi(u.x), bflo(u.y), bfhi(u.y)}; }
    return ((const GAS f32x4*)((const float*)base + row * 1024))[idx];
}
__device__ __forceinline__ u32x4 ldrow4raw(const void* base, bool isbf, size_t row, int idx) {
    if (isbf) { const u32x2 u = ((const GAS u32x2*)((const bf16*)base + row * 1024))[idx]; return (u32x4){u.x, u.y, 0u, 0u}; }
    return ((const GAS u32x4*)((const float*)base + row * 1024))[idx];
}
__device__ __forceinline__ f32x4 cvtrow4(u32x4 raw, bool isbf) {
    if (isbf) return (f32x4){bflo(raw.x), bfhi(raw.x), bflo(raw.y), bfhi(raw.y)};
    return __builtin_bit_cast(f32x4, raw);
}
#define MFMA32(a, b, c) __builtin_amdgcn_mfma_f32_32x32x16_bf16((a), (b), (c), 0, 0, 0)
#define XB_TMO      128
#define XB_XCNT(j)  (256  + 64 * (j))
#define XB_XSUB(j)  (1280 + 64 * (j))
#define XB_XGEN(j)  (2304 + 64 * (j))
#define XB_TOP      3328
#define XB_TOPGEN   3392
#define XCD_BAR_WORDS 3456
#define XB_SPIN_CAP (1u << 18)

__device__ __forceinline__ unsigned xb_ld(unsigned* p)              { return __hip_atomic_load(p, __ATOMIC_RELAXED, __HIP_MEMORY_SCOPE_AGENT); }
__device__ __forceinline__ unsigned xb_add(unsigned* p, unsigned v) { return __hip_atomic_fetch_add(p, v, __ATOMIC_RELAXED, __HIP_MEMORY_SCOPE_AGENT); }
__device__ __forceinline__ unsigned xb_xcc_id() { return (unsigned)__builtin_amdgcn_s_getreg((3 << 11) | 20) & 0xFu; }
#define XB_SPIN(cond, bar) do { unsigned _sp = 0; while (cond) { __builtin_amdgcn_s_sleep(1); \
    if ((++_sp & 255u) == 0u) { if (xb_ld(&(bar)[XB_TMO])) break; if (_sp > XB_SPIN_CAP) { atomicAdd(&(bar)[XB_TMO], 1u); break; } } } } while (0)

__device__ __forceinline__ int xb_lane() { int l; asm volatile("v_mbcnt_lo_u32_b32 %0, -1, 0\n\tv_mbcnt_hi_u32_b32 %0, -1, %0" : "=v"(l)); return l; }
struct XcdBarrier {
    int wv;
    unsigned* bar; unsigned x;
    volatile LAS unsigned* st;
};

__device__ __forceinline__ XcdBarrier xcd_barrier_post(unsigned* bar, volatile LAS unsigned* st, int wv) {
    XcdBarrier b; b.wv = wv; b.bar = bar; b.x = xb_xcc_id(); b.st = st;
    if (wv == 0 && xb_lane() == 0) (void)xb_add(&bar[XB_XCNT(b.x)], 1u);
    return b;
}
__device__ __forceinline__ void xcd_barrier_complete(unsigned* bar, unsigned x, unsigned& nloc, unsigned& nx) {
    const unsigned G = gridDim.x * gridDim.y * gridDim.z;
    unsigned sum, cnt, mine, sp = 0u;
    for (;;) {
        sum = 0u; cnt = 0u; mine = 0u;
#pragma unroll
        for (unsigned j = 0; j < 16; ++j) { const unsigned c = xb_ld(&bar[XB_XCNT(j)]); sum += c; cnt += (c > 0u) ? 1u : 0u; mine = (j == x) ? c : mine; }
        if (sum == G) break;
        __builtin_amdgcn_s_sleep(1);
        if ((++sp & 255u) == 0u) { if (xb_ld(&bar[XB_TMO])) break; if (sp > XB_SPIN_CAP) { atomicAdd(&bar[XB_TMO], 1u); break; } }
    }
    nloc = mine > 0u ? mine : 1u; nx = cnt > 0u ? cnt : 1u;
}

__device__ __forceinline__ void xcd_barrier(const XcdBarrier& b) {
    asm volatile("s_waitcnt vmcnt(0)" ::: "memory");
    __syncthreads();
    if (b.wv == 0 && xb_lane() == 0) {
        unsigned* bar = b.bar;
        __builtin_amdgcn_s_waitcnt(0);
        unsigned nloc = b.st[0], nx = b.st[1];
        if (nloc == 0u) { xcd_barrier_complete(bar, b.x, nloc, nx); b.st[0] = nloc; b.st[1] = nx; }
        const unsigned old = xb_add(&bar[XB_XSUB(b.x)], 1u);
        const unsigned gen = old / nloc;
        if (old + 1u == (gen + 1u) * nloc) {
            __builtin_amdgcn_fence(__ATOMIC_RELEASE, "agent");
            asm volatile("s_waitcnt vmcnt(0)" ::: "memory");
            const unsigned og = xb_add(&bar[XB_TOP], 1u);
            const unsigned tg = og / nx;
            if (og + 1u == (tg + 1u) * nx) xb_add(&bar[XB_TOPGEN], 1u);
            else XB_SPIN(xb_ld(&bar[XB_TOPGEN]) == tg, bar);
            __builtin_amdgcn_fence(__ATOMIC_ACQUIRE, "agent");
            xb_add(&bar[XB_XGEN(b.x)], 1u);
            asm volatile("s_waitcnt vmcnt(0)" ::: "memory");
        } else {
            XB_SPIN(xb_ld(&bar[XB_XGEN(b.x)]) == gen, bar);
            __builtin_amdgcn_fence(__ATOMIC_ACQUIRE, "agent");
            asm volatile("s_waitcnt vmcnt(0)" ::: "memory");
        }
    }
    __syncthreads();
}
struct Args {
    const float* in[23]; float* out; unsigned char* ws; int ph_lo, ph_hi;
};
struct Ctx {
    LAS unsigned char* lds; volatile LAS unsigned* MISC; gu32* ctl; unsigned char* ws;
    int tid, lane, wave, vcu, G;
};
template <class T> __device__ __forceinline__ T* wsp(const Ctx& C, size_t off) { return (T*)(C.ws + off); }
__device__ __forceinline__ bf16* proj(const Ctx& C, int j) { return (bf16*)(C.ws + WS_PROJ + (size_t)j * PROJ_STRIDE); }

struct TrItem { const float* W; int ldn, k0, n0; bf16* WT; int Kdst, drow0; const float* rs = nullptr;   bool f8 = false;   };
__device__ __forceinline__ unsigned pk4f8(float a, float b, float c, float d) { int p = __builtin_amdgcn_cvt_pk_fp8_f32(a, b, 0, false); p = __builtin_amdgcn_cvt_pk_fp8_f32(c, d, p, true); return (unsigned)p; }
__device__ __forceinline__ void transpose_load(const TrItem& t, f32x4 (&v)[8], int lane) {
    const float* src = t.W + (size_t)(t.k0 + (lane >> 3)) * t.ldn + t.n0 + 4 * (lane & 7);
#pragma unroll
    for (int i = 0; i < 8; ++i) v[i] = *(const GAS f32x4*)(src + (size_t)(8 * i) * t.ldn);
    if (t.rs) { float s[8];
#pragma unroll
        for (int i = 0; i < 8; ++i) s[i] = *(const GAS float*)(t.rs + t.k0 + (lane >> 3) + 8 * i);
#pragma unroll
        for (int i = 0; i < 8; ++i) v[i] *= s[i]; }
}
__device__ __forceinline__ void transpose_commit(const TrItem& t, const f32x4 (&v)[8], LAS float* scr, int lane) {
    { const int c4 = lane & 7;
#pragma unroll
        for (int i = 0; i < 8; ++i) { LAS float* d = scr + ((lane >> 3) + 8 * i) * 33 + 4 * c4; d[0] = v[i].x; d[1] = v[i].y; d[2] = v[i].z; d[3] = v[i].w; } }
    LDS_WAIT(); asm volatile("" ::: "memory");
    const int c = lane & 7;
#pragma unroll
    for (int j = 0; j < 4; ++j) { const int n = (lane >> 3) + 8 * j; const LAS float* s = scr + (8 * c) * 33 + n;
        if (t.f8) { u32x2 o8; o8.x = pk4f8(s[0 * 33] * 64.f, s[1 * 33] * 64.f, s[2 * 33] * 64.f, s[3 * 33] * 64.f); o8.y = pk4f8(s[4 * 33] * 64.f, s[5 * 33] * 64.f, s[6 * 33] * 64.f, s[7 * 33] * 64.f);
            *(GAS u32x2*)((unsigned char*)t.WT + (size_t)(t.drow0 + n) * t.Kdst + t.k0 + 8 * c) = o8; }
        else { u32x4 o; o.x = pk2(s[0 * 33], s[1 * 33]); o.y = pk2(s[2 * 33], s[3 * 33]); o.z = pk2(s[4 * 33], s[5 * 33]); o.w = pk2(s[6 * 33], s[7 * 33]);
        *(GAS u32x4*)(t.WT + (size_t)(t.drow0 + n) * t.Kdst + t.k0 + 8 * c) = o; } }
    LDS_WAIT(); asm volatile("" ::: "memory");
}
__device__ __forceinline__ TrItem layer_weight_decode(const Args& A, const Ctx& C, int layer, int it) {
    const float* win = A.in[2] + (size_t)layer * DM * INC;
    constexpr int I1 = 16 * 160, I2 = 16 * 96, I3 = 3 * 8 * 32;
    int r = it;
    if (r < I1) { const int nb = r % 160, kb = r / 160, nd = nb * 32, j = nd >> 9; const int sc = (j < 4 ? j * 512 : 2056 + (j - 4) * 512) + (nd & 511);
        if (j == 3) return TrItem{win, INC, kb * 64, sc, (bf16*)(C.ws + WS_WAO8), 1024, nd - 1536, nullptr, true};
        return TrItem{win, INC, kb * 64, sc, wsp<bf16>(C, WS_WT1), 1024, nd}; } r -= I1;
    if (r < I2) { const int nb = r % 96, kb = r / 96; return TrItem{win, INC, kb * 64, 5128 + nb * 32, wsp<bf16>(C, WS_WT2), 1024, nb * 32, nullptr, true}; } r -= I2;
    if (r < I3) { const int br = r / 256, q = r % 256, nb = q % 32, kb = q / 32;
        return TrItem{A.in[13] + (size_t)(layer * 3 + br) * 512 * 1024, 1024, kb * 64, nb * 32, wsp<bf16>(C, WS_PT) + (size_t)br * 1024 * 512, 512, nb * 32}; } r -= I3;
    { const int nb = r % 32, kb = r / 32; return TrItem{A.in[14] + (size_t)layer * 1024 * 1024, 1024, kb * 64, nb * 32, wsp<bf16>(C, WS_WOT), 1024, nb * 32}; }
}
__device__ __forceinline__ void layer_weight_items(const Args& A, const Ctx& C, int layer, int first = 0, int count = -1) {
    LAS float* scr = (LAS float*)(C.lds + C.wave * 16384);
    const int gw = (C.vcu - first) * NWAVES + C.wave, NGW = (count < 0 ? C.G : count) * NWAVES;
    constexpr int NI = 16 * 160 + 16 * 96 + 3 * 8 * 32 + 16 * 32;
    if (gw >= NI) return;
    TrItem cur = layer_weight_decode(A, C, layer, gw); f32x4 v[8]; transpose_load(cur, v, C.lane);
    for (int it = gw; it < NI; it += NGW) { f32x4 vn[8]; TrItem nxt = cur; const bool hn = it + NGW < NI;
        if (hn) { nxt = layer_weight_decode(A, C, layer, it + NGW); transpose_load(nxt, vn, C.lane); }
        transpose_commit(cur, v, scr, C.lane);
        if (hn) {
#pragma unroll
            for (int i = 0; i < 8; ++i) v[i] = vn[i]; }
        cur = nxt; }
}
__device__ __forceinline__ TrItem moe_weight_decode(const Args& A, const Ctx& C, int layer, int it) {
    constexpr int I1 = 32 * 256;
    int r = it;
    if (r < I1) { const int e = r >> 8, q = r & 255, mat = q >> 7, q2 = q & 127, nb = q2 & 7, kb = q2 >> 3, n0 = nb * 32;
        const float* src = (mat ? A.in[21] : A.in[20]) + (size_t)(layer * 32 + e) * 1024 * 256;
        return TrItem{src, 256, kb * 64, n0, wsp<bf16>(C, WS_W1T), 1024, e * 512 + (n0 >> 7) * 256 + mat * 128 + (n0 & 127), A.in[15] + layer * 1024, true}; } r -= I1;
    { const int e = r >> 7, q = r & 127, nb = q & 31, kb = q >> 5;
        return TrItem{A.in[22] + (size_t)(layer * 32 + e) * 256 * 1024, 1024, kb * 64, nb * 32, wsp<bf16>(C, WS_W2T), 256, e * 1024 + nb * 32, nullptr, true}; }
}
__device__ __forceinline__ void moe_weight_items(const Args& A, const Ctx& C, int layer) {
    LAS float* scr = (LAS float*)(C.lds + C.wave * 16384);
    const int gw = C.vcu * NWAVES + C.wave, NGW = C.G * NWAVES;
    constexpr int NI = 32 * 256 + 32 * 128;
    if (gw >= NI) return;
    TrItem cur = moe_weight_decode(A, C, layer, gw); f32x4 v[8]; transpose_load(cur, v, C.lane);
    for (int it = gw; it < NI; it += NGW) { f32x4 vn[8]; TrItem nxt = cur; const bool hn = it + NGW < NI;
        if (hn) { nxt = moe_weight_decode(A, C, layer, it + NGW); transpose_load(nxt, vn, C.lane); }
        transpose_commit(cur, v, scr, C.lane);
        if (hn) {
#pragma unroll
            for (int i = 0; i < 8; ++i) v[i] = vn[i]; }
        cur = nxt; }
}
template <int KIND> __device__ __forceinline__ void phase0(const Args& A, const Ctx& C, int parts = 7  ) {
    constexpr int layer = KIND;
    if (layer < 2) { if ((parts & 1) && !(layer == 1 && C.G == 256)) layer_weight_items(A, C, layer);
        const float* wr = A.in[18] + layer * 32768; const float* wgp = A.in[16] + layer * 4096; bf16* wt = wsp<bf16>(C, WS_WRT);
        for (int idx = C.vcu * NTHR + C.tid; idx < ((parts & 2) ? 65536 : 0); idx += C.G * NTHR) { const int n = idx >> 10, k = idx & 1023;
            const float w = (n < 32 ? wr[k * 32 + n] : n < 36 ? wgp[k * 4 + (n - 32)] : 0.f) * (A.in[15] + layer * 1024)[k]; const unsigned hi = pk2(w, 0.f) & 0xffffu; const unsigned lo = pk2(w - bflo(hi), 0.f) & 0xffffu;
            ((GAS bf16*)wt)[idx] = (bf16)hi; ((GAS bf16*)wt)[65536 + idx] = (bf16)lo; } }
    __syncthreads();
    LAS float* WG = (LAS float*)(C.lds);
    LAS float* GL = (LAS float*)(C.lds + 32768);
    const int ll = layer < 2 ? layer : 0;
    const float* win = A.in[2] + (size_t)ll * DM * INC;
    if (layer < 2) { float wv[16];
#pragma unroll
        for (int q = 0; q < 16; ++q) { const int i = C.tid + NTHR * q; wv[q] = *(const GAS float*)(win + (size_t)(i >> 3) * INC + 2048 + (i & 7)); }
#pragma unroll
        for (int q = 0; q < 16; ++q) { const int i = C.tid + NTHR * q, k = i >> 3, gt = i & 7;
            WG[(gt >> 2) * 4096 + ((((k >> 8) * 4 + (k & 3)) * 64 + ((k & 255) >> 2)) << 2) + (gt & 3)] = wv[q]; } }
    __syncthreads();
    const float* g1 = A.in[1] + ll * 1024; const float* gb = A.in[5] + ll * 8;
    const void* xsrc = (layer == 0) ? (const void*)A.in[0] : (const void*)wsp<bf16>(C, WS_XB1); const bool xbf = layer > 0;
    const GAS int* tokp = (const GAS int*)wsp<int>(C, WS_TOKP); const GAS float* tokw = (const GAS float*)wsp<float>(C, WS_TOKW);
    const bf16* osl = wsp<bf16>(C, WS_OSL); bf16* hb = wsp<bf16>(C, WS_HB); unsigned char* h8b = (unsigned char*)((bf16*)A.out + (size_t)NTOK * DM);
    const int gq_ = 4 * (C.lane & 1) + 2 * ((C.lane >> 1) & 1) + ((C.lane >> 2) & 1); const float gbq = *(const GAS float*)(gb + gq_);
    f32x4 g1r[4];
#pragma unroll
    for (int j = 0; j < 4; ++j) g1r[j] = ((const GAS f32x4*)g1)[64 * j + C.lane];
    for (int item = C.vcu; item < ((parts & 4) ? NTOK / 64 : 0); item += C.G) {
        const int row0 = item * 64;
        u32x4 vnx[4]; unsigned onx0[4] = {}, onx1[4] = {};        float nw0 = 0.f, nw1 = 0.f, nnw0 = 0.f, nnw1 = 0.f; int nnp0 = 0, nnp1 = 0;
        { const int r0 = row0 + C.wave * 8;
#pragma unroll
            for (int j = 0; j < 4; ++j) vnx[j] = ldrow4raw(xsrc, xbf, (size_t)r0, C.lane + 64 * j);
            if (layer > 0) { nw0 = tokw[r0 * 2]; nw1 = tokw[r0 * 2 + 1]; const size_t p0 = (size_t)tokp[r0 * 2], p1 = (size_t)tokp[r0 * 2 + 1];
                nnw0 = tokw[r0 * 2 + 2]; nnw1 = tokw[r0 * 2 + 3]; nnp0 = tokp[r0 * 2 + 2]; nnp1 = tokp[r0 * 2 + 3];
                const GAS unsigned* o0 = (const GAS unsigned*)((const unsigned char*)osl + p0 * DM) + C.lane; const GAS unsigned* o1 = (const GAS unsigned*)((const unsigned char*)osl + p1 * DM) + C.lane;
#pragma unroll
                for (int j = 0; j < 4; ++j) { onx0[j] = o0[64 * j]; onx1[j] = o1[64 * j]; } } }
        for (int i = 0; i < 8; ++i) {
            const int rl = C.wave * 8 + i, row = row0 + rl;
            f32x4 v[4]; unsigned oc0[4], oc1[4]; const float w0 = nw0 * (1.f / 16.f), w1 = nw1 * (1.f / 16.f);
#pragma unroll
            for (int j = 0; j < 4; ++j) { v[j] = cvtrow4(vnx[j], xbf); oc0[j] = onx0[j]; oc1[j] = onx1[j]; }
            if (i < 7) {
#pragma unroll
                for (int j = 0; j < 4; ++j) vnx[j] = ldrow4raw(xsrc, xbf, (size_t)(row + 1), C.lane + 64 * j);
                if (layer > 0) { nw0 = nnw0; nw1 = nnw1;
                    const GAS unsigned* o0 = (const GAS unsigned*)((const unsigned char*)osl + (size_t)nnp0 * DM) + C.lane; const GAS unsigned* o1 = (const GAS unsigned*)((const unsigned char*)osl + (size_t)nnp1 * DM) + C.lane;
#pragma unroll
                    for (int j = 0; j < 4; ++j) { onx0[j] = o0[64 * j]; onx1[j] = o1[64 * j]; }
                    if (i < 6) { nnw0 = tokw[row * 2 + 4]; nnw1 = tokw[row * 2 + 5]; nnp0 = tokp[row * 2 + 4]; nnp1 = tokp[row * 2 + 5]; } } }
            if (layer > 0) {
#pragma unroll
                for (int j = 0; j < 4; ++j) { const auto a0 = __builtin_amdgcn_cvt_pk_f32_fp8((int)oc0[j], false), a1 = __builtin_amdgcn_cvt_pk_f32_fp8((int)oc0[j], true), b0 = __builtin_amdgcn_cvt_pk_f32_fp8((int)oc1[j], false), b1 = __builtin_amdgcn_cvt_pk_f32_fp8((int)oc1[j], true);
                    v[j].x += w0 * a0[0] + w1 * b0[0]; v[j].y += w0 * a0[1] + w1 * b0[1]; v[j].z += w0 * a1[0] + w1 * b1[0]; v[j].w += w0 * a1[1] + w1 * b1[1]; }
                if (layer == 2) { GAS f32x4* xo = (GAS f32x4*)(A.out + (size_t)row * DM) + C.lane;
#pragma unroll
                    for (int j = 0; j < 4; ++j) xo[64 * j] = v[j]; }
                else { GAS u32x2* xo = (GAS u32x2*)((bf16*)A.out + (size_t)row * DM) + C.lane;
#pragma unroll
                    for (int j = 0; j < 4; ++j) { u32x2 o; o.x = pk2(v[j].x, v[j].y); o.y = pk2(v[j].z, v[j].w); xo[64 * j] = o; } }
            }
            if (layer < 2) {
                float ss = 0.f;
#pragma unroll
                for (int j = 0; j < 4; ++j) ss += (v[j].x * v[j].x + v[j].y * v[j].y) + (v[j].z * v[j].z + v[j].w * v[j].w);
                const float rstd = rsqrtf(wave_sum(ss) * (1.f / DM) + EPS);
                float gd[8];
#pragma unroll
                for (int q = 0; q < 8; ++q) gd[q] = 0.f;
                GAS u32x2* ho = (GAS u32x2*)(hb + (size_t)row * DM) + C.lane; GAS unsigned* h8o = (GAS unsigned*)(h8b + (size_t)row * DM) + C.lane;
#pragma unroll
                for (int j = 0; j < 4; ++j) { const f32x4 g = g1r[j];
                    const f32x4 h = {v[j].x * rstd * g.x, v[j].y * rstd * g.y, v[j].z * rstd * g.z, v[j].w * rstd * g.w};
                    u32x2 o; o.x = pk2(h.x, h.y); o.y = pk2(h.z, h.w); ho[64 * j] = o; h8o[64 * j] = pk4f8(h.x, h.y, h.z, h.w);
                    const int k = 256 * j + 4 * C.lane;
#pragma unroll
                    for (int c = 0; c < 4; ++c) { const f32x4 wa = *(const LAS f32x4*)(WG + (((j * 4 + c) * 64 + C.lane) << 2)), wb = *(const LAS f32x4*)(WG + 4096 + (((j * 4 + c) * 64 + C.lane) << 2));
                        gd[0] += h[c] * wa.x; gd[1] += h[c] * wa.y; gd[2] += h[c] * wa.z; gd[3] += h[c] * wa.w; gd[4] += h[c] * wb.x; gd[5] += h[c] * wb.y; gd[6] += h[c] * wb.z; gd[7] += h[c] * wb.w; } }
                float gv;
                { const bool b1 = C.lane & 1, b2 = C.lane & 2, b3 = C.lane & 4; float a4[4], a2[2];
#pragma unroll
                    for (int q = 0; q < 4; ++q) { const float mine = b1 ? gd[q + 4] : gd[q], send = b1 ? gd[q] : gd[q + 4]; a4[q] = mine + xor_shfl<1>(send); }
#pragma unroll
                    for (int q = 0; q < 2; ++q) { const float mine = b2 ? a4[q + 2] : a4[q], send = b2 ? a4[q] : a4[q + 2]; a2[q] = mine + xor_shfl<2>(send); }
                    { const float mine = b3 ? a2[1] : a2[0], send = b3 ? a2[0] : a2[1]; gv = mine + xor_shfl<4>(send); }
                    gv += xor_shfl<8>(gv); gv += xor_shfl<16>(gv); gv = pair_sum(gv); }
                if (C.lane < 8) { const int q = 4 * (C.lane & 1) + 2 * ((C.lane >> 1) & 1) + ((C.lane >> 2) & 1);
                    const float val = gv + gbq;
                    float r;
                    if (q < 4) r = 15.f * tanhf(val * (1.f / 15.f));
                    else r = (val < 0.f) ? (val - log1pf(expf(val))) : -log1pf(expf(-val));
                    GL[rl * 8 + q] = r; }
            }
        }
        if (layer < 2) {
            __syncthreads();
            if (C.wave < 4) { const int hh = C.wave, t = C.lane; const float lf = GL[t * 8 + 4 + hh], ig = GL[t * 8 + hh];
                float b = lf;
#pragma unroll
                for (int o = 1; o < 64; o <<= 1) { const float u = lane_up(b, t, o); if (t >= o) b += u; }
                const float bl = lane_get(b, 63); const float gm = wave_max(bl - b + ig);
                wsp<float>(C, WS_BC)[(size_t)(row0 + t) * 4 + hh] = b; wsp<float>(C, WS_IG)[(size_t)(row0 + t) * 4 + hh] = ig;
                if (t == 0) { const int bb = row0 / SEQ, c = (row0 % SEQ) / 64; wsp<float>(C, WS_BLAST)[(bb * 4 + hh) * 128 + c] = bl; wsp<float>(C, WS_GMAX)[(bb * 4 + hh) * 128 + c] = gm; } }
            __syncthreads();
        }
    }
}
__device__ __forceinline__ void mscan(const Ctx& C, int bh, LAS float* MV) {
    const GAS float* bl = (const GAS float*)(wsp<float>(C, WS_BLAST) + bh * 128); const GAS float* gm = (const GAS float*)(wsp<float>(C, WS_GMAX) + bh * 128); const int i = C.lane;
    const float a0 = bl[2 * i], g0 = gm[2 * i], a1 = bl[2 * i + 1], g1 = gm[2 * i + 1];
    float Aa = a0 + a1, Gg = fmaxf(g0 + a1, g1);
#pragma unroll
    for (int o = 1; o < 64; o <<= 1) { const float Ap = lane_up(Aa, i, o), Gp = lane_up(Gg, i, o); if (i >= o) { Gg = fmaxf(Gp + Aa, Gg); Aa = Ap + Aa; } }
    float Ax = lane_up(Aa, i, 1), Gx = lane_up(Gg, i, 1); if (i == 0) { Ax = 0.f; Gx = -INFINITY; }
    if (i == 0) MV[0] = 0.f;
    MV[2 * i + 1] = fmaxf(Ax + a0, fmaxf(Gx + a0, g0));
    MV[2 * i + 2] = fmaxf(Aa, Gg);
}
struct ConvU { u32x4 u[2][4]; };
struct ConvW { f32x4 w[4][2]; f32x4 b[2]; };
__device__ __forceinline__ void conv_issue_u(const Ctx& C, const bf16* src  , int row0, int seq0, ConvU& R) {
    const int ch = C.tid & 15;
#pragma unroll
    for (int i = 0; i < 2; ++i) { const int t = (C.tid + NTHR * i) >> 4;
#pragma unroll
        for (int j = 0; j < 4; ++j) { int row = row0 + t - j; row = row < seq0 ? seq0 : row; R.u[i][j] = *(const GAS u32x4*)(src + (size_t)row * 512 + ch * 8); } }
}
__device__ __forceinline__ void conv_issue_w(const Ctx& C, const float* cw  , const float* cb, ConvW& W) {
    const int ch = C.tid & 15;
#pragma unroll
    for (int j = 0; j < 4; ++j) { W.w[j][0] = *(const GAS f32x4*)(cw + j * 1024 + ch * 8); W.w[j][1] = *(const GAS f32x4*)(cw + j * 1024 + ch * 8 + 4); }
    W.b[0] = *(const GAS f32x4*)(cb + ch * 8); W.b[1] = *(const GAS f32x4*)(cb + ch * 8 + 4);
}
template <int ST> __device__ __forceinline__ void conv_finish(const Ctx& C, const ConvU& R, const ConvW& W, int row0, int seq0, const LAS float* rs, float sc, LAS unsigned char* dst, bf16* gdst = nullptr  ) {
    const int ch = C.tid & 15;
#pragma unroll
    for (int i = 0; i < 2; ++i) { const int t = (C.tid + NTHR * i) >> 4;
        float y[8] = {W.b[0].x, W.b[0].y, W.b[0].z, W.b[0].w, W.b[1].x, W.b[1].y, W.b[1].z, W.b[1].w};
#pragma unroll
        for (int j = 0; j < 4; ++j) { const float m = (row0 + t - j >= seq0) ? 1.f : 0.f; const u32x4 u = R.u[i][j]; const f32x4 w0 = W.w[j][0] * m, w1 = W.w[j][1] * m;
            y[0] += w0.x * bflo(u.x); y[1] += w0.y * bfhi(u.x); y[2] += w0.z * bflo(u.y); y[3] += w0.w * bfhi(u.y); y[4] += w1.x * bflo(u.z); y[5] += w1.y * bfhi(u.z); y[6] += w1.z * bflo(u.w); y[7] += w1.w * bfhi(u.w); }
#pragma unroll
        for (int q = 0; q < 8; ++q) y[q] = y[q] * sigm(y[q]) * sc;
        if (gdst) { u32x4 og; og.x = pk2(y[0], y[1]); og.y = pk2(y[2], y[3]); og.z = pk2(y[4], y[5]); og.w = pk2(y[6], y[7]); *(GAS u32x4*)(gdst + (size_t)(row0 + t) * 512 + ch * 8) = og; }
        if (rs) { const float s = rs[t];
#pragma unroll
            for (int q = 0; q < 8; ++q) y[q] *= s; }
        u32x4 o; o.x = pk2(y[0], y[1]); o.y = pk2(y[2], y[3]); o.z = pk2(y[4], y[5]); o.w = pk2(y[6], y[7]);
        *(LAS u32x4*)(dst + t * (ST * 2) + ch * 16) = o; }
}
template <int ST> __device__ __forceinline__ void stage_raw128(const Ctx& C, const bf16* src  , int row0, LAS unsigned char* dst) {
#pragma unroll
    for (int i = 0; i < 2; ++i) { const int task = C.tid + NTHR * i, t = task >> 4, ch = task & 15;
        *(LAS u32x4*)(dst + t * (ST * 2) + ch * 16) = *(const GAS u32x4*)(src + (size_t)(row0 + t) * 512 + ch * 8); }
}
__device__ __forceinline__ const LAS unsigned char* tr_addr(const LAS unsigned char* base, int stride_b, int r0, int c0, int lane) {
    return base + (r0 + ((lane & 15) >> 2)) * stride_b + (c0 + 16 * ((lane >> 4) & 1) + 4 * (lane & 3)) * 2;
}
constexpr int ML_MV = 0, ML_BC = 1024, ML_GS = 1280, ML_RS = 1536, ML_NV = 2048, ML_SC = 2560, ML_KT = 4608, ML_VT = ML_KT + 20480, ML_QT = ML_VT + 20480, ML_CT = ML_QT + 17408, ML_END = ML_CT + 34816, ML_OUT = ML_KT;
static_assert(ML_END <= RING_BYTES, "mLSTM LDS map");
__device__ __forceinline__ void mlstm_u_item(const Args& A, const Ctx& C0, int layer, int bh, int c, bool scan, bool pref  ) {
    Ctx C = C0; asm volatile("" : "+v"(C.tid), "+v"(C.lane));
    LAS float* MV = (LAS float*)(C.lds + ML_MV); LAS float* RS = (LAS float*)(C.lds + ML_RS);
    LAS unsigned char* KT = C.lds + ML_KT; LAS unsigned char* VT = C.lds + ML_VT;
    const int b = bh >> 2, hh = bh & 3, row0 = b * SEQ + c * 64, seq0 = b * SEQ, lane = C.lane, hi = lane >> 5, r32 = lane & 31;
    ConvU ku; ConvW kw; u32x4 vr[2]; float rbl = 0.f, rbc = 0.f, rig = 0.f;
    conv_issue_u(C, proj(C, PJ_AK) + hh * 128, row0, seq0, ku);
#pragma unroll
    for (int i = 0; i < 2; ++i) { const int task = C.tid + NTHR * i; vr[i] = *(const GAS u32x4*)(proj(C, PJ_AV) + hh * 128 + (size_t)(row0 + (task >> 4)) * 512 + (task & 15) * 8); }
    conv_issue_w(C, A.in[3] + layer * 4096 + 512 + hh * 128, A.in[4] + layer * 1024 + 512 + hh * 128, kw);
    if (C.tid < 64) { rbl = *(const GAS float*)(wsp<float>(C, WS_BLAST) + bh * 128 + c); rbc = *(const GAS float*)(wsp<float>(C, WS_BC) + (size_t)(row0 + C.tid) * 4 + hh); rig = *(const GAS float*)(wsp<float>(C, WS_IG) + (size_t)(row0 + C.tid) * 4 + hh); }
    if (scan) { if (C.wave == 0) mscan(C, bh, MV); __syncthreads(); }
    if (C.tid < 64) RS[C.tid] = __expf(rbl - rbc + rig - MV[c + 1]);
    __syncthreads();
    conv_finish<160>(C, ku, kw, row0, seq0, RS, 0.08838834764831845f, KT, wsp<bf16>(C, WS_KC) + hh * 128);
#pragma unroll
    for (int i = 0; i < 2; ++i) { const int task = C.tid + NTHR * i; *(LAS u32x4*)(VT + (task >> 4) * 320 + (task & 15) * 16) = vr[i]; }
    __syncthreads();
    unsigned pf0 = 0u;
    if (pref) { const int t = C.tid, rown = row0 + 64; const char* p0 = nullptr;
        if (t < 134) p0 = (const char*)(proj(C, PJ_AK) + (size_t)(rown - 3 + (t >> 1)) * 512 + hh * 128) + (t & 1) * 128;
        else if (t < 262) { const int q = t - 134; p0 = (const char*)(proj(C, PJ_AV) + (size_t)(rown + (q >> 1)) * 512 + hh * 128) + (q & 1) * 128; }
        else if (t < 270) p0 = (const char*)(wsp<float>(C, WS_BC) + (size_t)(rown + (t - 262) * 8) * 4);
        else if (t < 278) p0 = (const char*)(wsp<float>(C, WS_IG) + (size_t)(rown + (t - 270) * 8) * 4);
        if (p0) pf0 = *(const GAS unsigned*)p0; }
    const int eb = C.wave >> 1, db0 = (C.wave & 1) * 2;
    f32x16 acc0 = {}, acc1 = {};
#pragma unroll
    for (int st = 0; st < 4; ++st) { const int t0 = 16 * st + 8 * hi;
        const bf16x8 af = cat8(tr16(tr_addr(VT, 320, t0, 32 * eb, lane)), tr16(tr_addr(VT, 320, t0 + 4, 32 * eb, lane)));
        const bf16x8 b0 = cat8(tr16(tr_addr(KT, 320, t0, 32 * db0, lane)), tr16(tr_addr(KT, 320, t0 + 4, 32 * db0, lane)));
        const bf16x8 b1 = cat8(tr16(tr_addr(KT, 320, t0, 32 * db0 + 32, lane)), tr16(tr_addr(KT, 320, t0 + 4, 32 * db0 + 32, lane)));
        acc0 = MFMA32(af, b0, acc0); acc1 = MFMA32(af, b1, acc1); }
    bf16* U = wsp<bf16>(C, WS_HB) + (size_t)(bh * 128 + c) * 16384;
    if (C.tid < 128) { float s0 = 0.f, s1 = 0.f, s2 = 0.f, s3 = 0.f;
#pragma unroll
        for (int t = 0; t < 64; t += 4) { s0 += bflo((unsigned)*(const LAS bf16*)(KT + t * 320 + C.tid * 2)); s1 += bflo((unsigned)*(const LAS bf16*)(KT + (t + 1) * 320 + C.tid * 2));
            s2 += bflo((unsigned)*(const LAS bf16*)(KT + (t + 2) * 320 + C.tid * 2)); s3 += bflo((unsigned)*(const LAS bf16*)(KT + (t + 3) * 320 + C.tid * 2)); }
        wsp<float>(C, WS_NUC)[(size_t)(bh * 128 + c) * 128 + C.tid] = (s0 + s1) + (s2 + s3); }
    __syncthreads();
    { LAS bf16* US = (LAS bf16*)(C.lds + ML_KT);
#pragma unroll
        for (int r = 0; r < 16; ++r) { const int e = 32 * eb + crow(r, hi);
            US[e * 136 + 32 * db0 + r32] = (bf16)(pk2(acc0[r], 0.f) & 0xffffu); US[e * 136 + 32 * db0 + 32 + r32] = (bf16)(pk2(acc1[r], 0.f) & 0xffffu); }
        __syncthreads();
#pragma unroll
        for (int i = 0; i < 4; ++i) { const int task = C.tid + NTHR * i, e = task >> 4, ch = task & 15; *(GAS u32x4*)(U + e * 128 + ch * 8) = *(const LAS u32x4*)(US + e * 136 + ch * 8); } }
    asm volatile("" :: "v"(pf0));
    __syncthreads();
}
__device__ __forceinline__ void qknorm_rows(const Args& A, const Ctx& C, int layer) {
    const int gw = C.vcu * NWAVES + C.wave, NGW = C.G * NWAVES, lane = C.lane;
    for (int it = gw; it < NTOK * 4; it += NGW) { const int which = it & 3, row = it >> 2;
        bf16* p = proj(C, which == 0 ? PJ_BQ : which == 1 ? PJ_BK : which == 2 ? PJ_CQ : PJ_CK) + (size_t)row * 512 + lane * 8;
        const float* g = (which < 2 ? A.in[7] : A.in[9]) + layer * 128 + (which & 1) * 64 + (lane & 7) * 8;
        const u32x4 u = *(const GAS u32x4*)p; const f32x4 g0 = *(const GAS f32x4*)g, g1 = *(const GAS f32x4*)(g + 4);
        float v[8] = {bflo(u.x), bfhi(u.x), bflo(u.y), bfhi(u.y), bflo(u.z), bfhi(u.z), bflo(u.w), bfhi(u.w)}; float ss = 0.f;
#pragma unroll
        for (int i = 0; i < 8; ++i) ss += v[i] * v[i];
        ss += xor_shfl<1>(ss); ss += xor_shfl<2>(ss); ss += xor_shfl<4>(ss);
        const float rinv = rsqrtf(ss * (1.f / 64.f) + EPS) * ((which & 1) ? 1.f : 0.125f * LOG2E);
        const u32x4 o = {pk2(v[0] * rinv * g0.x, v[1] * rinv * g0.y), pk2(v[2] * rinv * g0.z, v[3] * rinv * g0.w), pk2(v[4] * rinv * g1.x, v[5] * rinv * g1.y), pk2(v[6] * rinv * g1.z, v[7] * rinv * g1.w)};
        *(GAS u32x4*)p = o; }
}
__device__ __forceinline__ void mlstm_scan(const Ctx& C) {
    LAS float* MV = (LAS float*)(C.lds + ML_MV); LAS float* DEC = (LAS float*)(C.lds + ML_RS);
    for (int w = C.vcu; w < 256; w += C.G) { const int bh = w >> 4, sl = w & 15;
        if (C.wave == 0) mscan(C, bh, MV);
        __syncthreads();
        if (C.tid < 128) DEC[C.tid] = __expf(wsp<float>(C, WS_BLAST)[bh * 128 + C.tid] + MV[C.tid] - MV[C.tid + 1]);
        __syncthreads();
        GAS unsigned* p = (GAS unsigned*)(wsp<unsigned>(C, WS_HB) + (size_t)bh * 128 * 8192 + sl * 512 + C.tid);
        float s0 = 0.f, s1 = 0.f;
        for (int c0 = 0; c0 < 128; c0 += 32) { unsigned u[32];
#pragma unroll
            for (int q = 0; q < 32; ++q) u[q] = p[(size_t)(c0 + q) * 8192];
#pragma unroll
            for (int q = 0; q < 32; ++q) { p[(size_t)(c0 + q) * 8192] = pk2(s0, s1); const float d = DEC[c0 + q]; s0 = d * s0 + bflo(u[q]); s1 = d * s1 + bfhi(u[q]); } }
        if (sl == 0 && C.tid < 128) { GAS float* np = (GAS float*)(wsp<float>(C, WS_NUC) + (size_t)bh * 128 * 128 + C.tid); float s = 0.f;
            for (int c0 = 0; c0 < 128; c0 += 16) { float u[16];
#pragma unroll
                for (int q = 0; q < 16; ++q) u[q] = np[(c0 + q) * 128];
#pragma unroll
                for (int q = 0; q < 16; ++q) { np[(c0 + q) * 128] = s; s = DEC[c0 + q] * s + u[q]; } } }
        __syncthreads();
    }
}
__device__ __forceinline__ void mlstm_out_item(const Args& A, const Ctx& C0, int layer, int bh, int c, bool scan, bool pref  , bf16* habase = nullptr  ) {
    Ctx C = C0; asm volatile("" : "+v"(C.tid), "+v"(C.lane));
    LAS float* MV = (LAS float*)(C.lds + ML_MV); LAS float* BC = (LAS float*)(C.lds + ML_BC); LAS float* GS = (LAS float*)(C.lds + ML_GS); LAS float* NV = (LAS float*)(C.lds + ML_NV);
    LAS float* SC = (LAS float*)(C.lds + ML_SC) + C.wave * 64;
    LAS unsigned char* KT = C.lds + ML_KT; LAS unsigned char* VT = C.lds + ML_VT; LAS unsigned char* QT = C.lds + ML_QT; LAS unsigned char* CT = C.lds + ML_CT; LAS float* OUT = (LAS float*)(C.lds + ML_OUT);
    const int b = bh >> 2, hh = bh & 3, row0 = b * SEQ + c * 64, seq0 = b * SEQ, lane = C.lane, hi = lane >> 5, r32 = lane & 31;
    ConvU qu; ConvW qw; u32x4 vr[2], kr[2], cr[4]; float r0_ = 0.f, r1_ = 0.f;
    conv_issue_u(C, proj(C, PJ_AQ) + hh * 128, row0, seq0, qu);
#pragma unroll
    for (int i = 0; i < 2; ++i) { const int task = C.tid + NTHR * i; vr[i] = *(const GAS u32x4*)(proj(C, PJ_AV) + hh * 128 + (size_t)(row0 + (task >> 4)) * 512 + (task & 15) * 8);
        kr[i] = *(const GAS u32x4*)(wsp<bf16>(C, WS_KC) + hh * 128 + (size_t)(row0 + (task >> 4)) * 512 + (task & 15) * 8); }
    { const bf16* cs = wsp<bf16>(C, WS_HB) + (size_t)(bh * 128 + c) * 16384;
#pragma unroll
        for (int i = 0; i < 4; ++i) { const int task = C.tid + NTHR * i; cr[i] = *(const GAS u32x4*)(cs + (task >> 4) * 128 + (task & 15) * 8); } }
    if (C.tid >= 64 && C.tid < 128) { const int t = C.tid - 64; r0_ = *(const GAS float*)(wsp<float>(C, WS_BC) + (size_t)(row0 + t) * 4 + hh); r1_ = *(const GAS float*)(wsp<float>(C, WS_IG) + (size_t)(row0 + t) * 4 + hh); }
    if (C.tid >= 128 && C.tid < 256) r0_ = *(const GAS float*)(wsp<float>(C, WS_NUC) + (size_t)(bh * 128 + c) * 128 + C.tid - 128);
    conv_issue_w(C, A.in[3] + layer * 4096 + hh * 128, A.in[4] + layer * 1024 + hh * 128, qw);
    if (scan && C.wave == 0) mscan(C, bh, MV);
    conv_finish<136>(C, qu, qw, row0, seq0, nullptr, 1.f, QT);
#pragma unroll
    for (int i = 0; i < 2; ++i) { const int task = C.tid + NTHR * i; *(LAS u32x4*)(VT + (task >> 4) * 320 + (task & 15) * 16) = vr[i]; *(LAS u32x4*)(KT + (task >> 4) * 272 + (task & 15) * 16) = kr[i]; }
#pragma unroll
    for (int i = 0; i < 4; ++i) { const int task = C.tid + NTHR * i; *(LAS u32x4*)(CT + (task >> 4) * 272 + (task & 15) * 16) = cr[i]; }
    if (C.tid >= 64 && C.tid < 128) { BC[C.tid - 64] = r0_; GS[C.tid - 64] = r1_ - r0_; }
    if (C.tid >= 128 && C.tid < 256) NV[C.tid - 128] = r0_;
    __syncthreads();
    unsigned pf0 = 0u, pf1 = 0u;
    { const int t = C.tid; const char* p0 = nullptr; const char* p1 = nullptr;
        if (t < 128) p0 = (const char*)(proj(C, PJ_AO) + (size_t)(row0 + (t >> 1)) * 512 + hh * 128) + (t & 1) * 128;
        if (pref) { const int rown = row0 + 64;
            if (t >= 128 && t < 262) { const int q = t - 128; p0 = (const char*)(proj(C, PJ_AQ) + (size_t)(rown - 3 + (q >> 1)) * 512 + hh * 128) + (q & 1) * 128; }
            else if (t >= 262 && t < 390) { const int q = t - 262; p0 = (const char*)(wsp<bf16>(C, WS_KC) + (size_t)(rown + (q >> 1)) * 512 + hh * 128) + (q & 1) * 128; }
            else if (t >= 396) { const int q = t - 396; p0 = (const char*)(proj(C, PJ_AV) + (size_t)(rown + (q >> 1)) * 512 + hh * 128) + (q & 1) * 128; }
            if (t < 12) { const int q = t + 116; p1 = (const char*)(proj(C, PJ_AV) + (size_t)(rown + (q >> 1)) * 512 + hh * 128) + (q & 1) * 128; }
            else if (t < 268) p1 = (const char*)(wsp<bf16>(C, WS_HB) + (size_t)(bh * 128 + c + 1) * 16384) + (t - 12) * 128; }
        if (p0) pf0 = *(const GAS unsigned*)p0;
        if (p1) pf1 = *(const GAS unsigned*)p1; }
    const float mc = MV[c]; const int lb = C.wave >> 2, cb = C.wave & 3, lq = 32 * lb + r32; const float bl = BC[lq];
    bf16x8 qf[8];
#pragma unroll
    for (int st = 0; st < 8; ++st) qf[st] = *(const LAS bf16x8*)(QT + lq * 272 + (16 * st + 8 * hi) * 2);
    f32x16 p0 = {}, p1 = {};
#pragma unroll
    for (int st = 0; st < 8; ++st) p0 = MFMA32(*(const LAS bf16x8*)(KT + r32 * 272 + (16 * st + 8 * hi) * 2), qf[st], p0);
    if (lb == 1) {
#pragma unroll
        for (int st = 0; st < 8; ++st) p1 = MFMA32(*(const LAS bf16x8*)(KT + (32 + r32) * 272 + (16 * st + 8 * hi) * 2), qf[st], p1); }
    f32x16 d0, d1; float mt = bl + mc;
    f32x4 gsa[4], gsb[4];
#pragma unroll
    for (int k = 0; k < 4; ++k) { gsa[k] = *(const LAS f32x4*)(GS + 8 * k + 4 * hi); gsb[k] = *(const LAS f32x4*)(GS + 32 + 8 * k + 4 * hi); }
#pragma unroll
    for (int r = 0; r < 16; ++r) { const int s = crow(r, hi); const float g = gsa[r >> 2][r & 3]; d0[r] = (s <= lq) ? bl + g : -INFINITY; mt = fmaxf(mt, d0[r]); }
#pragma unroll
    for (int r = 0; r < 16; ++r) { const int s = 32 + crow(r, hi); const float g = gsb[r >> 2][r & 3]; d1[r] = (lb == 1 && s <= lq) ? bl + g : -INFINITY; mt = fmaxf(mt, d1[r]); }
    mt = pair_max(mt);
    float rs = 0.f;
#pragma unroll
    for (int r = 0; r < 16; ++r) { p0[r] *= __expf(d0[r] - mt); p1[r] *= __expf(d1[r] - mt); rs += p0[r] + p1[r]; }
    rs = pair_sum(rs);
    float qn = 0.f;
#pragma unroll
    for (int st = 0; st < 8; ++st) { const f32x4 n0 = *(const LAS f32x4*)(NV + 16 * st + 8 * hi), n1 = *(const LAS f32x4*)(NV + 16 * st + 8 * hi + 4); const u32x4 q = __builtin_bit_cast(u32x4, qf[st]);
        qn += bflo(q.x) * n0.x + bfhi(q.x) * n0.y + bflo(q.y) * n0.z + bfhi(q.y) * n0.w + bflo(q.z) * n1.x + bfhi(q.z) * n1.y + bflo(q.w) * n1.z + bfhi(q.w) * n1.w; }
    qn = pair_sum(qn);
    const float wi = __expf(bl + mc - mt), den = wi * qn + rs, dn = fmaxf(fabsf(den), __expf(-mt));
    SC[r32] = wi / dn; SC[32 + r32] = 1.f / dn;
    f32x16 acc1 = {}, acc2 = {};
#define PKF(P, B) (bf16x8)__builtin_bit_cast(bf16x8, ((u32x4){pk2(P[B], P[B + 1]), pk2(P[B + 2], P[B + 3]), pk2(P[B + 4], P[B + 5]), pk2(P[B + 6], P[B + 7])}))
#pragma unroll
    for (int s2 = 0; s2 < 2; ++s2) { const int k0 = 16 * s2;
        const bf16x8 vf = cat8(tr16(tr_addr(VT, 320, k0 + 4 * hi, 32 * cb, lane)), tr16(tr_addr(VT, 320, k0 + 8 + 4 * hi, 32 * cb, lane)));
        acc2 = MFMA32(s2 == 0 ? PKF(p0, 0) : PKF(p0, 8), vf, acc2); }
    if (lb == 1) {
#pragma unroll
        for (int s2 = 0; s2 < 2; ++s2) { const int k0 = 32 + 16 * s2;
            const bf16x8 vf = cat8(tr16(tr_addr(VT, 320, k0 + 4 * hi, 32 * cb, lane)), tr16(tr_addr(VT, 320, k0 + 8 + 4 * hi, 32 * cb, lane)));
            acc2 = MFMA32(s2 == 0 ? PKF(p1, 0) : PKF(p1, 8), vf, acc2); } }
#undef PKF
#pragma unroll
    for (int st = 0; st < 8; ++st) acc1 = MFMA32(qf[st], *(const LAS bf16x8*)(CT + (32 * cb + r32) * 272 + (16 * st + 8 * hi) * 2), acc1);
    const int frow = C.tid >> 3, fseg = C.tid & 7; u32x4 aor[2]; f32x4 gnr[4];
    { const float* gn = A.in[6] + layer * 512 + hh * 128 + fseg * 16; const bf16* ao = proj(C, PJ_AO) + (size_t)(row0 + frow) * 512 + hh * 128 + fseg * 16;
#pragma unroll
        for (int q = 0; q < 2; ++q) { aor[q] = *(const GAS u32x4*)(ao + 8 * q); gnr[2 * q] = *(const GAS f32x4*)(gn + 8 * q); gnr[2 * q + 1] = *(const GAS f32x4*)(gn + 8 * q + 4); } }
    __syncthreads();
#pragma unroll
    for (int r = 0; r < 16; ++r) { const int l_ = crow(r, hi); OUT[(32 * lb + l_) * 132 + 32 * cb + r32] = SC[l_] * acc1[r] + SC[32 + l_] * acc2[r]; }
    __syncthreads();
    { const int row = C.tid >> 3, seg = C.tid & 7; float v[16]; float ss = 0.f;
#pragma unroll
        for (int q = 0; q < 4; ++q) { const f32x4 x = *(const LAS f32x4*)(OUT + row * 132 + seg * 16 + 4 * q); v[4 * q] = x.x; v[4 * q + 1] = x.y; v[4 * q + 2] = x.z; v[4 * q + 3] = x.w; ss += (x.x * x.x + x.y * x.y) + (x.z * x.z + x.w * x.w); }
        ss += xor_shfl<1>(ss); ss += xor_shfl<2>(ss); ss += xor_shfl<4>(ss);
        const float rinv = rsqrtf(ss * (1.f / 128.f) + EPS);
        bf16* ha = (habase ? habase : proj(C, PJ_AV)) + (size_t)(row0 + row) * 512 + hh * 128 + seg * 16;
#pragma unroll
        for (int q = 0; q < 2; ++q) { const u32x4 a = aor[q]; const f32x4 g0 = gnr[2 * q], g1 = gnr[2 * q + 1]; const float* vv = v + 8 * q;
            u32x4 o; o.x = pk2(vv[0] * rinv * g0.x * sigm(bflo(a.x)), vv[1] * rinv * g0.y * sigm(bfhi(a.x))); o.y = pk2(vv[2] * rinv * g0.z * sigm(bflo(a.y)), vv[3] * rinv * g0.w * sigm(bfhi(a.y)));
            o.z = pk2(vv[4] * rinv * g1.x * sigm(bflo(a.z)), vv[5] * rinv * g1.y * sigm(bfhi(a.z))); o.w = pk2(vv[6] * rinv * g1.z * sigm(bflo(a.w)), vv[7] * rinv * g1.w * sigm(bfhi(a.w)));
            *(GAS u32x4*)(ha + 8 * q) = o; } }
    asm volatile("" :: "v"(pf0), "v"(pf1));
    __syncthreads();
}
#ifdef AT_SETPRIO
#define AT_PRIO(p_) __builtin_amdgcn_s_setprio(p_)
#else
#define AT_PRIO(p_) do {} while (0)
#endif
#ifdef AT_PV_ALIGNED
#define AT_PVALIGN(n_) do { __builtin_amdgcn_s_waitcnt(0xC07F | ((n_) << 8)); asm volatile(".p2align 3"); __builtin_amdgcn_sched_barrier(0); } while (0)
#else
#define AT_PVALIGN(n_) do {} while (0)
#endif
#ifdef AT_QK_ALIGNED
#define AT_QKALIGN do { __builtin_amdgcn_s_waitcnt(0xC07F); asm volatile(".p2align 3"); __builtin_amdgcn_sched_barrier(0); } while (0)
#else
#define AT_QKALIGN do {} while (0)
#endif
constexpr int AT_TAB = 0, AT_SCR = 4096, AT_K = 6144;
template <int DV, bool ISC, bool FUSE5 = false> __device__ __forceinline__ void attn_unit(const Args& A, const Ctx& C0, int layer, int b, int hs, int qblk, bf16* obase = nullptr  ) {
    Ctx C = C0; asm volatile("" : "+v"(C.tid), "+v"(C.lane));
    constexpr int KSTB = 144, VSTB = 2 * DV + 64, KB = 64 * KSTB, VB = 64 * VSTB, AT_V = AT_K + 4 * KB, NBLK = DV / 32;
    static_assert(AT_V + 4 * VB <= RING_BYTES, "attention LDS map");
    LAS float* TAB = (LAS float*)(C.lds + AT_TAB); LAS float* SCR = (LAS float*)(C.lds + AT_SCR) + C.wave * 64;
    const int lane = C.lane, hi = lane >> 5, r32 = lane & 31, tid = C.tid;
    const bf16 *Qp, *Kp, *Vp; bf16* Op; int pitchO; const float *gq, *gk; int hbias;
    if (ISC) { const int h = hs >> 1, wh = hs & 1; Qp = proj(C, PJ_CQ) + h * 128 + wh * 64; Kp = proj(C, PJ_CK) + h * 128 + wh * 64; Vp = proj(C, PJ_CV) + h * 128;
        Op = wsp<bf16>(C, WS_O12) + h * 256 + wh * 128; pitchO = 1024; gq = A.in[9] + layer * 128; gk = gq + 64; hbias = h; }
    else { Qp = proj(C, PJ_BQ) + hs * 64; Kp = proj(C, PJ_BK) + hs * 64; Vp = proj(C, PJ_BV) + hs * 64; Op = (obase ? obase : proj(C, PJ_BQ)) + hs * 64; pitchO = 512; gq = A.in[7] + layer * 128; gk = gq + 64; hbias = hs; }
    const size_t rowb = (size_t)b * SEQ;
    const int qs0 = qblk * 256 + C.wave * 32;
    const int krow = tid >> 3, kch = tid & 7;
    const int jhi = qblk * 4 + 3, jlo = ISC ? 0 : (qblk * 4 - 8 < 0 ? 0 : qblk * 4 - 8), cqw = qblk * 4 + (C.wave >> 1);
    const bf16* ksrc = Kp + (rowb + krow) * 512 + kch * 8;
    u32x4 kregA, kregB, vregA[NBLK / 2], vregB[NBLK / 2];
#define AT_LOADT(j, KR, VR) do { KR = *(const GAS u32x4*)(ksrc + (size_t)(j) * 64 * 512); \
        if (DV == 128) { _Pragma("unroll") for (int i_ = 0; i_ < 2; ++i_) { const int idx = tid + NTHR * i_; VR[i_] = *(const GAS u32x4*)(Vp + (rowb + (size_t)(j) * 64 + (idx >> 4)) * 512 + (idx & 15) * 8); } } \
        else VR[0] = *(const GAS u32x4*)(Vp + (rowb + (size_t)(j) * 64 + krow) * 512 + kch * 8); } while (0)
    const GAS float* tsrc = (const GAS float*)(ISC ? A.in[12] : A.in[8] + (size_t)layer * 513 * 8);
#define AT_TIDX(i_, out_) do { const int d_ = 703 - (i_); \
        if (ISC) { const int n_ = d_ < 0 ? -d_ : d_; int bk_ = n_ < 8 ? n_ : n_ < 15 ? 8 : n_ < 27 ? 9 : n_ < 50 ? 10 : n_ < 91 ? 11 : n_ < 166 ? 12 : n_ < 305 ? 13 : n_ < 559 ? 14 : 15; if (d_ < 0) bk_ += 16; out_ = bk_ * 4 + hbias; } \
        else { const int dc_ = d_ < -256 ? -256 : d_ > 256 ? 256 : d_; out_ = (dc_ + 256) * 8 + hbias; } } while (0)
    int ti0, ti1; AT_TIDX(tid, ti0); AT_TIDX(tid + 512, ti1);
    const float tv0 = tsrc[ti0], tv1 = tsrc[ti1];
#undef AT_TIDX
    const float gqv = *(const GAS float*)(gq + lane), gkv = *(const GAS float*)(gk + lane);
    float bmr[9];
#pragma unroll
    for (int k = 0; k < 9; ++k) bmr[k] = 0.f;
    if (ISC) bmr[0] = tsrc[(lane & 31) * 4 + hbias];
    else {
#pragma unroll
        for (int k = 0; k < 9; ++k) { const int i = lane + 64 * k; bmr[k] = tsrc[(i < 513 ? i : 512) * 8 + hbias]; } }
    u32x4 qraw[4]; f32x4 gg[4][4];
    { const bf16* qrow = Qp + (rowb + qs0 + r32) * 512 + 8 * hi;
#pragma unroll
        for (int st = 0; st < 4; ++st) qraw[st] = *(const GAS u32x4*)(qrow + 16 * st);
#pragma unroll
        for (int st = 0; st < 4; ++st) { gg[st][0] = *(const GAS f32x4*)(gq + 16 * st + 8 * hi); gg[st][1] = *(const GAS f32x4*)(gq + 16 * st + 8 * hi + 4); gg[st][2] = *(const GAS f32x4*)(gk + 16 * st + 8 * hi); gg[st][3] = *(const GAS f32x4*)(gk + 16 * st + 8 * hi + 4); } }
    AT_LOADT(jlo, kregA, vregA); AT_LOADT(jlo + 1, kregB, vregB);
    float MB;
    { const float gqm = wave_max(fabsf(gqv)), gkm = wave_max(fabsf(gkv));
        float bm = 0.f;
#pragma unroll
        for (int k = 0; k < 9; ++k) bm = fmaxf(bm, fabsf(bmr[k]));
        bm = wave_max(bm);
        MB = 64.f * (0.125f * LOG2E) * gqm * gkm * 1.02f + bm * LOG2E; }
    TAB[tid] = tv0 * LOG2E - MB; TAB[tid + 512] = tv1 * LOG2E - MB;
    bf16x8 qf[4];
    { float qv[32]; float ss = 0.f;
#pragma unroll
        for (int st = 0; st < 4; ++st) { const u32x4 u = qraw[st];
            qv[8 * st] = bflo(u.x); qv[8 * st + 1] = bfhi(u.x); qv[8 * st + 2] = bflo(u.y); qv[8 * st + 3] = bfhi(u.y); qv[8 * st + 4] = bflo(u.z); qv[8 * st + 5] = bfhi(u.z); qv[8 * st + 6] = bflo(u.w); qv[8 * st + 7] = bfhi(u.w); }
#pragma unroll
        for (int i = 0; i < 32; ++i) ss += qv[i] * qv[i];
        ss = pair_sum(ss);
        const float rinv = rsqrtf(ss * (1.f / 64.f) + EPS) * (0.125f * LOG2E);
#pragma unroll
        for (int st = 0; st < 4; ++st) { const f32x4 g0 = gg[st][0] * gg[st][2], g1 = gg[st][1] * gg[st][3]; const float* q = qv + 8 * st;
            const u32x4 o = {pk2(q[0] * rinv * g0.x, q[1] * rinv * g0.y), pk2(q[2] * rinv * g0.z, q[3] * rinv * g0.w), pk2(q[4] * rinv * g1.x, q[5] * rinv * g1.y), pk2(q[6] * rinv * g1.z, q[7] * rinv * g1.w)};
            qf[st] = __builtin_bit_cast(bf16x8, o); } }
    float l = 0.f; f32x16 o[NBLK];
#pragma unroll
    for (int nb = 0; nb < NBLK; ++nb) o[nb] = f32x16{};
#define AT_VLOAD(F, nb_) do { _Pragma("unroll") for (int ks_ = 0; ks_ < 4; ++ks_) { F[2 * ks_] = tr16(vb_ + (16 * ks_) * VSTB + (nb_) * 64); F[2 * ks_ + 1] = tr16(vb_ + (16 * ks_ + 8) * VSTB + (nb_) * 64); } } while (0)
#define AT_STAGE(buf, KR, VR) do { \
        LAS unsigned char* KT = C.lds + AT_K + (buf) * KB; LAS unsigned char* VT = C.lds + AT_V + (buf) * VB; \
        { float kv[8] = {bflo(KR.x), bfhi(KR.x), bflo(KR.y), bfhi(KR.y), bflo(KR.z), bfhi(KR.z), bflo(KR.w), bfhi(KR.w)}; float ss = 0.f; \
            _Pragma("unroll") for (int i = 0; i < 8; ++i) ss += kv[i] * kv[i]; \
            ss += xor_shfl<1>(ss); ss += xor_shfl<2>(ss); ss += xor_shfl<4>(ss); \
            const float rinv = rsqrtf(ss * (1.f / 64.f) + EPS); \
            const u32x4 w = {pk2(kv[0] * rinv, kv[1] * rinv), pk2(kv[2] * rinv, kv[3] * rinv), pk2(kv[4] * rinv, kv[5] * rinv), pk2(kv[6] * rinv, kv[7] * rinv)}; \
            *(LAS u32x4*)(KT + krow * KSTB + kch * 16) = w; } \
        if (DV == 128) { _Pragma("unroll") for (int i_ = 0; i_ < 2; ++i_) { const int idx = tid + NTHR * i_; *(LAS u32x4*)(VT + (idx >> 4) * VSTB + (idx & 15) * 16) = VR[i_]; } } \
        else *(LAS u32x4*)(VT + krow * VSTB + kch * 16) = VR[0]; \
    } while (0)
#define AT_COMP(j, buf) do { \
        LAS unsigned char* KT = C.lds + AT_K + (buf) * KB; LAS unsigned char* VT = C.lds + AT_V + (buf) * VB; \
        const bool act = ((j) <= cqw) && (ISC || (j) >= cqw - 8); \
        if (act) { \
            f32x16 p0, p1; \
            { int ti_ = 703 - (qs0 + r32) + 64 * (j) + 4 * hi; if (ISC) ti_ = ti_ < 0 ? 0 : ti_;        \
                const LAS float* tp = TAB + ti_; \
                _Pragma("unroll") for (int r = 0; r < 16; ++r) { p0[r] = tp[(r & 3) + 8 * (r >> 2)]; p1[r] = tp[32 + (r & 3) + 8 * (r >> 2)]; } } \
            { bf16x8 kf[8]; \
                _Pragma("unroll") for (int st = 0; st < 4; ++st) { kf[2 * st] = *(const LAS bf16x8*)(KT + r32 * KSTB + (16 * st + 8 * hi) * 2); kf[2 * st + 1] = *(const LAS bf16x8*)(KT + (32 + r32) * KSTB + (16 * st + 8 * hi) * 2); } \
                __builtin_amdgcn_sched_barrier(0);        \
                AT_QKALIGN; \
                AT_PRIO(1); _Pragma("unroll") for (int st = 0; st < 4; ++st) { p0 = MFMA32(kf[2 * st], qf[st], p0); p1 = MFMA32(kf[2 * st + 1], qf[st], p1); } AT_PRIO(0); } \
            float rs0 = 0.f, rs1 = 0.f, rs2 = 0.f, rs3 = 0.f;        \
            _Pragma("unroll") for (int r = 0; r < 16; r += 2) { p0[r] = __builtin_amdgcn_exp2f(p0[r]); p1[r] = __builtin_amdgcn_exp2f(p1[r]); p0[r + 1] = __builtin_amdgcn_exp2f(p0[r + 1]); p1[r + 1] = __builtin_amdgcn_exp2f(p1[r + 1]); \
                rs0 += p0[r]; rs1 += p1[r]; rs2 += p0[r + 1]; rs3 += p1[r + 1]; } \
            l += (rs0 + rs1) + (rs2 + rs3); \
            bf16x8 pw[4]; \
            pw[0] = PKF(p0, 0); pw[1] = PKF(p0, 8); pw[2] = PKF(p1, 0); pw[3] = PKF(p1, 8); \
            { s16x4 fa[8], fb[8]; const LAS unsigned char* vb_ = tr_addr(VT, VSTB, 4 * hi, 0, lane);        \
                AT_VLOAD(fa, 0); AT_VLOAD(fb, 1); __builtin_amdgcn_sched_barrier(0); \
                if constexpr (NBLK == 4) { s16x4 ga[8], gb[8]; \
                    AT_PRIO(1); _Pragma("unroll") for (int ks = 0; ks < 4; ++ks) { o[0] = MFMA32(pw[ks], cat8(fa[2 * ks], fa[2 * ks + 1]), o[0]); o[1] = MFMA32(pw[ks], cat8(fb[2 * ks], fb[2 * ks + 1]), o[1]); \
                        ga[2 * ks] = tr16(vb_ + (16 * ks) * VSTB + 2 * 64); ga[2 * ks + 1] = tr16(vb_ + (16 * ks + 8) * VSTB + 2 * 64); gb[2 * ks] = tr16(vb_ + (16 * ks) * VSTB + 3 * 64); gb[2 * ks + 1] = tr16(vb_ + (16 * ks + 8) * VSTB + 3 * 64); \
                        __builtin_amdgcn_sched_barrier(0); } \
                    _Pragma("unroll") for (int ks = 0; ks < 4; ++ks) { o[2] = MFMA32(pw[ks], cat8(ga[2 * ks], ga[2 * ks + 1]), o[2]); o[3] = MFMA32(pw[ks], cat8(gb[2 * ks], gb[2 * ks + 1]), o[3]); } AT_PRIO(0); \
                } else { \
                    AT_PRIO(1); _Pragma("unroll") for (int ks = 0; ks < 4; ++ks) { o[0] = MFMA32(pw[ks], cat8(fa[2 * ks], fa[2 * ks + 1]), o[0]); o[1] = MFMA32(pw[ks], cat8(fb[2 * ks], fb[2 * ks + 1]), o[1]); } AT_PRIO(0); } \
                __builtin_amdgcn_sched_barrier(0); } \
        } } while (0)
#define PKF(P, B) __builtin_bit_cast(bf16x8, ((u32x4){pk2(P[B], P[B + 1]), pk2(P[B + 2], P[B + 3]), pk2(P[B + 4], P[B + 5]), pk2(P[B + 6], P[B + 7])}))
    AT_ALIGN_ASM;
    for (int j = jlo; j <= jhi; j += 2) { const int sb = (((j - jlo) >> 1) & 1) * 2;
        AT_STAGE(sb, kregA, vregA); AT_STAGE(sb + 1, kregB, vregB);
        __syncthreads();
        if (j + 2 <= jhi) { AT_LOADT(j + 2, kregA, vregA); AT_LOADT(j + 3, kregB, vregB); }
        AT_COMP(j, sb); AT_COMP(j + 1, sb + 1); }
#undef PKF
#undef AT_STAGE
#undef AT_COMP
#undef AT_VLOAD
#undef AT_LOADT
    l = pair_sum(l);
    SCR[32 + r32] = 1.f / l;
    bf16* orow = Op + (rowb + qs0) * pitchO;
    if (ISC && FUSE5 && (hs & 1)) {
        const float lam_init = 0.8f - 0.6f * __expf(-0.3f * (float)layer), post = 1.f - lam_init;
        const GAS float* cl = (const GAS float*)(A.in[10] + layer * 256); const GAS float* gs = (const GAS float*)(A.in[11] + layer * 128);
        const GAS bf16* o1p = (const GAS bf16*)(wsp<bf16>(C, WS_O12) + (hs >> 1) * 256 + (rowb + qs0) * 1024);
        GAS bf16* hcp = (GAS bf16*)(proj(C, PJ_CQ) + (hs >> 1) * 128 + (rowb + qs0) * 512);
        const float c0 = cl[lane], c1 = cl[64 + lane], c2 = cl[128 + lane], c3 = cl[192 + lane];
        float gsv[NBLK]; bf16 o1v[16][NBLK];
#pragma unroll
        for (int nb = 0; nb < NBLK; ++nb) gsv[nb] = gs[32 * nb + r32];
#pragma unroll
        for (int r = 0; r < 16; ++r)
#pragma unroll
            for (int nb = 0; nb < NBLK; ++nb) o1v[r][nb] = __hip_atomic_load(o1p + (size_t)crow(r, hi) * 1024 + 32 * nb + r32, __ATOMIC_RELAXED, __HIP_MEMORY_SCOPE_AGENT);
        const float lam = __expf(wave_sum(c0 * c1)) - __expf(wave_sum(c2 * c3)) + lam_init;
#pragma unroll
        for (int r = 0; r < 16; ++r) { const int q = crow(r, hi); const float rl = SCR[32 + q] * lam; float d[NBLK]; float ss = 0.f;
#pragma unroll
            for (int nb = 0; nb < NBLK; ++nb) { d[nb] = bflo((unsigned)o1v[r][nb]) - o[nb][r] * rl; ss += d[nb] * d[nb]; }
            ss += xor_shfl<1>(ss); ss += xor_shfl<2>(ss); ss += xor_shfl<4>(ss); ss += xor_shfl<8>(ss); ss += xor_shfl<16>(ss);
            const float rinv = rsqrtf(ss * (1.f / 128.f) + EPS) * post;
#pragma unroll
            for (int nb = 0; nb < NBLK; ++nb) hcp[(size_t)q * 512 + 32 * nb + r32] = (bf16)(pk2(d[nb] * rinv * gsv[nb], 0.f) & 0xffffu); }
    } else {
#pragma unroll
    for (int r = 0; r < 16; ++r) { const int q = crow(r, hi); const float rl = SCR[32 + q];
#pragma unroll
        for (int nb = 0; nb < NBLK; ++nb) ((GAS bf16*)orow)[(size_t)q * pitchO + 32 * nb + r32] = (bf16)(pk2(o[nb][r] * rl, 0.f) & 0xffffu); }
    }
    __syncthreads();
}
__device__ __forceinline__ void phase5(const Args& A, const Ctx& C, int layer) {
    const int gw = C.vcu * NWAVES + C.wave, NGW = C.G * NWAVES, lane = C.lane;
    const float lam_init = 0.8f - 0.6f * __expf(-0.3f * (float)layer);
    const float* cl = A.in[10] + layer * 256;
    const float lam = __expf(wave_sum(cl[lane] * cl[64 + lane])) - __expf(wave_sum(cl[128 + lane] * cl[192 + lane])) + lam_init;
    const float* gs = A.in[11] + layer * 128 + (lane & 15) * 8;
    const f32x4 gs0 = *(const GAS f32x4*)gs, gs1 = *(const GAS f32x4*)(gs + 4);
    const float post = 1.f - lam_init;
    const bf16* o12 = wsp<bf16>(C, WS_O12); bf16* hc = proj(C, PJ_CQ);
    const int h = lane >> 4, e0 = (lane & 15) * 8;
    for (int row0 = gw; row0 < NTOK; row0 += 8 * NGW) {
        u32x4 av[8], bv[8];
#pragma unroll
        for (int q = 0; q < 8; ++q) { const int row = row0 + q * NGW; if (row < NTOK) { av[q] = *(const GAS u32x4*)(o12 + (size_t)row * 1024 + h * 256 + e0); bv[q] = *(const GAS u32x4*)(o12 + (size_t)row * 1024 + h * 256 + 128 + e0); } }
#pragma unroll
        for (int q = 0; q < 8; ++q) { const int row = row0 + q * NGW; if (row < NTOK) { const u32x4 a = av[q], bq = bv[q];
            float v[8] = {bflo(a.x) - lam * bflo(bq.x), bfhi(a.x) - lam * bfhi(bq.x), bflo(a.y) - lam * bflo(bq.y), bfhi(a.y) - lam * bfhi(bq.y), bflo(a.z) - lam * bflo(bq.z), bfhi(a.z) - lam * bfhi(bq.z), bflo(a.w) - lam * bflo(bq.w), bfhi(a.w) - lam * bfhi(bq.w)};
            float ss = 0.f;
#pragma unroll
            for (int i = 0; i < 8; ++i) ss += v[i] * v[i];
            ss += xor_shfl<1>(ss); ss += xor_shfl<2>(ss); ss += xor_shfl<4>(ss); ss += xor_shfl<8>(ss);
            const float rinv = rsqrtf(ss * (1.f / 128.f) + EPS) * post;
            const u32x4 o = {pk2(v[0] * rinv * gs0.x, v[1] * rinv * gs0.y), pk2(v[2] * rinv * gs0.z, v[3] * rinv * gs0.w), pk2(v[4] * rinv * gs1.x, v[5] * rinv * gs1.y), pk2(v[6] * rinv * gs1.z, v[7] * rinv * gs1.w)};
            *(GAS u32x4*)(hc + (size_t)row * 512 + h * 128 + e0) = o; } }
    }
}
constexpr int RT_RSTD = 0, RT_HT = 1024, RT_WT = RT_HT + 128 * 68 * 4, RT_LOG = RT_WT + 128 * 40 * 4, RT_HIST = RT_LOG + 64 * 37 * 4, RT_BASE = RT_HIST + 128, RT_SEL = RT_BASE + 128, RT_G2S = RT_SEL + 64 * 4 * 4, RT_END = RT_G2S + 4096, RT_RED = RT_HT;
static_assert(RT_END <= RING_BYTES && 2 * 64 * 65 * 4 <= RT_LOG - RT_HT && 3 * 64 * 272 <= RT_LOG - RT_HT, "routing LDS map");
#ifndef P9PARTS
#define P9PARTS 15
#endif
__device__ __forceinline__ void phase9(const Args& A, const Ctx& C, int layer, bool dummy = false  ) {
    const int parts = dummy ? (P9PARTS) : 15;
    const size_t doff = dummy ? (476 * MiB) : 0;
    if (parts & 1) moe_weight_items(A, C, layer);
    __syncthreads();
    LAS float* RSTD = (LAS float*)(C.lds + RT_RSTD); LAS float* HT = (LAS float*)(C.lds + RT_HT); LAS float* WT = (LAS float*)(C.lds + RT_WT); LAS float* LOG = (LAS float*)(C.lds + RT_LOG); LAS float* RED = (LAS float*)(C.lds + RT_RED);
    LAS int* HIST = (LAS int*)(C.lds + RT_HIST); LAS int* BASE = (LAS int*)(C.lds + RT_BASE); LAS int* SEL = (LAS int*)(C.lds + RT_SEL);
    const float* g2 = A.in[15] + layer * 1024; const float* wg = A.in[16] + layer * 4096; const float* bg = A.in[17] + layer * 4; const float* wr = A.in[18] + layer * 32768; const float* br = A.in[19] + layer * 32;
    bf16* h2 = wsp<bf16>(C, dummy ? 128 * MiB : WS_H2); const bf16* xb1 = wsp<bf16>(C, WS_XB1); const int lane = C.lane, tid = C.tid, wv = C.wave;
    for (int item = C.vcu; item < NTOK / 64; item += C.G) {
        const int row0 = item * 64;
        if (tid < 32) HIST[tid] = 0;
        __syncthreads();
        if (parts & 4) {
            const int rb = wv & 1, cb = (wv >> 1) & 1, kh = wv >> 2, r32 = lane & 31, hh = lane >> 5;
            LAS unsigned char* XS_ = C.lds + RT_HT; LAS unsigned char* WH = XS_ + 64 * 272; LAS unsigned char* WL = WH + 64 * 272;
            const bf16* wrt = wsp<bf16>(C, WS_WRT);
            u32x4 xr[2], whr[2], wlr[2];
#define RT_LD(kc_) do { _Pragma("unroll") for (int i_ = 0; i_ < 2; ++i_) { const int idx = tid + NTHR * i_, t = idx >> 4, ch = idx & 15; \
                xr[i_] = *(const GAS u32x4*)(xb1 + (size_t)(row0 + t) * DM + (kc_) * 128 + ch * 8); whr[i_] = *(const GAS u32x4*)(wrt + (size_t)t * DM + (kc_) * 128 + ch * 8); wlr[i_] = *(const GAS u32x4*)(wrt + 65536 + (size_t)t * DM + (kc_) * 128 + ch * 8); } } while (0)
            RT_LD(0);
            f32x16 acc = {}; float ssq[2] = {0.f, 0.f};
            for (int kc = 0; kc < 8; ++kc) {
#pragma unroll
                for (int i_ = 0; i_ < 2; ++i_) { const int idx = tid + NTHR * i_, t = idx >> 4, ch = idx & 15; const u32x4 xv = xr[i_];
                    ssq[i_] += (bflo(xv.x) * bflo(xv.x) + bfhi(xv.x) * bfhi(xv.x)) + (bflo(xv.y) * bflo(xv.y) + bfhi(xv.y) * bfhi(xv.y)) + (bflo(xv.z) * bflo(xv.z) + bfhi(xv.z) * bfhi(xv.z)) + (bflo(xv.w) * bflo(xv.w) + bfhi(xv.w) * bfhi(xv.w));
                    *(LAS u32x4*)(XS_ + t * 272 + ch * 16) = xv; *(LAS u32x4*)(WH + t * 272 + ch * 16) = whr[i_]; *(LAS u32x4*)(WL + t * 272 + ch * 16) = wlr[i_];
                    if (!dummy) { u32x2 x8v; x8v.x = pk4f8(bflo(xv.x), bfhi(xv.x), bflo(xv.y), bfhi(xv.y)); x8v.y = pk4f8(bflo(xv.z), bfhi(xv.z), bflo(xv.w), bfhi(xv.w));
                        *(GAS u32x2*)(wsp<unsigned char>(C, WS_X8) + (size_t)(row0 + t) * DM + kc * 128 + ch * 8) = x8v; } }
                __syncthreads();
                if (kc < 7) RT_LD(kc + 1);
#pragma unroll
                for (int s = 0; s < 4; ++s) { const int ko = 16 * (kh * 4 + s) + 8 * hh;
                    const bf16x8 ax = *(const LAS bf16x8*)(XS_ + (32 * rb + r32) * 272 + ko * 2);
                    const bf16x8 bhi = *(const LAS bf16x8*)(WH + (32 * cb + r32) * 272 + ko * 2), blo = *(const LAS bf16x8*)(WL + (32 * cb + r32) * 272 + ko * 2);
                    acc = MFMA32(ax, bhi, acc); acc = MFMA32(ax, blo, acc); }
                __syncthreads();
            }
#undef RT_LD
#pragma unroll
            for (int i_ = 0; i_ < 2; ++i_) { float s = ssq[i_]; s += xor_shfl<1>(s); s += xor_shfl<2>(s); s += xor_shfl<4>(s); s += xor_shfl<8>(s);
                if ((lane & 15) == 0) { const int t = (tid >> 4) + 32 * i_; const float rstd = rsqrtf(s * (1.f / DM) + EPS); RSTD[t] = rstd; *(GAS float*)(wsp<float>(C, WS_RSTD) + doff / 4 + row0 + t) = rstd; } }
#pragma unroll
            for (int r_ = 0; r_ < 16; ++r_) RED[(kh * 64 + 32 * rb + crow(r_, hh)) * 65 + 32 * cb + r32] = acc[r_];
        }
        __syncthreads();
        { const int tok = tid & 63, cgr = tid >> 6;
#pragma unroll
            for (int c = 0; c < 4; ++c) { const int col = 4 * cgr + c; LOG[tok * 37 + col] = (RED[tok * 65 + col] + RED[(64 + tok) * 65 + col]) * RSTD[tok] + br[col]; }
            if (cgr < 4) { const int col = 32 + cgr; LOG[tok * 37 + col] = (RED[tok * 65 + col] + RED[(64 + tok) * 65 + col]) * RSTD[tok] + bg[cgr]; } }
        __syncthreads();
        if (tid < 64 && (parts & 8)) { const LAS float* lg = LOG + tid * 37;
            int gi = 0; float gmx = lg[32];
#pragma unroll
            for (int q = 1; q < 4; ++q) if (lg[32 + q] > gmx) { gmx = lg[32 + q]; gi = q; }
            float gsum = 0.f;
#pragma unroll
            for (int q = 0; q < 4; ++q) gsum += __expf(lg[32 + q] - gmx);
            const float pg = 1.f / gsum;
            const LAS float* el = lg + gi * 8; int i0 = 0; float e0 = el[0];
#pragma unroll
            for (int q = 1; q < 8; ++q) if (el[q] > e0) { e0 = el[q]; i0 = q; }
            int i1 = -1; float e1 = -INFINITY;
#pragma unroll
            for (int q = 0; q < 8; ++q) if (q != i0 && el[q] > e1) { e1 = el[q]; i1 = q; }
            const float x1 = __expf(e1 - e0), w0 = pg / (1.f + x1), w1 = pg * x1 / (1.f + x1);
            const int ea = gi * 8 + i0, eb = gi * 8 + i1;
            const int ra = atomicAdd((int*)(HIST + ea), 1), rb = atomicAdd((int*)(HIST + eb), 1);
            SEL[tid * 4 + 0] = ea; SEL[tid * 4 + 1] = eb; SEL[tid * 4 + 2] = ra; SEL[tid * 4 + 3] = rb;
            wsp<float>(C, WS_TOKW + doff)[(size_t)(row0 + tid) * 2] = w0; wsp<float>(C, WS_TOKW + doff)[(size_t)(row0 + tid) * 2 + 1] = w1; }
        __syncthreads();
        if (tid < 32) wsp<int>(C, WS_HISTG + doff)[item * 32 + tid] = HIST[tid];
        if (tid < 64) { wsp<int>(C, WS_TOKE + doff)[(size_t)(row0 + tid) * 2] = SEL[tid * 4]; wsp<int>(C, WS_TOKE + doff)[(size_t)(row0 + tid) * 2 + 1] = SEL[tid * 4 + 1];
            wsp<int>(C, WS_TOKR + doff)[(size_t)(row0 + tid) * 2] = SEL[tid * 4 + 2]; wsp<int>(C, WS_TOKR + doff)[(size_t)(row0 + tid) * 2 + 1] = SEL[tid * 4 + 3]; }
        __syncthreads();
    }
}
constexpr int P10_H = 0, P10_SEG = 65536, P10_BASE = P10_SEG + 16 * 32 * 4, P10_TOT = P10_BASE + 16 * 32 * 4;
__device__ __forceinline__ void phase10(const Ctx& C, int layer) {
    LAS int* H = (LAS int*)(C.lds + P10_H); LAS int* SEG = (LAS int*)(C.lds + P10_SEG); LAS int* SBASE = (LAS int*)(C.lds + P10_BASE); LAS int* TOT = (LAS int*)(C.lds + P10_TOT);
    LAS int* OFFS = (LAS int*)(C.lds + OFFS_OFF);
    { const int* hg = wsp<int>(C, WS_HISTG);
        { u32x4 hv[8];
#pragma unroll
            for (int q = 0; q < 8; ++q) hv[q] = *(const GAS u32x4*)(hg + 4 * (C.tid + NTHR * q));
#pragma unroll
            for (int q = 0; q < 8; ++q) *(LAS u32x4*)(H + 4 * (C.tid + NTHR * q)) = hv[q]; }
        __syncthreads();
        const int e = C.tid & 31, sg = C.tid >> 5; int s = 0;
        for (int i = 0; i < 32; ++i) s += H[(sg * 32 + i) * 32 + e];
        SEG[sg * 32 + e] = s;
        __syncthreads();
        if (C.tid < 32) { int run = 0; for (int q = 0; q < 16; ++q) { SBASE[q * 32 + C.tid] = run; run += SEG[q * 32 + C.tid]; } TOT[C.tid] = run; }
        __syncthreads();
        int run = SBASE[sg * 32 + e];
        for (int i = 0; i < 32; ++i) { const int v = H[(sg * 32 + i) * 32 + e]; H[(sg * 32 + i) * 32 + e] = run; run += v; }
        if (C.tid == 0) { int o = 0; for (int q = 0; q < 32; ++q) { OFFS[q] = o; o += (TOT[q] + 255) & ~255; } OFFS[32] = o; }
        __syncthreads(); }
    if (blockIdx.x == 0) { int* texp = wsp<int>(C, WS_TEXP); const int RT = OFFS[32] >> 8;
        for (int rt = C.tid; rt < RT; rt += NTHR) { int e = 0;
            for (int q = 1; q < 32; ++q) if (rt * 256 >= OFFS[q]) e = q;
            texp[rt] = e; }
        if (C.tid == 0) texp[511] = RT; }
    { const GAS int* toke = (const GAS int*)wsp<int>(C, WS_TOKE); const GAS int* tokr = (const GAS int*)wsp<int>(C, WS_TOKR); GAS int* tokp = (GAS int*)wsp<int>(C, WS_TOKP); GAS int* toks = (GAS int*)wsp<int>(C, WS_TOKS);
        for (int s = C.vcu * NTHR + C.tid; s < NTOK * 2; s += C.G * NTHR) { const int e = toke[s]; const int ipos = OFFS[e] + H[(s >> 7) * 32 + e] + tokr[s]; tokp[s] = ipos; toks[ipos] = s >> 1; } }
}
constexpr int PH_PER_LAYER = 13, N_PHASES = 2 * PH_PER_LAYER + 1;
#ifndef MK_ONE_LAUNCH
#define MK_ONE_LAUNCH 1
#endif
#ifndef E2_ALIGN
#define E2_ALIGN false
#define E2_SP2 true
#endif
__global__ void __launch_bounds__(NTHR, 2) fwd(Args A) {
    extern __shared__ __attribute__((aligned(16))) unsigned char lds_raw[];
    Ctx C_;
    C_.lds = (LAS unsigned char*)lds_raw; C_.MISC = (volatile LAS unsigned*)(C_.lds + MISC_OFF);
    C_.tid = threadIdx.x; C_.lane = C_.tid & 63; C_.wave = __builtin_amdgcn_readfirstlane(C_.tid >> 6);
    C_.G = gridDim.x; { const int bx = blockIdx.x; C_.vcu = (C_.G % 8 == 0) ? (bx % 8) * (C_.G / 8) + bx / 8 : bx; }
    C_.ws = A.ws; C_.ctl = (gu32*)(A.ws + WS_CTL);
    for (int u = C_.tid; u < 128; u += NTHR) ((LAS unsigned*)(C_.lds + MISC_OFF))[u] = 0u;
    __syncthreads();
    const int lo = A.ph_lo, hi = A.ph_hi;
    const bool multi = (hi - lo) > 1;
    XcdBarrier bar; bar.wv = C_.wave; bar.bar = (unsigned*)(C_.ctl + CW_BAR); bar.x = 0; bar.st = nullptr;
    if (multi) bar = xcd_barrier_post((unsigned*)(C_.ctl + CW_BAR), C_.MISC + 8, C_.wave);
#ifndef PHASE_MASK
#define PHASE_MASK 0x1fff
#endif
#define HAS(k) (((PHASE_MASK) >> (k)) & 1)
#ifndef REPMASK
#define REPMASK 0
#endif
#define STAGGER(ticks) do { if ((ticks) > 0 && ((blockIdx.x >> 3) & 1)) { const unsigned long long t0_ = __builtin_amdgcn_s_memrealtime(); while (__builtin_amdgcn_s_memrealtime() - t0_ < (unsigned long long)(ticks)) __builtin_amdgcn_s_sleep(16); } } while (0)
#ifndef STG1
#define STG1 0
#endif
#ifndef STG6
#define STG6 0
#endif
#ifndef STG7
#define STG7 0
#endif
#ifndef STG8
#define STG8 0
#endif
#ifndef STG11
#define STG11 0
#endif
#ifndef STG12
#define STG12 0
#endif
#if defined(MERGE_PROBE)
#define MPM , (rep_ < NREP(7) - 1 ? MERGE_PROBE : 0)
#else
#define MPM
#endif
#ifndef P1_ALIGN
#define P1_ALIGN true
#endif
#ifndef P1_SP2
#define P1_SP2 true
#endif
#ifndef P0PARTS
#define P0PARTS 7
#endif
#ifndef REPCNT
#define REPCNT 2
#endif
#define NREP(k) ((((REPMASK) >> (k)) & 1) && layer == 0 ? REPCNT : 1)
#define IN(k) (lo <= (k) && (k) < hi)
#define SEAM(k) do { if (IN(k) && IN((k) + 1)) xcd_barrier(bar); } while (0)
#define FRESH() Ctx C = C_; C.lane = xb_lane(); C.tid = C_.wave * 64 + C.lane; asm volatile("" : "+s"(C.ws), "+s"(C.ctl), "+s"(C.vcu), "+s"(C.G))
    for (int layer = 0; layer < 3; ++layer) {
        const int pb = layer * PH_PER_LAYER;
        if (HAS(0) && IN(pb + 0)) for (int rep_ = 0; rep_ < NREP(0); ++rep_) { FRESH(); const int pp_ = rep_ == 0 ? 7 : P0PARTS; if (layer == 0) phase0<0>(A, C, pp_); else if (layer == 1) phase0<1>(A, C, pp_); else phase0<2>(A, C, pp_); }
        if (layer == 2) break;
        SEAM(pb + 0);
#ifdef XBAR_PROBE
        if (layer == 0 && IN(pb + 0) && IN(pb + 1)) { for (int q = 0; q < XBAR_PROBE; ++q) xcd_barrier(bar); }
#endif
        if (HAS(1) && IN(pb + 1)) for (int rep_ = 0; rep_ < NREP(1); ++rep_) { FRESH();
            { pg8::Gemm g{wsp<bf16>(C, WS_HB), wsp<bf16>(C, WS_WT1), NTOK, 4608, 1024}; pg8::SkipOrder S; S.base.init(NTOK, 4608, C.G, (int)blockIdx.x); S.skip0 = 6; S.nskip = 2;
              pg8::EpiOut<0> E{proj(C, 0), nullptr, nullptr, PROJ_STRIDE / 2};
              STAGGER(STG1); pg8::gemm_phase<pg8::EpiOut<0>, pg8::SkipOrder, P1_ALIGN, P1_SP2>(C.lds, g, S, E, C.tid); }
            { pg8::Gemm g{(bf16*)A.out + (size_t)NTOK * DM, (bf16*)(C.ws + WS_WAO8 - (size_t)6 * 256 * 1024), NTOK, 512, 512}; pg8::SkipOrder S; S.base.init(NTOK, 512, C.G, (int)blockIdx.x); S.skip0 = 6; S.nskip = -1;
              pg8::EpiOut<3> E{proj(C, 0), nullptr, nullptr, PROJ_STRIDE / 2};
              pg8::gemm_phase<pg8::EpiOut<3>, pg8::SkipOrder, P1_ALIGN, P1_SP2, false, true>(C.lds, g, S, E, C.tid); }
        }
        SEAM(pb + 1);
        if (HAS(2) && IN(pb + 2)) for (int rep_ = 0; rep_ < NREP(2); ++rep_) { FRESH();  for (int g8 = C.vcu; g8 < 256; g8 += C.G) for (int i8 = 0; i8 < 8; ++i8) mlstm_u_item(A, C, layer, g8 >> 4, (g8 & 15) * 8 + i8, i8 == 0, i8 < 7); }
        SEAM(pb + 2);
        if (HAS(3) && IN(pb + 3)) for (int rep_ = 0; rep_ < NREP(3); ++rep_) { FRESH(); mlstm_scan(C); }
        SEAM(pb + 3);
        if (HAS(4) && IN(pb + 4)) for (int rep_ = 0; rep_ < NREP(4); ++rep_) { FRESH();
            gu32* q0 = C.ctl + CW_Q + 64 * (layer * 4 + 0); gu32* q1 = C.ctl + CW_Q + 64 * (layer * 4 + 1); gu32* q2 = C.ctl + CW_Q + 64 * (layer * 4 + 2);
            for (int rc_ = 0; rc_ < NREP(13); ++rc_) {
                if (C.G == 256) { const int xg = C.vcu >> 5, r = C.vcu & 31;
                    for (int rd = 0; rd < 2; ++rd) { const int bvh = xg * 4 + 2 * (r >> 4) + rd, pr = r & 15;
                        attn_unit<128, true, true>(A, C, layer, bvh >> 3, bvh & 7, 31 - pr); attn_unit<128, true, true>(A, C, layer, bvh >> 3, bvh & 7, pr); } }
                else { for (int it = C.vcu; it < 1024; it += C.G) attn_unit<128, true>(A, C, layer, (it & 31) >> 3, it & 7, 31 - (it >> 5)); } }
            for (int rc_ = NREP(15) - 1; rc_ >= 0; --rc_) { gu32* qq = rc_ ? C.ctl + CW_Q + 64 * (17 + 2 * rc_) : q2;
            for (;;) { if (C.tid == 0) C.MISC[0] = __hip_atomic_fetch_add(qq, 1u, RLX_AGENT); __syncthreads(); const int it = (int)C.MISC[0]; __syncthreads(); if (it >= 512) break;
                for (int i4 = 0; i4 < 4; ++i4) mlstm_out_item(A, C, layer, it >> 5, (it & 31) * 4 + i4, i4 == 0, i4 < 3, rc_ ? wsp<bf16>(C, 480 * MiB) : nullptr); } }
            for (int rc_ = NREP(14) - 1; rc_ >= 0; --rc_) { gu32* qq = rc_ ? C.ctl + CW_Q + 64 * (16 + 2 * rc_) : q1;
            for (;;) { if (C.tid == 0) C.MISC[0] = __hip_atomic_fetch_add(qq, 1u, RLX_AGENT); __syncthreads(); const int it = (int)C.MISC[0]; __syncthreads(); if (it >= 1024) break;
                attn_unit<64, false>(A, C, layer, (it & 31) >> 3, it & 7, 31 - (it >> 5), rc_ ? wsp<bf16>(C, 480 * MiB) : nullptr); } }
        }
        SEAM(pb + 4);
        if (HAS(6) && IN(pb + 6)) for (int rep_ = 0; rep_ < NREP(6); ++rep_) { FRESH();
            if (rep_ == 0 && C.G != 256) phase5(A, C, layer);
            pg8::Gemm g{(bf16*)A.out + (size_t)NTOK * DM, wsp<bf16>(C, WS_WT2), NTOK, 3072, 512}; pg8::StaticOrder S; S.init(NTOK, 3072, C.G, (int)blockIdx.x);
            pg8::EpiOut<1> E{wsp<bf16>(C, WS_G0), wsp<bf16>(C, WS_G1), wsp<bf16>(C, WS_G2), 0};
            STAGGER(STG6); pg8::gemm_phase<pg8::EpiOut<1>, pg8::StaticOrder, true, true, false, true>(C.lds, g, S, E, C.tid);
        }
        SEAM(pb + 6);
        if (HAS(7) && IN(pb + 7)) for (int rep_ = 0; rep_ < NREP(7); ++rep_) { FRESH();
            pg8::ChainOrder S; S.base.init(NTOK, 1024, C.G, (int)blockIdx.x);
            pg8::Gemm g{proj(C, PJ_AV), wsp<bf16>(C, WS_PT), NTOK, 1024, 512}; pg8::EpiChain E{wsp<bf16>(C, WS_O12), wsp<bf16>(C, WS_G0)};
            pg8::gemm_phase<pg8::EpiChain, pg8::ChainOrder, true, true>(C.lds, g, S, E, C.tid);
        }
        SEAM(pb + 7);
        if (HAS(8) && IN(pb + 8)) for (int rep_ = 0; rep_ < NREP(8); ++rep_) { FRESH();
            pg8::Gemm g{wsp<bf16>(C, WS_O12), wsp<bf16>(C, WS_WOT), NTOK, 1024, 1024}; pg8::StaticOrder S; S.init(NTOK, 1024, C.G, (int)blockIdx.x);
            pg8::EpiResid E{layer == 0 ? (const void*)A.in[0] : (const void*)A.out, layer > 0, wsp<bf16>(C, WS_XB1)};
            STAGGER(STG8); pg8::gemm_phase<pg8::EpiResid, pg8::StaticOrder, true, true>(C.lds, g, S, E, C.tid);
        }
        SEAM(pb + 8);
        if (HAS(9) && IN(pb + 9)) for (int rep_ = 0; rep_ < NREP(9); ++rep_) { FRESH(); for (int r9 = 1; r9 < NREP(16); ++r9) { phase9(A, C, layer, true); __syncthreads(); } if (NREP(17) >= 2) { moe_weight_items(A, C, layer); __syncthreads(); } phase9(A, C, layer); }
        SEAM(pb + 9);
        if (HAS(10) && IN(pb + 10)) for (int rep_ = 0; rep_ < NREP(10); ++rep_) { FRESH(); phase10(C, layer); }
        SEAM(pb + 10);
        if (HAS(11) && IN(pb + 11)) for (int rep_ = 0; rep_ < NREP(11); ++rep_) { FRESH();
            LAS int* texp = (LAS int*)(C.lds + TEXP_OFF); { const int tv_ = *(const GAS int*)(wsp<int>(C, WS_TEXP) + C.tid); texp[C.tid] = tv_; } __syncthreads(); const int RT = __builtin_amdgcn_readfirstlane(texp[511]);
            LAS int* tokl = (LAS int*)(C.lds + TOKL_OFF);
            { const GAS int* toks = (const GAS int*)wsp<int>(C, WS_TOKS); int tv_[2] = {0, 0};
#pragma unroll
                for (int q_ = 0; q_ < 2; ++q_) { const int idx = C.tid + NTHR * q_, sl = idx >> 8, rt_ = (sl * C.G + C.vcu) >> 1; if (sl < 3 && rt_ < RT) tv_[q_] = toks[rt_ * 256 + (idx & 255)]; }
#pragma unroll
                for (int q_ = 0; q_ < 2; ++q_) { const int idx = C.tid + NTHR * q_; if (idx < 768) tokl[idx] = ((unsigned)tv_[q_] < (unsigned)NTOK) ? tv_[q_] : 0; } }
            __syncthreads();
            pg8::Gemm g{wsp<bf16>(C, WS_X8), wsp<bf16>(C, WS_W1T), NTOK, 32 * 512, 512}; pg8::MoeOrder<1> S{C.G, C.vcu, RT, texp};
            pg8::EpiSiluMul E{wsp<bf16>(C, WS_HE), wsp<float>(C, WS_RSTD), tokl};
            STAGGER(STG11); pg8::gemm_phase<pg8::EpiSiluMul, pg8::MoeOrder<1>, true, true, true, true>(C.lds, g, S, E, C.tid, tokl);
            if (layer == 0 && C.G == 256 && rep_ == 0) { const int n3 = 2 * RT - 512 < 0 ? 0 : (2 * RT - 512 > 128 ? 128 : 2 * RT - 512);
                __syncthreads(); if (C.vcu >= n3) layer_weight_items(A, C, 1, n3, 256 - n3); }
        }
        SEAM(pb + 11);
        if (HAS(12) && IN(pb + 12)) for (int rep_ = 0; rep_ < NREP(12); ++rep_) { FRESH();
            LAS int* texp = (LAS int*)(C.lds + TEXP_OFF); { const int tv_ = *(const GAS int*)(wsp<int>(C, WS_TEXP) + C.tid); texp[C.tid] = tv_; } __syncthreads(); const int RT = __builtin_amdgcn_readfirstlane(texp[511]);
            pg8::Gemm g{wsp<bf16>(C, WS_HE), wsp<bf16>(C, WS_W2T), 73728, 32 * 1024, 128}; pg8::MoeOrder<2> S{C.G, C.vcu, RT, texp};
            pg8::EpiOut<2> E{wsp<bf16>(C, WS_OSL), nullptr, nullptr, 0};
            STAGGER(STG12); pg8::gemm_phase<pg8::EpiOut<2>, pg8::MoeOrder<2>, true, true, false, true>(C.lds, g, S, E, C.tid);
        }
        SEAM(pb + 12);
    }
#undef IN
#undef SEAM
}

extern "C" void kernel_launch(void* const* d_in, const int* in_sizes, int n_in, void* d_out, int out_size, void* d_ws, size_t ws_size, hipStream_t stream) {
    static int grid = 0;
    if (grid == 0) {
        if (n_in != 23 || out_size != NTOK * DM || ws_size < WS_NEED) { fprintf(stderr, "kernel_launch: unexpected shapes (n_in %d out %d ws %zu)\n", n_in, out_size, ws_size); grid = -1; return; }
        int dev = 0, cus = 0, per_cu = 0;
        if (hipGetDevice(&dev) != hipSuccess || hipDeviceGetAttribute(&cus, hipDeviceAttributeMultiprocessorCount, dev) != hipSuccess) { grid = -1; return; }
        if (hipFuncSetAttribute((const void*)fwd, hipFuncAttributeMaxDynamicSharedMemorySize, LDS_BYTES) != hipSuccess) { fprintf(stderr, "kernel_launch: hipFuncSetAttribute failed\n"); grid = -1; return; }
        if (hipOccupancyMaxActiveBlocksPerMultiprocessor(&per_cu, (const void*)fwd, NTHR, LDS_BYTES) != hipSuccess || per_cu < 1) fprintf(stderr, "kernel_launch: occupancy query says %d\n", per_cu);
        (void)hipGetLastError();
        grid = cus;
    }
    if (grid < 0) return;
    (void)hipMemsetAsync((char*)d_ws + WS_CTL, 0, CTL_ZERO_BYTES, stream);
    Args a{};
    for (int i = 0; i < 23; ++i) a.in[i] = (const float*)d_in[i];
    a.out = (float*)d_out; a.ws = (unsigned char*)d_ws;
#if MK_ONE_LAUNCH
    a.ph_lo = 0; a.ph_hi = N_PHASES;
    hipLaunchKernelGGL(fwd, dim3(grid), dim3(NTHR), LDS_BYTES, stream, a);
#else
    for (int p = 0; p < N_PHASES; ++p) { a.ph_lo = p; a.ph_hi = p + 1; hipLaunchKernelGGL(fwd, dim3(grid), dim3(NTHR), LDS_BYTES, stream, a); }
#endif
}
```
